# Optimizing an MI355X kernel written in HIP

```python
import jax
import jax.numpy as jnp
from jax import lax
import numpy as np

D_MODEL = 1024
BATCH = 16
SEQ = 2048
DEPTH = 2

CTX_LEN = 256
GRID_W = 64
EPS = 1e-6
Q_BLOCK = 128

NA_HEADS = 4
NA_DIM = 64
NA_KH = 8
NA_KW = 16
NA_QBW = 16
NA_KBW = 32
MLA_HEADS = 4
MLA_Q_RANK = 256
MLA_KV_RANK = 128
MLA_NOPE = 64
MLA_ROPE = 32
MLA_V = 128
MLA_QK = MLA_NOPE + MLA_ROPE
ROPE_AXIS = MLA_ROPE // 2
ROPE_THETA = 10000.0
GLA_HEADS = 4
GLA_DK = 32
GLA_DV = 64
GLA_GATE_RANK = 16
GLA_GATE_NORM = 16.0
GLA_CHUNK = 64
NA_WIDTH = NA_HEADS * NA_DIM
MLA_WIDTH = MLA_HEADS * MLA_V
GLA_KW = GLA_HEADS * GLA_DK
GLA_WIDTH = GLA_HEADS * GLA_DV
MIX_WIDTH = NA_WIDTH + MLA_WIDTH + GLA_WIDTH
IN_SIZES = (NA_WIDTH, NA_WIDTH, NA_WIDTH, MLA_Q_RANK, MLA_KV_RANK, MLA_ROPE, GLA_KW, GLA_KW, GLA_WIDTH, GLA_WIDTH, GLA_GATE_RANK, GLA_GATE_RANK)
IN_COLS = 3 * NA_WIDTH + MLA_Q_RANK + MLA_KV_RANK + MLA_ROPE + 2 * GLA_KW + 2 * GLA_WIDTH + 2 * GLA_GATE_RANK
N_EXPERTS = 32
TOP_K = 4
D_EXPERT = D_MODEL
SWIGLU_LIMIT = 7.0
SWIGLU_ALPHA = 1.702
MOE_BLOCK = 256

kernel_name = 'hybrid_na_mla_gla_moe_dit'


def rms_norm(x, g):
    xf = x.astype(jnp.float32)
    y = xf * lax.rsqrt(jnp.mean(xf * xf, axis=-1, keepdims=True) + EPS)
    return y.astype(x.dtype) * g


def modulation(cvec, w, b):
    mod = jax.nn.silu(cvec) @ w + b
    return [m[:, None, :] for m in jnp.split(mod, 6, axis=-1)]


def axial_rope_tables(n_tokens):
    t = jnp.arange(n_tokens)
    row = (t // GRID_W).astype(jnp.float32)[:, None]
    col = (t % GRID_W).astype(jnp.float32)[:, None]
    inv = 1.0 / (ROPE_THETA ** (jnp.arange(0, ROPE_AXIS, 2, dtype=jnp.float32) / ROPE_AXIS))
    ang = jnp.concatenate([row * inv, row * inv, col * inv, col * inv], axis=-1)
    return jnp.cos(ang), jnp.sin(ang)


def apply_axial_rope(x, cos, sin):
    xs = x.reshape(x.shape[:-1] + (2, 2, ROPE_AXIS // 2))
    rot = jnp.concatenate([-xs[..., 1:, :], xs[..., :1, :]], axis=-2).reshape(x.shape)
    return x * cos[None, :, None, :].astype(x.dtype) + rot * sin[None, :, None, :].astype(x.dtype)


def block_attention(q, k, v):
    B, T, H, d = q.shape
    qb = min(Q_BLOCK, T)
    q_blocks = jnp.moveaxis(q.reshape(B, T // qb, qb, H, d), 1, 0)
    scale = d ** -0.5

    def attend(q_i):
        s = jnp.einsum('bqhd,bkhd->bhqk', q_i, k).astype(jnp.float32) * scale
        p = jax.nn.softmax(s, axis=-1).astype(v.dtype)
        return jnp.einsum('bhqk,bkhe->bqhe', p, v)

    out = lax.map(attend, q_blocks)
    return jnp.moveaxis(out, 0, 1).reshape(B, T, H, v.shape[-1])


def neighbourhood_attention(q, k, v, k_ctx, v_ctx, rpb):
    B, T, H, d = q.shape
    rows = T // GRID_W
    kh = min(NA_KH, rows)
    n_cb = GRID_W // NA_QBW
    r = np.arange(rows)
    rs = np.clip(r - kh // 2, 0, rows - kh)
    key_rows = rs[:, None] + np.arange(kh)
    cb = np.arange(n_cb) * NA_QBW
    kb = np.clip(cb - NA_KW // 2, 0, GRID_W - NA_KBW)
    key_cols = kb[:, None] + np.arange(NA_KBW)
    q_cols = cb[:, None] + np.arange(NA_QBW)
    cs = np.clip(q_cols - NA_KW // 2, 0, GRID_W - NA_KW)
    in_win = (key_cols[:, None, :] >= cs[:, :, None]) & (key_cols[:, None, :] < cs[:, :, None] + NA_KW)
    dr = key_rows - r[:, None] + NA_KH - 1
    dc = np.clip(key_cols[:, None, :] - q_cols[:, :, None] + NA_KW - 1, 0, 2 * NA_KW - 2)
    key_pos = (key_rows[:, None, :, None] * GRID_W + key_cols[None, :, None, :]).reshape(rows, n_cb, kh * NA_KBW)
    bias = rpb[:, dr[:, None, None, :, None], dc[None, :, :, None, :]]
    bias = jnp.where(in_win[None, None, :, :, None, :], bias.astype(jnp.float32), -jnp.inf)
    bias = jnp.moveaxis(bias.reshape(H, rows, n_cb, NA_QBW, kh * NA_KBW), 1, 0)
    q_blk = jnp.moveaxis(q.reshape(B, rows, n_cb, NA_QBW, H, d), 1, 0)
    n_loc = kh * NA_KBW
    scale = d ** -0.5

    def row_block(args):
        q_r, pos_r, bias_r = args
        k_r = k[:, pos_r]
        v_r = v[:, pos_r]
        s_loc = jnp.einsum('bcqhd,bclhd->bhcql', q_r, k_r).astype(jnp.float32) * scale + bias_r
        s_ctx = jnp.einsum('bcqhd,bmhd->bhcqm', q_r, k_ctx).astype(jnp.float32) * scale
        p = jax.nn.softmax(jnp.concatenate([s_loc, s_ctx], axis=-1), axis=-1).astype(v.dtype)
        return (jnp.einsum('bhcql,bclhe->bcqhe', p[..., :n_loc], v_r)
                + jnp.einsum('bhcqm,bmhe->bcqhe', p[..., n_loc:], v_ctx))

    out = lax.map(row_block, (q_blk, jnp.asarray(key_pos, dtype=jnp.int32), bias))
    return jnp.moveaxis(out, 0, 1).reshape(B, T, H, d)


def gla_chunked(q, k, v, g, s0):
    B, H, T, dk = q.shape
    dv = v.shape[-1]
    n = T // GLA_CHUNK

    def chunks(a):
        return jnp.moveaxis(a.astype(jnp.float32).reshape(B, H, n, GLA_CHUNK, a.shape[-1]), 2, 0)

    lower = jnp.tril(jnp.ones((GLA_CHUNK, GLA_CHUNK), dtype=bool))[:, :, None]

    def step(s, inp):
        q_i, k_i, v_i, g_i = inp
        b = jnp.cumsum(g_i, axis=-2)
        rel = jnp.exp(jnp.where(lower, b[..., :, None, :] - b[..., None, :, :], -jnp.inf))
        attn = jnp.einsum('bhtd,bhtsd,bhsd->bhts', q_i, rel, k_i)
        o = jnp.einsum('bhts,bhse->bhte', attn, v_i) + jnp.einsum('bhtd,bhde->bhte', q_i * jnp.exp(b), s)
        b_end = b[..., -1:, :]
        s = jnp.exp(b_end[..., 0, :])[..., None] * s + jnp.einsum('bhsd,bhse->bhde', k_i * jnp.exp(b_end - b), v_i)
        return s, o

    s, o = lax.scan(step, s0.astype(jnp.float32), (chunks(q), chunks(k), chunks(v), chunks(g)))
    return jnp.moveaxis(o, 0, 2).reshape(B, H, T, dv).astype(v.dtype), s


def gla_final_state(k, v, g):
    b = jnp.cumsum(g.astype(jnp.float32), axis=-2)
    return jnp.einsum('bhsd,bhse->bhde', k.astype(jnp.float32) * jnp.exp(b[..., -1:, :] - b), v.astype(jnp.float32))


def gla_mixer(q, k, v, gf, gb, qc, kc, vc, gfc, gbc, ctx_out):
    def flip(a):
        return jnp.flip(a, axis=2)
    B, H, _, dk = q.shape
    o_ctx = None
    if ctx_out:
        zeros = jnp.zeros((B, H, dk, v.shape[-1]), jnp.float32)
        oc_f, s_f = gla_chunked(qc, kc, vc, gfc, zeros)
        oc_b, s_b = gla_chunked(flip(qc), flip(kc), flip(vc), flip(gbc), zeros)
        o_ctx = oc_f + flip(oc_b)
    else:
        s_f = gla_final_state(kc, vc, gfc)
        s_b = gla_final_state(flip(kc), flip(vc), flip(gbc))
    ox_f, _ = gla_chunked(q, k, v, gf, s_f)
    ox_b, _ = gla_chunked(flip(q), flip(k), flip(v), flip(gb), s_b)
    return ox_f + flip(ox_b), o_ctx


def gla_output(o, gate, o_norm):
    B, H, T, dv = o.shape
    o = rms_norm(o.transpose(0, 2, 1, 3), o_norm).reshape(B, T, H * dv)
    return o * jax.nn.silu(gate)


def project_stream(h, w_in, na_q_norm, na_k_norm, mla_q_a_norm, mla_w_q_b, mla_kv_a_norm,
                   mla_w_kv_b, mla_q_norm, mla_k_norm, gla_w_gate, gla_b_gate, rope):
    B, T, _ = h.shape
    splits = np.cumsum(IN_SIZES)[:-1].tolist()
    (na_q, na_k, na_v, m_cq, m_ckv, m_kr, g_q, g_k, g_v, g_out, g_lf, g_lb) = jnp.split(h @ w_in, splits, axis=-1)

    def heads(a, n):
        return a.reshape(B, T, n, -1)

    def bhtd(a):
        return heads(a, GLA_HEADS).transpose(0, 2, 1, 3)

    na_q = rms_norm(heads(na_q, NA_HEADS), na_q_norm)
    na_k = rms_norm(heads(na_k, NA_HEADS), na_k_norm)
    na_v = heads(na_v, NA_HEADS)
    mq = rms_norm(heads(rms_norm(m_cq, mla_q_a_norm) @ mla_w_q_b, MLA_HEADS), mla_q_norm)
    kv = heads(rms_norm(m_ckv, mla_kv_a_norm) @ mla_w_kv_b, MLA_HEADS)
    k_rope = jnp.broadcast_to(m_kr[:, :, None, :], (B, T, MLA_HEADS, MLA_ROPE))
    mk = rms_norm(jnp.concatenate([kv[..., :MLA_NOPE], k_rope], axis=-1), mla_k_norm)
    mv = kv[..., MLA_NOPE:]
    if rope is not None:
        cos, sin = rope
        mq = jnp.concatenate([mq[..., :MLA_NOPE], apply_axial_rope(mq[..., MLA_NOPE:], cos, sin)], axis=-1)
        mk = jnp.concatenate([mk[..., :MLA_NOPE], apply_axial_rope(mk[..., MLA_NOPE:], cos, sin)], axis=-1)
    gq = bhtd(g_q) * (GLA_DK ** -0.5)
    gk = bhtd(g_k)
    gv = bhtd(g_v)
    gf = bhtd(jax.nn.log_sigmoid(g_lf @ gla_w_gate[0] + gla_b_gate[0])) / GLA_GATE_NORM
    gb = bhtd(jax.nn.log_sigmoid(g_lb @ gla_w_gate[1] + gla_b_gate[1])) / GLA_GATE_NORM
    return na_q, na_k, na_v, mq, mk, mv, gq, gk, gv, gf, gb, g_out


def moe_ffn(h, w_router, b_router, w1, b1, w2, b2):
    shp = h.shape
    xt = h.reshape(-1, shp[-1])
    N, D = xt.shape
    NK = N * TOP_K
    logits = (xt @ w_router + b_router).astype(jnp.float32)
    top_val, top_idx = lax.top_k(logits, TOP_K)
    gates = jax.nn.softmax(top_val, axis=-1)
    flat_e = top_idx.reshape(-1)
    flat_tok = jnp.repeat(jnp.arange(N, dtype=jnp.int32), TOP_K)
    order = jnp.argsort(flat_e)
    e_sorted = flat_e[order]
    counts = jnp.bincount(flat_e, length=N_EXPERTS)
    padded = (counts + MOE_BLOCK - 1) // MOE_BLOCK * MOE_BLOCK
    start = jnp.cumsum(counts) - counts
    pend = jnp.cumsum(padded)
    pstart = pend - padded
    dest_sorted = pstart[e_sorted] + jnp.arange(NK, dtype=jnp.int32) - start[e_sorted]
    dest = jnp.zeros_like(dest_sorted).at[order].set(dest_sorted)
    cap = -(-NK // MOE_BLOCK) * MOE_BLOCK + N_EXPERTS * MOE_BLOCK
    n_blk = cap // MOE_BLOCK
    row_tok = jnp.full((cap,), N, jnp.int32).at[dest].set(flat_tok)
    buf = xt.at[row_tok].get(mode='fill', fill_value=0)
    blk_e = jnp.minimum(jnp.searchsorted(pend, jnp.arange(n_blk, dtype=pend.dtype) * MOE_BLOCK, side='right'), N_EXPERTS - 1)

    def expert_block(args):
        xb, e = args
        hb = xb @ w1[e] + b1[e]
        glu = jnp.minimum(hb[:, :D_EXPERT], SWIGLU_LIMIT)
        lin = jnp.clip(hb[:, D_EXPERT:], -SWIGLU_LIMIT, SWIGLU_LIMIT)
        return ((lin + 1) * (glu * jax.nn.sigmoid(SWIGLU_ALPHA * glu))) @ w2[e] + b2[e]

    y_buf = lax.map(expert_block, (buf.reshape(n_blk, MOE_BLOCK, D), blk_e)).reshape(cap, D)
    y = y_buf[dest].reshape(N, TOP_K, D)
    return jnp.einsum('nk,nkd->nd', gates.astype(y.dtype), y).reshape(shp)


def setup_inputs(seed: int = 0) -> dict:
    key = jax.random.key(seed)
    ks = iter(jax.random.split(key, 32))

    def nrm(shape, scale):
        return jax.random.normal(next(ks), shape, jnp.float32) * scale

    def gain(shape):
        return 1.0 + nrm(shape, 0.05)

    L, D, E, F = DEPTH, D_MODEL, N_EXPERTS, D_EXPERT
    return {
        'x': nrm((BATCH, SEQ, D), 1.0),
        'c': nrm((BATCH, D), 1.0),
        'ctx': nrm((BATCH, CTX_LEN, D), 1.0),
        'c_ctx': nrm((D,), 1.0),
        'w_ada': nrm((L, D, 6 * D), 0.5 * D ** -0.5),
        'b_ada': nrm((L, 6 * D), 0.02),
        'g_mix': gain((L, D)),
        'w_in': nrm((L, D, IN_COLS), D ** -0.5),
        'na_q_norm': gain((L, NA_DIM)),
        'na_k_norm': gain((L, NA_DIM)),
        'na_rpb': nrm((L, NA_HEADS, 2 * NA_KH - 1, 2 * NA_KW - 1), 0.2),
        'mla_q_a_norm': gain((L, MLA_Q_RANK)),
        'mla_w_q_b': nrm((L, MLA_Q_RANK, MLA_HEADS * MLA_QK), MLA_Q_RANK ** -0.5),
        'mla_kv_a_norm': gain((L, MLA_KV_RANK)),
        'mla_w_kv_b': nrm((L, MLA_KV_RANK, MLA_HEADS * (MLA_NOPE + MLA_V)), MLA_KV_RANK ** -0.5),
        'mla_q_norm': gain((L, MLA_QK)),
        'mla_k_norm': gain((L, MLA_QK)),
        'gla_w_gate': nrm((L, 2, GLA_GATE_RANK, GLA_KW), GLA_GATE_RANK ** -0.5),
        'gla_b_gate': nrm((L, 2, GLA_KW), 0.1),
        'gla_o_norm': gain((L, GLA_DV)),
        'w_out': nrm((L, MIX_WIDTH, D), MIX_WIDTH ** -0.5),
        'g_ffn': gain((L, D)),
        'w_router': nrm((L, D, E), D ** -0.5),
        'b_router': nrm((L, E), 0.01),
        'w_moe1': nrm((L, E, D, 2 * F), D ** -0.5),
        'b_moe1': nrm((L, E, 2 * F), 0.01),
        'w_moe2': nrm((L, E, F, D), F ** -0.5),
        'b_moe2': nrm((L, E, D), 0.01),
    }


def reference(x, c, ctx, c_ctx, w_ada, b_ada, g_mix, w_in, na_q_norm, na_k_norm, na_rpb,
              mla_q_a_norm, mla_w_q_b, mla_kv_a_norm, mla_w_kv_b, mla_q_norm, mla_k_norm,
              gla_w_gate, gla_b_gate, gla_o_norm, w_out, g_ffn, w_router, b_router,
              w_moe1, b_moe1, w_moe2, b_moe2):
    B, T, _ = x.shape
    rope = axial_rope_tables(T)
    h_ctx = ctx
    for l in range(DEPTH):
        ctx_out = l < DEPTH - 1
        sh1, sc1, gt1, sh2, sc2, gt2 = modulation(c, w_ada[l], b_ada[l])
        csh1, csc1, cgt1, csh2, csc2, cgt2 = modulation(c_ctx[None, :], w_ada[l], b_ada[l])
        stream_w = (w_in[l], na_q_norm[l], na_k_norm[l], mla_q_a_norm[l], mla_w_q_b[l], mla_kv_a_norm[l],
                    mla_w_kv_b[l], mla_q_norm[l], mla_k_norm[l], gla_w_gate[l], gla_b_gate[l])
        moe_w = (w_router[l], b_router[l], w_moe1[l], b_moe1[l], w_moe2[l], b_moe2[l])
        (na_q, na_k, na_v, mq, mk, mv, gq, gk, gv, gf, gb, g_out) = project_stream(
            rms_norm(x, g_mix[l]) * (1 + sc1) + sh1, *stream_w, rope=rope)
        (cna_q, cna_k, cna_v, cmq, cmk, cmv, cgq, cgk, cgv, cgf, cgb, cg_out) = project_stream(
            rms_norm(h_ctx, g_mix[l]) * (1 + csc1) + csh1, *stream_w, rope=None)

        a_x = neighbourhood_attention(na_q, na_k, na_v, cna_k, cna_v, na_rpb[l])
        b_x = block_attention(mq, jnp.concatenate([mk, cmk], axis=1), jnp.concatenate([mv, cmv], axis=1))
        gla_x, gla_c = gla_mixer(gq, gk, gv, gf, gb, cgq, cgk, cgv, cgf, cgb, ctx_out)
        c_x = gla_output(gla_x, g_out, gla_o_norm[l])
        mix_x = jnp.concatenate([a_x.reshape(B, T, NA_WIDTH), b_x.reshape(B, T, MLA_WIDTH), c_x], axis=-1) @ w_out[l]
        x_new = x + gt1 * mix_x
        x_new = x_new + gt2 * moe_ffn(rms_norm(x_new, g_ffn[l]) * (1 + sc2) + sh2, *moe_w)

        if ctx_out:
            Tc = h_ctx.shape[1]
            a_c = block_attention(cna_q, cna_k, cna_v)
            b_c = block_attention(cmq, cmk, cmv)
            c_c = gla_output(gla_c, cg_out, gla_o_norm[l])
            mix_c = jnp.concatenate([a_c.reshape(B, Tc, NA_WIDTH), b_c.reshape(B, Tc, MLA_WIDTH), c_c], axis=-1) @ w_out[l]
            h_ctx = h_ctx + cgt1 * mix_c
            h_ctx = h_ctx + cgt2 * moe_ffn(rms_norm(h_ctx, g_ffn[l]) * (1 + csc2) + csh2, *moe_w)
        x = x_new
    return x
```

```cpp
#include <hip/hip_runtime.h>
#include <cstdio>
#include <cstdint>

#define GAS __attribute__((address_space(1)))
#define LAS __attribute__((address_space(3)))
typedef unsigned short bf16;
typedef short bf16x8 __attribute__((ext_vector_type(8)));
typedef short bf16x4 __attribute__((ext_vector_type(4)));
typedef float f32x4 __attribute__((ext_vector_type(4)));
typedef unsigned u32x4 __attribute__((ext_vector_type(4)));
typedef unsigned u32x2 __attribute__((ext_vector_type(2)));

#ifndef REP_MASK
#define REP_MASK 0
#endif
#define NREP(i) (((REP_MASK >> (i)) & 1) ? 2 : 1)
#ifndef MK_N_LAUNCHES
#define MK_N_LAUNCHES 1
#endif

namespace pg8 {
constexpr int BM = 256, BK = 64, HALF = 128, HTB = HALF * BK * 2, STAGE_BYTES = 8 * HTB;
__host__ __device__ __forceinline__ int lds_byte(int r, int c) { const int st = (r >> 4) * 2 + (c >> 5), rr = r & 15, cc = c & 31, ob = rr * 64 + cc * 2; return st * 1024 + (ob ^ (((ob >> 9) & 1) << 5)); }
__host__ __device__ __forceinline__ void stage_rc(int b, int& R, int& C) { const int st = b / 1024, sb = b % 1024, swz = sb ^ (((sb >> 9) & 1) << 5); R = (st >> 1) * 16 + swz / 64; C = (st & 1) * 32 + (swz % 64) / 2; }
__host__ __device__ __forceinline__ int perm32(int rho) { const int n = rho >> 4, i = rho & 15; return 8 * (i >> 2) + 4 * n + (i & 3); }

struct Unit { int pm, pn, pb, pa; };
struct Gemm { const bf16* A; const bf16* Bt; const int* rowmap; };

__device__ __forceinline__ unsigned cvt_pk_bf16(float lo, float hi) { unsigned r; asm volatile("v_cvt_pk_bf16_f32 %0, %1, %2" : "=v"(r) : "v"(lo), "v"(hi)); return r; }

typedef int i32x4v __attribute__((ext_vector_type(4)));
typedef int i32x8v __attribute__((ext_vector_type(8)));
template <class Epi, class Sched, int K, int LDA, bool ALIGN_EPI, bool SP2, bool FP8 = false, bool GATHER = false>
__device__ __forceinline__ void gemm_phase(LAS unsigned char* lds, const Gemm g, const Sched& S, const Epi& E, const int tid) {
    const int wid = __builtin_amdgcn_readfirstlane(tid >> 6), lane = tid & 63, wr = wid >> 2, wc = wid & 3, fr = lane & 15, fq = lane >> 4;
    constexpr int nt = K / BK;
    unsigned voffA[2], voffB[2]; int rA[2]; unsigned cA2[2];
#pragma unroll
    for (int i = 0; i < 2; ++i) { int R, C; stage_rc(tid * 16 + i * 8192, R, C); const int Rb = Epi::PERM ? ((R & ~31) + perm32(R & 31)) : R;
        voffA[i] = (unsigned)(R * LDA + C) * 2u; voffB[i] = (unsigned)(Rb * K + C) * 2u; rA[i] = R; cA2[i] = (unsigned)C * 2u; }
    constexpr size_t kstep = (size_t)(BK * 2);
    constexpr size_t hA = GATHER ? 0 : (size_t)HALF * LDA * 2, hB = (size_t)HALF * K * 2;
    constexpr size_t tA = 2 * hA, tB = 2 * hB;
    unsigned gC[2][2], gN[2][2];
#define PG8_GLOAD(dst, unit) do { if constexpr (GATHER) { _Pragma("unroll") for (int _h = 0; _h < 2; ++_h) _Pragma("unroll") for (int _i = 0; _i < 2; ++_i) \
        dst[_h][_i] = (unsigned)g.rowmap[(unit).pa * 256 + _h * 128 + rA[_i]] * (unsigned)(LDA * 2) + cA2[_i]; } } while (0)
#define PG8_STAGE_A(b, h, ptr, nx) do { if constexpr (GATHER) { _Pragma("unroll") for (int _i = 0; _i < 2; ++_i) \
        __builtin_amdgcn_global_load_lds((const unsigned*)((const char*)(ptr) + ((nx) ? gN[h][_i] : gC[h][_i])), (LAS unsigned*)(lds + PG8_SA(b, h) + ldsw + _i * 8192), 16, 0, 0); } \
        else PG8_STAGE(PG8_SA(b, h), (ptr) + (h) * hA, voffA); } while (0)
    const unsigned ldsw = (unsigned)wid * 1024u;
    const int aoff = FP8 ? lds_byte(wr * 64 + fr, (fq & 1) * 16) + (fq >> 1) * 1024 : lds_byte(wr * 64 + fr, fq * 8);
    const int boff = FP8 ? lds_byte(wc * 32 + fr, (fq & 1) * 16) + (fq >> 1) * 1024 : lds_byte(wc * 32 + fr, fq * 8);
#define PG8_SA(b, h) (((b) * 2 + (h)) * HTB)
#define PG8_SB(b, h) ((4 + (b) * 2 + (h)) * HTB)
#define PG8_STAGE(bufoff, gbase, voff) do { _Pragma("unroll") for (int _i = 0; _i < 2; ++_i) \
        __builtin_amdgcn_global_load_lds((const unsigned*)((const char*)(gbase) + (voff)[_i]), (LAS unsigned*)(lds + (bufoff) + ldsw + _i * 8192), 16, 0, 0); } while (0)
#define PG8_LDA(dst, b, h) do { _Pragma("unroll") for (int m = 0; m < 4; ++m) { if constexpr (FP8) { const i32x4v lo_ = *(const LAS i32x4v*)(lds + PG8_SA(b, h) + aoff + m * 2048), hi_ = *(const LAS i32x4v*)(lds + PG8_SA(b, h) + aoff + m * 2048 + 16); dst[m] = __builtin_shufflevector(lo_, hi_, 0, 1, 2, 3, 4, 5, 6, 7); } \
        else { dst[m].lo = *(const LAS i32x4v*)(lds + PG8_SA(b, h) + aoff + m * 2048); dst[m].hi = *(const LAS i32x4v*)(lds + PG8_SA(b, h) + aoff + m * 2048 + 1024); } } } while (0)
#define PG8_LDB(dst, b, h) do { _Pragma("unroll") for (int n = 0; n < 2; ++n) { if constexpr (FP8) { const i32x4v lo_ = *(const LAS i32x4v*)(lds + PG8_SB(b, h) + boff + n * 2048), hi_ = *(const LAS i32x4v*)(lds + PG8_SB(b, h) + boff + n * 2048 + 16); dst[n] = __builtin_shufflevector(lo_, hi_, 0, 1, 2, 3, 4, 5, 6, 7); } \
        else { dst[n].lo = *(const LAS i32x4v*)(lds + PG8_SB(b, h) + boff + n * 2048); dst[n].hi = *(const LAS i32x4v*)(lds + PG8_SB(b, h) + boff + n * 2048 + 1024); } } } while (0)
#define PG8_MMA(ai, bj, At, Bt) do { __builtin_amdgcn_s_setprio(1); _Pragma("unroll") for (int m = 0; m < 4; ++m) _Pragma("unroll") for (int n = 0; n < 2; ++n) { \
        if constexpr (FP8) asm volatile("v_mfma_scale_f32_16x16x128_f8f6f4 %0, %1, %2, %0, %3, %3 op_sel_hi:[0,0,0]" : "+v"(acc[ai][bj][m][n]) : "v"(Bt[n]), "v"(At[m]), "v"(sc8)); \
        else { const i32x4v bl_ = __builtin_shufflevector(Bt[n], Bt[n], 0, 1, 2, 3), bh_ = __builtin_shufflevector(Bt[n], Bt[n], 4, 5, 6, 7), al_ = __builtin_shufflevector(At[m], At[m], 0, 1, 2, 3), ah_ = __builtin_shufflevector(At[m], At[m], 4, 5, 6, 7); \
               acc[ai][bj][m][n] = __builtin_amdgcn_mfma_f32_16x16x32_bf16(__builtin_bit_cast(bf16x8, bl_), __builtin_bit_cast(bf16x8, al_), acc[ai][bj][m][n], 0, 0, 0);   \
               acc[ai][bj][m][n] = __builtin_amdgcn_mfma_f32_16x16x32_bf16(__builtin_bit_cast(bf16x8, bh_), __builtin_bit_cast(bf16x8, ah_), acc[ai][bj][m][n], 0, 0, 0); } } \
        __builtin_amdgcn_s_setprio(0); } while (0)
#define PG8_WAIT_V(n) asm volatile("s_waitcnt vmcnt(" #n ")" ::: "memory")
#define PG8_WAIT_L(n) asm volatile("s_waitcnt lgkmcnt(" #n ")" ::: "memory")
#define PG8_BAR __builtin_amdgcn_s_barrier()
#define PG8_SCHED __builtin_amdgcn_sched_barrier(0)
    int sc8 = 0x7f7f7f7f; asm volatile("" : "+v"(sc8));
    Unit cur, nxt; int ui = 0;
    if (!S.next(0, cur)) return;
    f32x4 acc[2][2][4][2];
#pragma unroll
    for (int a = 0; a < 2; ++a)
#pragma unroll
        for (int b = 0; b < 2; ++b)
#pragma unroll
            for (int m = 0; m < 4; ++m)
#pragma unroll
                for (int n = 0; n < 2; ++n) acc[a][b][m][n] = (f32x4){0.f, 0.f, 0.f, 0.f};
    i32x8v At[4], B0[2], B1[2];
    const char* cA = (const char*)g.A + (size_t)cur.pa * tA; const char* cB = (const char*)g.Bt + (size_t)cur.pb * tB;
    typename Epi::Pre pre = E.prefetch(cur, wc, fq);
    PG8_GLOAD(gC, cur);
#pragma unroll
    for (int _h = 0; _h < 2; ++_h)
#pragma unroll
        for (int _i = 0; _i < 2; ++_i) gN[_h][_i] = gC[_h][_i];
    if constexpr (SP2) {
        PG8_STAGE(PG8_SB(0, 0), cB, voffB); PG8_STAGE(PG8_SB(0, 1), cB + hB, voffB); PG8_STAGE_A(0, 0, cA, false); PG8_STAGE_A(0, 1, cA, false);
        if (wr == 1) PG8_BAR;
        PG8_WAIT_V(2); PG8_BAR;
        PG8_STAGE(PG8_SB(1, 0), cB + kstep, voffB); PG8_STAGE_A(1, 0, cA + kstep, false); PG8_STAGE(PG8_SB(1, 1), cB + hB + kstep, voffB);
        PG8_WAIT_V(6); PG8_BAR;
    } else {
        static_assert(!GATHER, "the gathered A operand is wired into the SP2 loop only");
        PG8_STAGE(PG8_SB(0, 0), cB, voffB); PG8_STAGE(PG8_SA(0, 0), cA, voffA); PG8_STAGE(PG8_SB(0, 1), cB + hB, voffB); PG8_STAGE(PG8_SA(0, 1), cA + hA, voffA);
        if (wr == 1) PG8_BAR;
        PG8_WAIT_V(4); PG8_BAR;
        PG8_STAGE(PG8_SB(1, 0), cB + kstep, voffB); PG8_STAGE(PG8_SA(1, 0), cA + kstep, voffA); PG8_STAGE(PG8_SB(1, 1), cB + hB + kstep, voffB);
        PG8_WAIT_V(6); PG8_BAR;
    }
    for (;;) {
        const bool has_next = S.next(ui + 1, nxt);
        const char* nA = has_next ? (const char*)g.A + (size_t)nxt.pa * tA : cA; const char* nB = has_next ? (const char*)g.Bt + (size_t)nxt.pb * tB : cB;
        if (has_next) PG8_GLOAD(gN, nxt);
#pragma nounroll
        for (int t = 0; t < nt; t += 2) {
            const bool last = (t == nt - 2);
            const char* a1 = cA + (size_t)(t + 1) * kstep;
            const char* a2 = last ? nA : cA + (size_t)(t + 2) * kstep; const char* b2 = last ? nB : cB + (size_t)(t + 2) * kstep;
            const char* a3 = a2 + kstep; const char* b3 = b2 + kstep;
            if constexpr (SP2) {
            PG8_LDB(B0, 0, 0); PG8_LDB(B1, 0, 1); PG8_SCHED; PG8_LDA(At, 0, 0); PG8_STAGE_A(1, 1, a1, false);
            PG8_WAIT_V(8); PG8_WAIT_L(0); PG8_BAR; PG8_MMA(0, 0, At, B0); PG8_MMA(0, 1, At, B1); PG8_BAR; PG8_SCHED;
            PG8_LDA(At, 0, 1); PG8_STAGE(PG8_SB(0, 0), b2, voffB); PG8_STAGE(PG8_SB(0, 1), b2 + hB, voffB); PG8_STAGE_A(0, 0, a2, last);
            PG8_WAIT_V(8); PG8_WAIT_L(0); PG8_BAR; PG8_MMA(1, 0, At, B0); PG8_MMA(1, 1, At, B1); PG8_BAR; PG8_SCHED;
            PG8_LDB(B0, 1, 0); PG8_LDB(B1, 1, 1); PG8_SCHED; PG8_LDA(At, 1, 0); PG8_STAGE_A(0, 1, a2, last);
            PG8_WAIT_V(8); PG8_WAIT_L(0); PG8_BAR; PG8_MMA(0, 0, At, B0); PG8_MMA(0, 1, At, B1); PG8_BAR; PG8_SCHED;
            PG8_LDA(At, 1, 1); PG8_STAGE(PG8_SB(1, 0), b3, voffB); PG8_STAGE(PG8_SB(1, 1), b3 + hB, voffB); PG8_STAGE_A(1, 0, a3, last);
            PG8_WAIT_V(8); PG8_WAIT_L(0); PG8_BAR; PG8_MMA(1, 0, At, B0); PG8_MMA(1, 1, At, B1); PG8_BAR; PG8_SCHED;
            } else {
            PG8_LDB(B0, 0, 0); PG8_SCHED; PG8_LDA(At, 0, 0); PG8_STAGE(PG8_SA(1, 1), a1 + hA, voffA);
            PG8_WAIT_L(8); PG8_BAR; PG8_WAIT_L(0); PG8_MMA(0, 0, At, B0); PG8_BAR; PG8_SCHED;
            PG8_LDB(B1, 0, 1); PG8_STAGE(PG8_SB(0, 0), b2, voffB);
            PG8_BAR; PG8_WAIT_L(0); PG8_MMA(0, 1, At, B1); PG8_BAR;
            PG8_LDA(At, 0, 1); PG8_STAGE(PG8_SA(0, 0), a2, voffA);
            PG8_BAR; PG8_WAIT_L(0); PG8_MMA(1, 0, At, B0); PG8_BAR; PG8_SCHED;
            PG8_STAGE(PG8_SB(0, 1), b2 + hB, voffB);
            PG8_WAIT_V(6); PG8_BAR; PG8_MMA(1, 1, At, B1); PG8_BAR;
            PG8_LDB(B0, 1, 0); PG8_SCHED; PG8_LDA(At, 1, 0); PG8_STAGE(PG8_SA(0, 1), a2 + hA, voffA);
            PG8_WAIT_L(8); PG8_BAR; PG8_WAIT_L(0); PG8_MMA(0, 0, At, B0); PG8_BAR; PG8_SCHED;
            PG8_LDB(B1, 1, 1); PG8_STAGE(PG8_SB(1, 0), b3, voffB);
            PG8_BAR; PG8_WAIT_L(0); PG8_MMA(0, 1, At, B1); PG8_BAR;
            PG8_LDA(At, 1, 1); PG8_STAGE(PG8_SA(1, 0), a3, voffA);
            PG8_BAR; PG8_WAIT_L(0); PG8_MMA(1, 0, At, B0); PG8_BAR; PG8_SCHED;
            PG8_STAGE(PG8_SB(1, 1), b3 + hB, voffB);
            PG8_WAIT_V(6); PG8_BAR; PG8_MMA(1, 1, At, B1); PG8_BAR;
            }
        }
        if constexpr (FP8) asm volatile("s_nop 15\n\ts_nop 15" ::: "memory");
        if constexpr (ALIGN_EPI) { if (wr == 0) PG8_BAR; }
        E(acc, cur, wr, wc, fr, fq, pre);
        if (!has_next) break;
        pre = E.prefetch(nxt, wc, fq);
#pragma unroll
        for (int a = 0; a < 2; ++a)
#pragma unroll
            for (int b = 0; b < 2; ++b)
#pragma unroll
                for (int m = 0; m < 4; ++m)
#pragma unroll
                    for (int n = 0; n < 2; ++n) acc[a][b][m][n] = (f32x4){0.f, 0.f, 0.f, 0.f};
        cur = nxt; cA = nA; cB = nB; ++ui;
#pragma unroll
        for (int _h = 0; _h < 2; ++_h)
#pragma unroll
            for (int _i = 0; _i < 2; ++_i) gC[_h][_i] = gN[_h][_i];
        if constexpr (ALIGN_EPI) { if (wr == 1) PG8_BAR; }
    }
    PG8_WAIT_V(0);
    if constexpr (!ALIGN_EPI) { if (wr == 0) PG8_BAR; }
    PG8_BAR;
#undef PG8_SA
#undef PG8_SB
#undef PG8_STAGE
#undef PG8_STAGE_A
#undef PG8_GLOAD
#undef PG8_LDA
#undef PG8_LDB
#undef PG8_MMA
#undef PG8_WAIT_V
#undef PG8_WAIT_L
#undef PG8_BAR
#undef PG8_SCHED
}
}

constexpr int BATCH = 16, SEQ = 2048, CTXL = 256, TPB = SEQ + CTXL, MROWS = BATCH * TPB, DM = 1024, DEPTH = 2;
constexpr int ZC = 2048, YC = 1280, INC = 1984;
constexpr int NEXP = 32, MAXTILES = 608, XSROWS = MAXTILES * 256;
constexpr float EPS = 1e-6f, LOG2E = 1.4426950408889634f;
constexpr float QS_NA = 0.125f * LOG2E;
constexpr float QS_MLA = 0.10206207261596575f * LOG2E;
constexpr int Z_NAQ = 0, Z_NAK = 256, Z_NAV = 512, Z_CQ = 768, Z_CKV = 1024, Z_KR = 1152, Z_GQ = 1184, Z_GK = 1312, Z_GV = 1440, Z_GO = 1696, Z_LF = 1952, Z_LB = 1968;
constexpr int NPH = 1 + 13 * DEPTH;

constexpr size_t MiB = 1u << 20;
constexpr size_t WS_CTL = 0, CTL_ZERO_BYTES = 1 * MiB;
constexpr size_t WS_MOD = 1 * MiB, WS_WSM = 2 * MiB, WS_WIN = 4 * MiB, WS_WOUT = 12 * MiB, WS_W1 = 16 * MiB, WS_W2 = 272 * MiB;
constexpr size_t WS_XU = 400 * MiB, WS_H = 544 * MiB, WS_ATT = 616 * MiB, WS_Z = 688 * MiB, WS_Y = 832 * MiB;
constexpr size_t WS_NAQ = 922 * MiB, WS_NAK = 940 * MiB, WS_NAVT = 958 * MiB, WS_MQ = 976 * MiB, WS_MK = 1012 * MiB, WS_MV = 1048 * MiB;
constexpr size_t WS_EGF = 1084 * MiB, WS_EGB = 1102 * MiB, WS_GQ = 1120 * MiB, WS_GK = 1138 * MiB, WS_GV = 1156 * MiB, WS_CS = 1192 * MiB, WS_AD = 1228 * MiB;
constexpr size_t WS_OGF = 1229 * MiB, WS_OGB = 1265 * MiB, WS_TOPE = 1301 * MiB, WS_TOPG = 1302 * MiB, WS_DEST = 1303 * MiB, WS_HIST = 1304 * MiB;
constexpr size_t WS_XS = 1305 * MiB, WS_ACT = 1609 * MiB, WS_END = 1913 * MiB;
static_assert((size_t)XSROWS * DM * 2 <= 304 * MiB && (size_t)MROWS * YC * 2 <= 90 * MiB && (size_t)MROWS * 384 * 2 <= 27 * MiB, "ws map");
constexpr int CW_BAR = 4096;

constexpr int RING_OFF = 0, MISC_OFF = 139264, LDS_BYTES = 147456;
constexpr int MW_BAR = 8, MW_CNT = 64, MW_BB = 96, MW_TS = 128, MW_TE = 192, MW_TMP = 384, MW_WH = 1536;
constexpr int WRT_PITCH = 1028;
constexpr int VT_PITCH = 1544;
static_assert(NEXP * WRT_PITCH * 4 <= MISC_OFF && 64 * VT_PITCH <= MISC_OFF, "LDS map");

#define RLX_AGENT __ATOMIC_RELAXED, __HIP_MEMORY_SCOPE_AGENT
#define LDS_WAIT() asm volatile("s_waitcnt lgkmcnt(0)" ::: "memory")
#define VM_WAIT() asm volatile("s_waitcnt vmcnt(0)" ::: "memory")
__device__ __forceinline__ float bf2f(unsigned u) { return __uint_as_float(u << 16); }
__device__ __forceinline__ unsigned pk2(float lo, float hi) { unsigned r; asm("v_cvt_pk_bf16_f32 %0, %1, %2" : "=v"(r) : "v"(lo), "v"(hi)); return r; }
__device__ __forceinline__ unsigned f2bf(float f) { return pk2(f, 0.f) & 0xffffu; }
__device__ __forceinline__ float clamp8(float v) { return fminf(fmaxf(v, -448.0f), 448.0f); }
__device__ __forceinline__ unsigned pk4f8(float a, float b, float c, float d) {
    int p = __builtin_amdgcn_cvt_pk_fp8_f32(clamp8(a), clamp8(b), 0, false); p = __builtin_amdgcn_cvt_pk_fp8_f32(clamp8(c), clamp8(d), p, true); return (unsigned)p; }
constexpr float SC_W = 256.0f, SC_X = 16.0f, SC_ACT = 4.0f;
__device__ __forceinline__ void ld4bf(const bf16* p, float (&f)[4]) { const u32x2 w = *(const u32x2*)p; f[0] = __uint_as_float(w.x << 16); f[1] = __uint_as_float(w.x & 0xffff0000u); f[2] = __uint_as_float(w.y << 16); f[3] = __uint_as_float(w.y & 0xffff0000u); }
__device__ __forceinline__ f32x4 bf4f(const u32x2 w) { return (f32x4){__uint_as_float(w.x << 16), __uint_as_float(w.x & 0xffff0000u), __uint_as_float(w.y << 16), __uint_as_float(w.y & 0xffff0000u)}; }
__device__ __forceinline__ void st4bf(bf16* p, float a, float b, float c, float d) { u32x2 w; w.x = pk2(a, b); w.y = pk2(c, d); *(u32x2*)p = w; }
template <int M> __device__ __forceinline__ float swz_xor(float v) { return __int_as_float(__builtin_amdgcn_ds_swizzle(__float_as_int(v), 0x1f | (M << 10))); }
__device__ __forceinline__ float half_sum(float v) { auto rr = __builtin_amdgcn_permlane32_swap(__float_as_uint(v), __float_as_uint(v), false, false); return __uint_as_float(rr[0]) + __uint_as_float(rr[1]); }
__device__ __forceinline__ float half_max(float v) { auto rr = __builtin_amdgcn_permlane32_swap(__float_as_uint(v), __float_as_uint(v), false, false); return fmaxf(__uint_as_float(rr[0]), __uint_as_float(rr[1])); }
template <int CTRL> __device__ __forceinline__ float dpp_f(float v) { return __int_as_float(__builtin_amdgcn_update_dpp(0, __float_as_int(v), CTRL, 0xF, 0xF, true)); }
__device__ __forceinline__ float g8_sum(float v) { v += dpp_f<0xB1>(v); v += dpp_f<0x4E>(v); v += dpp_f<0x141>(v); return v; }
__device__ __forceinline__ float g16_sum(float v) { v = g8_sum(v); v += dpp_f<0x140>(v); return v; }
__device__ __forceinline__ float rl_f(float v, int l) { return __int_as_float(__builtin_amdgcn_readlane(__float_as_int(v), l)); }
__device__ __forceinline__ float wave_sum(float v) { v = g16_sum(v); return (rl_f(v, 0) + rl_f(v, 16)) + (rl_f(v, 32) + rl_f(v, 48)); }
__device__ __forceinline__ float row_sum(float v) { auto rr = __builtin_amdgcn_permlane16_swap(__float_as_uint(v), __float_as_uint(v), false, false); return __uint_as_float(rr[0]) + __uint_as_float(rr[1]); }
__device__ __forceinline__ float row_max(float v) { auto rr = __builtin_amdgcn_permlane16_swap(__float_as_uint(v), __float_as_uint(v), false, false); return fmaxf(__uint_as_float(rr[0]), __uint_as_float(rr[1])); }
template <int CTRL> __device__ __forceinline__ float dpp_max(float v) { return fmaxf(v, dpp_f<CTRL>(v)); }
__device__ __forceinline__ float wave_max(float v) { v = dpp_max<0xB1>(v); v = dpp_max<0x4E>(v); v = dpp_max<0x141>(v); v = dpp_max<0x140>(v); return fmaxf(fmaxf(rl_f(v, 0), rl_f(v, 16)), fmaxf(rl_f(v, 32), rl_f(v, 48))); }
__device__ __forceinline__ float q4_sum(float v) { return half_sum(row_sum(v)); }
__device__ __forceinline__ float q4_max(float v) { return half_max(row_max(v)); }
__device__ __forceinline__ float rsq(float x) { return __builtin_amdgcn_rsqf(x); }

#define XB_TMO      128
#define XB_XCNT(j)  (256  + 64 * (j))
#define XB_XSUB(j)  (1280 + 64 * (j))
#define XB_XGEN(j)  (2304 + 64 * (j))
#define XB_TOP      3328
#define XB_TOPGEN   3392
#define XCD_BAR_WORDS 3456
#define XB_SPIN_CAP (1u << 18)
__device__ __forceinline__ unsigned xb_ld(unsigned* p)              { return __hip_atomic_load(p, __ATOMIC_RELAXED, __HIP_MEMORY_SCOPE_AGENT); }
__device__ __forceinline__ unsigned xb_add(unsigned* p, unsigned v) { return __hip_atomic_fetch_add(p, v, __ATOMIC_RELAXED, __HIP_MEMORY_SCOPE_AGENT); }
__device__ __forceinline__ unsigned xb_xcc_id() { return (unsigned)__builtin_amdgcn_s_getreg((3 << 11) | 20) & 0xFu; }
#define XB_SPIN(cond, bar) do { unsigned _sp = 0; while (cond) { __builtin_amdgcn_s_sleep(1); \
    if ((++_sp & 255u) == 0u) { if (xb_ld(&(bar)[XB_TMO])) break; if (_sp > XB_SPIN_CAP) { atomicAdd(&(bar)[XB_TMO], 1u); break; } } } } while (0)
struct XcdBarrier { unsigned* bar; unsigned x; volatile LAS unsigned* st; };
__device__ __forceinline__ XcdBarrier xcd_barrier_post(unsigned* bar, volatile LAS unsigned* st) {
    XcdBarrier b; b.bar = bar; b.x = xb_xcc_id(); b.st = st;
    if (threadIdx.x == 0) (void)xb_add(&bar[XB_XCNT(b.x)], 1u);
    return b;
}
__device__ __forceinline__ void xcd_barrier_complete(unsigned* bar, unsigned x, unsigned& nloc, unsigned& nx) {
    const unsigned G = gridDim.x * gridDim.y * gridDim.z;
    unsigned sum, cnt, mine, sp = 0u;
    for (;;) {
        sum = 0u; cnt = 0u; mine = 0u;
#pragma unroll
        for (unsigned j = 0; j < 16; ++j) { const unsigned c = xb_ld(&bar[XB_XCNT(j)]); sum += c; cnt += (c > 0u) ? 1u : 0u; }
        mine = xb_ld(&bar[XB_XCNT(x)]);
        if (sum == G) break;
        __builtin_amdgcn_s_sleep(1);
        if ((++sp & 255u) == 0u) { if (xb_ld(&bar[XB_TMO])) break; if (sp > XB_SPIN_CAP) { atomicAdd(&bar[XB_TMO], 1u); break; } }
    }
    nloc = mine > 0u ? mine : 1u; nx = cnt > 0u ? cnt : 1u;
}
__device__ __attribute__((noinline)) void xcd_barrier(unsigned* const bbar, const unsigned bx, volatile LAS unsigned* const bst, const int tid) {
    XcdBarrier b; b.bar = bbar; b.x = bx; b.st = bst;
    asm volatile("s_waitcnt vmcnt(0)" ::: "memory");
    __syncthreads();
    if (tid == 0) {
        unsigned* bar = b.bar;
        __builtin_amdgcn_s_waitcnt(0);
        unsigned nloc = b.st[0], nx = b.st[1];
        if (nloc == 0u) { xcd_barrier_complete(bar, b.x, nloc, nx); b.st[0] = nloc; b.st[1] = nx; }
        const unsigned old = xb_add(&bar[XB_XSUB(b.x)], 1u);
        const unsigned gen = old / nloc;
        if (old + 1u == (gen + 1u) * nloc) {
            __builtin_amdgcn_fence(__ATOMIC_RELEASE, "agent");
            asm volatile("s_waitcnt vmcnt(0)" ::: "memory");
            const unsigned og = xb_add(&bar[XB_TOP], 1u);
            const unsigned tg = og / nx;
            if (og + 1u == (tg + 1u) * nx) xb_add(&bar[XB_TOPGEN], 1u);
            else XB_SPIN(xb_ld(&bar[XB_TOPGEN]) == tg, bar);
            __builtin_amdgcn_fence(__ATOMIC_ACQUIRE, "agent");
            xb_add(&bar[XB_XGEN(b.x)], 1u);
            asm volatile("s_waitcnt vmcnt(0)" ::: "memory");
        } else {
            XB_SPIN(xb_ld(&bar[XB_XGEN(b.x)]) == gen, bar);
            __builtin_amdgcn_fence(__ATOMIC_ACQUIRE, "agent");
            asm volatile("s_waitcnt vmcnt(0)" ::: "memory");
        }
    }
    __syncthreads();
}

struct Args { const float* in[28]; float* out; unsigned char* ws; int ph_lo, ph_hi, li, pad; };
struct Frame {
    LAS unsigned char* lds;
    volatile LAS unsigned* MISC;
    int tid, lane, wave, G, blk, gw, ngw;
    const Args* A;
};
#define IN_F(F, i) ((F).A->in[i])
#define x_        IN_F(F, 0)
#define c_        IN_F(F, 1)
#define ctx_      IN_F(F, 2)
#define c_ctx_    IN_F(F, 3)
#define w_ada_    IN_F(F, 4)
#define b_ada_    IN_F(F, 5)
#define g_mix_    IN_F(F, 6)
#define w_in_     IN_F(F, 7)
#define na_q_norm_ IN_F(F, 8)
#define na_k_norm_ IN_F(F, 9)
#define na_rpb_   IN_F(F, 10)
#define mla_q_a_norm_ IN_F(F, 11)
#define mla_w_q_b_ IN_F(F, 12)
#define mla_kv_a_norm_ IN_F(F, 13)
#define mla_w_kv_b_ IN_F(F, 14)
#define mla_q_norm_ IN_F(F, 15)
#define mla_k_norm_ IN_F(F, 16)
#define gla_w_gate_ IN_F(F, 17)
#define gla_b_gate_ IN_F(F, 18)
#define gla_o_norm_ IN_F(F, 19)
#define w_out_    IN_F(F, 20)
#define g_ffn_    IN_F(F, 21)
#define w_router_ IN_F(F, 22)
#define b_router_ IN_F(F, 23)
#define w_moe1_   IN_F(F, 24)
#define b_moe1_   IN_F(F, 25)
#define w_moe2_   IN_F(F, 26)
#define b_moe2_   IN_F(F, 27)
#define out_      ((F).A->out)
#define WSP(F, T, off) ((T*)((F).A->ws + (off)))
#define MOD_  WSP(F, float, WS_MOD)
#define XU_   WSP(F, bf16, WS_XU)
#define EGF_  WSP(F, float, WS_EGF)
#define EGB_  WSP(F, float, WS_EGB)
#define GQ_   WSP(F, float, WS_GQ)
#define GK_   WSP(F, float, WS_GK)
#define GV_   WSP(F, float, WS_GV)
#define CS_   WSP(F, float, WS_CS)
#define AD_   WSP(F, float, WS_AD)
#define OGF_  WSP(F, float, WS_OGF)
#define OGB_  WSP(F, float, WS_OGB)
#define TOPG_ WSP(F, float, WS_TOPG)
#define WSM_  WSP(F, bf16, WS_WSM)
#define WIN_  WSP(F, bf16, WS_WIN)
#define WOUT_ WSP(F, bf16, WS_WOUT)
#define W1_   WSP(F, bf16, WS_W1)
#define W2_   WSP(F, bf16, WS_W2)
#define H_    WSP(F, bf16, WS_H)
#define ATT_  WSP(F, bf16, WS_ATT)
#define Z_    WSP(F, bf16, WS_Z)
#define Y_    WSP(F, bf16, WS_Y)
#define NAQ_  WSP(F, bf16, WS_NAQ)
#define NAK_  WSP(F, bf16, WS_NAK)
#define NAVT_ WSP(F, bf16, WS_NAVT)
#define MQ_   WSP(F, bf16, WS_MQ)
#define MK_   WSP(F, bf16, WS_MK)
#define MV_   WSP(F, bf16, WS_MV)
#define XS_   WSP(F, bf16, WS_XS)
#define ACT_  WSP(F, bf16, WS_ACT)
#define TOPE_ WSP(F, int, WS_TOPE)
#define DEST_ WSP(F, int, WS_DEST)
#define ROWMAP_ WSP(F, int, WS_GQ)
#define HISTB_ WSP(F, int, WS_HIST)
#define WHIST_ WSP(F, int, WS_HIST + 65536)

struct DenseOrder {
    int nMa, nN, G, c, skipctx, rep;
    __device__ __forceinline__ bool next(int i, pg8::Unit& u) const {
        const int x = c & 7, y = c >> 3, Y = G >> 3;
        if (rep > 1) i >>= 1;
        const int j = i * Y + y; const int mg = j / nN, pn = j - mg * nN, a = mg * 8 + x;
        if (a >= nMa) return false;
        u.pm = skipctx ? (a >> 3) * 9 + (a & 7) : a; u.pn = pn; u.pb = pn; u.pa = u.pm; return true;
    }
};
struct MoeOrder {
    const volatile LAS int* ts; const volatile LAS unsigned char* te; int nN, G, c, rep;
    __device__ __forceinline__ bool next(int i, pg8::Unit& u) const {
        const int x = c & 7, y = c >> 3, Y = G >> 3;
        const int i0 = i; if (rep > 1) i >>= 1;
        const int j = i * Y + y; const int mg = j / nN, pn = j - mg * nN, a = mg * 8 + x;
        if (a >= ts[NEXP]) return false;
        const int e = te[a]; u.pm = a; u.pn = pn; u.pb = e * nN + pn; u.pa = a;
        if (NREP(19) > 1 && rep > 1 && !(i0 & 1)) { const int a2 = (a + 296) % ts[NEXP]; u.pa = a2; u.pb = te[a2] * nN + pn; }
        return true;
    }
};

struct EpiNoPre { };
template <bool SCALED> struct EpiBf16PlainT {
    static constexpr bool PERM = true; typedef EpiNoPre Pre;
    bf16* O; int ldc;
    __device__ __forceinline__ Pre prefetch(const pg8::Unit&, int, int) const { return Pre{}; }
    __device__ __forceinline__ void operator()(const f32x4 (&acc)[2][2][4][2], const pg8::Unit& u, int wr, int wc, int fr, int fq, const Pre&) const {
        const int row0 = u.pm * 256 + wr * 64 + fr, col0 = u.pn * 256 + wc * 32 + 8 * fq;
#pragma unroll
        for (int ai = 0; ai < 2; ++ai)
#pragma unroll
            for (int m = 0; m < 4; ++m) { bf16* rowp = O + (size_t)(row0 + ai * 128 + m * 16) * ldc + col0;
#pragma unroll
                for (int bj = 0; bj < 2; ++bj) { f32x4 v0 = acc[ai][bj][m][0], v1 = acc[ai][bj][m][1];
                    if constexpr (SCALED) { v0 = v0 * (1.0f / (SC_W * SC_X)); v1 = v1 * (1.0f / (SC_W * SC_X)); }
                    u32x4 w; w.x = pg8::cvt_pk_bf16(v0[0], v0[1]); w.y = pg8::cvt_pk_bf16(v0[2], v0[3]); w.z = pg8::cvt_pk_bf16(v1[0], v1[1]); w.w = pg8::cvt_pk_bf16(v1[2], v1[3]);
                    *(u32x4*)(rowp + bj * 128) = w; } }
    }
};
typedef EpiBf16PlainT<false> EpiBf16Plain;
struct EpiResid {
    static constexpr bool PERM = true; typedef EpiNoPre Pre;
    bf16* X; const float* gt;
    const float* xin; const float* cin;
    __device__ __forceinline__ Pre prefetch(const pg8::Unit&, int, int) const { return Pre{}; }
    __device__ __forceinline__ void operator()(const f32x4 (&acc)[2][2][4][2], const pg8::Unit& u, int wr, int wc, int fr, int fq, const Pre&) const {
        const int row0 = u.pm * 256 + wr * 64 + fr, col0 = u.pn * 256 + wc * 32 + 8 * fq;
        const int bi = u.pm / 9, t9 = u.pm - bi * 9, mc = (t9 == 8) ? 16 : bi; const float* g = gt + mc * 6144 + col0;
        const float* base = xin ? (t9 == 8 ? cin + (size_t)bi * CTXL * DM : xin + ((size_t)bi * SEQ + t9 * 256) * DM) + (size_t)(wr * 64 + fr) * DM + col0 : nullptr;
        f32x4 gv[2][2];
#pragma unroll
        for (int bj = 0; bj < 2; ++bj)
#pragma unroll
            for (int n = 0; n < 2; ++n) gv[bj][n] = *(const f32x4*)(g + bj * 128 + 4 * n);
#pragma unroll
        for (int ai = 0; ai < 2; ++ai)
#pragma unroll
            for (int m = 0; m < 4; ++m) { bf16* rowp = X + (size_t)(row0 + ai * 128 + m * 16) * DM + col0;
#pragma unroll
                for (int bj = 0; bj < 2; ++bj) { f32x4 b0, b1;
                    if (xin) { const float* bp = base + (size_t)(ai * 128 + m * 16) * DM + bj * 128; b0 = *(const f32x4*)bp; b1 = *(const f32x4*)(bp + 4); }
                    else { const u32x4 w = *(const u32x4*)(rowp + bj * 128); u32x2 lo, hi; lo.x = w.x; lo.y = w.y; hi.x = w.z; hi.y = w.w; b0 = bf4f(lo); b1 = bf4f(hi); }
                    const f32x4 v0 = b0 + gv[bj][0] * acc[ai][bj][m][0], v1 = b1 + gv[bj][1] * acc[ai][bj][m][1];
                    u32x4 o; o.x = pg8::cvt_pk_bf16(v0[0], v0[1]); o.y = pg8::cvt_pk_bf16(v0[2], v0[3]); o.z = pg8::cvt_pk_bf16(v1[0], v1[1]); o.w = pg8::cvt_pk_bf16(v1[2], v1[3]);
                    *(u32x4*)(rowp + bj * 128) = o; } }
    }
};
struct EpiSwiglu {
    static constexpr bool PERM = true; struct Pre { f32x4 bg[2], bl[2]; };
    unsigned char* O; const float* b1;
    __device__ __forceinline__ Pre prefetch(const pg8::Unit& u, int wc, int fq) const { Pre p; const float* bb = b1 + (u.pb >> 3) * 2048 + u.pn * 128 + wc * 32 + 8 * fq;
#pragma unroll
        for (int n = 0; n < 2; ++n) { p.bg[n] = *(const f32x4*)(bb + 4 * n); p.bl[n] = *(const f32x4*)(bb + 1024 + 4 * n); }
        return p; }
    __device__ __forceinline__ void operator()(const f32x4 (&acc)[2][2][4][2], const pg8::Unit& u, int wr, int wc, int fr, int fq, const Pre& pre) const {
        const int row0 = u.pm * 256 + wr * 64 + fr, oc0 = u.pn * 128 + wc * 32 + 8 * fq;
        const f32x4 (&bg)[2] = pre.bg; const f32x4 (&bl)[2] = pre.bl;
        constexpr float S = 1.0f / (SC_W * SC_X);
#pragma unroll
        for (int ai = 0; ai < 2; ++ai)
#pragma unroll
            for (int m = 0; m < 4; ++m) { u32x2 w;
#pragma unroll
                for (int n = 0; n < 2; ++n) { f32x4 gl = acc[ai][0][m][n] * S + bg[n], li = acc[ai][1][m][n] * S + bl[n];
#pragma unroll
                    for (int i = 0; i < 4; ++i) { gl[i] = fminf(gl[i], 7.0f); li[i] = __builtin_amdgcn_fmed3f(li[i], -7.0f, 7.0f); }
                    f32x4 e = gl * (-1.702f * LOG2E);
#pragma unroll
                    for (int i = 0; i < 4; ++i) e[i] = __builtin_amdgcn_exp2f(e[i]);
                    e = e + 1.0f;
#pragma unroll
                    for (int i = 0; i < 4; ++i) e[i] = __builtin_amdgcn_rcpf(e[i]);
                    const f32x4 o = (li * SC_ACT + SC_ACT) * (gl * e);
                    int p = __builtin_amdgcn_cvt_pk_fp8_f32(o[0], o[1], 0, false); p = __builtin_amdgcn_cvt_pk_fp8_f32(o[2], o[3], p, true);
                    if (n == 0) w.x = (unsigned)p; else w.y = (unsigned)p; }
                *(u32x2*)(O + (size_t)(row0 + ai * 128 + m * 16) * DM + oc0) = w; }
    }
};
struct EpiBf16Bias {
    static constexpr bool PERM = true; struct Pre { f32x4 bv[2][2]; };
    bf16* O; const float* b2;
    __device__ __forceinline__ Pre prefetch(const pg8::Unit& u, int wc, int fq) const { Pre p; const float* bb = b2 + (u.pb >> 2) * 1024 + u.pn * 256 + wc * 32 + 8 * fq;
#pragma unroll
        for (int bj = 0; bj < 2; ++bj)
#pragma unroll
            for (int n = 0; n < 2; ++n) p.bv[bj][n] = *(const f32x4*)(bb + bj * 128 + 4 * n);
        return p; }
    __device__ __forceinline__ void operator()(const f32x4 (&acc)[2][2][4][2], const pg8::Unit& u, int wr, int wc, int fr, int fq, const Pre& pre) const {
        const int row0 = u.pm * 256 + wr * 64 + fr, col0 = u.pn * 256 + wc * 32 + 8 * fq;
        const f32x4 (&bv)[2][2] = pre.bv;
#pragma unroll
        for (int ai = 0; ai < 2; ++ai)
#pragma unroll
            for (int m = 0; m < 4; ++m) { bf16* rowp = O + (size_t)(row0 + ai * 128 + m * 16) * DM + col0;
#pragma unroll
                for (int bj = 0; bj < 2; ++bj) { const f32x4 v0 = acc[ai][bj][m][0] * (1.0f / (SC_W * SC_ACT)) + bv[bj][0], v1 = acc[ai][bj][m][1] * (1.0f / (SC_W * SC_ACT)) + bv[bj][1];
                    u32x4 w; w.x = pg8::cvt_pk_bf16(v0[0], v0[1]); w.y = pg8::cvt_pk_bf16(v0[2], v0[3]); w.z = pg8::cvt_pk_bf16(v1[0], v1[1]); w.w = pg8::cvt_pk_bf16(v1[2], v1[3]);
                    *(u32x4*)(rowp + bj * 128) = w; } }
    }
};

__device__ __forceinline__ void relane(Frame& F) { int ln_; asm volatile("v_mbcnt_lo_u32_b32 %0, -1, 0\n\tv_mbcnt_hi_u32_b32 %0, -1, %0" : "=v"(ln_)); ln_ &= 63; F.lane = ln_; F.tid = F.wave * 64 + ln_; }

__device__ __forceinline__ void tr_item(const float* src, int ldsrc, bool valid, const float* ksc, bf16* dst, int lddst, LAS float* scr, int lane) {
    float v[32];
#pragma unroll
    for (int i = 0; i < 32; ++i) { const int kk = 2 * i + (lane >> 5); v[i] = valid ? src[(size_t)kk * ldsrc + (lane & 31)] : 0.f; }
    if (valid && ksc) {
#pragma unroll
        for (int i = 0; i < 32; ++i) v[i] *= ksc[2 * i + (lane >> 5)];
    }
#pragma unroll
    for (int i = 0; i < 32; ++i) { const int kk = 2 * i + (lane >> 5); scr[kk * 33 + (lane & 31)] = v[i]; }
    LDS_WAIT(); asm volatile("" ::: "memory");
    const int c = lane & 7;
#pragma unroll
    for (int j = 0; j < 4; ++j) { const int n = (lane >> 3) + 8 * j; const LAS float* s = scr + (8 * c) * 33 + n;
        u32x4 o; o.x = pk2(s[0 * 33], s[1 * 33]); o.y = pk2(s[2 * 33], s[3 * 33]); o.z = pk2(s[4 * 33], s[5 * 33]); o.w = pk2(s[6 * 33], s[7 * 33]);
        *(u32x4*)(dst + (size_t)n * lddst + 8 * c) = o; }
    LDS_WAIT(); asm volatile("" ::: "memory");
}
__device__ __forceinline__ void tr_item8(const float* src, int ldsrc, unsigned char* dst, int lddst, LAS float* scr, int lane) {
    float v[32];
#pragma unroll
    for (int i = 0; i < 32; ++i) { const int kk = 2 * i + (lane >> 5); v[i] = src[(size_t)kk * ldsrc + (lane & 31)] * SC_W; }
#pragma unroll
    for (int i = 0; i < 32; ++i) { const int kk = 2 * i + (lane >> 5); scr[kk * 33 + (lane & 31)] = v[i]; }
    LDS_WAIT(); asm volatile("" ::: "memory");
    const int c = lane & 7;
#pragma unroll
    for (int j = 0; j < 4; ++j) { const int n = (lane >> 3) + 8 * j; const LAS float* s = scr + (8 * c) * 33 + n;
        u32x2 o; o.x = pk4f8(s[0 * 33], s[1 * 33], s[2 * 33], s[3 * 33]); o.y = pk4f8(s[4 * 33], s[5 * 33], s[6 * 33], s[7 * 33]);
        *(u32x2*)(dst + (size_t)n * lddst + 8 * c) = o; }
    LDS_WAIT(); asm volatile("" ::: "memory");
}
__device__ __forceinline__ void tr_item8w(const float* src, int ldsrc, unsigned char* dst, LAS float* scr, int lane) {
    const int kr = lane >> 4, nc = (lane & 15) * 4;
    f32x4 v[16];
#pragma unroll
    for (int i = 0; i < 16; ++i) v[i] = *(const f32x4*)(src + (size_t)(4 * i + kr) * ldsrc + nc);
#pragma unroll
    for (int i = 0; i < 16; ++i) *(LAS f32x4*)(scr + (4 * i + kr) * 68 + nc) = v[i] * SC_W;
    LDS_WAIT(); asm volatile("" ::: "memory");
#pragma unroll
    for (int c = 0; c < 4; ++c) { const LAS float* s = scr + (16 * c) * 68 + lane; u32x4 o;
        o.x = pk4f8(s[0 * 68], s[1 * 68], s[2 * 68], s[3 * 68]); o.y = pk4f8(s[4 * 68], s[5 * 68], s[6 * 68], s[7 * 68]);
        o.z = pk4f8(s[8 * 68], s[9 * 68], s[10 * 68], s[11 * 68]); o.w = pk4f8(s[12 * 68], s[13 * 68], s[14 * 68], s[15 * 68]);
        *(u32x4*)(dst + (size_t)lane * 1024 + 16 * c) = o; }
    LDS_WAIT(); asm volatile("" ::: "memory");
}
__device__ __forceinline__ void p0_prologue(Frame& F) {
    for (int ch = F.blk; ch < 192; ch += F.G) {
        LAS float* s = (LAS float*)(F.lds + RING_OFF);
        LAS float* red = s + 17 * 1024;
        for (int idx = F.tid; idx < 17 * 1024; idx += 512) { const int m = idx >> 10, k = idx & 1023; const float cv = m < 16 ? c_[m * 1024 + k] : c_ctx_[k]; s[idx] = cv / (1.0f + __expf(-cv)); }
        __syncthreads();
        const int l = ch / 96, col0 = (ch % 96) * 64;
        const float* W = w_ada_ + (size_t)l * 1024 * 6144 + col0 + F.lane;
        float acc[17];
#pragma unroll
        for (int m = 0; m < 17; ++m) acc[m] = 0.f;
#pragma unroll 8
        for (int kk = 0; kk < 128; ++kk) { const int k = F.wave * 128 + kk; const float w = W[(size_t)k * 6144];
#pragma unroll
            for (int m = 0; m < 17; ++m) acc[m] += s[m * 1024 + k] * w; }
#pragma unroll
        for (int m = 0; m < 17; ++m) red[(F.wave * 17 + m) * 64 + F.lane] = acc[m];
        __syncthreads();
        for (int idx = F.tid; idx < 17 * 64; idx += 512) { const int m = idx >> 6, cc = idx & 63; float a = b_ada_[l * 6144 + col0 + cc];
#pragma unroll
            for (int w = 0; w < 8; ++w) a += red[(w * 17 + m) * 64 + cc];
            MOD_[((size_t)l * 17 + m) * 6144 + col0 + cc] = a; }
        __syncthreads();
    }
    LAS float* scr = (LAS float*)(F.lds + RING_OFF + F.wave * 17408);
    constexpr int IT_W1 = 64 * 512, IT_W2 = 64 * 256, IT_WIN = 2 * 512, IT_WOUT = 2 * 512, IT_SM = 2 * 240;
    static_assert(8 * 17408 <= MISC_OFF, "prologue LDS tiles");
    constexpr int NIT = IT_W1 + IT_W2 + IT_WIN + IT_WOUT + IT_SM;
    for (int it = IT_W1 + IT_W2 + F.gw; it < NIT; it += F.ngw) {
        int r = it;
        if (r < IT_W1) { const int le = r >> 9, q = r & 511, kb = q >> 5, nb = q & 31, n0 = nb * 64, pn = n0 >> 8, j = n0 & 255; const int sc = j < 128 ? 128 * pn + j : 1024 + 128 * pn + (j - 128);
            tr_item8w(w_moe1_ + ((size_t)le * 1024 + kb * 64) * 2048 + sc, 2048, (unsigned char*)W1_ + ((size_t)le * 2048 + n0) * 1024 + kb * 64, scr, F.lane); continue; }
        r -= IT_W1;
        if (r < IT_W2) { const int le = r >> 8, q = r & 255, kb = q >> 4, nb = q & 15, n0 = nb * 64;
            tr_item8w(w_moe2_ + ((size_t)le * 1024 + kb * 64) * 1024 + n0, 1024, (unsigned char*)W2_ + ((size_t)le * 1024 + n0) * 1024 + kb * 64, scr, F.lane); continue; }
        r -= IT_W2;
        if (r < IT_WIN) { const int l = r >> 9, q = r & 511, kb = q >> 5, nb = q & 31, n0 = nb * 64;
            unsigned char* dst = (unsigned char*)WIN_ + ((size_t)l * 2048 + n0) * 1024 + kb * 64;
            if (n0 < INC) tr_item8w(w_in_ + ((size_t)l * 1024 + kb * 64) * INC + n0, INC, dst, scr, F.lane);
            else { const u32x4 z = {0u, 0u, 0u, 0u};
#pragma unroll
                for (int c = 0; c < 4; ++c) *(u32x4*)(dst + (size_t)F.lane * 1024 + 16 * c) = z; }
            continue; }
        r -= IT_WIN;
        if (r < IT_WOUT) { const int l = r >> 9, q = r & 511, kb = q >> 5, nb = q & 31, n0 = nb * 32;
            tr_item(w_out_ + ((size_t)l * 1024 + kb * 64) * 1024 + n0, 1024, true, nullptr, WOUT_ + ((size_t)l * 1024 + n0) * 1024 + kb * 64, 1024, scr, F.lane); continue; }
        r -= IT_WOUT;
        { const int l = r / 240, q = r - l * 240, kb = q / 40, nb = q - kb * 40, n0 = nb * 32, k0 = kb * 64;
            bf16* dst = WSM_ + ((size_t)l * 1280 + n0) * 384 + k0;
            if (n0 < 384) tr_item(mla_w_q_b_ + ((size_t)l * 256 + (k0 & 255)) * 384 + n0, 384, k0 < 256, mla_q_a_norm_ + l * 256 + (k0 & 255), dst, 384, scr, F.lane);
            else if (n0 < 1152) tr_item(mla_w_kv_b_ + ((size_t)l * 128 + ((k0 - 256) & 127)) * 768 + (n0 - 384), 768, k0 >= 256, mla_kv_a_norm_ + l * 128 + ((k0 - 256) & 127), dst, 384, scr, F.lane);
            else tr_item(w_out_, 1024, false, nullptr, dst, 384, scr, F.lane); }
    }
    __syncthreads();
}

__device__ __forceinline__ void norm_mod_store(const f32x4 (&v)[4], float rstd, const float* g, const float* sc, const float* sh, unsigned char* orow  , int lane) {
#pragma unroll
    for (int j = 0; j < 4; ++j) { const int col = 256 * j + 4 * lane; const f32x4 gg = *(const f32x4*)(g + col), s1 = *(const f32x4*)(sc + col), s0 = *(const f32x4*)(sh + col);
        const f32x4 h = (v[j] * rstd * gg * (s1 + 1.0f) + s0) * SC_X; *(unsigned*)(orow + col) = pk4f8(h[0], h[1], h[2], h[3]); }
}
__device__ __forceinline__ float sumsq4(const f32x4 (&v)[4]) { float s = 0.f;
#pragma unroll
    for (int j = 0; j < 4; ++j) s += (v[j][0] * v[j][0] + v[j][1] * v[j][1]) + (v[j][2] * v[j][2] + v[j][3] * v[j][3]);
    return s; }

__device__ __forceinline__ const float* pA_src(Frame& F, int row) { const int b = row / TPB, p = row - b * TPB; return p < SEQ ? x_ + ((size_t)b * SEQ + p) * DM : ctx_ + ((size_t)b * CTXL + (p - SEQ)) * DM; }
__device__ __forceinline__ void pA_init(Frame& F) {
    const int lane = F.lane, step = F.ngw;
    int row = F.gw; if (row >= MROWS) return;
    f32x4 gm[4];
#pragma unroll
    for (int j = 0; j < 4; ++j) gm[j] = *(const f32x4*)(g_mix_ + 256 * j + 4 * lane);
    auto load = [&](f32x4 (&v)[4], int r) __attribute__((always_inline)) { const float* src = pA_src(F, r);
#pragma unroll
        for (int j = 0; j < 4; ++j) v[j] = *(const f32x4*)(src + 256 * j + 4 * lane); };
    auto one = [&](const f32x4 (&v)[4], int r) __attribute__((always_inline)) {
        const int b = r / TPB, p = r - b * TPB; const int mc = p < SEQ ? b : 16; const float* mod = MOD_ + (size_t)mc * 6144;
        f32x4 s1[4], s0[4];
#pragma unroll
        for (int j = 0; j < 4; ++j) { s1[j] = *(const f32x4*)(mod + 1024 + 256 * j + 4 * lane); s0[j] = *(const f32x4*)(mod + 256 * j + 4 * lane); }
        const float rstd = rsq(wave_sum(sumsq4(v)) * (1.0f / DM) + EPS);
        unsigned char* orow = (unsigned char*)H_ + (size_t)r * DM;
#pragma unroll
        for (int j = 0; j < 4; ++j) { const f32x4 h = (v[j] * rstd * gm[j] * (s1[j] + 1.0f) + s0[j]) * SC_X; *(unsigned*)(orow + 256 * j + 4 * lane) = pk4f8(h[0], h[1], h[2], h[3]); }
    };
    f32x4 A[4], B[4]; load(A, row);
    for (; row < MROWS; row += 2 * step) {
        if (row + step < MROWS) load(B, row + step);
        one(A, row);
        if (row + step >= MROWS) break;
        if (row + 2 * step < MROWS) load(A, row + 2 * step);
        one(B, row + step);
    }
}

__device__ __forceinline__ float logsigmoid(float x) { return fminf(x, 0.f) - __logf(1.0f + __expf(-fabsf(x))); }
__device__ __forceinline__ void up4(const u32x2 w, float (&f)[4]) { f[0] = __uint_as_float(w.x << 16); f[1] = __uint_as_float(w.x & 0xffff0000u); f[2] = __uint_as_float(w.y << 16); f[3] = __uint_as_float(w.y & 0xffff0000u); }
struct DIn { u32x2 naq, nak, nav, cq, ckv, yq, yk; u32x4 lf0, lf1, lb0, lb1, yv; bf16 kr0, kr1, yq0, yq1; };
__device__ __forceinline__ void pD_load(Frame& F, DIn& d, int row, int lane) {
    const int c4 = 4 * lane, hh = lane >> 4, jj = lane & 15, ra = jj >> 3, j8 = jj & 7, ri = 64 + ra * 16 + j8;
    const bf16* z = Z_ + (size_t)row * ZC; const bf16* y = Y_ + (size_t)row * YC; const u32x2 zero2 = {0u, 0u};
    d.naq = *(const u32x2*)(z + Z_NAQ + c4); d.nak = *(const u32x2*)(z + Z_NAK + c4); d.nav = *(const u32x2*)(z + Z_NAV + c4); d.cq = *(const u32x2*)(z + Z_CQ + c4);
    d.ckv = lane < 32 ? *(const u32x2*)(z + Z_CKV + c4) : zero2;
    d.lf0 = *(const u32x4*)(z + Z_LF); d.lf1 = *(const u32x4*)(z + Z_LF + 8); d.lb0 = *(const u32x4*)(z + Z_LB); d.lb1 = *(const u32x4*)(z + Z_LB + 8);
    d.kr0 = z[Z_KR + ra * 16 + j8]; d.kr1 = z[Z_KR + ra * 16 + j8 + 8];
    d.yq = *(const u32x2*)(y + hh * 96 + 4 * jj); d.yq0 = y[hh * 96 + ri]; d.yq1 = y[hh * 96 + ri + 8];
    d.yk = *(const u32x2*)(y + 384 + hh * 192 + 4 * jj); d.yv = *(const u32x4*)(y + 384 + hh * 192 + 64 + 8 * jj);
}
__device__ __forceinline__ int pD_row(const Frame& F, int g) { const int tile = min(F.blk + (g >> 2) * F.G, MROWS / 32 - 1); return tile * 32 + F.wave + 8 * (g & 3); }
__device__ __forceinline__ void pD_tokens(Frame& F, int l) {
    const int lane = F.lane, c4 = 4 * lane, hh = lane >> 4, jj = lane & 15, ra = jj >> 3, j8 = jj & 7;
    LAS float* wgs = (LAS float*)(F.lds + RING_OFF + 65536);
    for (int i = F.tid; i < 2 * 16 * 128; i += 512) wgs[i] = gla_w_gate_[(size_t)l * 2 * 16 * 128 + i];
    LDS_WAIT(); __syncthreads();
    typedef float f32x2v __attribute__((ext_vector_type(2)));
    const LAS float* wgl = wgs + 2 * lane;
    const float bgf0 = gla_b_gate_[(l * 2 + 0) * 128 + 2 * lane], bgf1 = gla_b_gate_[(l * 2 + 0) * 128 + 2 * lane + 1];
    const float bgb0 = gla_b_gate_[(l * 2 + 1) * 128 + 2 * lane], bgb1 = gla_b_gate_[(l * 2 + 1) * 128 + 2 * lane + 1];
    const float inv = exp2f(-(float)j8 * 1.6609640474436813f);
    const float* qn_g = na_q_norm_ + l * 64 + (c4 & 63); const float* kn_g = na_k_norm_ + l * 64 + (c4 & 63);
    const float* mq_g = mla_q_norm_ + l * 96; const float* mk_g = mla_k_norm_ + l * 96;
    const int ri = 64 + ra * 16 + j8;
    const float qg0 = qn_g[0], qg1 = qn_g[1], qg2 = qn_g[2], qg3 = qn_g[3], kg0 = kn_g[0], kg1 = kn_g[1], kg2 = kn_g[2], kg3 = kn_g[3];
    const float mqn0 = mq_g[4 * jj], mqn1 = mq_g[4 * jj + 1], mqn2 = mq_g[4 * jj + 2], mqn3 = mq_g[4 * jj + 3], mqr0 = mq_g[ri], mqr1 = mq_g[ri + 8];
    const float mkn0 = mk_g[4 * jj], mkn1 = mk_g[4 * jj + 1], mkn2 = mk_g[4 * jj + 2], mkn3 = mk_g[4 * jj + 3], mkr0 = mk_g[ri], mkr1 = mk_g[ri + 8];
    LAS unsigned char* vt = F.lds + RING_OFF;
    const int ntok = 4 * ((MROWS / 32 - F.blk + F.G - 1) / F.G);
    auto one = [&](const DIn& cur, const int g) __attribute__((always_inline)) {
        {
            const int tile = F.blk + (g >> 2) * F.G, it = g & 3, b = tile / 72, p0 = (tile - b * 72) * 32;
            const int tl = F.wave + 8 * it, row = tile * 32 + tl, p = p0 + tl; const bool lat = p < SEQ;
            float f[4];
            { up4(cur.naq, f); const float r = rsq(g16_sum(f[0] * f[0] + f[1] * f[1] + f[2] * f[2] + f[3] * f[3]) * (1.0f / 64) + EPS) * QS_NA;
              st4bf(NAQ_ + (size_t)row * 256 + c4, f[0] * r * qg0, f[1] * r * qg1, f[2] * r * qg2, f[3] * r * qg3); }
            { up4(cur.nak, f); const float r = rsq(g16_sum(f[0] * f[0] + f[1] * f[1] + f[2] * f[2] + f[3] * f[3]) * (1.0f / 64) + EPS);
              st4bf(NAK_ + (size_t)row * 256 + c4, f[0] * r * kg0, f[1] * r * kg1, f[2] * r * kg2, f[3] * r * kg3); }
            *(LAS u32x2*)(vt + tl * VT_PITCH + c4 * 2) = cur.nav;
            up4(cur.cq, f); const float rq = rsq(wave_sum(f[0] * f[0] + f[1] * f[1] + f[2] * f[2] + f[3] * f[3]) * (1.0f / 256) + EPS);
            up4(cur.ckv, f); const float rkv = rsq(wave_sum(f[0] * f[0] + f[1] * f[1] + f[2] * f[2] + f[3] * f[3]) * (1.0f / 128) + EPS);
            const float ang = lat ? (float)(ra == 0 ? (p >> 6) : (p & 63)) * inv : 0.f;
            const float cs = __cosf(ang), sn = __sinf(ang);
            { up4(cur.yq, f); float a0 = bf2f(cur.yq0) * rq, a1 = bf2f(cur.yq1) * rq;
#pragma unroll
              for (int i = 0; i < 4; ++i) f[i] *= rq;
              const float r = rsq(g16_sum(f[0] * f[0] + f[1] * f[1] + f[2] * f[2] + f[3] * f[3] + a0 * a0 + a1 * a1) * (1.0f / 96) + EPS);
              a0 *= r * mqr0; a1 *= r * mqr1;
              bf16* o = MQ_ + (size_t)row * 384 + hh * 96;
              st4bf(o + 4 * jj, f[0] * r * mqn0, f[1] * r * mqn1, f[2] * r * mqn2, f[3] * r * mqn3);
              o[ri] = (bf16)f2bf(a0 * cs - a1 * sn); o[ri + 8] = (bf16)f2bf(a1 * cs + a0 * sn); }
            { up4(cur.yk, f); float a0 = bf2f(cur.kr0), a1 = bf2f(cur.kr1);
#pragma unroll
              for (int i = 0; i < 4; ++i) f[i] *= rkv;
              const float r = rsq(g16_sum(f[0] * f[0] + f[1] * f[1] + f[2] * f[2] + f[3] * f[3] + a0 * a0 + a1 * a1) * (1.0f / 96) + EPS);
              a0 *= r * mkr0; a1 *= r * mkr1;
              bf16* o = MK_ + (size_t)row * 384 + hh * 96;
              st4bf(o + 4 * jj, f[0] * r * mkn0, f[1] * r * mkn1, f[2] * r * mkn2, f[3] * r * mkn3);
              o[ri] = (bf16)f2bf(a0 * cs - a1 * sn); o[ri + 8] = (bf16)f2bf(a1 * cs + a0 * sn); }
            { float g[4]; u32x2 lo, hi; lo.x = cur.yv.x; lo.y = cur.yv.y; hi.x = cur.yv.z; hi.y = cur.yv.w; up4(lo, f); up4(hi, g);
              u32x4 w; w.x = pk2(f[0] * rkv, f[1] * rkv); w.y = pk2(f[2] * rkv, f[3] * rkv); w.z = pk2(g[0] * rkv, g[1] * rkv); w.w = pk2(g[2] * rkv, g[3] * rkv);
              *(u32x4*)(MV_ + (size_t)row * 512 + hh * 128 + 8 * jj) = w; }
            { float xf0 = bgf0, xf1 = bgf1, xb0 = bgb0, xb1 = bgb1;
              const unsigned lfw[8] = {cur.lf0.x, cur.lf0.y, cur.lf0.z, cur.lf0.w, cur.lf1.x, cur.lf1.y, cur.lf1.z, cur.lf1.w};
              const unsigned lbw[8] = {cur.lb0.x, cur.lb0.y, cur.lb0.z, cur.lb0.w, cur.lb1.x, cur.lb1.y, cur.lb1.z, cur.lb1.w};
#pragma unroll
              for (int k2 = 0; k2 < 8; ++k2) { const float a0 = __uint_as_float(lfw[k2] << 16), a1 = __uint_as_float(lfw[k2] & 0xffff0000u), b0 = __uint_as_float(lbw[k2] << 16), b1 = __uint_as_float(lbw[k2] & 0xffff0000u);
                  const f32x2v wf0 = *(const LAS f32x2v*)(wgl + (2 * k2) * 128), wf1 = *(const LAS f32x2v*)(wgl + (2 * k2 + 1) * 128), wb0 = *(const LAS f32x2v*)(wgl + (16 + 2 * k2) * 128), wb1 = *(const LAS f32x2v*)(wgl + (17 + 2 * k2) * 128);
                  xf0 += a0 * wf0.x + a1 * wf1.x; xf1 += a0 * wf0.y + a1 * wf1.y; xb0 += b0 * wb0.x + b1 * wb1.x; xb1 += b0 * wb0.y + b1 * wb1.y; }
              float* ef = EGF_ + (size_t)row * 128 + 2 * lane; float* eb = EGB_ + (size_t)row * 128 + 2 * lane;
              ef[0] = logsigmoid(xf0) * (1.0f / 16); ef[1] = logsigmoid(xf1) * (1.0f / 16);
              eb[0] = logsigmoid(xb0) * (1.0f / 16); eb[1] = logsigmoid(xb1) * (1.0f / 16); }
        }
        if ((g & 3) == 3) {
            const int tile = F.blk + (g >> 2) * F.G, b = tile / 72, p0 = (tile - b * 72) * 32;
            LDS_WAIT(); __syncthreads();
            for (int cI = 0; cI < 16; ++cI) { const int cc = F.wave * 32 + 2 * cI + (lane >> 5), tk = lane & 31; const bf16 val = *(const LAS bf16*)(vt + tk * VT_PITCH + cc * 2);
                NAVT_[((size_t)(b * 4 + (cc >> 6)) * 64 + (cc & 63)) * TPB + p0 + tk] = val; }
            LDS_WAIT(); __syncthreads();
        }
    };
    DIn b0, b1, b2;
    pD_load(F, b0, pD_row(F, 0), lane); pD_load(F, b1, pD_row(F, 1), lane);
    for (int g = 0; g < ntok; g += 3) {
        pD_load(F, b2, pD_row(F, g + 2), lane); one(b0, g);
        if (g + 1 < ntok) { pD_load(F, b0, pD_row(F, g + 3), lane); one(b1, g + 1); }
        if (g + 2 < ntok) { pD_load(F, b1, pD_row(F, g + 4), lane); one(b2, g + 2); }
    }
}

template <int DV> struct AttnSt { f32x4 o[DV / 16]; float m, l; };
#define MFMA16(a, b, c) __builtin_amdgcn_mfma_f32_16x16x32_bf16((a), (b), (c), 0, 0, 0)
template <int DQK, int DV> struct KvFrag { bf16x8 k0[DQK / 32], k1[DQK / 32]; u32x2 vlo[DV / 16], vhi[DV / 16]; };
template <int DQK, int DV, bool NA, bool FIXM, class RP = const float*>
__device__ __forceinline__ void attn_math32(AttnSt<DV>& st, const bf16x8 (&qf)[DQK / 32], const KvFrag<DQK, DV>& f, int q, RP rpbrow, int kcol0, int qc, int cs) {
    const float c0 = FIXM ? -st.m : 0.f;
    f32x4 s0 = (f32x4){c0, c0, c0, c0}, s1 = s0;
#pragma unroll
    for (int s = 0; s < DQK / 32; ++s) { s0 = MFMA16(f.k0[s], qf[s], s0); s1 = MFMA16(f.k1[s], qf[s], s1); }
    if constexpr (NA) {
        float bs[8];
#pragma unroll
        for (int i = 0; i < 4; ++i) { bs[i] = rpbrow[kcol0 + 4 * q - qc + 15 + i]; bs[4 + i] = rpbrow[kcol0 + 4 * q - qc + 31 + i]; }
#pragma unroll
        for (int i = 0; i < 4; ++i) {
            const int k0 = kcol0 + 4 * q + i, k1 = k0 + 16;
            const float t0 = s0[i] + bs[i], t1 = s1[i] + bs[4 + i];
            s0[i] = (k0 >= cs && k0 < cs + 16) ? t0 : -INFINITY;
            s1[i] = (k1 >= cs && k1 < cs + 16) ? t1 : -INFINITY;
        }
    }
    float p0[4], p1[4], ps = 0.f, al = 1.f;
    if constexpr (FIXM) {
#pragma unroll
        for (int i = 0; i < 4; ++i) { p0[i] = __builtin_amdgcn_exp2f(s0[i]); p1[i] = __builtin_amdgcn_exp2f(s1[i]); ps += p0[i] + p1[i]; }
        st.l += ps;
    } else {
        float mx = fmaxf(fmaxf(fmaxf(s0[0], s0[1]), fmaxf(s0[2], s0[3])), fmaxf(fmaxf(s1[0], s1[1]), fmaxf(s1[2], s1[3])));
        mx = q4_max(mx);
        const float mn = fmaxf(st.m, mx); al = __builtin_amdgcn_exp2f(st.m - mn); st.m = mn;
#pragma unroll
        for (int i = 0; i < 4; ++i) { p0[i] = __builtin_amdgcn_exp2f(s0[i] - mn); p1[i] = __builtin_amdgcn_exp2f(s1[i] - mn); ps += p0[i] + p1[i]; }
        st.l = st.l * al + ps;
    }
    u32x4 pw; pw.x = pg8::cvt_pk_bf16(p0[0], p0[1]); pw.y = pg8::cvt_pk_bf16(p0[2], p0[3]); pw.z = pg8::cvt_pk_bf16(p1[0], p1[1]); pw.w = pg8::cvt_pk_bf16(p1[2], p1[3]);
    const bf16x8 pf = __builtin_bit_cast(bf16x8, pw);
#pragma unroll
    for (int n = 0; n < DV / 16; ++n) {
        u32x4 aw; aw.x = f.vlo[n].x; aw.y = f.vlo[n].y; aw.z = f.vhi[n].x; aw.w = f.vhi[n].y;
        if constexpr (FIXM) st.o[n] = MFMA16(__builtin_bit_cast(bf16x8, aw), pf, st.o[n]); else st.o[n] = MFMA16(__builtin_bit_cast(bf16x8, aw), pf, st.o[n] * al);
    }
}
template <int DV> __device__ __forceinline__ void attn_init(AttnSt<DV>& st, float mfix  ) { st.m = mfix; st.l = 0.f;
#pragma unroll
    for (int n = 0; n < DV / 16; ++n) st.o[n] = (f32x4){0.f, 0.f, 0.f, 0.f}; }
template <int DV> __device__ __forceinline__ void attn_store(AttnSt<DV>& st, bf16* orow  , int q) {
    const float il = __builtin_amdgcn_rcpf(q4_sum(st.l));
#pragma unroll
    for (int n = 0; n < DV / 16; ++n) st4bf(orow + 16 * n + 4 * q, st.o[n][0] * il, st.o[n][1] * il, st.o[n][2] * il, st.o[n][3] * il);
}
constexpr int NA_TILE = 2 * 9216;
__device__ __forceinline__ void na_tile_load(Frame& F, u32x4 (&st)[2], int b, int h, int key0) {
    const int kr = F.tid >> 3, kc = (F.tid & 7) * 8;
    st[0] = *(const u32x4*)(NAK_ + ((size_t)b * TPB + key0 + kr) * 256 + h * 64 + kc);
    st[1] = *(const u32x4*)(NAVT_ + ((size_t)(b * 4 + h) * 64 + kr) * TPB + key0 + kc);
}
__device__ __forceinline__ void na_tile_write(Frame& F, const u32x4 (&st)[2], int buf) {
    const int kr = F.tid >> 3, kc = (F.tid & 7) * 8; LAS unsigned char* tb = F.lds + RING_OFF + buf * NA_TILE;
    *(LAS u32x4*)(tb + kr * 144 + kc * 2) = st[0]; *(LAS u32x4*)(tb + 9216 + kr * 144 + kc * 2) = st[1];
}
__device__ __forceinline__ void na_frag_lds(KvFrag<64, 64>& f, const LAS unsigned char* tb, int kl  , int r, int q) {
#pragma unroll
    for (int s = 0; s < 2; ++s) { f.k0[s] = *(const LAS bf16x8*)(tb + (kl + r) * 144 + 64 * s + 16 * q); f.k1[s] = *(const LAS bf16x8*)(tb + (kl + 16 + r) * 144 + 64 * s + 16 * q); }
#pragma unroll
    for (int n = 0; n < 4; ++n) { const LAS unsigned char* vr = tb + 9216 + (16 * n + r) * 144 + (kl + 4 * q) * 2; f.vlo[n] = *(const LAS u32x2*)vr; f.vhi[n] = *(const LAS u32x2*)(vr + 32); }
}
template <bool FIXM> __device__ __forceinline__ void na_block_unit(Frame& F, int l, int u, float mfix) {
    const int lane = F.lane, r = lane & 15, q = lane >> 4, rp = u & 7, h = (u >> 3) & 3, b = u >> 5;
    const int g0 = 4 * rp + 2 * (F.wave >> 2), cb = F.wave & 3;
    const size_t qrow = (size_t)b * TPB + g0 * 64 + cb * 16 + r;
    bf16x8 qa[2], qb[2];
#pragma unroll
    for (int s = 0; s < 2; ++s) { qa[s] = *(const bf16x8*)(NAQ_ + qrow * 256 + h * 64 + 32 * s + 8 * q); qb[s] = *(const bf16x8*)(NAQ_ + (qrow + 64) * 256 + h * 64 + 32 * s + 8 * q); }
    AttnSt<64> sa, sb2; attn_init(sa, FIXM ? mfix : -INFINITY); attn_init(sb2, FIXM ? mfix : -INFINITY);
    const int rsA = min(max(g0 - 4, 0), 24), rsB = min(max(g0 - 3, 0), 24), kb = min(max(cb * 16 - 8, 0), 32), qc = cb * 16 + r, cs = min(max(qc - 8, 0), 48);
    const int rs_lo = min(max(4 * rp - 4, 0), 24), rs_hi = min(max(4 * rp - 1, 0), 24), nloc = rs_hi + 8 - rs_lo, nst = nloc + 4;
    LAS float* rpbs = (LAS float*)(F.lds + RING_OFF + 2 * NA_TILE);
    for (int i = F.tid; i < 15 * 31; i += 512) rpbs[i] = na_rpb_[(size_t)(l * 4 + h) * 15 * 31 + i] * LOG2E;
    const LAS float* rpbA = rpbs + (7 - g0) * 31;
    u32x4 stg[2], stg1[2], stg2[2];
#define NA_KEY0(jj) ((jj) < nloc ? (rs_lo + (jj)) * 64 : SEQ + 64 * ((jj) - nloc))
    na_tile_load(F, stg, b, h, NA_KEY0(0)); na_tile_load(F, stg1, b, h, NA_KEY0(1)); na_tile_load(F, stg2, b, h, NA_KEY0(2));
    for (int j = 0; j < nst; ++j) {
        na_tile_write(F, stg, j & 1);
        LDS_WAIT(); __syncthreads();
        stg[0] = stg1[0]; stg[1] = stg1[1]; stg1[0] = stg2[0]; stg1[1] = stg2[1];
        if (j + 3 < nst) na_tile_load(F, stg2, b, h, NA_KEY0(j + 3));
        const LAS unsigned char* tb = F.lds + RING_OFF + (j & 1) * NA_TILE;
        KvFrag<64, 64> f;
        if (j < nloc) { const int kr = rs_lo + j; const bool inA = kr >= rsA && kr < rsA + 8, inB = kr >= rsB && kr < rsB + 8;
            if (inA || inB) { na_frag_lds(f, tb, kb, r, q);
                if (inA) attn_math32<64, 64, true, FIXM, const LAS float*>(sa, qa, f, q, rpbA + kr * 31, kb, qc, cs);
                if (inB) attn_math32<64, 64, true, FIXM, const LAS float*>(sb2, qb, f, q, rpbA + (kr - 1) * 31, kb, qc, cs); }
        } else {
            na_frag_lds(f, tb, 0, r, q); attn_math32<64, 64, false, FIXM>(sa, qa, f, q, nullptr, 0, 0, 0); attn_math32<64, 64, false, FIXM>(sb2, qb, f, q, nullptr, 0, 0, 0);
            na_frag_lds(f, tb, 32, r, q); attn_math32<64, 64, false, FIXM>(sa, qa, f, q, nullptr, 0, 0, 0); attn_math32<64, 64, false, FIXM>(sb2, qb, f, q, nullptr, 0, 0, 0);
        }
    }
    attn_store(sa, ATT_ + qrow * DM + h * 64, q); attn_store(sb2, ATT_ + (qrow + 64) * DM + h * 64, q);
    LDS_WAIT(); __syncthreads();
#undef NA_KEY0
}
template <bool FIXM> __device__ __forceinline__ void ctx_block_unit(Frame& F, int u, float mfix) {
    const int lane = F.lane, r = lane & 15, q = lane >> 4, h = u & 3, b = u >> 2;
    const size_t qrow0 = (size_t)b * TPB + SEQ + 32 * F.wave + r;
    bf16x8 qa[2], qb[2];
#pragma unroll
    for (int s = 0; s < 2; ++s) { qa[s] = *(const bf16x8*)(NAQ_ + qrow0 * 256 + h * 64 + 32 * s + 8 * q); qb[s] = *(const bf16x8*)(NAQ_ + (qrow0 + 16) * 256 + h * 64 + 32 * s + 8 * q); }
    AttnSt<64> sa, sb2; attn_init(sa, FIXM ? mfix : -INFINITY); attn_init(sb2, FIXM ? mfix : -INFINITY);
    u32x4 stg[2], stg1[2], stg2[2];
    na_tile_load(F, stg, b, h, SEQ); na_tile_load(F, stg1, b, h, SEQ + 64); na_tile_load(F, stg2, b, h, SEQ + 128);
    for (int j = 0; j < 4; ++j) {
        na_tile_write(F, stg, j & 1);
        LDS_WAIT(); __syncthreads();
        stg[0] = stg1[0]; stg[1] = stg1[1]; stg1[0] = stg2[0]; stg1[1] = stg2[1];
        if (j == 0) na_tile_load(F, stg2, b, h, SEQ + 192);
        const LAS unsigned char* tb = F.lds + RING_OFF + (j & 1) * NA_TILE;
        KvFrag<64, 64> f;
        na_frag_lds(f, tb, 0, r, q); attn_math32<64, 64, false, FIXM>(sa, qa, f, q, nullptr, 0, 0, 0); attn_math32<64, 64, false, FIXM>(sb2, qb, f, q, nullptr, 0, 0, 0);
        na_frag_lds(f, tb, 32, r, q); attn_math32<64, 64, false, FIXM>(sa, qa, f, q, nullptr, 0, 0, 0); attn_math32<64, 64, false, FIXM>(sb2, qb, f, q, nullptr, 0, 0, 0);
    }
    attn_store(sa, ATT_ + qrow0 * DM + h * 64, q); attn_store(sb2, ATT_ + (qrow0 + 16) * DM + h * 64, q);
    LDS_WAIT(); __syncthreads();
}

struct BgConv { int next; unsigned char* pend; };
constexpr int BG_G1 = NEXP * 32 * 16, BG_G2 = NEXP * 16 * 16, BG_NG = BG_G1 + BG_G2;
constexpr int BG_LDS = 69632;
static_assert(BG_LDS + 8 * 8192 <= MISC_OFF, "background slots");
__device__ __forceinline__ void bg_issue(Frame& F, int l, BgConv& bg, int lane) {
    const int G = F.gw + (bg.next >> 1) * F.ngw, sub = bg.next & 1;
    if (G >= BG_NG) return;
    ++bg.next;
    const float* src; int ld;
    if (G < BG_G1) { const int le = G >> 9, q = G & 511, k0 = (q >> 5) * 64 + sub * 32, nb = q & 31, n0 = nb * 64, pn = n0 >> 8, j = n0 & 255; const int sc = j < 128 ? 128 * pn + j : 1024 + 128 * pn + (j - 128);
        src = w_moe1_ + ((size_t)(l * NEXP + le) * 1024 + k0 + (lane >> 4)) * 2048 + sc + (lane & 15) * 4; ld = 2048;
        bg.pend = (unsigned char*)W1_ + ((size_t)(l * NEXP + le) * 2048 + n0 + lane) * 1024 + k0; }
    else { const int G2 = G - BG_G1, le = G2 >> 8, q = G2 & 255, k0 = (q >> 4) * 64 + sub * 32, nb = q & 15, n0 = nb * 64;
        src = w_moe2_ + ((size_t)(l * NEXP + le) * 1024 + k0 + (lane >> 4)) * 1024 + n0 + (lane & 15) * 4; ld = 1024;
        bg.pend = (unsigned char*)W2_ + ((size_t)(l * NEXP + le) * 1024 + n0 + lane) * 1024 + k0; }
    LAS unsigned char* lb = F.lds + RING_OFF + BG_LDS + F.wave * 8192;
#pragma unroll
    for (int i = 0; i < 8; ++i) __builtin_amdgcn_global_load_lds((const unsigned*)(src + (size_t)(4 * i) * ld), (LAS unsigned*)(lb + i * 1024), 16, 0, 0);
}
__device__ __forceinline__ void bg_finish(Frame& F, BgConv& bg, int lane) {
    if (!bg.pend) return;
    const LAS float* lb = (const LAS float*)(F.lds + RING_OFF + BG_LDS + F.wave * 8192) + lane;
#pragma unroll
    for (int h = 0; h < 2; ++h) { float v[16];
#pragma unroll
        for (int i = 0; i < 16; ++i) v[i] = lb[(16 * h + i) * 64] * SC_W;
        u32x4 o; o.x = pk4f8(v[0], v[1], v[2], v[3]); o.y = pk4f8(v[4], v[5], v[6], v[7]); o.z = pk4f8(v[8], v[9], v[10], v[11]); o.w = pk4f8(v[12], v[13], v[14], v[15]);
        *(u32x4*)(bg.pend + 16 * h) = o; }
    bg.pend = nullptr;
    LDS_WAIT(); __builtin_amdgcn_sched_barrier(0);
}
__device__ __forceinline__ void bg_drain(Frame& F, int l, BgConv& bg) {
    for (;;) { VM_WAIT(); bg_finish(F, bg, F.lane); bg_issue(F, l, bg, F.lane); if (!bg.pend) break; }
}

namespace fa {
constexpr int   D = 128, NW = 8, QBLK = 32, KVBLK = 64;
constexpr float SCALE = 0.10206207261596575f;
constexpr float THR = 8.f;
constexpr int   SDEPTH = 2;
constexpr int   DQK = 96, LDQ = 384, LDKK = 384, LDK = 512, LDO = 1024;
constexpr size_t SHM_V = KVBLK * D * 2, SHM_K = KVBLK * D * 2, SHM_ATTN = 2 * SHM_V + 2 * SHM_K + NW * 64 * 4;
using s16x4  = __attribute__((ext_vector_type(4))) short;
using f32x16 = __attribute__((ext_vector_type(16))) float;
#define KSWZ(row, colB) ((row) * 256 + ((colB) ^ (((row) & 7) << 4)))
#define SBAR() __builtin_amdgcn_sched_barrier(0)
__device__ __forceinline__ int crow(int r, int hi) { return (r & 3) + 8 * (r >> 2) + 4 * hi; }
__device__ __forceinline__ unsigned cvtpk(float lo, float hi) { unsigned r; asm volatile("v_cvt_pk_bf16_f32 %0, %1, %2" : "=v"(r) : "v"(lo), "v"(hi)); return r; }
__device__ __forceinline__ void partialSM(f32x16& p0, f32x16& p1, float& m_reg, float& mn, float& alpha) {
  constexpr float C = SCALE * 1.4426950408889634f;
  float pmax = p0[0]; for (int r = 1; r < 16; ++r) pmax = fmaxf(pmax, p0[r]); for (int r = 0; r < 16; ++r) pmax = fmaxf(pmax, p1[r]);
  { auto rr = __builtin_amdgcn_permlane32_swap(__float_as_uint(pmax), __float_as_uint(pmax), false, false);
    pmax = fmaxf(__uint_as_float(rr[0]), __uint_as_float(rr[1])); }
  if (__builtin_expect(__all(pmax - m_reg <= THR / SCALE), 1)) { mn = m_reg; alpha = 1.f; }
  else { mn = fmaxf(m_reg, pmax); alpha = __builtin_amdgcn_exp2f((m_reg - mn) * C); m_reg = mn; }
  float mnC = -mn * C;
  for (int r = 0; r < 16; ++r) p0[r] = fmaf(p0[r], C, mnC); for (int r = 0; r < 16; ++r) p1[r] = fmaf(p1[r], C, mnC);
  for (int r = 0; r < 16; ++r) p0[r] = __builtin_amdgcn_exp2f(p0[r]);
}
__device__ __forceinline__ void finishSM(f32x16& p0, f32x16& p1, float alpha, float& l_reg, bf16x8& pa0, bf16x8& pa1, bf16x8& pa2, bf16x8& pa3) {
  for (int r = 0; r < 16; ++r) p1[r] = __builtin_amdgcn_exp2f(p1[r]);
  float ps = 0; for (int r = 0; r < 16; ++r) ps += p0[r]; for (int r = 0; r < 16; ++r) ps += p1[r];
  { auto rr = __builtin_amdgcn_permlane32_swap(__float_as_uint(ps), __float_as_uint(ps), false, false);
    ps = __uint_as_float(rr[0]) + __uint_as_float(rr[1]); }
  l_reg = l_reg * alpha + ps;
#define PK4(P, BASE, OUT) do { unsigned a0 = cvtpk(P[BASE + 0], P[BASE + 1]), a1 = cvtpk(P[BASE + 2], P[BASE + 3]);   \
    unsigned b0 = cvtpk(P[BASE + 4], P[BASE + 5]), b1 = cvtpk(P[BASE + 6], P[BASE + 7]);                              \
    auto r0 = __builtin_amdgcn_permlane32_swap(a0, b0, false, false); auto r1 = __builtin_amdgcn_permlane32_swap(a1, b1, false, false); \
    u32x4 w = {r0[0], r1[0], r0[1], r1[1]}; OUT = *reinterpret_cast<bf16x8*>(&w); } while (0)
  PK4(p0, 0, pa0); PK4(p0, 8, pa1); PK4(p1, 0, pa2); PK4(p1, 8, pa3);
#undef PK4
}
__device__ __forceinline__ void qkt(f32x16& p0, f32x16& p1, const bf16* Ks, const bf16x8* qr, int r32, int hi) {
  p0 = f32x16{}; p1 = f32x16{};
  for (int d0 = 0; d0 < DQK / 16; ++d0) { int cb = (d0 * 16 + hi * 8) * 2;
    bf16x8 b0 = *reinterpret_cast<const bf16x8*>((const char*)Ks + KSWZ(r32, cb));
    bf16x8 b1 = *reinterpret_cast<const bf16x8*>((const char*)Ks + KSWZ(32 + r32, cb));
    p0 = __builtin_amdgcn_mfma_f32_32x32x16_bf16(b0, qr[d0], p0, 0, 0, 0);
    p1 = __builtin_amdgcn_mfma_f32_32x32x16_bf16(b1, qr[d0], p1, 0, 0, 0); }
}
__device__ __forceinline__ int v_st(int k, int c) { const int kk = (k & ~0xC) | ((k & 4) << 1) | ((k & 8) >> 1); return ((kk >> 3) * 4 + (c >> 5)) * 512 + ((kk & 7) * 32 + (c & 31)) * 2; }
__device__ __forceinline__ int v_rd_base(int lane) { return ((lane & 3) << 3) | (((lane >> 2) & 3) << 6) | (((lane >> 4) & 1) << 5) | (((lane >> 5) & 1) << 8); }
constexpr int v_rd_off(int d0, int ks, int half) { return d0 * 512 + ks * 4096 + half * 2048; }
template <int OFF> __device__ __forceinline__ s16x4 tr_read(int vb) {
  s16x4 r; asm volatile("ds_read_b64_tr_b16 %0, %1 offset:%2" : "=&v"(r) : "v"(vb), "i"(OFF) : "memory"); return r;
}
template <int D0> __device__ __forceinline__ void pv_one(f32x16& od, int vb, bf16x8 pa0, bf16x8 pa1, bf16x8 pa2, bf16x8 pa3) {
  const s16x4 l0 = tr_read<v_rd_off(D0, 0, 0)>(vb), h0 = tr_read<v_rd_off(D0, 0, 1)>(vb), l1 = tr_read<v_rd_off(D0, 1, 0)>(vb), h1 = tr_read<v_rd_off(D0, 1, 1)>(vb);
  const s16x4 l2 = tr_read<v_rd_off(D0, 2, 0)>(vb), h2 = tr_read<v_rd_off(D0, 2, 1)>(vb), l3 = tr_read<v_rd_off(D0, 3, 0)>(vb), h3 = tr_read<v_rd_off(D0, 3, 1)>(vb);
  asm volatile("s_waitcnt lgkmcnt(0)" ::: "memory"); SBAR();
#define PK(L, H) (bf16x8){L[0], L[1], L[2], L[3], H[0], H[1], H[2], H[3]}
  od = __builtin_amdgcn_mfma_f32_32x32x16_bf16(pa0, PK(l0, h0), od, 0, 0, 0);
  od = __builtin_amdgcn_mfma_f32_32x32x16_bf16(pa1, PK(l1, h1), od, 0, 0, 0);
  od = __builtin_amdgcn_mfma_f32_32x32x16_bf16(pa2, PK(l2, h2), od, 0, 0, 0);
  od = __builtin_amdgcn_mfma_f32_32x32x16_bf16(pa3, PK(l3, h3), od, 0, 0, 0);
#undef PK
}
__device__ __forceinline__ void pv_d0(f32x16* o, int vb, bf16x8 pa0, bf16x8 pa1, bf16x8 pa2, bf16x8 pa3) {
  pv_one<0>(o[0], vb, pa0, pa1, pa2, pa3); pv_one<1>(o[1], vb, pa0, pa1, pa2, pa3); pv_one<2>(o[2], vb, pa0, pa1, pa2, pa3); pv_one<3>(o[3], vb, pa0, pa1, pa2, pa3);
}
__device__ __forceinline__ void attn_dense_body(const bf16* __restrict__ Qb, const bf16* __restrict__ Kh, const bf16* __restrict__ Vh, bf16* __restrict__ Ob, int seq, char* lds, const int tid, Frame& F, const int lyr, BgConv& bg) {
  const int wid = tid >> 6, lane = tid & 63, r32 = lane & 31, hi = lane >> 5;
  bf16* V_lds = (bf16*)lds; bf16* K_lds = (bf16*)(lds + 2 * SHM_V);
  float* ws = (float*)(lds + 2 * SHM_V + 2 * SHM_K) + wid * 64; float* li_l = ws; float* al_l = ws + 32;
  float m_reg = -1e30f, l_reg = 0; f32x16 o[4] = {}; bf16x8 qr[DQK / 16];
  const bf16* Qw = Qb + (long)(wid * QBLK + r32) * LDQ + hi * 8;
#pragma unroll
  for (int d0 = 0; d0 < DQK / 16; ++d0) qr[d0] = *reinterpret_cast<const bf16x8*>(Qw + d0 * 16);
  const int sr = tid >> 4, sc = (tid & 15) * 8, vst0 = v_st(sr, sc), vst1 = v_st(32 + sr, sc);
  const int vb0 = (int)(uintptr_t)V_lds + v_rd_base(lane);
  struct { bf16x8 vs0, vs1, ks0, ks1; } sr_[SDEPTH];
  const unsigned soff = (unsigned)(sr * LDK + sc) * 2u, soffk = (unsigned)(sr * LDKK + (sc < DQK ? sc : 0)) * 2u;
#define SLOAD(i, k0) do { const char* vt_ = (const char*)Vh + (size_t)(k0) * (LDK * 2); const char* kt_ = (const char*)Kh + (size_t)(k0) * (LDKK * 2);   \
    sr_[i].vs0 = *reinterpret_cast<const bf16x8*>(vt_ + soff); sr_[i].vs1 = *reinterpret_cast<const bf16x8*>(vt_ + 32 * LDK * 2 + soff); \
    sr_[i].ks0 = *reinterpret_cast<const bf16x8*>(kt_ + soffk); sr_[i].ks1 = *reinterpret_cast<const bf16x8*>(kt_ + 32 * LDKK * 2 + soffk); } while (0)
#define SWRITE(b, i) do { *(bf16x8*)((char*)V_lds + (b) * SHM_V + vst0) = sr_[i].vs0;          \
    *(bf16x8*)((char*)V_lds + (b) * SHM_V + vst1) = sr_[i].vs1; int kc = sc * 2;               \
    *(bf16x8*)((char*)K_lds + (b) * SHM_K + KSWZ(sr, kc)) = sr_[i].ks0;                       \
    *(bf16x8*)((char*)K_lds + (b) * SHM_K + KSWZ(32 + sr, kc)) = sr_[i].ks1; } while (0)
#define SWAIT() do { if constexpr (SDEPTH == 2) asm volatile("s_waitcnt vmcnt(4)" ::: "memory"); else asm volatile("s_waitcnt vmcnt(0)" ::: "memory"); } while (0)
#define RESC(a) do { if (__any((a) < 1.f)) { if (hi == 0) al_l[r32] = (a); asm volatile("s_waitcnt lgkmcnt(0)" ::: "memory"); \
    for (int d = 0; d < 4; ++d) for (int r = 0; r < 16; ++r) o[d][r] *= al_l[crow(r, hi)]; } } while (0)
  f32x16 pA0, pA1, pB0, pB1; float mnA, mnB, alA, alB; bf16x8 pa0, pa1, pa2, pa3; const int NT = seq / KVBLK;
  constexpr int SE = 0, SO = SDEPTH - 1;
  SLOAD(SE, 0); asm volatile("s_waitcnt vmcnt(0)" ::: "memory"); SWRITE(0, SE); __syncthreads();
  qkt(pA0, pA1, K_lds, qr, r32, hi); partialSM(pA0, pA1, m_reg, mnA, alA);
  SLOAD(SO, KVBLK); if constexpr (SDEPTH == 2) { if (2 < NT) SLOAD(SE, 2 * KVBLK); }
  SWAIT(); SWRITE(1, SO); __syncthreads();
  for (int j = 1; j + 1 < NT; j += 2) {
    bg_finish(F, bg, lane);
    if ((j >> 1) % 3 != 2) bg_issue(F, lyr, bg, lane);
    SBAR(); qkt(pB0, pB1, (bf16*)((char*)K_lds + SHM_K), qr, r32, hi);
    finishSM(pA0, pA1, alA, l_reg, pa0, pa1, pa2, pa3); SBAR();
    SLOAD(SO, (j + SDEPTH) * KVBLK); SBAR();
    pv_d0(o, vb0, pa0, pa1, pa2, pa3); partialSM(pB0, pB1, m_reg, mnB, alB);
    __syncthreads(); SWAIT(); SWRITE(0, SE);
    RESC(alB); __syncthreads();
    SBAR(); qkt(pA0, pA1, K_lds, qr, r32, hi);
    finishSM(pB0, pB1, alB, l_reg, pa0, pa1, pa2, pa3); SBAR();
    if (SDEPTH == 1 || j + 3 < NT) SLOAD(SE, (j + 1 + SDEPTH) * KVBLK); SBAR();
    pv_d0(o, vb0 + (int)SHM_V, pa0, pa1, pa2, pa3); partialSM(pA0, pA1, m_reg, mnA, alA);
    __syncthreads(); SWAIT(); SWRITE(1, SO);
    RESC(alA); __syncthreads();
  }
  SBAR(); qkt(pB0, pB1, (bf16*)((char*)K_lds + SHM_K), qr, r32, hi);
  finishSM(pA0, pA1, alA, l_reg, pa0, pa1, pa2, pa3); SBAR();
  pv_d0(o, vb0, pa0, pa1, pa2, pa3); partialSM(pB0, pB1, m_reg, mnB, alB);
  __syncthreads(); RESC(alB);
  finishSM(pB0, pB1, alB, l_reg, pa0, pa1, pa2, pa3); SBAR();
  pv_d0(o, vb0 + (int)SHM_V, pa0, pa1, pa2, pa3);
  if (hi == 0) li_l[r32] = l_reg; asm volatile("s_waitcnt lgkmcnt(0)" ::: "memory");
  int ln2; asm volatile("v_mbcnt_lo_u32_b32 %0, -1, 0\n\tv_mbcnt_hi_u32_b32 %0, -1, %0" : "=v"(ln2)); ln2 &= 63;
  const int r32e = ln2 & 31, hie = ln2 >> 5;
  float rli[16];
#pragma unroll
  for (int r = 0; r < 16; ++r) rli[r] = __builtin_amdgcn_rcpf(li_l[crow(r, hie)]);
  bf16* Ow = Ob + (long)(wid * QBLK) * LDO;
#pragma unroll
  for (int r = 0; r < 16; ++r) { const unsigned eo = (unsigned)(crow(r, hie) * LDO + r32e);
    for (int d0 = 0; d0 < 4; ++d0) Ow[eo + d0 * 32] = (bf16)(cvtpk(o[d0][r] * rli[r], 0.f) & 0xffffu); }
  if (bg.pend) { asm volatile("s_waitcnt vmcnt(0)" ::: "memory"); bg_finish(F, bg, lane); }
  __syncthreads();
#undef SLOAD
#undef SWRITE
#undef SWAIT
#undef RESC
}
#undef KSWZ
#undef SBAR
}

constexpr int GL_Q = 0, GL_K = 2048, GL_V = 4096, GL_EF = 8192, GL_EB = 10240, GL_OF = 12288, GL_OB = 16384;
__device__ __forceinline__ int gla_dirchunk(int dir, int tc) { return dir == 0 ? tc : (tc < 4 ? 3 - tc : 39 - tc); }
__device__ __forceinline__ void gla_stage_load(Frame& F, u32x4 (&st)[4], int b, int h, int tc) {
    const size_t row0 = (size_t)b * TPB + (tc < 4 ? SEQ + 64 * tc : 64 * (tc - 4));
#pragma unroll
    for (int k = 0; k < 4; ++k) { const int pid = F.tid + 512 * k, r = pid >> 5, j = pid & 31; const size_t row = row0 + r; const void* src;
        if (j < 4)       src = Z_ + row * ZC + Z_GQ + h * 32 + 8 * j;
        else if (j < 8)  src = Z_ + row * ZC + Z_GK + h * 32 + 8 * (j - 4);
        else if (j < 16) src = Z_ + row * ZC + Z_GV + h * 64 + 8 * (j - 8);
        else if (j < 24) src = EGF_ + row * 128 + h * 32 + 4 * (j - 16);
        else             src = EGB_ + row * 128 + h * 32 + 4 * (j - 24);
        st[k] = *(const u32x4*)src; }
}
__device__ __forceinline__ void gla_stage_write(Frame& F, const u32x4 (&st)[4]) {
    LAS float* sm = (LAS float*)(F.lds + RING_OFF);
#pragma unroll
    for (int k = 0; k < 4; ++k) { const int pid = F.tid + 512 * k, r = pid >> 5, j = pid & 31;
        if (j < 16) { LAS float* dst = j < 4 ? sm + GL_Q + r * 32 + 8 * j : j < 8 ? sm + GL_K + r * 32 + 8 * (j - 4) : sm + GL_V + r * 64 + 8 * (j - 8);
            const float sc = j < 4 ? 0.17677669529663687f : 1.0f; float f[4], g[4]; u32x2 lo, hi; lo.x = st[k].x; lo.y = st[k].y; hi.x = st[k].z; hi.y = st[k].w; up4(lo, f); up4(hi, g);
            *(LAS f32x4*)dst = (f32x4){f[0], f[1], f[2], f[3]} * sc; *(LAS f32x4*)(dst + 4) = (f32x4){g[0], g[1], g[2], g[3]} * sc; }
        else { LAS float* dst = j < 24 ? sm + GL_EF + r * 32 + 4 * (j - 16) : sm + GL_EB + r * 32 + 4 * (j - 24); *(LAS u32x4*)dst = st[k]; } }
}
constexpr int GB_O = 0, GB_QS = 49152, GB_KT = GB_QS + 2 * 5120, GB_QE = GB_KT + 2 * 5120, GB_VT = GB_QE + 2 * 5120, GB_S0 = GB_VT + 2 * 9216, GB_END = GB_S0 + 2 * 5120;
static_assert(GB_END <= MISC_OFF, "GLA LDS map");
template <int N> __device__ __forceinline__ float dpp_shr(float v) { return __int_as_float(__builtin_amdgcn_update_dpp(0, __float_as_int(v), 0x110 + N, 0xF, 0xF, false)); }
__device__ __forceinline__ void gla_compute(Frame& F, int l, int b, int h, int tc, bool outputs) {
    LAS float* sm = (LAS float*)(F.lds + RING_OFF); LAS unsigned char* sb = F.lds + RING_OFF;
    const size_t row0 = (size_t)b * TPB + (tc < 4 ? SEQ + 64 * tc : 64 * (tc - 4));
    const int lane = F.lane, wdir = F.wave >> 2, wsub = F.wave & 3;
    float s0pre[8]; u32x4 gpre = {0u, 0u, 0u, 0u}; f32x4 gnpre0 = {0.f, 0.f, 0.f, 0.f}, gnpre1 = gnpre0;
    if (outputs) { const int dir = F.tid >> 8, e = (F.tid >> 2) & 63, dq = F.tid & 3;
        const float* ps = OGF_ + ((size_t)((b * 4 + h) * 2 + dir) * 36 + gla_dirchunk(dir, tc)) * 2048 + (size_t)(8 * dq) * 64 + e;
#pragma unroll
        for (int i = 0; i < 8; ++i) s0pre[i] = __hip_atomic_load(ps + i * 64, __ATOMIC_RELAXED, __HIP_MEMORY_SCOPE_AGENT);
        gpre = *(const u32x4*)(Z_ + (row0 + (F.tid >> 3)) * ZC + Z_GO + h * 64 + (F.tid & 7) * 8);
        gnpre0 = *(const f32x4*)(gla_o_norm_ + l * 64 + (F.tid & 7) * 8); gnpre1 = *(const f32x4*)(gla_o_norm_ + l * 64 + (F.tid & 7) * 8 + 4); }
    { const int t = wdir ? 63 - lane : lane; LAS float* gp = sm + (wdir ? GL_EB : GL_EF) + t * 32 + 8 * wsub;
#pragma unroll
      for (int i = 0; i < 8; ++i) { float x = gp[i]; x += dpp_shr<1>(x); x += dpp_shr<2>(x); x += dpp_shr<4>(x); x += dpp_shr<8>(x);
          const float t0 = rl_f(x, 15), t1 = rl_f(x, 31), t2 = rl_f(x, 47);
          x += (lane >= 16 ? t0 : 0.f) + (lane >= 32 ? t1 : 0.f) + (lane >= 48 ? t2 : 0.f); gp[i] = x; } }
    LDS_WAIT(); __syncthreads();
    { const int dir = F.tid >> 8, o = (F.tid >> 2) & 63, dq = F.tid & 3, t = dir ? 63 - o : o;
      const LAS float* Bp = sm + (dir ? GL_EB : GL_EF) + 8 * dq; const int tm = dir ? 32 : 31, te = dir ? 0 : 63;
      float Bt[8], Bm[8], Be[8], qv[8], kv[8];
#pragma unroll
      for (int i = 0; i < 8; i += 4) { *(f32x4*)(Bt + i) = *(const LAS f32x4*)(Bp + t * 32 + i); *(f32x4*)(Bm + i) = *(const LAS f32x4*)(Bp + tm * 32 + i); *(f32x4*)(Be + i) = *(const LAS f32x4*)(Bp + te * 32 + i);
          *(f32x4*)(qv + i) = *(const LAS f32x4*)(sm + GL_Q + t * 32 + 8 * dq + i); *(f32x4*)(kv + i) = *(const LAS f32x4*)(sm + GL_K + t * 32 + 8 * dq + i); }
      if (outputs) {
          float qs[8], kt[8], qe[8];
#pragma unroll
          for (int i = 0; i < 8; ++i) { qs[i] = qv[i] * __expf(Bt[i] - Bm[i]); kt[i] = kv[i] * __expf(Bm[i] - Bt[i]); qe[i] = qv[i] * __expf(Bt[i]); }
          u32x4 w; w.x = pk2(qs[0], qs[1]); w.y = pk2(qs[2], qs[3]); w.z = pk2(qs[4], qs[5]); w.w = pk2(qs[6], qs[7]); *(LAS u32x4*)(sb + GB_QS + dir * 5120 + o * 80 + 16 * dq) = w;
          w.x = pk2(kt[0], kt[1]); w.y = pk2(kt[2], kt[3]); w.z = pk2(kt[4], kt[5]); w.w = pk2(kt[6], kt[7]); *(LAS u32x4*)(sb + GB_KT + dir * 5120 + o * 80 + 16 * dq) = w;
          w.x = pk2(qe[0], qe[1]); w.y = pk2(qe[2], qe[3]); w.z = pk2(qe[4], qe[5]); w.w = pk2(qe[6], qe[7]); *(LAS u32x4*)(sb + GB_QE + dir * 5120 + o * 80 + 16 * dq) = w;
      } else {
#pragma unroll
          for (int i = 0; i < 8; ++i) *(LAS bf16*)(sb + GB_KT + dir * 5120 + (8 * dq + i) * 144 + 2 * o) = (bf16)f2bf(kv[i] * __expf(Be[i] - Bt[i]));
          if (o == 63) { const size_t sidx = (size_t)((b * 4 + h) * 2 + dir) * 36 + gla_dirchunk(dir, tc); float* ad = AD_ + sidx * 32 + 8 * dq;
#pragma unroll
              for (int i = 0; i < 8; ++i) ad[i] = __expf(Be[i]); }
      } }
    { const int dir = F.tid >> 8, e = F.tid & 63, og = (F.tid >> 6) & 3;
      float vv[16];
#pragma unroll
      for (int k = 0; k < 16; ++k) { const int o = 16 * og + k, t = dir ? 63 - o : o; vv[k] = sm[GL_V + t * 64 + e]; }
      u32x4 w0, w1; w0.x = pk2(vv[0], vv[1]); w0.y = pk2(vv[2], vv[3]); w0.z = pk2(vv[4], vv[5]); w0.w = pk2(vv[6], vv[7]); w1.x = pk2(vv[8], vv[9]); w1.y = pk2(vv[10], vv[11]); w1.z = pk2(vv[12], vv[13]); w1.w = pk2(vv[14], vv[15]);
      LAS unsigned char* vp = sb + GB_VT + dir * 9216 + e * 144 + 32 * og; *(LAS u32x4*)vp = w0; *(LAS u32x4*)(vp + 16) = w1; }
    if (outputs) {
        const int dir = F.tid >> 8, e = (F.tid >> 2) & 63, dq = F.tid & 3;
        u32x4 w; w.x = pk2(s0pre[0], s0pre[1]); w.y = pk2(s0pre[2], s0pre[3]); w.z = pk2(s0pre[4], s0pre[5]); w.w = pk2(s0pre[6], s0pre[7]); *(LAS u32x4*)(sb + GB_S0 + dir * 5120 + e * 80 + 16 * dq) = w;
    }
    LDS_WAIT(); __syncthreads();
    const int r = lane & 15, q = lane >> 4;
    if (outputs) {
        const int dir = wdir, tt = wsub; const LAS unsigned char* qsb = sb + GB_QS + dir * 5120; const LAS unsigned char* ktb = sb + GB_KT + dir * 5120;
        const LAS unsigned char* vtb = sb + GB_VT + dir * 9216; const LAS unsigned char* s0b = sb + GB_S0 + dir * 5120;
        f32x4 acc[4];
#pragma unroll
        for (int n = 0; n < 4; ++n) acc[n] = (f32x4){0.f, 0.f, 0.f, 0.f};
        const bf16x8 qsf = *(const LAS bf16x8*)(qsb + (16 * tt + r) * 80 + 16 * q);
        const int to = 16 * tt + r;
        for (int sp = 0; sp <= (tt >> 1); ++sp) {
            const bf16x8 k0 = *(const LAS bf16x8*)(ktb + (32 * sp + r) * 80 + 16 * q), k1 = *(const LAS bf16x8*)(ktb + (32 * sp + 16 + r) * 80 + 16 * q);
            f32x4 s0 = MFMA16(k0, qsf, ((f32x4){0.f, 0.f, 0.f, 0.f})), s1 = MFMA16(k1, qsf, ((f32x4){0.f, 0.f, 0.f, 0.f}));
#pragma unroll
            for (int i = 0; i < 4; ++i) { const int so = 32 * sp + 4 * q + i; s0[i] = so <= to ? s0[i] : 0.f; s1[i] = so + 16 <= to ? s1[i] : 0.f; }
            u32x4 pw; pw.x = pk2(s0[0], s0[1]); pw.y = pk2(s0[2], s0[3]); pw.z = pk2(s1[0], s1[1]); pw.w = pk2(s1[2], s1[3]);
            const bf16x8 pf = __builtin_bit_cast(bf16x8, pw);
#pragma unroll
            for (int n = 0; n < 4; ++n) { const LAS unsigned char* vr = vtb + (16 * n + r) * 144 + (32 * sp + 4 * q) * 2; const u32x2 lo = *(const LAS u32x2*)vr, hi = *(const LAS u32x2*)(vr + 32);
                u32x4 aw; aw.x = lo.x; aw.y = lo.y; aw.z = hi.x; aw.w = hi.y; acc[n] = MFMA16(__builtin_bit_cast(bf16x8, aw), pf, acc[n]); }
        }
        const bf16x8 qef = *(const LAS bf16x8*)(sb + GB_QE + dir * 5120 + (16 * tt + r) * 80 + 16 * q);
#pragma unroll
        for (int n = 0; n < 4; ++n) acc[n] = MFMA16(*(const LAS bf16x8*)(s0b + (16 * n + r) * 80 + 16 * q), qef, acc[n]);
        const int t = dir ? 63 - to : to;
#pragma unroll
        for (int n = 0; n < 4; ++n) *(LAS f32x4*)(sb + GB_O + dir * 16384 + (t * 64 + 16 * n + 4 * q) * 4) = acc[n];
        LDS_WAIT(); __syncthreads();
        const int tk = F.tid >> 3, e8 = (F.tid & 7) * 8; const size_t row = row0 + tk; const LAS float* of = (const LAS float*)(sb + GB_O) + tk * 64 + e8;
        const f32x4 f0 = *(const LAS f32x4*)of, f1 = *(const LAS f32x4*)(of + 4), b0 = *(const LAS f32x4*)(of + 4096), b1 = *(const LAS f32x4*)(of + 4100);
        const f32x4 o0 = f0 + b0, o1 = f1 + b1;
        float ss = (o0[0] * o0[0] + o0[1] * o0[1]) + (o0[2] * o0[2] + o0[3] * o0[3]) + (o1[0] * o1[0] + o1[1] * o1[1]) + (o1[2] * o1[2] + o1[3] * o1[3]);
        ss = g8_sum(ss);
        const float rn = rsq(ss * (1.0f / 64) + EPS);
        const float gn[8] = {gnpre0[0], gnpre0[1], gnpre0[2], gnpre0[3], gnpre1[0], gnpre1[1], gnpre1[2], gnpre1[3]}; float g[4], g2[4]; { u32x2 glo, ghi; glo.x = gpre.x; glo.y = gpre.y; ghi.x = gpre.z; ghi.y = gpre.w; up4(glo, g); up4(ghi, g2); }
        float w[8];
#pragma unroll
        for (int i = 0; i < 4; ++i) { w[i] = o0[i] * rn * gn[i] * g[i] * __builtin_amdgcn_rcpf(1.0f + __expf(-g[i])); w[4 + i] = o1[i] * rn * gn[4 + i] * g2[i] * __builtin_amdgcn_rcpf(1.0f + __expf(-g2[i])); }
        u32x4 pw; pw.x = pk2(w[0], w[1]); pw.y = pk2(w[2], w[3]); pw.z = pk2(w[4], w[5]); pw.w = pk2(w[6], w[7]);
        *(u32x4*)(ATT_ + row * DM + 768 + h * 64 + e8) = pw;
    } else {
        const int dir = wdir, et = wsub; const LAS unsigned char* vtb = sb + GB_VT + dir * 9216; const LAS unsigned char* khb = sb + GB_KT + dir * 5120;
        float* cs = CS_ + ((size_t)((b * 4 + h) * 2 + dir) * 36 + gla_dirchunk(dir, tc)) * 2048;
#pragma unroll
        for (int dt = 0; dt < 2; ++dt) { f32x4 acc = (f32x4){0.f, 0.f, 0.f, 0.f};
#pragma unroll
            for (int ks = 0; ks < 2; ++ks) acc = MFMA16(*(const LAS bf16x8*)(vtb + (16 * et + r) * 144 + (32 * ks + 8 * q) * 2), *(const LAS bf16x8*)(khb + (16 * dt + r) * 144 + (32 * ks + 8 * q) * 2), acc);
            *(f32x4*)(cs + (size_t)(16 * dt + r) * 64 + 16 * et + 4 * q) = acc; }
    }
}
__device__ __forceinline__ void gla_pass(Frame& F, int l, bool outputs) {
    const int nch = (outputs && l == DEPTH - 1) ? 32 : 36, c0 = 36 - nch, ntot = BATCH * 4 * nch;
    const int upb = (ntot + F.G - 1) / F.G, u_lo = min(F.blk * upb, ntot), u_hi = min(u_lo + upb, ntot);
    if (outputs) {
        const int lane = F.lane, dir = F.wave >> 2, eblk = F.wave & 3, dq = lane >> 4, e = eblk * 16 + (lane & 15);
        float S[8];
#pragma unroll
        for (int i = 0; i < 8; ++i) S[i] = 0.f;
        int pbh = -1, pc = -2;
        for (int k = 0; k < u_hi - u_lo; ++k) {
            const int u = dir == 0 ? u_lo + k : u_hi - 1 - k, bh = u / nch, tc = c0 + (u - bh * nch), c = gla_dirchunk(dir, tc);
            const size_t sidx = (size_t)(bh * 2 + dir) * 36;
            int j0 = pc;
            if (!(bh == pbh && c == pc + 1)) { j0 = 0;
#pragma unroll
                for (int i = 0; i < 8; ++i) S[i] = 0.f; }
#pragma unroll 4
            for (int j = j0; j < c; ++j) { const float* ad = AD_ + (sidx + j) * 32 + 8 * dq; const float* csp = CS_ + (sidx + j) * 2048 + (size_t)(8 * dq) * 64 + e;
                const f32x4 a0 = *(const f32x4*)ad, a1 = *(const f32x4*)(ad + 4);
#pragma unroll
                for (int i = 0; i < 4; ++i) { S[i] = a0[i] * S[i] + csp[i * 64]; S[4 + i] = a1[i] * S[4 + i] + csp[(4 + i) * 64]; } }
            float* ps = OGF_ + (sidx + c) * 2048 + (size_t)(8 * dq) * 64 + e;
#pragma unroll
            for (int i = 0; i < 8; ++i) __hip_atomic_store(ps + i * 64, S[i], __ATOMIC_RELAXED, __HIP_MEMORY_SCOPE_AGENT);
            pbh = bh; pc = c;
        }
        VM_WAIT();
    }
    u32x4 st[4];
    if (u_lo < u_hi) { const int bh = u_lo / nch; gla_stage_load(F, st, bh >> 2, bh & 3, c0 + (u_lo - bh * nch)); }
    for (int u = u_lo; u < u_hi; ++u) {
        const int bh = u / nch, tc = c0 + (u - bh * nch);
        gla_stage_write(F, st);
        LDS_WAIT(); __syncthreads();
        if (u + 1 < u_hi) { const int bh2 = (u + 1) / nch; gla_stage_load(F, st, bh2 >> 2, bh2 & 3, c0 + (u + 1 - bh2 * nch)); }
        gla_compute(F, l, bh >> 2, bh & 3, tc, outputs);
        LDS_WAIT(); __syncthreads();
    }
}
__device__ __forceinline__ void pE1(Frame& F, int l) {
    for (int rp = 0; rp < NREP(14); ++rp) gla_pass(F, l, false);
    relane(F);
    float gq = fabsf(na_q_norm_[l * 64 + F.lane]), gk = fabsf(na_k_norm_[l * 64 + F.lane]), rb = 0.f;
#pragma unroll
    for (int k = 0; k < 8; ++k) { const int i4 = F.lane + 64 * k;
        if (i4 < 465) { const f32x4 v = *(const f32x4*)(na_rpb_ + (size_t)l * 4 * 15 * 31 + 4 * i4); rb = fmaxf(rb, fmaxf(fmaxf(fabsf(v[0]), fabsf(v[1])), fmaxf(fabsf(v[2]), fabsf(v[3])))); } }
    gq = wave_max(gq); gk = wave_max(gk); rb = wave_max(rb);
    const float mfix = (QS_NA * 64.0f * gq * gk + rb * LOG2E) * 1.01f + 0.125f;
    if (mfix <= 60.0f) {
        for (int rp = 0; rp < NREP(15); ++rp)
        for (int u = F.blk; u < BATCH * 4 * 8; u += F.G) na_block_unit<true>(F, l, u, mfix);
        if (l == 0) for (int u = F.G - 1 - F.blk; u < BATCH * 4; u += F.G) ctx_block_unit<false>(F, u, mfix);
    } else {
        for (int u = F.blk; u < BATCH * 4 * 8; u += F.G) na_block_unit<false>(F, l, u, 0.f);
        if (l == 0) for (int u = F.G - 1 - F.blk; u < BATCH * 4; u += F.G) ctx_block_unit<false>(F, u, 0.f);
    }
}
__device__ __forceinline__ void pE2(Frame& F, int l) {
    const int nlat = BATCH * 4 * 8, nall = nlat + (l == 0 ? BATCH * 4 : 0);
    for (int rp = 0; rp < NREP(16); ++rp) { BgConv bg{0, nullptr};
    for (int u = F.blk; u < nall; u += F.G) {
        int b, h, qp, klo, seq;
        if (u < nlat) { const int qb = u & 7, bh = u >> 3; b = bh >> 2; h = bh & 3; qp = 256 * qb; klo = 0; seq = TPB; }
        else { const int bh = u - nlat; b = bh >> 2; h = bh & 3; qp = SEQ; klo = SEQ; seq = CTXL; }
        const size_t qrow = (size_t)b * TPB + qp, krow = (size_t)b * TPB + klo;
        fa::attn_dense_body(MQ_ + qrow * 384 + h * 96, MK_ + krow * 384 + h * 96, MV_ + krow * 512 + h * 128, ATT_ + qrow * DM + 256 + h * 128, seq, (char*)(F.lds + RING_OFF), F.tid, F, l, bg);
    }
    bg_drain(F, l, bg); }
    relane(F);
    for (int rp = 0; rp < NREP(17); ++rp) gla_pass(F, l, true);
}

__device__ __forceinline__ int moe_rpb(const Frame& F) { return (((MROWS + F.G - 1) / F.G) + 15) & ~15; }
constexpr int G1_TP = 1028;
__device__ __forceinline__ void pG1(Frame& F, int l) {
    LAS float* T = (LAS float*)(F.lds + RING_OFF);
    LAS float* P = T + 16 * G1_TP;
    volatile LAS unsigned* wh = F.MISC + MW_WH + F.wave * 32;
    if (F.lane < 32) wh[F.lane] = 0u;
    const int lane = F.lane, c = lane & 15, q = lane >> 4, rpb = moe_rpb(F), row_lo = F.blk * rpb;
    float bw[32][2];
#pragma unroll
    for (int s = 0; s < 32; ++s) { const float* wp = w_router_ + ((size_t)l * 1024 + 128 * F.wave + 32 * q + s) * NEXP + c; bw[s][0] = wp[0]; bw[s][1] = wp[16]; }
    const float brl = b_router_[l * NEXP + (lane & 31)];
    const float* gf = g_ffn_ + l * DM;
    int mcC = -1; f32x4 gsC[4], shC[4];
    u32x2 n0[4], n1[4];
    { const size_t rr = (size_t)min(row_lo + 2 * F.wave, MROWS - 2);
#pragma unroll
      for (int j = 0; j < 4; ++j) { n0[j] = *(const u32x2*)(XU_ + rr * DM + 256 * j + 4 * lane); n1[j] = *(const u32x2*)(XU_ + (rr + 1) * DM + 256 * j + 4 * lane); } }
    for (int r0 = row_lo; r0 < row_lo + rpb && r0 < MROWS; r0 += 16) {
        const int b = r0 / TPB, p0 = r0 - b * TPB;
        const int mc = p0 < SEQ ? b : 16, row = r0 + 2 * F.wave;
        f32x4 h0[4], h1[4];
#pragma unroll
        for (int j = 0; j < 4; ++j) { h0[j] = bf4f(n0[j]); h1[j] = bf4f(n1[j]); }
        { const size_t rr = (size_t)min(row + 16, MROWS - 2);
#pragma unroll
          for (int j = 0; j < 4; ++j) { n0[j] = *(const u32x2*)(XU_ + rr * DM + 256 * j + 4 * lane); n1[j] = *(const u32x2*)(XU_ + (rr + 1) * DM + 256 * j + 4 * lane); } }
        if (l == DEPTH - 1 && p0 >= SEQ) continue;
        const float rs0 = rsq(wave_sum(sumsq4(h0)) * (1.0f / DM) + EPS), rs1 = rsq(wave_sum(sumsq4(h1)) * (1.0f / DM) + EPS);
        if (mc != mcC) { const float* mod = MOD_ + ((size_t)l * 17 + mc) * 6144; mcC = mc;
#pragma unroll
            for (int j = 0; j < 4; ++j) { const int col = 256 * j + 4 * lane; gsC[j] = *(const f32x4*)(gf + col) * (*(const f32x4*)(mod + 4 * 1024 + col) + 1.0f); shC[j] = *(const f32x4*)(mod + 3 * 1024 + col); } }
#pragma unroll
        for (int j = 0; j < 4; ++j) { const int col = 256 * j + 4 * lane; const f32x4 gs = gsC[j], sh = shC[j];
            h0[j] = h0[j] * rs0 * gs + sh; h1[j] = h1[j] * rs1 * gs + sh;
            *(unsigned*)((unsigned char*)H_ + (size_t)row * DM + col) = pk4f8(h0[j][0] * SC_X, h0[j][1] * SC_X, h0[j][2] * SC_X, h0[j][3] * SC_X);
            *(unsigned*)((unsigned char*)H_ + (size_t)(row + 1) * DM + col) = pk4f8(h1[j][0] * SC_X, h1[j][1] * SC_X, h1[j][2] * SC_X, h1[j][3] * SC_X);
            *(LAS f32x4*)(T + (2 * F.wave) * G1_TP + col) = h0[j]; *(LAS f32x4*)(T + (2 * F.wave + 1) * G1_TP + col) = h1[j]; }
        LDS_WAIT(); __syncthreads();
        f32x4 a0 = (f32x4){0.f, 0.f, 0.f, 0.f}, a1 = a0;
        { const LAS float* tp = T + c * G1_TP + 128 * F.wave + 32 * q;
#pragma unroll
          for (int s4 = 0; s4 < 8; ++s4) { const f32x4 av = *(const LAS f32x4*)(tp + 4 * s4);
#pragma unroll
              for (int i = 0; i < 4; ++i) { a0 = __builtin_amdgcn_mfma_f32_16x16x4f32(av[i], bw[4 * s4 + i][0], a0, 0, 0, 0); a1 = __builtin_amdgcn_mfma_f32_16x16x4f32(av[i], bw[4 * s4 + i][1], a1, 0, 0, 0); } } }
#pragma unroll
        for (int i = 0; i < 4; ++i) { P[(F.wave * 16 + 4 * q + i) * 32 + c] = a0[i]; P[(F.wave * 16 + 4 * q + i) * 32 + 16 + c] = a1[i]; }
        LDS_WAIT(); __syncthreads();
        { const int rr = 2 * F.wave + (lane >> 5), e = lane & 31; float lg = brl;
#pragma unroll
          for (int w = 0; w < 8; ++w) lg += P[(w * 16 + rr) * 32 + e];
          float tv[4]; int ti[4];
#pragma unroll
          for (int k = 0; k < 4; ++k) { float m = lg; m = fmaxf(m, dpp_f<0xB1>(m)); m = fmaxf(m, dpp_f<0x4E>(m)); m = fmaxf(m, dpp_f<0x141>(m)); m = fmaxf(m, dpp_f<0x140>(m)); m = fmaxf(m, swz_xor<16>(m));
              const unsigned long long bal = __builtin_amdgcn_ballot_w64(lg == m); const unsigned half = (lane >> 5) ? (unsigned)(bal >> 32) : (unsigned)bal;
              const int bi = __builtin_ctz(half);
              tv[k] = m; ti[k] = bi; lg = (e == bi) ? -INFINITY : lg; }
          const float e1 = __expf(tv[1] - tv[0]), e2 = __expf(tv[2] - tv[0]), e3 = __expf(tv[3] - tv[0]); const float isum = 1.0f / (1.0f + e1 + e2 + e3);
          if (e < 4) { const int ek = e == 0 ? ti[0] : e == 1 ? ti[1] : e == 2 ? ti[2] : ti[3]; const float gg = (e == 0 ? 1.0f : e == 1 ? e1 : e == 2 ? e2 : e3) * isum;
              unsigned rank = 0;
              if (lane < 32) rank = __hip_atomic_fetch_add((LAS unsigned*)(F.MISC + MW_WH + F.wave * 32 + ek), 1u, __ATOMIC_RELAXED, __HIP_MEMORY_SCOPE_WORKGROUP);
              __builtin_amdgcn_s_waitcnt(0xc07f);
              if (lane >= 32) rank = __hip_atomic_fetch_add((LAS unsigned*)(F.MISC + MW_WH + F.wave * 32 + ek), 1u, __ATOMIC_RELAXED, __HIP_MEMORY_SCOPE_WORKGROUP);
              TOPE_[(size_t)(r0 + rr) * 4 + e] = ek | (int)(rank << 8); TOPG_[(size_t)(r0 + rr) * 4 + e] = gg; } }
        LDS_WAIT(); __syncthreads();
    }
    LDS_WAIT(); __syncthreads();
    if (F.lane < 32) WHIST_[(size_t)F.gw * 32 + F.lane] = (int)wh[F.lane];
    if (F.tid < 32) { unsigned s = 0;
#pragma nounroll
        for (int w = 0; w < 8; ++w) s += F.MISC[MW_WH + w * 32 + F.tid];
        HISTB_[F.blk * 32 + F.tid] = (int)s; }
    __syncthreads();
}
__device__ __forceinline__ void moe_tables(Frame& F) {
    const int e = F.tid & 31, part = F.tid >> 5; unsigned s = 0, sb = 0;
#pragma unroll 8
    for (int bq = part; bq < F.G; bq += 16) { const unsigned hv = (unsigned)HISTB_[bq * 32 + e]; s += hv; sb += bq < F.blk ? hv : 0u; }
    F.MISC[MW_TMP + part * 32 + e] = s; F.MISC[MW_TMP + 512 + part * 32 + e] = sb;
    LDS_WAIT(); __syncthreads();
    if (F.tid < 32) { unsigned a = 0, bsum = 0;
#pragma nounroll
        for (int pq = 0; pq < 16; ++pq) { a += F.MISC[MW_TMP + pq * 32 + F.tid]; bsum += F.MISC[MW_TMP + 512 + pq * 32 + F.tid]; }
        F.MISC[MW_CNT + F.tid] = a; F.MISC[MW_BB + F.tid] = bsum; }
    LDS_WAIT(); __syncthreads();
    if (F.tid < 64) {
        const int ln = F.tid; const unsigned nt = ln < NEXP ? (F.MISC[MW_CNT + ln] + 255u) >> 8 : 0u; unsigned inc = nt;
#pragma unroll
        for (int d = 1; d < 32; d <<= 1) { const unsigned v = (unsigned)__shfl_up((int)inc, d, 64); if (ln >= d) inc += v; }
        if (ln < NEXP) F.MISC[MW_TS + ln] = inc - nt;
        if (ln == NEXP - 1) F.MISC[MW_TS + NEXP] = inc; }
    LDS_WAIT(); __syncthreads();
    { const int q = F.tid >> 4, r = F.tid & 15; const unsigned ts = F.MISC[MW_TS + q], nt = F.MISC[MW_TS + q + 1] - ts;
      volatile LAS unsigned char* te = (volatile LAS unsigned char*)(F.MISC + MW_TE);
      for (unsigned t = r; t < nt; t += 16) te[ts + t] = (unsigned char)q; }
    LDS_WAIT(); __syncthreads();
}
__device__ __forceinline__ void pG2(Frame& F, int l) {
    moe_tables(F);
    const int lane = F.lane, rpb = moe_rpb(F), row_lo = F.blk * rpb;
    if (F.tid < 256) { const int w = F.tid >> 5, e = F.tid & 31; unsigned wb = 0;
#pragma unroll
        for (int w2 = 0; w2 < 7; ++w2) { const unsigned v = (unsigned)WHIST_[(size_t)(F.blk * 8 + w2) * 32 + e]; wb += w2 < w ? v : 0u; }
        F.MISC[MW_TMP + w * 32 + e] = 256u * F.MISC[MW_TS + e] + F.MISC[MW_BB + e] + wb; }
    LDS_WAIT(); __syncthreads();
    for (int e = F.blk; e < NEXP; e += F.G) {
        const int c = (int)F.MISC[MW_CNT + e], base = 256 * (int)F.MISC[MW_TS + e], end = 256 * (int)(F.MISC[MW_TS + e + 1] - F.MISC[MW_TS + e]);
        for (int i = c + F.tid; i < end; i += 512) ROWMAP_[base + i] = 0; }
    for (int i = F.tid; i < rpb * 4; i += 512) {
        const int row = row_lo + (i >> 2), k = i & 3; if (row >= MROWS) break;
        const int p = row % TPB; if (l == DEPTH - 1 && p >= SEQ) continue;
        const int te = TOPE_[(size_t)row * 4 + k];
        const int ow = ((row - row_lo) & 15) >> 1, ek = te & 255, rank = te >> 8;
        const int dest = (int)F.MISC[MW_TMP + ow * 32 + (ek & 31)] + rank;
        DEST_[(size_t)row * 4 + k] = dest; ROWMAP_[dest] = row;
    }
}
struct JLoad { u32x2 y[4][4]; u32x2 x[4]; };
__device__ __forceinline__ int pJ_row(int l, int a) { return l == DEPTH - 1 ? (a >> 11) * TPB + (a & (SEQ - 1)) : a; }
__device__ __forceinline__ void pJ_issue(Frame& F, JLoad& L, int row, int dk, int lane) {
#pragma unroll
    for (int k = 0; k < 4; ++k) { const int d = __builtin_amdgcn_readlane(dk, k);
#pragma unroll
        for (int j = 0; j < 4; ++j) L.y[k][j] = *(const u32x2*)(XS_   + (size_t)d * DM + 256 * j + 4 * lane); }
#pragma unroll
    for (int j = 0; j < 4; ++j) L.x[j] = *(const u32x2*)(XU_ + (size_t)row * DM + 256 * j + 4 * lane);
}
__device__ __forceinline__ void pJ(Frame& F, int l) {
    const int lane = F.lane, nrows = l == DEPTH - 1 ? BATCH * SEQ : MROWS, step = F.ngw;
    int a = F.gw; if (a >= nrows) return;
    auto route = [&](int aa, int& dk, float& gk) __attribute__((always_inline)) { if (aa < nrows) { const int r = pJ_row(l, aa); dk = DEST_[(size_t)r * 4 + (lane & 3)]; gk = TOPG_[(size_t)r * 4 + (lane & 3)]; } };
    auto one = [&](const JLoad& L, const int aa, const float gkA) __attribute__((always_inline)) {
        const int row = pJ_row(l, aa), b = row / TPB, p = row - b * TPB; const int mc = p < SEQ ? b : 16; const float* mod = MOD_ + ((size_t)l * 17 + mc) * 6144;
        f32x4 g2[4], s1[4], s0[4], gm[4];
#pragma unroll
        for (int j = 0; j < 4; ++j) { const int col = 256 * j + 4 * lane; g2[j] = *(const f32x4*)(mod + 5 * 1024 + col);
            if (l != DEPTH - 1) { const float* mod1 = MOD_ + ((size_t)(l + 1) * 17 + mc) * 6144; s1[j] = *(const f32x4*)(mod1 + 1024 + col); s0[j] = *(const f32x4*)(mod1 + col); gm[j] = *(const f32x4*)(g_mix_ + (l + 1) * DM + col); } }
        float g[4];
#pragma unroll
        for (int k = 0; k < 4; ++k) g[k] = rl_f(gkA, k);
        f32x4 v[4];
#pragma unroll
        for (int j = 0; j < 4; ++j) { f32x4 acc = (f32x4){0.f, 0.f, 0.f, 0.f};
#pragma unroll
            for (int k = 0; k < 4; ++k) { float f[4]; up4(L.y[k][j], f); acc += (f32x4){f[0], f[1], f[2], f[3]} * g[k]; }
            v[j] = bf4f(L.x[j]) + g2[j] * acc; }
        if (l == DEPTH - 1) {
#pragma unroll
            for (int j = 0; j < 4; ++j) *(f32x4*)(out_ + ((size_t)b * SEQ + p) * DM + 256 * j + 4 * lane) = v[j];
        } else {
#pragma unroll
            for (int j = 0; j < 4; ++j) { u32x2 o; o.x = pg8::cvt_pk_bf16(v[j][0], v[j][1]); o.y = pg8::cvt_pk_bf16(v[j][2], v[j][3]); *(u32x2*)(XU_ + (size_t)row * DM + 256 * j + 4 * lane) = o; v[j] = bf4f(o); }
            const float rstd = rsq(wave_sum(sumsq4(v)) * (1.0f / DM) + EPS);
            unsigned char* orow = (unsigned char*)H_ + (size_t)row * DM;
#pragma unroll
            for (int j = 0; j < 4; ++j) { const f32x4 h = (v[j] * rstd * gm[j] * (s1[j] + 1.0f) + s0[j]) * SC_X; *(unsigned*)(orow + 256 * j + 4 * lane) = pk4f8(h[0], h[1], h[2], h[3]); }
        }
    };
    int dk0 = 0, dk1 = 0, dk2 = 0, dk3 = 0; float gk0 = 0.f, gk1 = 0.f, gk2 = 0.f, gk3 = 0.f;
    route(a, dk0, gk0); route(a + step, dk1, gk1);
    JLoad A, B; pJ_issue(F, A, pJ_row(l, a), dk0, lane);
    for (; a < nrows; a += 2 * step) {
        route(a + 2 * step, dk2, gk2);
        if (a + step < nrows) pJ_issue(F, B, pJ_row(l, a + step), dk1, lane);
        one(A, a, gk0);
        if (a + step >= nrows) break;
        route(a + 3 * step, dk3, gk3);
        if (a + 2 * step < nrows) pJ_issue(F, A, pJ_row(l, a + 2 * step), dk2, lane);
        one(B, a + step, gk1);
        dk0 = dk2; gk0 = gk2; dk1 = dk3; gk1 = gk3;
    }
}

#ifndef PH_MASK
#define PH_MASK 0x3fff
#endif
#define IN(k) (lo <= (k) && (k) < hi)
#define EN(i) ((PH_MASK >> (i)) & 1)
#define RELOAD() do { int ln_; asm volatile("v_mbcnt_lo_u32_b32 %0, -1, 0\n\tv_mbcnt_hi_u32_b32 %0, -1, %0" : "=v"(ln_)); ln_ &= 63; F.lane = ln_; F.wave = wave0; F.tid = wave0 * 64 + ln_; \
    { int b_ = (int)blockIdx.x, g_ = (int)gridDim.x, w_ = wave0; asm volatile("" : "+s"(b_), "+s"(g_), "+s"(w_)); F.blk = b_; F.G = g_; F.wave = w_ & 7; F.tid = (w_ & 7) * 64 + ln_; F.gw = b_ * 8 + (w_ & 7); F.ngw = g_ * 8; } \
    int z_ = 0; asm volatile("" : "+s"(z_)); F.A = (const Args*)((const char*)&args + z_); } while (0)
#define SEAM(k) do { if ((k) + 1 < hi) { xcd_barrier(bar.bar, bar.x, bar.st, F.tid); if (NREP(18) > 1) xcd_barrier(bar.bar, bar.x, bar.st, F.tid); } } while (0)
template <int l>
__device__ __forceinline__ void layer_phases(Frame& F, const Args& args, const XcdBarrier& bar, const int lo, const int hi, const int wave0) {
        const int pb = 1 + 13 * l; const bool lastl = (l == DEPTH - 1);
        if (EN(1) && IN(pb + 0) && l == 0) { RELOAD(); pA_init(F); SEAM(pb + 0); }
        if (EN(2) && IN(pb + 1)) { RELOAD();
            pg8::Gemm g{H_  , (const bf16*)((const unsigned char*)WIN_ + (size_t)l * 2048 * 1024), nullptr}; DenseOrder S{MROWS / 256, ZC / 256, F.G, F.blk, 0, NREP(2)}; EpiBf16PlainT<true> E{Z_, ZC};
            pg8::gemm_phase<EpiBf16PlainT<true>, DenseOrder, 512, 512, true, true, true>(F.lds + RING_OFF, g, S, E, F.tid); SEAM(pb + 1); }
        if (EN(3) && IN(pb + 2)) { RELOAD();
            pg8::Gemm g{Z_ + Z_CQ, WSM_ + (size_t)l * 1280 * 384, nullptr}; DenseOrder S{MROWS / 256, YC / 256, F.G, F.blk, 0, NREP(3)}; EpiBf16Plain E{Y_, YC};
            pg8::gemm_phase<EpiBf16Plain, DenseOrder, 384, ZC, true, true>(F.lds + RING_OFF, g, S, E, F.tid); SEAM(pb + 2); }
        if (EN(4) && IN(pb + 3)) { for (int rp = 0; rp < NREP(4); ++rp) { RELOAD(); pD_tokens(F, l); } SEAM(pb + 3); }
        if (EN(5) && IN(pb + 4)) { for (int rp = 0; rp < NREP(5); ++rp) { RELOAD(); pE1(F, l); } SEAM(pb + 4); }
        if (EN(6) && IN(pb + 5)) { for (int rp = 0; rp < NREP(6); ++rp) { RELOAD(); pE2(F, l); } SEAM(pb + 5); }
        if (EN(8) && IN(pb + 7)) { RELOAD();
            pg8::Gemm g{ATT_, WOUT_ + (size_t)l * 1024 * 1024, nullptr}; DenseOrder S{lastl ? BATCH * 8 : MROWS / 256, DM / 256, F.G, F.blk, lastl ? 1 : 0, 1};
            EpiResid E{XU_, MOD_ + (size_t)l * 17 * 6144 + 2 * 1024, l == 0 ? x_ : nullptr, l == 0 ? ctx_ : nullptr};
            pg8::gemm_phase<EpiResid, DenseOrder, DM, DM, true, true>(F.lds + RING_OFF, g, S, E, F.tid); SEAM(pb + 7); }
        if (EN(9) && IN(pb + 8)) { for (int rp = 0; rp < NREP(9); ++rp) { RELOAD(); pG1(F, l); } SEAM(pb + 8); }
        if (EN(10) && IN(pb + 9)) { for (int rp = 0; rp < NREP(10); ++rp) { RELOAD(); pG2(F, l); } SEAM(pb + 9); }
        if (EN(11) && IN(pb + 10)) { RELOAD();
            pg8::Gemm g{H_  , (const bf16*)((const unsigned char*)W1_ + (size_t)l * NEXP * 2048 * 1024), ROWMAP_};
            MoeOrder S{(const volatile LAS int*)(F.MISC + MW_TS), (const volatile LAS unsigned char*)(F.MISC + MW_TE), 8, F.G, F.blk, NREP(11)};
            EpiSwiglu E{(unsigned char*)ACT_, b_moe1_ + (size_t)l * NEXP * 2048};
            pg8::gemm_phase<EpiSwiglu, MoeOrder, 512, 512, false, true, true, true>(F.lds + RING_OFF, g, S, E, F.tid); SEAM(pb + 10); }
        if (EN(12) && IN(pb + 11)) { RELOAD();
            pg8::Gemm g{ACT_, (const bf16*)((const unsigned char*)W2_ + (size_t)l * NEXP * 1024 * 1024), nullptr};
            MoeOrder S{(const volatile LAS int*)(F.MISC + MW_TS), (const volatile LAS unsigned char*)(F.MISC + MW_TE), 4, F.G, F.blk, NREP(12)};
            EpiBf16Bias E{XS_, b_moe2_ + (size_t)l * NEXP * 1024};
            pg8::gemm_phase<EpiBf16Bias, MoeOrder, 512, 512, false, true, true>(F.lds + RING_OFF, g, S, E, F.tid); SEAM(pb + 11); }
        if (EN(13) && IN(pb + 12)) { for (int rp = 0; rp < (lastl ? NREP(13) : 1); ++rp) { RELOAD(); pJ(F, l); } if (!lastl) SEAM(pb + 12); }
}
__global__ void __launch_bounds__(512, 2) fwd(Args args) {
    extern __shared__ __attribute__((aligned(16))) unsigned char lds[];
    Frame F;
    F.lds = (LAS unsigned char*)lds; F.MISC = (volatile LAS unsigned*)(F.lds + MISC_OFF);
    F.tid = threadIdx.x; F.lane = F.tid & 63; F.wave = __builtin_amdgcn_readfirstlane(F.tid >> 6); const int wave0 = F.wave & 7;
    F.G = gridDim.x; F.blk = blockIdx.x; F.gw = F.blk * 8 + F.wave; F.ngw = F.G * 8;
    F.A = &args; unsigned char* ws = args.ws;
    for (int u = F.tid; u < (LDS_BYTES - MISC_OFF) / 4; u += 512) F.MISC[u] = 0u;
    __syncthreads();
    XcdBarrier bar = xcd_barrier_post((unsigned*)(ws + WS_CTL) + CW_BAR + args.li * XCD_BAR_WORDS, F.MISC + MW_BAR);
    const int lo = args.ph_lo, hi = args.ph_hi;
    if (EN(0) && IN(0)) { for (int rp = 0; rp < NREP(0); ++rp) { RELOAD(); p0_prologue(F); } SEAM(0); }
    layer_phases<0>(F, args, bar, lo, hi, wave0);
    layer_phases<1>(F, args, bar, lo, hi, wave0);
    static_assert(DEPTH == 2, "two layer instantiations");
#undef IN
#undef SEAM
}

extern "C" void kernel_launch(void* const* d_in, const int* in_sizes, int n_in, void* d_out, int out_size, void* d_ws, size_t ws_size, hipStream_t stream) {
    static int grid = 0;
    if (grid == 0) {
        if (n_in != 28 || out_size != BATCH * SEQ * DM || ws_size < WS_END) { fprintf(stderr, "kernel_launch: unexpected problem (n_in %d out %d ws %zu)\n", n_in, out_size, ws_size); grid = -1; return; }
        int dev = 0, cus = 0, per_cu = 0;
        if (hipGetDevice(&dev) != hipSuccess || hipDeviceGetAttribute(&cus, hipDeviceAttributeMultiprocessorCount, dev) != hipSuccess) { grid = -1; return; }
        if (hipFuncSetAttribute((const void*)fwd, hipFuncAttributeMaxDynamicSharedMemorySize, LDS_BYTES) != hipSuccess) { fprintf(stderr, "kernel_launch: hipFuncSetAttribute failed\n"); grid = -1; return; }
        if (hipOccupancyMaxActiveBlocksPerMultiprocessor(&per_cu, (const void*)fwd, 512, LDS_BYTES) != hipSuccess || per_cu < 1) { fprintf(stderr, "kernel_launch: occupancy query says %d\n", per_cu); }
        (void)hipGetLastError();
        grid = cus & ~7;
        if (grid < 8) { grid = -1; return; }
    }
    if (grid < 0) return;
    (void)hipMemsetAsync((char*)d_ws + WS_CTL, 0, CTL_ZERO_BYTES, stream);
    Args a{};
    for (int i = 0; i < 28; ++i) a.in[i] = (const float*)d_in[i];
    a.out = (float*)d_out; a.ws = (unsigned char*)d_ws; a.pad = 0;
#if MK_N_LAUNCHES == 1
    a.ph_lo = 0; a.ph_hi = NPH; a.li = 0;
    hipLaunchKernelGGL(fwd, dim3(grid), dim3(512), LDS_BYTES, stream, a);
#else
    for (int ph = 0, li = 0; ph < NPH; ++ph) {
        if (ph == 1 + 13 || ph == 1 + 6 || ph == 1 + 13 + 6) continue;
        a.ph_lo = ph; a.ph_hi = ph + 1; a.li = li++;
        hipLaunchKernelGGL(fwd, dim3(grid), dim3(512), LDS_BYTES, stream, a);
    }
#endif
}
```

```cpp
#include <hip/hip_runtime.h>
#include <cstdio>
#include <cstdint>

#define GAS __attribute__((address_space(1)))
#define LAS __attribute__((address_space(3)))
typedef unsigned short bf16;
typedef short bf16x8 __attribute__((ext_vector_type(8)));
typedef short bf16x4 __attribute__((ext_vector_type(4)));
typedef float f32x4 __attribute__((ext_vector_type(4)));
typedef unsigned u32x4 __attribute__((ext_vector_type(4)));
typedef unsigned u32x2 __attribute__((ext_vector_type(2)));

#ifndef REP_MASK
#define REP_MASK 0
#endif
#define NREP(i) (((REP_MASK >> (i)) & 1) ? 2 : 1)
#ifndef MK_N_LAUNCHES
#define MK_N_LAUNCHES 1
#endif

namespace pg8 {
constexpr int BM = 256, BK = 64, HALF = 128, HTB = HALF * BK * 2, STAGE_BYTES = 8 * HTB;
__host__ __device__ __forceinline__ int lds_byte(int r, int c) { const int st = (r >> 4) * 2 + (c >> 5), rr = r & 15, cc = c & 31, ob = rr * 64 + cc * 2; return st * 1024 + (ob ^ (((ob >> 9) & 1) << 5)); }
__host__ __device__ __forceinline__ void stage_rc(int b, int& R, int& C) { const int st = b / 1024, sb = b % 1024, swz = sb ^ (((sb >> 9) & 1) << 5); R = (st >> 1) * 16 + swz / 64; C = (st & 1) * 32 + (swz % 64) / 2; }
__host__ __device__ __forceinline__ int perm32(int rho) { const int n = rho >> 4, i = rho & 15; return 8 * (i >> 2) + 4 * n + (i & 3); }

struct Unit { int pm, pn, pb, pa; };
struct Gemm { const bf16* A; const bf16* Bt; const int* rowmap; };

__device__ __forceinline__ unsigned cvt_pk_bf16(float lo, float hi) { unsigned r; asm volatile("v_cvt_pk_bf16_f32 %0, %1, %2" : "=v"(r) : "v"(lo), "v"(hi)); return r; }

typedef int i32x4v __attribute__((ext_vector_type(4)));
typedef int i32x8v __attribute__((ext_vector_type(8)));
template <class Epi, class Sched, int K, int LDA, bool ALIGN_EPI, bool SP2, bool FP8 = false, bool GATHER = false>
__device__ __forceinline__ void gemm_phase(LAS unsigned char* lds, const Gemm g, const Sched& S, const Epi& E, const int tid) {
    const int wid = __builtin_amdgcn_readfirstlane(tid >> 6), lane = tid & 63, wr = wid >> 2, wc = wid & 3, fr = lane & 15, fq = lane >> 4;
    constexpr int nt = K / BK;
    unsigned voffA[2], voffB[2]; int rA[2]; unsigned cA2[2];
#pragma unroll
    for (int i = 0; i < 2; ++i) { int R, C; stage_rc(tid * 16 + i * 8192, R, C); const int Rb = Epi::PERM ? ((R & ~31) + perm32(R & 31)) : R;
        voffA[i] = (unsigned)(R * LDA + C) * 2u; voffB[i] = (unsigned)(Rb * K + C) * 2u; rA[i] = R; cA2[i] = (unsigned)C * 2u; }
    constexpr size_t kstep = (size_t)(BK * 2);
    constexpr size_t hA = GATHER ? 0 : (size_t)HALF * LDA * 2, hB = (size_t)HALF * K * 2;
    constexpr size_t tA = 2 * hA, tB = 2 * hB;
    unsigned gC[2][2], gN[2][2];
#define PG8_GLOAD(dst, unit) do { if constexpr (GATHER) { _Pragma("unroll") for (int _h = 0; _h < 2; ++_h) _Pragma("unroll") for (int _i = 0; _i < 2; ++_i) \
        dst[_h][_i] = (unsigned)g.rowmap[(unit).pa * 256 + _h * 128 + rA[_i]] * (unsigned)(LDA * 2) + cA2[_i]; } } while (0)
#define PG8_STAGE_A(b, h, ptr, nx) do { if constexpr (GATHER) { _Pragma("unroll") for (int _i = 0; _i < 2; ++_i) \
        __builtin_amdgcn_global_load_lds((const unsigned*)((const char*)(ptr) + ((nx) ? gN[h][_i] : gC[h][_i])), (LAS unsigned*)(lds + PG8_SA(b, h) + ldsw + _i * 8192), 16, 0, 0); } \
        else PG8_STAGE(PG8_SA(b, h), (ptr) + (h) * hA, voffA); } while (0)
    const unsigned ldsw = (unsigned)wid * 1024u;
    const int aoff = FP8 ? lds_byte(wr * 64 + fr, (fq & 1) * 16) + (fq >> 1) * 1024 : lds_byte(wr * 64 + fr, fq * 8);
    const int boff = FP8 ? lds_byte(wc * 32 + fr, (fq & 1) * 16) + (fq >> 1) * 1024 : lds_byte(wc * 32 + fr, fq * 8);
#define PG8_SA(b, h) (((b) * 2 + (h)) * HTB)
#define PG8_SB(b, h) ((4 + (b) * 2 + (h)) * HTB)
#define PG8_STAGE(bufoff, gbase, voff) do { _Pragma("unroll") for (int _i = 0; _i < 2; ++_i) \
        __builtin_amdgcn_global_load_lds((const unsigned*)((const char*)(gbase) + (voff)[_i]), (LAS unsigned*)(lds + (bufoff) + ldsw + _i * 8192), 16, 0, 0); } while (0)
#define PG8_LDA(dst, b, h) do { _Pragma("unroll") for (int m = 0; m < 4; ++m) { if constexpr (FP8) { const i32x4v lo_ = *(const LAS i32x4v*)(lds + PG8_SA(b, h) + aoff + m * 2048), hi_ = *(const LAS i32x4v*)(lds + PG8_SA(b, h) + aoff + m * 2048 + 16); dst[m] = __builtin_shufflevector(lo_, hi_, 0, 1, 2, 3, 4, 5, 6, 7); } \
        else { dst[m].lo = *(const LAS i32x4v*)(lds + PG8_SA(b, h) + aoff + m * 2048); dst[m].hi = *(const LAS i32x4v*)(lds + PG8_SA(b, h) + aoff + m * 2048 + 1024); } } } while (0)
#define PG8_LDB(dst, b, h) do { _Pragma("unroll") for (int n = 0; n < 2; ++n) { if constexpr (FP8) { const i32x4v lo_ = *(const LAS i32x4v*)(lds + PG8_SB(b, h) + boff + n * 2048), hi_ = *(const LAS i32x4v*)(lds + PG8_SB(b, h) + boff + n * 2048 + 16); dst[n] = __builtin_shufflevector(lo_, hi_, 0, 1, 2, 3, 4, 5, 6, 7); } \
        else { dst[n].lo = *(const LAS i32x4v*)(lds + PG8_SB(b, h) + boff + n * 2048); dst[n].hi = *(const LAS i32x4v*)(lds + PG8_SB(b, h) + boff + n * 2048 + 1024); } } } while (0)
#define PG8_MMA(ai, bj, At, Bt) do { __builtin_amdgcn_s_setprio(1); _Pragma("unroll") for (int m = 0; m < 4; ++m) _Pragma("unroll") for (int n = 0; n < 2; ++n) { \
        if constexpr (FP8) asm volatile("v_mfma_scale_f32_16x16x128_f8f6f4 %0, %1, %2, %0, %3, %3 op_sel_hi:[0,0,0]" : "+v"(acc[ai][bj][m][n]) : "v"(Bt[n]), "v"(At[m]), "v"(sc8)); \
        else { const i32x4v bl_ = __builtin_shufflevector(Bt[n], Bt[n], 0, 1, 2, 3), bh_ = __builtin_shufflevector(Bt[n], Bt[n], 4, 5, 6, 7), al_ = __builtin_shufflevector(At[m], At[m], 0, 1, 2, 3), ah_ = __builtin_shufflevector(At[m], At[m], 4, 5, 6, 7); \
               acc[ai][bj][m][n] = __builtin_amdgcn_mfma_f32_16x16x32_bf16(__builtin_bit_cast(bf16x8, bl_), __builtin_bit_cast(bf16x8, al_), acc[ai][bj][m][n], 0, 0, 0);   \
               acc[ai][bj][m][n] = __builtin_amdgcn_mfma_f32_16x16x32_bf16(__builtin_bit_cast(bf16x8, bh_), __builtin_bit_cast(bf16x8, ah_), acc[ai][bj][m][n], 0, 0, 0); } } \
        __builtin_amdgcn_s_setprio(0); } while (0)
#define PG8_WAIT_V(n) asm volatile("s_waitcnt vmcnt(" #n ")" ::: "memory")
#define PG8_WAIT_L(n) asm volatile("s_waitcnt lgkmcnt(" #n ")" ::: "memory")
#define PG8_BAR __builtin_amdgcn_s_barrier()
#define PG8_SCHED __builtin_amdgcn_sched_barrier(0)
    int sc8 = 0x7f7f7f7f; asm volatile("" : "+v"(sc8));
    Unit cur, nxt; int ui = 0;
    if (!S.next(0, cur)) return;
    f32x4 acc[2][2][4][2];
#pragma unroll
    for (int a = 0; a < 2; ++a)
#pragma unroll
        for (int b = 0; b < 2; ++b)
#pragma unroll
            for (int m = 0; m < 4; ++m)
#pragma unroll
                for (int n = 0; n < 2; ++n) acc[a][b][m][n] = (f32x4){0.f, 0.f, 0.f, 0.f};
    i32x8v At[4], B0[2], B1[2];
    const char* cA = (const char*)g.A + (size_t)cur.pa * tA; const char* cB = (const char*)g.Bt + (size_t)cur.pb * tB;
    typename Epi::Pre pre = E.prefetch(cur, wc, fq);
    PG8_GLOAD(gC, cur);
#pragma unroll
    for (int _h = 0; _h < 2; ++_h)
#pragma unroll
        for (int _i = 0; _i < 2; ++_i) gN[_h][_i] = gC[_h][_i];
    if constexpr (SP2) {
        PG8_STAGE(PG8_SB(0, 0), cB, voffB); PG8_STAGE(PG8_SB(0, 1), cB + hB, voffB); PG8_STAGE_A(0, 0, cA, false); PG8_STAGE_A(0, 1, cA, false);
        if (wr == 1) PG8_BAR;
        PG8_WAIT_V(2); PG8_BAR;
        PG8_STAGE(PG8_SB(1, 0), cB + kstep, voffB); PG8_STAGE_A(1, 0, cA + kstep, false); PG8_STAGE(PG8_SB(1, 1), cB + hB + kstep, voffB);
        PG8_WAIT_V(6); PG8_BAR;
    } else {
        static_assert(!GATHER, "the gathered A operand is wired into the SP2 loop only");
        PG8_STAGE(PG8_SB(0, 0), cB, voffB); PG8_STAGE(PG8_SA(0, 0), cA, voffA); PG8_STAGE(PG8_SB(0, 1), cB + hB, voffB); PG8_STAGE(PG8_SA(0, 1), cA + hA, voffA);
        if (wr == 1) PG8_BAR;
        PG8_WAIT_V(4); PG8_BAR;
        PG8_STAGE(PG8_SB(1, 0), cB + kstep, voffB); PG8_STAGE(PG8_SA(1, 0), cA + kstep, voffA); PG8_STAGE(PG8_SB(1, 1), cB + hB + kstep, voffB);
        PG8_WAIT_V(6); PG8_BAR;
    }
    for (;;) {
        const bool has_next = S.next(ui + 1, nxt);
        const char* nA = has_next ? (const char*)g.A + (size_t)nxt.pa * tA : cA; const char* nB = has_next ? (const char*)g.Bt + (size_t)nxt.pb * tB : cB;
        if (has_next) PG8_GLOAD(gN, nxt);
#pragma nounroll
        for (int t = 0; t < nt; t += 2) {
            const bool last = (t == nt - 2);
            const char* a1 = cA + (size_t)(t + 1) * kstep;
            const char* a2 = last ? nA : cA + (size_t)(t + 2) * kstep; const char* b2 = last ? nB : cB + (size_t)(t + 2) * kstep;
            const char* a3 = a2 + kstep; const char* b3 = b2 + kstep;
            if constexpr (SP2) {
            PG8_LDB(B0, 0, 0); PG8_LDB(B1, 0, 1); PG8_SCHED; PG8_LDA(At, 0, 0); PG8_STAGE_A(1, 1, a1, false);
            PG8_WAIT_V(8); PG8_WAIT_L(0); PG8_BAR; PG8_MMA(0, 0, At, B0); PG8_MMA(0, 1, At, B1); PG8_BAR; PG8_SCHED;
            PG8_LDA(At, 0, 1); PG8_STAGE(PG8_SB(0, 0), b2, voffB); PG8_STAGE(PG8_SB(0, 1), b2 + hB, voffB); PG8_STAGE_A(0, 0, a2, last);
            PG8_WAIT_V(8); PG8_WAIT_L(0); PG8_BAR; PG8_MMA(1, 0, At, B0); PG8_MMA(1, 1, At, B1); PG8_BAR; PG8_SCHED;
            PG8_LDB(B0, 1, 0); PG8_LDB(B1, 1, 1); PG8_SCHED; PG8_LDA(At, 1, 0); PG8_STAGE_A(0, 1, a2, last);
            PG8_WAIT_V(8); PG8_WAIT_L(0); PG8_BAR; PG8_MMA(0, 0, At, B0); PG8_MMA(0, 1, At, B1); PG8_BAR; PG8_SCHED;
            PG8_LDA(At, 1, 1); PG8_STAGE(PG8_SB(1, 0), b3, voffB); PG8_STAGE(PG8_SB(1, 1), b3 + hB, voffB); PG8_STAGE_A(1, 0, a3, last);
            PG8_WAIT_V(8); PG8_WAIT_L(0); PG8_BAR; PG8_MMA(1, 0, At, B0); PG8_MMA(1, 1, At, B1); PG8_BAR; PG8_SCHED;
            } else {
            PG8_LDB(B0, 0, 0); PG8_SCHED; PG8_LDA(At, 0, 0); PG8_STAGE(PG8_SA(1, 1), a1 + hA, voffA);
            PG8_WAIT_L(8); PG8_BAR; PG8_WAIT_L(0); PG8_MMA(0, 0, At, B0); PG8_BAR; PG8_SCHED;
            PG8_LDB(B1, 0, 1); PG8_STAGE(PG8_SB(0, 0), b2, voffB);
            PG8_BAR; PG8_WAIT_L(0); PG8_MMA(0, 1, At, B1); PG8_BAR;
            PG8_LDA(At, 0, 1); PG8_STAGE(PG8_SA(0, 0), a2, voffA);
            PG8_BAR; PG8_WAIT_L(0); PG8_MMA(1, 0, At, B0); PG8_BAR; PG8_SCHED;
            PG8_STAGE(PG8_SB(0, 1), b2 + hB, voffB);
            PG8_WAIT_V(6); PG8_BAR; PG8_MMA(1, 1, At, B1); PG8_BAR;
            PG8_LDB(B0, 1, 0); PG8_SCHED; PG8_LDA(At, 1, 0); PG8_STAGE(PG8_SA(0, 1), a2 + hA, voffA);
            PG8_WAIT_L(8); PG8_BAR; PG8_WAIT_L(0); PG8_MMA(0, 0, At, B0); PG8_BAR; PG8_SCHED;
            PG8_LDB(B1, 1, 1); PG8_STAGE(PG8_SB(1, 0), b3, voffB);
            PG8_BAR; PG8_WAIT_L(0); PG8_MMA(0, 1, At, B1); PG8_BAR;
            PG8_LDA(At, 1, 1); PG8_STAGE(PG8_SA(1, 0), a3, voffA);
            PG8_BAR; PG8_WAIT_L(0); PG8_MMA(1, 0, At, B0); PG8_BAR; PG8_SCHED;
            PG8_STAGE(PG8_SB(1, 1), b3 + hB, voffB);
            PG8_WAIT_V(6); PG8_BAR; PG8_MMA(1, 1, At, B1); PG8_BAR;
            }
        }
        if constexpr (FP8) asm volatile("s_nop 15\n\ts_nop 15" ::: "memory");
        if constexpr (ALIGN_EPI) { if (wr == 0) PG8_BAR; }
        E(acc, cur, wr, wc, fr, fq, pre);
        if (!has_next) break;
        pre = E.prefetch(nxt, wc, fq);
#pragma unroll
        for (int a = 0; a < 2; ++a)
#pragma unroll
            for (int b = 0; b < 2; ++b)
#pragma unroll
                for (int m = 0; m < 4; ++m)
#pragma unroll
                    for (int n = 0; n < 2; ++n) acc[a][b][m][n] = (f32x4){0.f, 0.f, 0.f, 0.f};
        cur = nxt; cA = nA; cB = nB; ++ui;
#pragma unroll
        for (int _h = 0; _h < 2; ++_h)
#pragma unroll
            for (int _i = 0; _i < 2; ++_i) gC[_h][_i] = gN[_h][_i];
        if constexpr (ALIGN_EPI) { if (wr == 1) PG8_BAR; }
    }
    PG8_WAIT_V(0);
    if constexpr (!ALIGN_EPI) { if (wr == 0) PG8_BAR; }
    PG8_BAR;
#undef PG8_SA
#undef PG8_SB
#undef PG8_STAGE
#undef PG8_STAGE_A
#undef PG8_GLOAD
#undef PG8_LDA
#undef PG8_LDB
#undef PG8_MMA
#undef PG8_WAIT_V
#undef PG8_WAIT_L
#undef PG8_BAR
#undef PG8_SCHED
}
}

constexpr int BATCH = 16, SEQ = 2048, CTXL = 256, TPB = SEQ + CTXL, MROWS = BATCH * TPB, DM = 1024, DEPTH = 2;
constexpr int ZC = 2048, YC = 1280, INC = 1984;
constexpr int NEXP = 32, MAXTILES = 608, XSROWS = MAXTILES * 256;
constexpr float EPS = 1e-6f, LOG2E = 1.4426950408889634f;
constexpr float QS_NA = 0.125f * LOG2E;
constexpr float QS_MLA = 0.10206207261596575f * LOG2E;
constexpr int Z_NAQ = 0, Z_NAK = 256, Z_NAV = 512, Z_CQ = 768, Z_CKV = 1024, Z_KR = 1152, Z_GQ = 1184, Z_GK = 1312, Z_GV = 1440, Z_GO = 1696, Z_LF = 1952, Z_LB = 1968;
constexpr int NPH = 1 + 13 * DEPTH;

constexpr size_t MiB = 1u << 20;
constexpr size_t WS_CTL = 0, CTL_ZERO_BYTES = 1 * MiB;
constexpr size_t WS_MOD = 1 * MiB, WS_WSM = 2 * MiB, WS_WIN = 4 * MiB, WS_WOUT = 12 * MiB, WS_W1 = 16 * MiB, WS_W2 = 272 * MiB;
constexpr size_t WS_XU = 400 * MiB, WS_H = 544 * MiB, WS_ATT = 616 * MiB, WS_Z = 688 * MiB, WS_Y = 832 * MiB;
constexpr size_t WS_NAQ = 922 * MiB, WS_NAK = 940 * MiB, WS_NAVT = 958 * MiB, WS_MQ = 976 * MiB, WS_MK = 1012 * MiB, WS_MV = 1048 * MiB;
constexpr size_t WS_EGF = 1084 * MiB, WS_EGB = 1102 * MiB, WS_GQ = 1120 * MiB, WS_GK = 1138 * MiB, WS_GV = 1156 * MiB, WS_CS = 1192 * MiB, WS_AD = 1228 * MiB;
constexpr size_t WS_OGF = 1229 * MiB, WS_OGB = 1265 * MiB, WS_TOPE = 1301 * MiB, WS_TOPG = 1302 * MiB, WS_DEST = 1303 * MiB, WS_HIST = 1304 * MiB;
constexpr size_t WS_XS = 1305 * MiB, WS_ACT = 1609 * MiB, WS_END = 1913 * MiB;
static_assert((size_t)XSROWS * DM * 2 <= 304 * MiB && (size_t)MROWS * YC * 2 <= 90 * MiB && (size_t)MROWS * 384 * 2 <= 27 * MiB, "ws map");
constexpr int CW_BAR = 4096;

constexpr int RING_OFF = 0, MISC_OFF = 139264, LDS_BYTES = 147456;
constexpr int MW_BAR = 8, MW_CNT = 64, MW_BB = 96, MW_TS = 128, MW_TE = 192, MW_TMP = 384, MW_WH = 1536;
constexpr int WRT_PITCH = 1028;
constexpr int VT_PITCH = 1544;
static_assert(NEXP * WRT_PITCH * 4 <= MISC_OFF && 64 * VT_PITCH <= MISC_OFF, "LDS map");

#define RLX_AGENT __ATOMIC_RELAXED, __HIP_MEMORY_SCOPE_AGENT
#define LDS_WAIT() asm volatile("s_waitcnt lgkmcnt(0)" ::: "memory")
#define VM_WAIT() asm volatile("s_waitcnt vmcnt(0)" ::: "memory")
__device__ __forceinline__ float bf2f(unsigned u) { return __uint_as_float(u << 16); }
__device__ __forceinline__ unsigned pk2(float lo, float hi) { unsigned r; asm("v_cvt_pk_bf16_f32 %0, %1, %2" : "=v"(r) : "v"(lo), "v"(hi)); return r; }
__device__ __forceinline__ unsigned f2bf(float f) { return pk2(f, 0.f) & 0xffffu; }
__device__ __forceinline__ float clamp8(float v) { return fminf(fmaxf(v, -448.0f), 448.0f); }
__device__ __forceinline__ unsigned pk4f8(float a, float b, float c, float d) {
    int p = __builtin_amdgcn_cvt_pk_fp8_f32(clamp8(a), clamp8(b), 0, false); p = __builtin_amdgcn_cvt_pk_fp8_f32(clamp8(c), clamp8(d), p, true); return (unsigned)p; }
constexpr float SC_Y = 8.0f;
constexpr float SC_W = 256.0f, SC_X = 16.0f, SC_ACT = 4.0f;
__device__ __forceinline__ void ld4bf(const bf16* p, float (&f)[4]) { const u32x2 w = *(const u32x2*)p; f[0] = __uint_as_float(w.x << 16); f[1] = __uint_as_float(w.x & 0xffff0000u); f[2] = __uint_as_float(w.y << 16); f[3] = __uint_as_float(w.y & 0xffff0000u); }
__device__ __forceinline__ f32x4 bf4f(const u32x2 w) { return (f32x4){__uint_as_float(w.x << 16), __uint_as_float(w.x & 0xffff0000u), __uint_as_float(w.y << 16), __uint_as_float(w.y & 0xffff0000u)}; }
__device__ __forceinline__ void st4bf(bf16* p, float a, float b, float c, float d) { u32x2 w; w.x = pk2(a, b); w.y = pk2(c, d); *(u32x2*)p = w; }
template <int M> __device__ __forceinline__ float swz_xor(float v) { return __int_as_float(__builtin_amdgcn_ds_swizzle(__float_as_int(v), 0x1f | (M << 10))); }
__device__ __forceinline__ float half_sum(float v) { auto rr = __builtin_amdgcn_permlane32_swap(__float_as_uint(v), __float_as_uint(v), false, false); return __uint_as_float(rr[0]) + __uint_as_float(rr[1]); }
__device__ __forceinline__ float half_max(float v) { auto rr = __builtin_amdgcn_permlane32_swap(__float_as_uint(v), __float_as_uint(v), false, false); return fmaxf(__uint_as_float(rr[0]), __uint_as_float(rr[1])); }
template <int CTRL> __device__ __forceinline__ float dpp_f(float v) { return __int_as_float(__builtin_amdgcn_update_dpp(0, __float_as_int(v), CTRL, 0xF, 0xF, true)); }
__device__ __forceinline__ float g8_sum(float v) { v += dpp_f<0xB1>(v); v += dpp_f<0x4E>(v); v += dpp_f<0x141>(v); return v; }
__device__ __forceinline__ float g16_sum(float v) { v = g8_sum(v); v += dpp_f<0x140>(v); return v; }
__device__ __forceinline__ float rl_f(float v, int l) { return __int_as_float(__builtin_amdgcn_readlane(__float_as_int(v), l)); }
__device__ __forceinline__ float wave_sum(float v) { v = g16_sum(v); return (rl_f(v, 0) + rl_f(v, 16)) + (rl_f(v, 32) + rl_f(v, 48)); }
__device__ __forceinline__ float row_sum(float v) { auto rr = __builtin_amdgcn_permlane16_swap(__float_as_uint(v), __float_as_uint(v), false, false); return __uint_as_float(rr[0]) + __uint_as_float(rr[1]); }
__device__ __forceinline__ float row_max(float v) { auto rr = __builtin_amdgcn_permlane16_swap(__float_as_uint(v), __float_as_uint(v), false, false); return fmaxf(__uint_as_float(rr[0]), __uint_as_float(rr[1])); }
template <int CTRL> __device__ __forceinline__ float dpp_max(float v) { return fmaxf(v, dpp_f<CTRL>(v)); }
__device__ __forceinline__ float wave_max(float v) { v = dpp_max<0xB1>(v); v = dpp_max<0x4E>(v); v = dpp_max<0x141>(v); v = dpp_max<0x140>(v); return fmaxf(fmaxf(rl_f(v, 0), rl_f(v, 16)), fmaxf(rl_f(v, 32), rl_f(v, 48))); }
__device__ __forceinline__ float q4_sum(float v) { return half_sum(row_sum(v)); }
__device__ __forceinline__ float q4_max(float v) { return half_max(row_max(v)); }
__device__ __forceinline__ float rsq(float x) { return __builtin_amdgcn_rsqf(x); }

#define XB_TMO      128
#define XB_XCNT(j)  (256  + 64 * (j))
#define XB_XSUB(j)  (1280 + 64 * (j))
#define XB_XGEN(j)  (2304 + 64 * (j))
#define XB_TOP      3328
#define XB_TOPGEN   3392
#define XCD_BAR_WORDS 3456
#define XB_SPIN_CAP (1u << 18)
__device__ __forceinline__ unsigned xb_ld(unsigned* p)              { return __hip_atomic_load(p, __ATOMIC_RELAXED, __HIP_MEMORY_SCOPE_AGENT); }
__device__ __forceinline__ unsigned xb_add(unsigned* p, unsigned v) { return __hip_atomic_fetch_add(p, v, __ATOMIC_RELAXED, __HIP_MEMORY_SCOPE_AGENT); }
__device__ __forceinline__ unsigned xb_xcc_id() { return (unsigned)__builtin_amdgcn_s_getreg((3 << 11) | 20) & 0xFu; }
#define XB_SPIN(cond, bar) do { unsigned _sp = 0; while (cond) { __builtin_amdgcn_s_sleep(1); \
    if ((++_sp & 255u) == 0u) { if (xb_ld(&(bar)[XB_TMO])) break; if (_sp > XB_SPIN_CAP) { atomicAdd(&(bar)[XB_TMO], 1u); break; } } } } while (0)
struct XcdBarrier { unsigned* bar; unsigned x; volatile LAS unsigned* st; };
__device__ __forceinline__ XcdBarrier xcd_barrier_post(unsigned* bar, volatile LAS unsigned* st) {
    XcdBarrier b; b.bar = bar; b.x = xb_xcc_id(); b.st = st;
    if (threadIdx.x == 0) (void)xb_add(&bar[XB_XCNT(b.x)], 1u);
    return b;
}
__device__ __forceinline__ void xcd_barrier_complete(unsigned* bar, unsigned x, unsigned& nloc, unsigned& nx) {
    const unsigned G = gridDim.x * gridDim.y * gridDim.z;
    unsigned sum, cnt, mine, sp = 0u;
    for (;;) {
        sum = 0u; cnt = 0u; mine = 0u;
#pragma unroll
        for (unsigned j = 0; j < 16; ++j) { const unsigned c = xb_ld(&bar[XB_XCNT(j)]); sum += c; cnt += (c > 0u) ? 1u : 0u; }
        mine = xb_ld(&bar[XB_XCNT(x)]);
        if (sum == G) break;
        __builtin_amdgcn_s_sleep(1);
        if ((++sp & 255u) == 0u) { if (xb_ld(&bar[XB_TMO])) break; if (sp > XB_SPIN_CAP) { atomicAdd(&bar[XB_TMO], 1u); break; } }
    }
    nloc = mine > 0u ? mine : 1u; nx = cnt > 0u ? cnt : 1u;
}
__device__ __attribute__((noinline)) void xcd_barrier(unsigned* const bbar, const unsigned bx, volatile LAS unsigned* const bst, const int tid) {
    XcdBarrier b; b.bar = bbar; b.x = bx; b.st = bst;
    asm volatile("s_waitcnt vmcnt(0)" ::: "memory");
    __syncthreads();
    if (tid == 0) {
        unsigned* bar = b.bar;
        __builtin_amdgcn_s_waitcnt(0);
        unsigned nloc = b.st[0], nx = b.st[1];
        if (nloc == 0u) { xcd_barrier_complete(bar, b.x, nloc, nx); b.st[0] = nloc; b.st[1] = nx; }
        const unsigned old = xb_add(&bar[XB_XSUB(b.x)], 1u);
        const unsigned gen = old / nloc;
        if (old + 1u == (gen + 1u) * nloc) {
            __builtin_amdgcn_fence(__ATOMIC_RELEASE, "agent");
            asm volatile("s_waitcnt vmcnt(0)" ::: "memory");
            const unsigned og = xb_add(&bar[XB_TOP], 1u);
            const unsigned tg = og / nx;
            if (og + 1u == (tg + 1u) * nx) xb_add(&bar[XB_TOPGEN], 1u);
            else XB_SPIN(xb_ld(&bar[XB_TOPGEN]) == tg, bar);
            __builtin_amdgcn_fence(__ATOMIC_ACQUIRE, "agent");
            xb_add(&bar[XB_XGEN(b.x)], 1u);
            asm volatile("s_waitcnt vmcnt(0)" ::: "memory");
        } else {
            XB_SPIN(xb_ld(&bar[XB_XGEN(b.x)]) == gen, bar);
            __builtin_amdgcn_fence(__ATOMIC_ACQUIRE, "agent");
            asm volatile("s_waitcnt vmcnt(0)" ::: "memory");
        }
    }
    __syncthreads();
}

struct Args { const float* in[28]; float* out; unsigned char* ws; int ph_lo, ph_hi, li, pad; };
struct Frame {
    LAS unsigned char* lds;
    volatile LAS unsigned* MISC;
    int tid, lane, wave, G, blk, gw, ngw;
    const Args* A;
};
#define IN_F(F, i) ((F).A->in[i])
#define x_        IN_F(F, 0)
#define c_        IN_F(F, 1)
#define ctx_      IN_F(F, 2)
#define c_ctx_    IN_F(F, 3)
#define w_ada_    IN_F(F, 4)
#define b_ada_    IN_F(F, 5)
#define g_mix_    IN_F(F, 6)
#define w_in_     IN_F(F, 7)
#define na_q_norm_ IN_F(F, 8)
#define na_k_norm_ IN_F(F, 9)
#define na_rpb_   IN_F(F, 10)
#define mla_q_a_norm_ IN_F(F, 11)
#define mla_w_q_b_ IN_F(F, 12)
#define mla_kv_a_norm_ IN_F(F, 13)
#define mla_w_kv_b_ IN_F(F, 14)
#define mla_q_norm_ IN_F(F, 15)
#define mla_k_norm_ IN_F(F, 16)
#define gla_w_gate_ IN_F(F, 17)
#define gla_b_gate_ IN_F(F, 18)
#define gla_o_norm_ IN_F(F, 19)
#define w_out_    IN_F(F, 20)
#define g_ffn_    IN_F(F, 21)
#define w_router_ IN_F(F, 22)
#define b_router_ IN_F(F, 23)
#define w_moe1_   IN_F(F, 24)
#define b_moe1_   IN_F(F, 25)
#define w_moe2_   IN_F(F, 26)
#define b_moe2_   IN_F(F, 27)
#define out_      ((F).A->out)
#define WSP(F, T, off) ((T*)((F).A->ws + (off)))
#define MOD_  WSP(F, float, WS_MOD)
#define XU_   WSP(F, bf16, WS_XU)
#define EGF_  WSP(F, float, WS_EGF)
#define EGB_  WSP(F, float, WS_EGB)
#define GQ_   WSP(F, float, WS_GQ)
#define GK_   WSP(F, float, WS_GK)
#define GV_   WSP(F, float, WS_GV)
#define CS_   WSP(F, float, WS_CS)
#define AD_   WSP(F, float, WS_AD)
#define OGF_  WSP(F, float, WS_OGF)
#define OGB_  WSP(F, float, WS_OGB)
#define TOPG_ WSP(F, float, WS_TOPG)
#define WSM_  WSP(F, bf16, WS_WSM)
#define WIN_  WSP(F, bf16, WS_WIN)
#define WOUT_ WSP(F, bf16, WS_WOUT)
#define W1_   WSP(F, bf16, WS_W1)
#define W2_   WSP(F, bf16, WS_W2)
#define H_    WSP(F, bf16, WS_H)
#define ATT_  WSP(F, bf16, WS_ATT)
#define Z_    WSP(F, bf16, WS_Z)
#define Y_    WSP(F, bf16, WS_Y)
#define NAQ_  WSP(F, bf16, WS_NAQ)
#define NAK_  WSP(F, bf16, WS_NAK)
#define NAVT_ WSP(F, bf16, WS_NAVT)
#define MQ_   WSP(F, bf16, WS_MQ)
#define MK_   WSP(F, bf16, WS_MK)
#define MV_   WSP(F, bf16, WS_MV)
#define XS_   WSP(F, bf16, WS_XS)
#define ACT_  WSP(F, bf16, WS_ACT)
#define TOPE_ WSP(F, int, WS_TOPE)
#define DEST_ WSP(F, int, WS_DEST)
#define ROWMAP_ WSP(F, int, WS_GQ)
#define HISTB_ WSP(F, int, WS_HIST)
#define WHIST_ WSP(F, int, WS_HIST + 65536)

struct DenseOrder {
    int nMa, nN, G, c, skipctx, rep;
    __device__ __forceinline__ bool next(int i, pg8::Unit& u) const {
        const int x = c & 7, y = c >> 3, Y = G >> 3;
        if (rep > 1) i >>= 1;
        const int j = i * Y + y; const int mg = j / nN, pn = j - mg * nN, a = mg * 8 + x;
        if (a >= nMa) return false;
        u.pm = skipctx ? (a >> 3) * 9 + (a & 7) : a; u.pn = pn; u.pb = pn; u.pa = u.pm; return true;
    }
};
struct MoeOrder {
    const volatile LAS int* ts; const volatile LAS unsigned char* te; int nN, G, c, rep;
    __device__ __forceinline__ bool next(int i, pg8::Unit& u) const {
        const int x = c & 7, y = c >> 3, Y = G >> 3;
        const int i0 = i; if (rep > 1) i >>= 1;
        const int j = i * Y + y; const int mg = j / nN, pn = j - mg * nN, a = mg * 8 + x;
        if (a >= ts[NEXP]) return false;
        const int e = te[a]; u.pm = a; u.pn = pn; u.pb = e * nN + pn; u.pa = a;
        if (NREP(19) > 1 && rep > 1 && !(i0 & 1)) { const int a2 = (a + 296) % ts[NEXP]; u.pa = a2; u.pb = te[a2] * nN + pn; }
        return true;
    }
};

struct EpiNoPre { };
template <bool SCALED> struct EpiBf16PlainT {
    static constexpr bool PERM = true; typedef EpiNoPre Pre;
    bf16* O; int ldc;
    __device__ __forceinline__ Pre prefetch(const pg8::Unit&, int, int) const { return Pre{}; }
    __device__ __forceinline__ void operator()(const f32x4 (&acc)[2][2][4][2], const pg8::Unit& u, int wr, int wc, int fr, int fq, const Pre&) const {
        const int row0 = u.pm * 256 + wr * 64 + fr, col0 = u.pn * 256 + wc * 32 + 8 * fq;
#pragma unroll
        for (int ai = 0; ai < 2; ++ai)
#pragma unroll
            for (int m = 0; m < 4; ++m) { bf16* rowp = O + (size_t)(row0 + ai * 128 + m * 16) * ldc + col0;
#pragma unroll
                for (int bj = 0; bj < 2; ++bj) { f32x4 v0 = acc[ai][bj][m][0], v1 = acc[ai][bj][m][1];
                    if constexpr (SCALED) { v0 = v0 * (1.0f / (SC_W * SC_X)); v1 = v1 * (1.0f / (SC_W * SC_X)); }
                    u32x4 w; w.x = pg8::cvt_pk_bf16(v0[0], v0[1]); w.y = pg8::cvt_pk_bf16(v0[2], v0[3]); w.z = pg8::cvt_pk_bf16(v1[0], v1[1]); w.w = pg8::cvt_pk_bf16(v1[2], v1[3]);
                    *(u32x4*)(rowp + bj * 128) = w; } }
    }
};
typedef EpiBf16PlainT<false> EpiBf16Plain;
struct EpiResid {
    static constexpr bool PERM = true; typedef EpiNoPre Pre;
    bf16* X; const float* gt;
    const float* xin; const float* cin;
    __device__ __forceinline__ Pre prefetch(const pg8::Unit&, int, int) const { return Pre{}; }
    __device__ __forceinline__ void operator()(const f32x4 (&acc)[2][2][4][2], const pg8::Unit& u, int wr, int wc, int fr, int fq, const Pre&) const {
        const int row0 = u.pm * 256 + wr * 64 + fr, col0 = u.pn * 256 + wc * 32 + 8 * fq;
        const int bi = u.pm / 9, t9 = u.pm - bi * 9, mc = (t9 == 8) ? 16 : bi; const float* g = gt + mc * 6144 + col0;
        const float* base = xin ? (t9 == 8 ? cin + (size_t)bi * CTXL * DM : xin + ((size_t)bi * SEQ + t9 * 256) * DM) + (size_t)(wr * 64 + fr) * DM + col0 : nullptr;
        f32x4 gv[2][2];
#pragma unroll
        for (int bj = 0; bj < 2; ++bj)
#pragma unroll
            for (int n = 0; n < 2; ++n) gv[bj][n] = *(const f32x4*)(g + bj * 128 + 4 * n);
#pragma unroll
        for (int ai = 0; ai < 2; ++ai)
#pragma unroll
            for (int m = 0; m < 4; ++m) { bf16* rowp = X + (size_t)(row0 + ai * 128 + m * 16) * DM + col0;
#pragma unroll
                for (int bj = 0; bj < 2; ++bj) { f32x4 b0, b1;
                    if (xin) { const float* bp = base + (size_t)(ai * 128 + m * 16) * DM + bj * 128; b0 = *(const f32x4*)bp; b1 = *(const f32x4*)(bp + 4); }
                    else { const u32x4 w = *(const u32x4*)(rowp + bj * 128); u32x2 lo, hi; lo.x = w.x; lo.y = w.y; hi.x = w.z; hi.y = w.w; b0 = bf4f(lo); b1 = bf4f(hi); }
                    const f32x4 v0 = b0 + gv[bj][0] * acc[ai][bj][m][0], v1 = b1 + gv[bj][1] * acc[ai][bj][m][1];
                    u32x4 o; o.x = pg8::cvt_pk_bf16(v0[0], v0[1]); o.y = pg8::cvt_pk_bf16(v0[2], v0[3]); o.z = pg8::cvt_pk_bf16(v1[0], v1[1]); o.w = pg8::cvt_pk_bf16(v1[2], v1[3]);
                    *(u32x4*)(rowp + bj * 128) = o; } }
    }
};
struct EpiSwiglu {
    static constexpr bool PERM = true; struct Pre { f32x4 bg[2], bl[2]; };
    unsigned char* O; const float* b1;
    __device__ __forceinline__ Pre prefetch(const pg8::Unit& u, int wc, int fq) const { Pre p; const float* bb = b1 + (u.pb >> 3) * 2048 + u.pn * 128 + wc * 32 + 8 * fq;
#pragma unroll
        for (int n = 0; n < 2; ++n) { p.bg[n] = *(const f32x4*)(bb + 4 * n); p.bl[n] = *(const f32x4*)(bb + 1024 + 4 * n); }
        return p; }
    __device__ __forceinline__ void operator()(const f32x4 (&acc)[2][2][4][2], const pg8::Unit& u, int wr, int wc, int fr, int fq, const Pre& pre) const {
        const int row0 = u.pm * 256 + wr * 64 + fr, oc0 = u.pn * 128 + wc * 32 + 8 * fq;
        const f32x4 (&bg)[2] = pre.bg; const f32x4 (&bl)[2] = pre.bl;
        constexpr float S = 1.0f / (SC_W * SC_X);
#pragma unroll
        for (int ai = 0; ai < 2; ++ai)
#pragma unroll
            for (int m = 0; m < 4; ++m) { u32x2 w;
#pragma unroll
                for (int n = 0; n < 2; ++n) { f32x4 gl = acc[ai][0][m][n] * S + bg[n], li = acc[ai][1][m][n] * S + bl[n];
#pragma unroll
                    for (int i = 0; i < 4; ++i) { gl[i] = fminf(gl[i], 7.0f); li[i] = __builtin_amdgcn_fmed3f(li[i], -7.0f, 7.0f); }
                    f32x4 e = gl * (-1.702f * LOG2E);
#pragma unroll
                    for (int i = 0; i < 4; ++i) e[i] = __builtin_amdgcn_exp2f(e[i]);
                    e = e + 1.0f;
#pragma unroll
                    for (int i = 0; i < 4; ++i) e[i] = __builtin_amdgcn_rcpf(e[i]);
                    const f32x4 o = (li * SC_ACT + SC_ACT) * (gl * e);
                    int p = __builtin_amdgcn_cvt_pk_fp8_f32(o[0], o[1], 0, false); p = __builtin_amdgcn_cvt_pk_fp8_f32(o[2], o[3], p, true);
                    if (n == 0) w.x = (unsigned)p; else w.y = (unsigned)p; }
                *(u32x2*)(O + (size_t)(row0 + ai * 128 + m * 16) * DM + oc0) = w; }
    }
};
struct EpiFp8Bias {
    static constexpr bool PERM = true; struct Pre { f32x4 bv[2][2]; };
    unsigned char* O; const float* b2;
    __device__ __forceinline__ Pre prefetch(const pg8::Unit& u, int wc, int fq) const { Pre p; const float* bb = b2 + (u.pb >> 2) * 1024 + u.pn * 256 + wc * 32 + 8 * fq;
#pragma unroll
        for (int bj = 0; bj < 2; ++bj)
#pragma unroll
            for (int n = 0; n < 2; ++n) p.bv[bj][n] = *(const f32x4*)(bb + bj * 128 + 4 * n);
        return p; }
    __device__ __forceinline__ void operator()(const f32x4 (&acc)[2][2][4][2], const pg8::Unit& u, int wr, int wc, int fr, int fq, const Pre& pre) const {
        const int row0 = u.pm * 256 + wr * 64 + fr, col0 = u.pn * 256 + wc * 32 + 8 * fq;
        const f32x4 (&bv)[2][2] = pre.bv;
#pragma unroll
        for (int ai = 0; ai < 2; ++ai)
#pragma unroll
            for (int m = 0; m < 4; ++m) { unsigned char* rowp = O + (size_t)(row0 + ai * 128 + m * 16) * DM + col0;
#pragma unroll
                for (int bj = 0; bj < 2; ++bj) { const f32x4 v0 = acc[ai][bj][m][0] * (SC_Y / (SC_W * SC_ACT)) + bv[bj][0] * SC_Y, v1 = acc[ai][bj][m][1] * (SC_Y / (SC_W * SC_ACT)) + bv[bj][1] * SC_Y;
                    u32x2 w; w.x = pk4f8(v0[0], v0[1], v0[2], v0[3]); w.y = pk4f8(v1[0], v1[1], v1[2], v1[3]);
                    *(u32x2*)(rowp + bj * 128) = w; } }
    }
};

__device__ __forceinline__ void relane(Frame& F) { int ln_; asm volatile("v_mbcnt_lo_u32_b32 %0, -1, 0\n\tv_mbcnt_hi_u32_b32 %0, -1, %0" : "=v"(ln_)); ln_ &= 63; F.lane = ln_; F.tid = F.wave * 64 + ln_; }

__device__ __forceinline__ void tr_item(const float* src, int ldsrc, bool valid, const float* ksc, bf16* dst, int lddst, LAS float* scr, int lane) {
    float v[32];
#pragma unroll
    for (int i = 0; i < 32; ++i) { const int kk = 2 * i + (lane >> 5); v[i] = valid ? src[(size_t)kk * ldsrc + (lane & 31)] : 0.f; }
    if (valid && ksc) {
#pragma unroll
        for (int i = 0; i < 32; ++i) v[i] *= ksc[2 * i + (lane >> 5)];
    }
#pragma unroll
    for (int i = 0; i < 32; ++i) { const int kk = 2 * i + (lane >> 5); scr[kk * 33 + (lane & 31)] = v[i]; }
    LDS_WAIT(); asm volatile("" ::: "memory");
    const int c = lane & 7;
#pragma unroll
    for (int j = 0; j < 4; ++j) { const int n = (lane >> 3) + 8 * j; const LAS float* s = scr + (8 * c) * 33 + n;
        u32x4 o; o.x = pk2(s[0 * 33], s[1 * 33]); o.y = pk2(s[2 * 33], s[3 * 33]); o.z = pk2(s[4 * 33], s[5 * 33]); o.w = pk2(s[6 * 33], s[7 * 33]);
        *(u32x4*)(dst + (size_t)n * lddst + 8 * c) = o; }
    LDS_WAIT(); asm volatile("" ::: "memory");
}
__device__ __forceinline__ void tr_item8(const float* src, int ldsrc, unsigned char* dst, int lddst, LAS float* scr, int lane) {
    float v[32];
#pragma unroll
    for (int i = 0; i < 32; ++i) { const int kk = 2 * i + (lane >> 5); v[i] = src[(size_t)kk * ldsrc + (lane & 31)] * SC_W; }
#pragma unroll
    for (int i = 0; i < 32; ++i) { const int kk = 2 * i + (lane >> 5); scr[kk * 33 + (lane & 31)] = v[i]; }
    LDS_WAIT(); asm volatile("" ::: "memory");
    const int c = lane & 7;
#pragma unroll
    for (int j = 0; j < 4; ++j) { const int n = (lane >> 3) + 8 * j; const LAS float* s = scr + (8 * c) * 33 + n;
        u32x2 o; o.x = pk4f8(s[0 * 33], s[1 * 33], s[2 * 33], s[3 * 33]); o.y = pk4f8(s[4 * 33], s[5 * 33], s[6 * 33], s[7 * 33]);
        *(u32x2*)(dst + (size_t)n * lddst + 8 * c) = o; }
    LDS_WAIT(); asm volatile("" ::: "memory");
}
__device__ __forceinline__ void tr_item8w(const float* src, int ldsrc, unsigned char* dst, LAS float* scr, int lane) {
    const int kr = lane >> 4, nc = (lane & 15) * 4;
    f32x4 v[16];
#pragma unroll
    for (int i = 0; i < 16; ++i) v[i] = *(const f32x4*)(src + (size_t)(4 * i + kr) * ldsrc + nc);
#pragma unroll
    for (int i = 0; i < 16; ++i) *(LAS f32x4*)(scr + (4 * i + kr) * 68 + nc) = v[i] * SC_W;
    LDS_WAIT(); asm volatile("" ::: "memory");
#pragma unroll
    for (int c = 0; c < 4; ++c) { const LAS float* s = scr + (16 * c) * 68 + lane; u32x4 o;
        o.x = pk4f8(s[0 * 68], s[1 * 68], s[2 * 68], s[3 * 68]); o.y = pk4f8(s[4 * 68], s[5 * 68], s[6 * 68], s[7 * 68]);
        o.z = pk4f8(s[8 * 68], s[9 * 68], s[10 * 68], s[11 * 68]); o.w = pk4f8(s[12 * 68], s[13 * 68], s[14 * 68], s[15 * 68]);
        *(u32x4*)(dst + (size_t)lane * 1024 + 16 * c) = o; }
    LDS_WAIT(); asm volatile("" ::: "memory");
}
__device__ __forceinline__ void p0_prologue(Frame& F) {
    for (int ch = F.blk; ch < 192; ch += F.G) {
        LAS float* s = (LAS float*)(F.lds + RING_OFF);
        LAS float* red = s + 17 * 1024;
        for (int idx = F.tid; idx < 17 * 1024; idx += 512) { const int m = idx >> 10, k = idx & 1023; const float cv = m < 16 ? c_[m * 1024 + k] : c_ctx_[k]; s[idx] = cv / (1.0f + __expf(-cv)); }
        __syncthreads();
        const int l = ch / 96, col0 = (ch % 96) * 64;
        const float* W = w_ada_ + (size_t)l * 1024 * 6144 + col0 + F.lane;
        float acc[17];
#pragma unroll
        for (int m = 0; m < 17; ++m) acc[m] = 0.f;
#pragma unroll 8
        for (int kk = 0; kk < 128; ++kk) { const int k = F.wave * 128 + kk; const float w = W[(size_t)k * 6144];
#pragma unroll
            for (int m = 0; m < 17; ++m) acc[m] += s[m * 1024 + k] * w; }
#pragma unroll
        for (int m = 0; m < 17; ++m) red[(F.wave * 17 + m) * 64 + F.lane] = acc[m];
        __syncthreads();
        for (int idx = F.tid; idx < 17 * 64; idx += 512) { const int m = idx >> 6, cc = idx & 63; float a = b_ada_[l * 6144 + col0 + cc];
#pragma unroll
            for (int w = 0; w < 8; ++w) a += red[(w * 17 + m) * 64 + cc];
            MOD_[((size_t)l * 17 + m) * 6144 + col0 + cc] = a; }
        __syncthreads();
    }
    LAS float* scr = (LAS float*)(F.lds + RING_OFF + F.wave * 17408);
    constexpr int IT_W1 = 64 * 512, IT_W2 = 64 * 256, IT_WIN = 2 * 512, IT_WOUT = 2 * 512, IT_SM = 2 * 240;
    static_assert(8 * 17408 <= MISC_OFF, "prologue LDS tiles");
    constexpr int NIT = IT_W1 + IT_W2 + IT_WIN + IT_WOUT + IT_SM;
    for (int it = IT_W1 + IT_W2 + F.gw; it < NIT; it += F.ngw) {
        int r = it;
        if (r < IT_W1) { const int le = r >> 9, q = r & 511, kb = q >> 5, nb = q & 31, n0 = nb * 64, pn = n0 >> 8, j = n0 & 255; const int sc = j < 128 ? 128 * pn + j : 1024 + 128 * pn + (j - 128);
            tr_item8w(w_moe1_ + ((size_t)le * 1024 + kb * 64) * 2048 + sc, 2048, (unsigned char*)W1_ + ((size_t)le * 2048 + n0) * 1024 + kb * 64, scr, F.lane); continue; }
        r -= IT_W1;
        if (r < IT_W2) { const int le = r >> 8, q = r & 255, kb = q >> 4, nb = q & 15, n0 = nb * 64;
            tr_item8w(w_moe2_ + ((size_t)le * 1024 + kb * 64) * 1024 + n0, 1024, (unsigned char*)W2_ + ((size_t)le * 1024 + n0) * 1024 + kb * 64, scr, F.lane); continue; }
        r -= IT_W2;
        if (r < IT_WIN) { const int l = r >> 9, q = r & 511, kb = q >> 5, nb = q & 31, n0 = nb * 64;
            unsigned char* dst = (unsigned char*)WIN_ + ((size_t)l * 2048 + n0) * 1024 + kb * 64;
            if (n0 < INC) tr_item8w(w_in_ + ((size_t)l * 1024 + kb * 64) * INC + n0, INC, dst, scr, F.lane);
            else { const u32x4 z = {0u, 0u, 0u, 0u};
#pragma unroll
                for (int c = 0; c < 4; ++c) *(u32x4*)(dst + (size_t)F.lane * 1024 + 16 * c) = z; }
            continue; }
        r -= IT_WIN;
        if (r < IT_WOUT) { const int l = r >> 9, q = r & 511, kb = q >> 5, nb = q & 31, n0 = nb * 32;
            tr_item(w_out_ + ((size_t)l * 1024 + kb * 64) * 1024 + n0, 1024, true, nullptr, WOUT_ + ((size_t)l * 1024 + n0) * 1024 + kb * 64, 1024, scr, F.lane); continue; }
        r -= IT_WOUT;
        { const int l = r / 240, q = r - l * 240, kb = q / 40, nb = q - kb * 40, n0 = nb * 32, k0 = kb * 64;
            bf16* dst = WSM_ + ((size_t)l * 1280 + n0) * 384 + k0;
            if (n0 < 384) tr_item(mla_w_q_b_ + ((size_t)l * 256 + (k0 & 255)) * 384 + n0, 384, k0 < 256, mla_q_a_norm_ + l * 256 + (k0 & 255), dst, 384, scr, F.lane);
            else if (n0 < 1152) tr_item(mla_w_kv_b_ + ((size_t)l * 128 + ((k0 - 256) & 127)) * 768 + (n0 - 384), 768, k0 >= 256, mla_kv_a_norm_ + l * 128 + ((k0 - 256) & 127), dst, 384, scr, F.lane);
            else tr_item(w_out_, 1024, false, nullptr, dst, 384, scr, F.lane); }
    }
    __syncthreads();
}

__device__ __forceinline__ void norm_mod_store(const f32x4 (&v)[4], float rstd, const float* g, const float* sc, const float* sh, unsigned char* orow  , int lane) {
#pragma unroll
    for (int j = 0; j < 4; ++j) { const int col = 256 * j + 4 * lane; const f32x4 gg = *(const f32x4*)(g + col), s1 = *(const f32x4*)(sc + col), s0 = *(const f32x4*)(sh + col);
        const f32x4 h = (v[j] * rstd * gg * (s1 + 1.0f) + s0) * SC_X; *(unsigned*)(orow + col) = pk4f8(h[0], h[1], h[2], h[3]); }
}
__device__ __forceinline__ float sumsq4(const f32x4 (&v)[4]) { float s = 0.f;
#pragma unroll
    for (int j = 0; j < 4; ++j) s += (v[j][0] * v[j][0] + v[j][1] * v[j][1]) + (v[j][2] * v[j][2] + v[j][3] * v[j][3]);
    return s; }

__device__ __forceinline__ const float* pA_src(Frame& F, int row) { const int b = row / TPB, p = row - b * TPB; return p < SEQ ? x_ + ((size_t)b * SEQ + p) * DM : ctx_ + ((size_t)b * CTXL + (p - SEQ)) * DM; }
__device__ __forceinline__ void pA_init(Frame& F) {
    const int lane = F.lane, step = F.ngw;
    int row = F.gw; if (row >= MROWS) return;
    f32x4 gm[4];
#pragma unroll
    for (int j = 0; j < 4; ++j) gm[j] = *(const f32x4*)(g_mix_ + 256 * j + 4 * lane);
    auto load = [&](f32x4 (&v)[4], int r) __attribute__((always_inline)) { const float* src = pA_src(F, r);
#pragma unroll
        for (int j = 0; j < 4; ++j) v[j] = *(const f32x4*)(src + 256 * j + 4 * lane); };
    auto one = [&](const f32x4 (&v)[4], int r) __attribute__((always_inline)) {
        const int b = r / TPB, p = r - b * TPB; const int mc = p < SEQ ? b : 16; const float* mod = MOD_ + (size_t)mc * 6144;
        f32x4 s1[4], s0[4];
#pragma unroll
        for (int j = 0; j < 4; ++j) { s1[j] = *(const f32x4*)(mod + 1024 + 256 * j + 4 * lane); s0[j] = *(const f32x4*)(mod + 256 * j + 4 * lane); }
        const float rstd = rsq(wave_sum(sumsq4(v)) * (1.0f / DM) + EPS);
        unsigned char* orow = (unsigned char*)H_ + (size_t)r * DM;
#pragma unroll
        for (int j = 0; j < 4; ++j) { const f32x4 h = (v[j] * rstd * gm[j] * (s1[j] + 1.0f) + s0[j]) * SC_X; *(unsigned*)(orow + 256 * j + 4 * lane) = pk4f8(h[0], h[1], h[2], h[3]); }
    };
    f32x4 A[4], B[4]; load(A, row);
    for (; row < MROWS; row += 2 * step) {
        if (row + step < MROWS) load(B, row + step);
        one(A, row);
        if (row + step >= MROWS) break;
        if (row + 2 * step < MROWS) load(A, row + 2 * step);
        one(B, row + step);
    }
}

__device__ __forceinline__ float logsigmoid(float x) { return fminf(x, 0.f) - __logf(1.0f + __expf(-fabsf(x))); }
__device__ __forceinline__ void up4(const u32x2 w, float (&f)[4]) { f[0] = __uint_as_float(w.x << 16); f[1] = __uint_as_float(w.x & 0xffff0000u); f[2] = __uint_as_float(w.y << 16); f[3] = __uint_as_float(w.y & 0xffff0000u); }
struct DIn { u32x2 naq, nak, nav, cq, ckv, yq, yk; u32x4 lf0, lf1, lb0, lb1, yv; bf16 kr0, kr1, yq0, yq1; };
__device__ __forceinline__ void pD_load(Frame& F, DIn& d, int row, int lane) {
    const int c4 = 4 * lane, hh = lane >> 4, jj = lane & 15, ra = jj >> 3, j8 = jj & 7, ri = 64 + ra * 16 + j8;
    const bf16* z = Z_ + (size_t)row * ZC; const bf16* y = Y_ + (size_t)row * YC; const u32x2 zero2 = {0u, 0u};
    d.naq = *(const u32x2*)(z + Z_NAQ + c4); d.nak = *(const u32x2*)(z + Z_NAK + c4); d.nav = *(const u32x2*)(z + Z_NAV + c4); d.cq = *(const u32x2*)(z + Z_CQ + c4);
    d.ckv = lane < 32 ? *(const u32x2*)(z + Z_CKV + c4) : zero2;
    d.lf0 = *(const u32x4*)(z + Z_LF); d.lf1 = *(const u32x4*)(z + Z_LF + 8); d.lb0 = *(const u32x4*)(z + Z_LB); d.lb1 = *(const u32x4*)(z + Z_LB + 8);
    d.kr0 = z[Z_KR + ra * 16 + j8]; d.kr1 = z[Z_KR + ra * 16 + j8 + 8];
    d.yq = *(const u32x2*)(y + hh * 96 + 4 * jj); d.yq0 = y[hh * 96 + ri]; d.yq1 = y[hh * 96 + ri + 8];
    d.yk = *(const u32x2*)(y + 384 + hh * 192 + 4 * jj); d.yv = *(const u32x4*)(y + 384 + hh * 192 + 64 + 8 * jj);
}
__device__ __forceinline__ int pD_row(const Frame& F, int g) { const int tile = min(F.blk + (g >> 2) * F.G, MROWS / 32 - 1); return tile * 32 + F.wave + 8 * (g & 3); }
__device__ __forceinline__ void pD_tokens(Frame& F, int l) {
    const int lane = F.lane, c4 = 4 * lane, hh = lane >> 4, jj = lane & 15, ra = jj >> 3, j8 = jj & 7;
    LAS float* wgs = (LAS float*)(F.lds + RING_OFF + 65536);
    for (int i = F.tid; i < 2 * 16 * 128; i += 512) wgs[i] = gla_w_gate_[(size_t)l * 2 * 16 * 128 + i];
    LDS_WAIT(); __syncthreads();
    typedef float f32x2v __attribute__((ext_vector_type(2)));
    const LAS float* wgl = wgs + 2 * lane;
    const float bgf0 = gla_b_gate_[(l * 2 + 0) * 128 + 2 * lane], bgf1 = gla_b_gate_[(l * 2 + 0) * 128 + 2 * lane + 1];
    const float bgb0 = gla_b_gate_[(l * 2 + 1) * 128 + 2 * lane], bgb1 = gla_b_gate_[(l * 2 + 1) * 128 + 2 * lane + 1];
    const float inv = exp2f(-(float)j8 * 1.6609640474436813f);
    const float* qn_g = na_q_norm_ + l * 64 + (c4 & 63); const float* kn_g = na_k_norm_ + l * 64 + (c4 & 63);
    const float* mq_g = mla_q_norm_ + l * 96; const float* mk_g = mla_k_norm_ + l * 96;
    const int ri = 64 + ra * 16 + j8;
    const float qg0 = qn_g[0], qg1 = qn_g[1], qg2 = qn_g[2], qg3 = qn_g[3], kg0 = kn_g[0], kg1 = kn_g[1], kg2 = kn_g[2], kg3 = kn_g[3];
    const float mqn0 = mq_g[4 * jj], mqn1 = mq_g[4 * jj + 1], mqn2 = mq_g[4 * jj + 2], mqn3 = mq_g[4 * jj + 3], mqr0 = mq_g[ri], mqr1 = mq_g[ri + 8];
    const float mkn0 = mk_g[4 * jj], mkn1 = mk_g[4 * jj + 1], mkn2 = mk_g[4 * jj + 2], mkn3 = mk_g[4 * jj + 3], mkr0 = mk_g[ri], mkr1 = mk_g[ri + 8];
    LAS unsigned char* vt = F.lds + RING_OFF;
    const int ntok = 4 * ((MROWS / 32 - F.blk + F.G - 1) / F.G);
    auto one = [&](const DIn& cur, const int g) __attribute__((always_inline)) {
        {
            const int tile = F.blk + (g >> 2) * F.G, it = g & 3, b = tile / 72, p0 = (tile - b * 72) * 32;
            const int tl = F.wave + 8 * it, row = tile * 32 + tl, p = p0 + tl; const bool lat = p < SEQ;
            float f[4];
            { up4(cur.naq, f); const float r = rsq(g16_sum(f[0] * f[0] + f[1] * f[1] + f[2] * f[2] + f[3] * f[3]) * (1.0f / 64) + EPS) * QS_NA;
              st4bf(NAQ_ + (size_t)row * 256 + c4, f[0] * r * qg0, f[1] * r * qg1, f[2] * r * qg2, f[3] * r * qg3); }
            { up4(cur.nak, f); const float r = rsq(g16_sum(f[0] * f[0] + f[1] * f[1] + f[2] * f[2] + f[3] * f[3]) * (1.0f / 64) + EPS);
              st4bf(NAK_ + (size_t)row * 256 + c4, f[0] * r * kg0, f[1] * r * kg1, f[2] * r * kg2, f[3] * r * kg3); }
            *(LAS u32x2*)(vt + tl * VT_PITCH + c4 * 2) = cur.nav;
            up4(cur.cq, f); const float rq = rsq(wave_sum(f[0] * f[0] + f[1] * f[1] + f[2] * f[2] + f[3] * f[3]) * (1.0f / 256) + EPS);
            up4(cur.ckv, f); const float rkv = rsq(wave_sum(f[0] * f[0] + f[1] * f[1] + f[2] * f[2] + f[3] * f[3]) * (1.0f / 128) + EPS);
            const float ang = lat ? (float)(ra == 0 ? (p >> 6) : (p & 63)) * inv : 0.f;
            const float cs = __cosf(ang), sn = __sinf(ang);
            { up4(cur.yq, f); float a0 = bf2f(cur.yq0) * rq, a1 = bf2f(cur.yq1) * rq;
#pragma unroll
              for (int i = 0; i < 4; ++i) f[i] *= rq;
              const float r = rsq(g16_sum(f[0] * f[0] + f[1] * f[1] + f[2] * f[2] + f[3] * f[3] + a0 * a0 + a1 * a1) * (1.0f / 96) + EPS);
              a0 *= r * mqr0; a1 *= r * mqr1;
              bf16* o = MQ_ + (size_t)row * 384 + hh * 96;
              st4bf(o + 4 * jj, f[0] * r * mqn0, f[1] * r * mqn1, f[2] * r * mqn2, f[3] * r * mqn3);
              o[ri] = (bf16)f2bf(a0 * cs - a1 * sn); o[ri + 8] = (bf16)f2bf(a1 * cs + a0 * sn); }
            { up4(cur.yk, f); float a0 = bf2f(cur.kr0), a1 = bf2f(cur.kr1);
#pragma unroll
              for (int i = 0; i < 4; ++i) f[i] *= rkv;
              const float r = rsq(g16_sum(f[0] * f[0] + f[1] * f[1] + f[2] * f[2] + f[3] * f[3] + a0 * a0 + a1 * a1) * (1.0f / 96) + EPS);
              a0 *= r * mkr0; a1 *= r * mkr1;
              bf16* o = MK_ + (size_t)row * 384 + hh * 96;
              st4bf(o + 4 * jj, f[0] * r * mkn0, f[1] * r * mkn1, f[2] * r * mkn2, f[3] * r * mkn3);
              o[ri] = (bf16)f2bf(a0 * cs - a1 * sn); o[ri + 8] = (bf16)f2bf(a1 * cs + a0 * sn); }
            { float g[4]; u32x2 lo, hi; lo.x = cur.yv.x; lo.y = cur.yv.y; hi.x = cur.yv.z; hi.y = cur.yv.w; up4(lo, f); up4(hi, g);
              u32x4 w; w.x = pk2(f[0] * rkv, f[1] * rkv); w.y = pk2(f[2] * rkv, f[3] * rkv); w.z = pk2(g[0] * rkv, g[1] * rkv); w.w = pk2(g[2] * rkv, g[3] * rkv);
              *(u32x4*)(MV_ + (size_t)row * 512 + hh * 128 + 8 * jj) = w; }
            { float xf0 = bgf0, xf1 = bgf1, xb0 = bgb0, xb1 = bgb1;
              const unsigned lfw[8] = {cur.lf0.x, cur.lf0.y, cur.lf0.z, cur.lf0.w, cur.lf1.x, cur.lf1.y, cur.lf1.z, cur.lf1.w};
              const unsigned lbw[8] = {cur.lb0.x, cur.lb0.y, cur.lb0.z, cur.lb0.w, cur.lb1.x, cur.lb1.y, cur.lb1.z, cur.lb1.w};
#pragma unroll
              for (int k2 = 0; k2 < 8; ++k2) { const float a0 = __uint_as_float(lfw[k2] << 16), a1 = __uint_as_float(lfw[k2] & 0xffff0000u), b0 = __uint_as_float(lbw[k2] << 16), b1 = __uint_as_float(lbw[k2] & 0xffff0000u);
                  const f32x2v wf0 = *(const LAS f32x2v*)(wgl + (2 * k2) * 128), wf1 = *(const LAS f32x2v*)(wgl + (2 * k2 + 1) * 128), wb0 = *(const LAS f32x2v*)(wgl + (16 + 2 * k2) * 128), wb1 = *(const LAS f32x2v*)(wgl + (17 + 2 * k2) * 128);
                  xf0 += a0 * wf0.x + a1 * wf1.x; xf1 += a0 * wf0.y + a1 * wf1.y; xb0 += b0 * wb0.x + b1 * wb1.x; xb1 += b0 * wb0.y + b1 * wb1.y; }
              float* ef = EGF_ + (size_t)row * 128 + 2 * lane; float* eb = EGB_ + (size_t)row * 128 + 2 * lane;
              ef[0] = logsigmoid(xf0) * (1.0f / 16); ef[1] = logsigmoid(xf1) * (1.0f / 16);
              eb[0] = logsigmoid(xb0) * (1.0f / 16); eb[1] = logsigmoid(xb1) * (1.0f / 16); }
        }
        if ((g & 3) == 3) {
            const int tile = F.blk + (g >> 2) * F.G, b = tile / 72, p0 = (tile - b * 72) * 32;
            LDS_WAIT(); __syncthreads();
            for (int cI = 0; cI < 16; ++cI) { const int cc = F.wave * 32 + 2 * cI + (lane >> 5), tk = lane & 31; const bf16 val = *(const LAS bf16*)(vt + tk * VT_PITCH + cc * 2);
                NAVT_[((size_t)(b * 4 + (cc >> 6)) * 64 + (cc & 63)) * TPB + p0 + tk] = val; }
            LDS_WAIT(); __syncthreads();
        }
    };
    DIn b0, b1, b2;
    pD_load(F, b0, pD_row(F, 0), lane); pD_load(F, b1, pD_row(F, 1), lane);
    for (int g = 0; g < ntok; g += 3) {
        pD_load(F, b2, pD_row(F, g + 2), lane); one(b0, g);
        if (g + 1 < ntok) { pD_load(F, b0, pD_row(F, g + 3), lane); one(b1, g + 1); }
        if (g + 2 < ntok) { pD_load(F, b1, pD_row(F, g + 4), lane); one(b2, g + 2); }
    }
}

template <int DV> struct AttnSt { f32x4 o[DV / 16]; float m, l; };
#define MFMA16(a, b, c) __builtin_amdgcn_mfma_f32_16x16x32_bf16((a), (b), (c), 0, 0, 0)
template <int DQK, int DV> struct KvFrag { bf16x8 k0[DQK / 32], k1[DQK / 32]; u32x2 vlo[DV / 16], vhi[DV / 16]; };
template <int DQK, int DV, bool NA, bool FIXM, class RP = const float*>
__device__ __forceinline__ void attn_math32(AttnSt<DV>& st, const bf16x8 (&qf)[DQK / 32], const KvFrag<DQK, DV>& f, int q, RP rpbrow, int kcol0, int qc, int cs) {
    const float c0 = FIXM ? -st.m : 0.f;
    f32x4 s0 = (f32x4){c0, c0, c0, c0}, s1 = s0;
#pragma unroll
    for (int s = 0; s < DQK / 32; ++s) { s0 = MFMA16(f.k0[s], qf[s], s0); s1 = MFMA16(f.k1[s], qf[s], s1); }
    if constexpr (NA) {
        float bs[8];
#pragma unroll
        for (int i = 0; i < 4; ++i) { bs[i] = rpbrow[kcol0 + 4 * q - qc + 15 + i]; bs[4 + i] = rpbrow[kcol0 + 4 * q - qc + 31 + i]; }
#pragma unroll
        for (int i = 0; i < 4; ++i) {
            const int k0 = kcol0 + 4 * q + i, k1 = k0 + 16;
            const float t0 = s0[i] + bs[i], t1 = s1[i] + bs[4 + i];
            s0[i] = (k0 >= cs && k0 < cs + 16) ? t0 : -INFINITY;
            s1[i] = (k1 >= cs && k1 < cs + 16) ? t1 : -INFINITY;
        }
    }
    float p0[4], p1[4], ps = 0.f, al = 1.f;
    if constexpr (FIXM) {
#pragma unroll
        for (int i = 0; i < 4; ++i) { p0[i] = __builtin_amdgcn_exp2f(s0[i]); p1[i] = __builtin_amdgcn_exp2f(s1[i]); ps += p0[i] + p1[i]; }
        st.l += ps;
    } else {
        float mx = fmaxf(fmaxf(fmaxf(s0[0], s0[1]), fmaxf(s0[2], s0[3])), fmaxf(fmaxf(s1[0], s1[1]), fmaxf(s1[2], s1[3])));
        mx = q4_max(mx);
        const float mn = fmaxf(st.m, mx); al = __builtin_amdgcn_exp2f(st.m - mn); st.m = mn;
#pragma unroll
        for (int i = 0; i < 4; ++i) { p0[i] = __builtin_amdgcn_exp2f(s0[i] - mn); p1[i] = __builtin_amdgcn_exp2f(s1[i] - mn); ps += p0[i] + p1[i]; }
        st.l = st.l * al + ps;
    }
    u32x4 pw; pw.x = pg8::cvt_pk_bf16(p0[0], p0[1]); pw.y = pg8::cvt_pk_bf16(p0[2], p0[3]); pw.z = pg8::cvt_pk_bf16(p1[0], p1[1]); pw.w = pg8::cvt_pk_bf16(p1[2], p1[3]);
    const bf16x8 pf = __builtin_bit_cast(bf16x8, pw);
#pragma unroll
    for (int n = 0; n < DV / 16; ++n) {
        u32x4 aw; aw.x = f.vlo[n].x; aw.y = f.vlo[n].y; aw.z = f.vhi[n].x; aw.w = f.vhi[n].y;
        if constexpr (FIXM) st.o[n] = MFMA16(__builtin_bit_cast(bf16x8, aw), pf, st.o[n]); else st.o[n] = MFMA16(__builtin_bit_cast(bf16x8, aw), pf, st.o[n] * al);
    }
}
template <int DV> __device__ __forceinline__ void attn_init(AttnSt<DV>& st, float mfix  ) { st.m = mfix; st.l = 0.f;
#pragma unroll
    for (int n = 0; n < DV / 16; ++n) st.o[n] = (f32x4){0.f, 0.f, 0.f, 0.f}; }
template <int DV> __device__ __forceinline__ void attn_store(AttnSt<DV>& st, bf16* orow  , int q) {
    const float il = __builtin_amdgcn_rcpf(q4_sum(st.l));
#pragma unroll
    for (int n = 0; n < DV / 16; ++n) st4bf(orow + 16 * n + 4 * q, st.o[n][0] * il, st.o[n][1] * il, st.o[n][2] * il, st.o[n][3] * il);
}
constexpr int NA_TILE = 2 * 9216;
__device__ __forceinline__ void na_tile_load(Frame& F, u32x4 (&st)[2], int b, int h, int key0) {
    const int kr = F.tid >> 3, kc = (F.tid & 7) * 8;
    st[0] = *(const u32x4*)(NAK_ + ((size_t)b * TPB + key0 + kr) * 256 + h * 64 + kc);
    st[1] = *(const u32x4*)(NAVT_ + ((size_t)(b * 4 + h) * 64 + kr) * TPB + key0 + kc);
}
__device__ __forceinline__ void na_tile_write(Frame& F, const u32x4 (&st)[2], int buf) {
    const int kr = F.tid >> 3, kc = (F.tid & 7) * 8; LAS unsigned char* tb = F.lds + RING_OFF + buf * NA_TILE;
    *(LAS u32x4*)(tb + kr * 144 + kc * 2) = st[0]; *(LAS u32x4*)(tb + 9216 + kr * 144 + kc * 2) = st[1];
}
__device__ __forceinline__ void na_frag_lds(KvFrag<64, 64>& f, const LAS unsigned char* tb, int kl  , int r, int q) {
#pragma unroll
    for (int s = 0; s < 2; ++s) { f.k0[s] = *(const LAS bf16x8*)(tb + (kl + r) * 144 + 64 * s + 16 * q); f.k1[s] = *(const LAS bf16x8*)(tb + (kl + 16 + r) * 144 + 64 * s + 16 * q); }
#pragma unroll
    for (int n = 0; n < 4; ++n) { const LAS unsigned char* vr = tb + 9216 + (16 * n + r) * 144 + (kl + 4 * q) * 2; f.vlo[n] = *(const LAS u32x2*)vr; f.vhi[n] = *(const LAS u32x2*)(vr + 32); }
}
template <bool FIXM> __device__ __forceinline__ void na_block_unit(Frame& F, int l, int u, float mfix) {
    const int lane = F.lane, r = lane & 15, q = lane >> 4, rp = u & 7, h = (u >> 3) & 3, b = u >> 5;
    const int g0 = 4 * rp + 2 * (F.wave >> 2), cb = F.wave & 3;
    const size_t qrow = (size_t)b * TPB + g0 * 64 + cb * 16 + r;
    bf16x8 qa[2], qb[2];
#pragma unroll
    for (int s = 0; s < 2; ++s) { qa[s] = *(const bf16x8*)(NAQ_ + qrow * 256 + h * 64 + 32 * s + 8 * q); qb[s] = *(const bf16x8*)(NAQ_ + (qrow + 64) * 256 + h * 64 + 32 * s + 8 * q); }
    AttnSt<64> sa, sb2; attn_init(sa, FIXM ? mfix : -INFINITY); attn_init(sb2, FIXM ? mfix : -INFINITY);
    const int rsA = min(max(g0 - 4, 0), 24), rsB = min(max(g0 - 3, 0), 24), kb = min(max(cb * 16 - 8, 0), 32), qc = cb * 16 + r, cs = min(max(qc - 8, 0), 48);
    const int rs_lo = min(max(4 * rp - 4, 0), 24), rs_hi = min(max(4 * rp - 1, 0), 24), nloc = rs_hi + 8 - rs_lo, nst = nloc + 4;
    LAS float* rpbs = (LAS float*)(F.lds + RING_OFF + 2 * NA_TILE);
    for (int i = F.tid; i < 15 * 31; i += 512) rpbs[i] = na_rpb_[(size_t)(l * 4 + h) * 15 * 31 + i] * LOG2E;
    const LAS float* rpbA = rpbs + (7 - g0) * 31;
    u32x4 stg[2], stg1[2], stg2[2];
#define NA_KEY0(jj) ((jj) < nloc ? (rs_lo + (jj)) * 64 : SEQ + 64 * ((jj) - nloc))
    na_tile_load(F, stg, b, h, NA_KEY0(0)); na_tile_load(F, stg1, b, h, NA_KEY0(1)); na_tile_load(F, stg2, b, h, NA_KEY0(2));
    for (int j = 0; j < nst; ++j) {
        na_tile_write(F, stg, j & 1);
        LDS_WAIT(); __syncthreads();
        stg[0] = stg1[0]; stg[1] = stg1[1]; stg1[0] = stg2[0]; stg1[1] = stg2[1];
        if (j + 3 < nst) na_tile_load(F, stg2, b, h, NA_KEY0(j + 3));
        const LAS unsigned char* tb = F.lds + RING_OFF + (j & 1) * NA_TILE;
        KvFrag<64, 64> f;
        if (j < nloc) { const int kr = rs_lo + j; const bool inA = kr >= rsA && kr < rsA + 8, inB = kr >= rsB && kr < rsB + 8;
            if (inA || inB) { na_frag_lds(f, tb, kb, r, q);
                if (inA) attn_math32<64, 64, true, FIXM, const LAS float*>(sa, qa, f, q, rpbA + kr * 31, kb, qc, cs);
                if (inB) attn_math32<64, 64, true, FIXM, const LAS float*>(sb2, qb, f, q, rpbA + (kr - 1) * 31, kb, qc, cs); }
        } else {
            na_frag_lds(f, tb, 0, r, q); attn_math32<64, 64, false, FIXM>(sa, qa, f, q, nullptr, 0, 0, 0); attn_math32<64, 64, false, FIXM>(sb2, qb, f, q, nullptr, 0, 0, 0);
            na_frag_lds(f, tb, 32, r, q); attn_math32<64, 64, false, FIXM>(sa, qa, f, q, nullptr, 0, 0, 0); attn_math32<64, 64, false, FIXM>(sb2, qb, f, q, nullptr, 0, 0, 0);
        }
    }
    attn_store(sa, ATT_ + qrow * DM + h * 64, q); attn_store(sb2, ATT_ + (qrow + 64) * DM + h * 64, q);
    LDS_WAIT(); __syncthreads();
#undef NA_KEY0
}
template <bool FIXM> __device__ __forceinline__ void ctx_block_unit(Frame& F, int u, float mfix) {
    const int lane = F.lane, r = lane & 15, q = lane >> 4, h = u & 3, b = u >> 2;
    const size_t qrow0 = (size_t)b * TPB + SEQ + 32 * F.wave + r;
    bf16x8 qa[2], qb[2];
#pragma unroll
    for (int s = 0; s < 2; ++s) { qa[s] = *(const bf16x8*)(NAQ_ + qrow0 * 256 + h * 64 + 32 * s + 8 * q); qb[s] = *(const bf16x8*)(NAQ_ + (qrow0 + 16) * 256 + h * 64 + 32 * s + 8 * q); }
    AttnSt<64> sa, sb2; attn_init(sa, FIXM ? mfix : -INFINITY); attn_init(sb2, FIXM ? mfix : -INFINITY);
    u32x4 stg[2], stg1[2], stg2[2];
    na_tile_load(F, stg, b, h, SEQ); na_tile_load(F, stg1, b, h, SEQ + 64); na_tile_load(F, stg2, b, h, SEQ + 128);
    for (int j = 0; j < 4; ++j) {
        na_tile_write(F, stg, j & 1);
        LDS_WAIT(); __syncthreads();
        stg[0] = stg1[0]; stg[1] = stg1[1]; stg1[0] = stg2[0]; stg1[1] = stg2[1];
        if (j == 0) na_tile_load(F, stg2, b, h, SEQ + 192);
        const LAS unsigned char* tb = F.lds + RING_OFF + (j & 1) * NA_TILE;
        KvFrag<64, 64> f;
        na_frag_lds(f, tb, 0, r, q); attn_math32<64, 64, false, FIXM>(sa, qa, f, q, nullptr, 0, 0, 0); attn_math32<64, 64, false, FIXM>(sb2, qb, f, q, nullptr, 0, 0, 0);
        na_frag_lds(f, tb, 32, r, q); attn_math32<64, 64, false, FIXM>(sa, qa, f, q, nullptr, 0, 0, 0); attn_math32<64, 64, false, FIXM>(sb2, qb, f, q, nullptr, 0, 0, 0);
    }
    attn_store(sa, ATT_ + qrow0 * DM + h * 64, q); attn_store(sb2, ATT_ + (qrow0 + 16) * DM + h * 64, q);
    LDS_WAIT(); __syncthreads();
}

struct BgConv { int next; unsigned char* pend; };
constexpr int BG_G1 = NEXP * 32 * 16, BG_G2 = NEXP * 16 * 16, BG_NG = BG_G1 + BG_G2;
constexpr int BG_LDS = 69632;
static_assert(BG_LDS + 8 * 8192 <= MISC_OFF, "background slots");
__device__ __forceinline__ void bg_issue(Frame& F, int l, BgConv& bg, int lane) {
    const int G = F.gw + (bg.next >> 1) * F.ngw, sub = bg.next & 1;
    if (G >= BG_NG) return;
    ++bg.next;
    const float* src; int ld;
    if (G < BG_G1) { const int le = G >> 9, q = G & 511, k0 = (q >> 5) * 64 + sub * 32, nb = q & 31, n0 = nb * 64, pn = n0 >> 8, j = n0 & 255; const int sc = j < 128 ? 128 * pn + j : 1024 + 128 * pn + (j - 128);
        src = w_moe1_ + ((size_t)(l * NEXP + le) * 1024 + k0 + (lane >> 4)) * 2048 + sc + (lane & 15) * 4; ld = 2048;
        bg.pend = (unsigned char*)W1_ + ((size_t)(l * NEXP + le) * 2048 + n0 + lane) * 1024 + k0; }
    else { const int G2 = G - BG_G1, le = G2 >> 8, q = G2 & 255, k0 = (q >> 4) * 64 + sub * 32, nb = q & 15, n0 = nb * 64;
        src = w_moe2_ + ((size_t)(l * NEXP + le) * 1024 + k0 + (lane >> 4)) * 1024 + n0 + (lane & 15) * 4; ld = 1024;
        bg.pend = (unsigned char*)W2_ + ((size_t)(l * NEXP + le) * 1024 + n0 + lane) * 1024 + k0; }
    LAS unsigned char* lb = F.lds + RING_OFF + BG_LDS + F.wave * 8192;
#pragma unroll
    for (int i = 0; i < 8; ++i) __builtin_amdgcn_global_load_lds((const unsigned*)(src + (size_t)(4 * i) * ld), (LAS unsigned*)(lb + i * 1024), 16, 0, 0);
}
__device__ __forceinline__ void bg_finish(Frame& F, BgConv& bg, int lane) {
    if (!bg.pend) return;
    const LAS float* lb = (const LAS float*)(F.lds + RING_OFF + BG_LDS + F.wave * 8192) + lane;
#pragma unroll
    for (int h = 0; h < 2; ++h) { float v[16];
#pragma unroll
        for (int i = 0; i < 16; ++i) v[i] = lb[(16 * h + i) * 64] * SC_W;
        u32x4 o; o.x = pk4f8(v[0], v[1], v[2], v[3]); o.y = pk4f8(v[4], v[5], v[6], v[7]); o.z = pk4f8(v[8], v[9], v[10], v[11]); o.w = pk4f8(v[12], v[13], v[14], v[15]);
        *(u32x4*)(bg.pend + 16 * h) = o; }
    bg.pend = nullptr;
    LDS_WAIT(); __builtin_amdgcn_sched_barrier(0);
}
__device__ __forceinline__ void bg_drain(Frame& F, int l, BgConv& bg) {
    for (;;) { VM_WAIT(); bg_finish(F, bg, F.lane); bg_issue(F, l, bg, F.lane); if (!bg.pend) break; }
}

namespace fa {
constexpr int   D = 128, NW = 8, QBLK = 32, KVBLK = 64;
constexpr float SCALE = 0.10206207261596575f;
constexpr float THR = 8.f;
constexpr int   SDEPTH = 2;
constexpr int   DQK = 96, LDQ = 384, LDKK = 384, LDK = 512, LDO = 1024;
constexpr size_t SHM_V = KVBLK * D * 2, SHM_K = KVBLK * D * 2, SHM_ATTN = 2 * SHM_V + 2 * SHM_K + NW * 64 * 4;
using s16x4  = __attribute__((ext_vector_type(4))) short;
using f32x16 = __attribute__((ext_vector_type(16))) float;
#define KSWZ(row, colB) ((row) * 256 + ((colB) ^ (((row) & 7) << 4)))
#define SBAR() __builtin_amdgcn_sched_barrier(0)
__device__ __forceinline__ int crow(int r, int hi) { return (r & 3) + 8 * (r >> 2) + 4 * hi; }
__device__ __forceinline__ unsigned cvtpk(float lo, float hi) { unsigned r; asm volatile("v_cvt_pk_bf16_f32 %0, %1, %2" : "=v"(r) : "v"(lo), "v"(hi)); return r; }
__device__ __forceinline__ void partialSM(f32x16& p0, f32x16& p1, float& m_reg, float& mn, float& alpha) {
  constexpr float C = SCALE * 1.4426950408889634f;
  float pmax = p0[0]; for (int r = 1; r < 16; ++r) pmax = fmaxf(pmax, p0[r]); for (int r = 0; r < 16; ++r) pmax = fmaxf(pmax, p1[r]);
  { auto rr = __builtin_amdgcn_permlane32_swap(__float_as_uint(pmax), __float_as_uint(pmax), false, false);
    pmax = fmaxf(__uint_as_float(rr[0]), __uint_as_float(rr[1])); }
  if (__builtin_expect(__all(pmax - m_reg <= THR / SCALE), 1)) { mn = m_reg; alpha = 1.f; }
  else { mn = fmaxf(m_reg, pmax); alpha = __builtin_amdgcn_exp2f((m_reg - mn) * C); m_reg = mn; }
  float mnC = -mn * C;
  for (int r = 0; r < 16; ++r) p0[r] = fmaf(p0[r], C, mnC); for (int r = 0; r < 16; ++r) p1[r] = fmaf(p1[r], C, mnC);
  for (int r = 0; r < 16; ++r) p0[r] = __builtin_amdgcn_exp2f(p0[r]);
}
__device__ __forceinline__ void finishSM(f32x16& p0, f32x16& p1, float alpha, float& l_reg, bf16x8& pa0, bf16x8& pa1, bf16x8& pa2, bf16x8& pa3) {
  for (int r = 0; r < 16; ++r) p1[r] = __builtin_amdgcn_exp2f(p1[r]);
  float ps = 0; for (int r = 0; r < 16; ++r) ps += p0[r]; for (int r = 0; r < 16; ++r) ps += p1[r];
  { auto rr = __builtin_amdgcn_permlane32_swap(__float_as_uint(ps), __float_as_uint(ps), false, false);
    ps = __uint_as_float(rr[0]) + __uint_as_float(rr[1]); }
  l_reg = l_reg * alpha + ps;
#define PK4(P, BASE, OUT) do { unsigned a0 = cvtpk(P[BASE + 0], P[BASE + 1]), a1 = cvtpk(P[BASE + 2], P[BASE + 3]);   \
    unsigned b0 = cvtpk(P[BASE + 4], P[BASE + 5]), b1 = cvtpk(P[BASE + 6], P[BASE + 7]);                              \
    auto r0 = __builtin_amdgcn_permlane32_swap(a0, b0, false, false); auto r1 = __builtin_amdgcn_permlane32_swap(a1, b1, false, false); \
    u32x4 w = {r0[0], r1[0], r0[1], r1[1]}; OUT = *reinterpret_cast<bf16x8*>(&w); } while (0)
  PK4(p0, 0, pa0); PK4(p0, 8, pa1); PK4(p1, 0, pa2); PK4(p1, 8, pa3);
#undef PK4
}
__device__ __forceinline__ void qkt(f32x16& p0, f32x16& p1, const bf16* Ks, const bf16x8* qr, int r32, int hi) {
  p0 = f32x16{}; p1 = f32x16{};
  for (int d0 = 0; d0 < DQK / 16; ++d0) { int cb = (d0 * 16 + hi * 8) * 2;
    bf16x8 b0 = *reinterpret_cast<const bf16x8*>((const char*)Ks + KSWZ(r32, cb));
    bf16x8 b1 = *reinterpret_cast<const bf16x8*>((const char*)Ks + KSWZ(32 + r32, cb));
    p0 = __builtin_amdgcn_mfma_f32_32x32x16_bf16(b0, qr[d0], p0, 0, 0, 0);
    p1 = __builtin_amdgcn_mfma_f32_32x32x16_bf16(b1, qr[d0], p1, 0, 0, 0); }
}
__device__ __forceinline__ int v_st(int k, int c) { const int kk = (k & ~0xC) | ((k & 4) << 1) | ((k & 8) >> 1); return ((kk >> 3) * 4 + (c >> 5)) * 512 + ((kk & 7) * 32 + (c & 31)) * 2; }
__device__ __forceinline__ int v_rd_base(int lane) { return ((lane & 3) << 3) | (((lane >> 2) & 3) << 6) | (((lane >> 4) & 1) << 5) | (((lane >> 5) & 1) << 8); }
constexpr int v_rd_off(int d0, int ks, int half) { return d0 * 512 + ks * 4096 + half * 2048; }
template <int OFF> __device__ __forceinline__ s16x4 tr_read(int vb) {
  s16x4 r; asm volatile("ds_read_b64_tr_b16 %0, %1 offset:%2" : "=&v"(r) : "v"(vb), "i"(OFF) : "memory"); return r;
}
template <int D0> __device__ __forceinline__ void pv_one(f32x16& od, int vb, bf16x8 pa0, bf16x8 pa1, bf16x8 pa2, bf16x8 pa3) {
  const s16x4 l0 = tr_read<v_rd_off(D0, 0, 0)>(vb), h0 = tr_read<v_rd_off(D0, 0, 1)>(vb), l1 = tr_read<v_rd_off(D0, 1, 0)>(vb), h1 = tr_read<v_rd_off(D0, 1, 1)>(vb);
  const s16x4 l2 = tr_read<v_rd_off(D0, 2, 0)>(vb), h2 = tr_read<v_rd_off(D0, 2, 1)>(vb), l3 = tr_read<v_rd_off(D0, 3, 0)>(vb), h3 = tr_read<v_rd_off(D0, 3, 1)>(vb);
  asm volatile("s_waitcnt lgkmcnt(0)" ::: "memory"); SBAR();
#define PK(L, H) (bf16x8){L[0], L[1], L[2], L[3], H[0], H[1], H[2], H[3]}
  od = __builtin_amdgcn_mfma_f32_32x32x16_bf16(pa0, PK(l0, h0), od, 0, 0, 0);
  od = __builtin_amdgcn_mfma_f32_32x32x16_bf16(pa1, PK(l1, h1), od, 0, 0, 0);
  od = __builtin_amdgcn_mfma_f32_32x32x16_bf16(pa2, PK(l2, h2), od, 0, 0, 0);
  od = __builtin_amdgcn_mfma_f32_32x32x16_bf16(pa3, PK(l3, h3), od, 0, 0, 0);
#undef PK
}
__device__ __forceinline__ void pv_d0(f32x16* o, int vb, bf16x8 pa0, bf16x8 pa1, bf16x8 pa2, bf16x8 pa3) {
  pv_one<0>(o[0], vb, pa0, pa1, pa2, pa3); pv_one<1>(o[1], vb, pa0, pa1, pa2, pa3); pv_one<2>(o[2], vb, pa0, pa1, pa2, pa3); pv_one<3>(o[3], vb, pa0, pa1, pa2, pa3);
}
__device__ __forceinline__ void attn_dense_body(const bf16* __restrict__ Qb, const bf16* __restrict__ Kh, const bf16* __restrict__ Vh, bf16* __restrict__ Ob, int seq, char* lds, const int tid, Frame& F, const int lyr, BgConv& bg) {
  const int wid = tid >> 6, lane = tid & 63, r32 = lane & 31, hi = lane >> 5;
  bf16* V_lds = (bf16*)lds; bf16* K_lds = (bf16*)(lds + 2 * SHM_V);
  float* ws = (float*)(lds + 2 * SHM_V + 2 * SHM_K) + wid * 64; float* li_l = ws; float* al_l = ws + 32;
  float m_reg = -1e30f, l_reg = 0; f32x16 o[4] = {}; bf16x8 qr[DQK / 16];
  const bf16* Qw = Qb + (long)(wid * QBLK + r32) * LDQ + hi * 8;
#pragma unroll
  for (int d0 = 0; d0 < DQK / 16; ++d0) qr[d0] = *reinterpret_cast<const bf16x8*>(Qw + d0 * 16);
  const int sr = tid >> 4, sc = (tid & 15) * 8, vst0 = v_st(sr, sc), vst1 = v_st(32 + sr, sc);
  const int vb0 = (int)(uintptr_t)V_lds + v_rd_base(lane);
  struct { bf16x8 vs0, vs1, ks0, ks1; } sr_[SDEPTH];
  const unsigned soff = (unsigned)(sr * LDK + sc) * 2u, soffk = (unsigned)(sr * LDKK + (sc < DQK ? sc : 0)) * 2u;
#define SLOAD(i, k0) do { const char* vt_ = (const char*)Vh + (size_t)(k0) * (LDK * 2); const char* kt_ = (const char*)Kh + (size_t)(k0) * (LDKK * 2);   \
    sr_[i].vs0 = *reinterpret_cast<const bf16x8*>(vt_ + soff); sr_[i].vs1 = *reinterpret_cast<const bf16x8*>(vt_ + 32 * LDK * 2 + soff); \
    sr_[i].ks0 = *reinterpret_cast<const bf16x8*>(kt_ + soffk); sr_[i].ks1 = *reinterpret_cast<const bf16x8*>(kt_ + 32 * LDKK * 2 + soffk); } while (0)
#define SWRITE(b, i) do { *(bf16x8*)((char*)V_lds + (b) * SHM_V + vst0) = sr_[i].vs0;          \
    *(bf16x8*)((char*)V_lds + (b) * SHM_V + vst1) = sr_[i].vs1; int kc = sc * 2;               \
    *(bf16x8*)((char*)K_lds + (b) * SHM_K + KSWZ(sr, kc)) = sr_[i].ks0;                       \
    *(bf16x8*)((char*)K_lds + (b) * SHM_K + KSWZ(32 + sr, kc)) = sr_[i].ks1; } while (0)
#define SWAIT() do { if constexpr (SDEPTH == 2) asm volatile("s_waitcnt vmcnt(4)" ::: "memory"); else asm volatile("s_waitcnt vmcnt(0)" ::: "memory"); } while (0)
#define RESC(a) do { if (__any((a) < 1.f)) { if (hi == 0) al_l[r32] = (a); asm volatile("s_waitcnt lgkmcnt(0)" ::: "memory"); \
    for (int d = 0; d < 4; ++d) for (int r = 0; r < 16; ++r) o[d][r] *= al_l[crow(r, hi)]; } } while (0)
  f32x16 pA0, pA1, pB0, pB1; float mnA, mnB, alA, alB; bf16x8 pa0, pa1, pa2, pa3; const int NT = seq / KVBLK;
  constexpr int SE = 0, SO = SDEPTH - 1;
  SLOAD(SE, 0); asm volatile("s_waitcnt vmcnt(0)" ::: "memory"); SWRITE(0, SE); __syncthreads();
  qkt(pA0, pA1, K_lds, qr, r32, hi); partialSM(pA0, pA1, m_reg, mnA, alA);
  SLOAD(SO, KVBLK); if constexpr (SDEPTH == 2) { if (2 < NT) SLOAD(SE, 2 * KVBLK); }
  SWAIT(); SWRITE(1, SO); __syncthreads();
  for (int j = 1; j + 1 < NT; j += 2) {
    bg_finish(F, bg, lane);
    if ((j >> 1) % 3 != 2) bg_issue(F, lyr, bg, lane);
    SBAR(); qkt(pB0, pB1, (bf16*)((char*)K_lds + SHM_K), qr, r32, hi);
    finishSM(pA0, pA1, alA, l_reg, pa0, pa1, pa2, pa3); SBAR();
    SLOAD(SO, (j + SDEPTH) * KVBLK); SBAR();
    pv_d0(o, vb0, pa0, pa1, pa2, pa3); partialSM(pB0, pB1, m_reg, mnB, alB);
    __syncthreads(); SWAIT(); SWRITE(0, SE);
    RESC(alB); __syncthreads();
    SBAR(); qkt(pA0, pA1, K_lds, qr, r32, hi);
    finishSM(pB0, pB1, alB, l_reg, pa0, pa1, pa2, pa3); SBAR();
    if (SDEPTH == 1 || j + 3 < NT) SLOAD(SE, (j + 1 + SDEPTH) * KVBLK); SBAR();
    pv_d0(o, vb0 + (int)SHM_V, pa0, pa1, pa2, pa3); partialSM(pA0, pA1, m_reg, mnA, alA);
    __syncthreads(); SWAIT(); SWRITE(1, SO);
    RESC(alA); __syncthreads();
  }
  SBAR(); qkt(pB0, pB1, (bf16*)((char*)K_lds + SHM_K), qr, r32, hi);
  finishSM(pA0, pA1, alA, l_reg, pa0, pa1, pa2, pa3); SBAR();
  pv_d0(o, vb0, pa0, pa1, pa2, pa3); partialSM(pB0, pB1, m_reg, mnB, alB);
  __syncthreads(); RESC(alB);
  finishSM(pB0, pB1, alB, l_reg, pa0, pa1, pa2, pa3); SBAR();
  pv_d0(o, vb0 + (int)SHM_V, pa0, pa1, pa2, pa3);
  if (hi == 0) li_l[r32] = l_reg; asm volatile("s_waitcnt lgkmcnt(0)" ::: "memory");
  int ln2; asm volatile("v_mbcnt_lo_u32_b32 %0, -1, 0\n\tv_mbcnt_hi_u32_b32 %0, -1, %0" : "=v"(ln2)); ln2 &= 63;
  const int r32e = ln2 & 31, hie = ln2 >> 5;
  float rli[16];
#pragma unroll
  for (int r = 0; r < 16; ++r) rli[r] = __builtin_amdgcn_rcpf(li_l[crow(r, hie)]);
  bf16* Ow = Ob + (long)(wid * QBLK) * LDO;
#pragma unroll
  for (int r = 0; r < 16; ++r) { const unsigned eo = (unsigned)(crow(r, hie) * LDO + r32e);
    for (int d0 = 0; d0 < 4; ++d0) Ow[eo + d0 * 32] = (bf16)(cvtpk(o[d0][r] * rli[r], 0.f) & 0xffffu); }
  if (bg.pend) { asm volatile("s_waitcnt vmcnt(0)" ::: "memory"); bg_finish(F, bg, lane); }
  __syncthreads();
#undef SLOAD
#undef SWRITE
#undef SWAIT
#undef RESC
}
#undef KSWZ
#undef SBAR
}

constexpr int GL_Q = 0, GL_K = 2048, GL_V = 4096, GL_EF = 8192, GL_EB = 10240, GL_OF = 12288, GL_OB = 16384;
__device__ __forceinline__ int gla_dirchunk(int dir, int tc) { return dir == 0 ? tc : (tc < 4 ? 3 - tc : 39 - tc); }
__device__ __forceinline__ void gla_stage_load(Frame& F, u32x4 (&st)[4], int b, int h, int tc) {
    const size_t row0 = (size_t)b * TPB + (tc < 4 ? SEQ + 64 * tc : 64 * (tc - 4));
#pragma unroll
    for (int k = 0; k < 4; ++k) { const int pid = F.tid + 512 * k, r = pid >> 5, j = pid & 31; const size_t row = row0 + r; const void* src;
        if (j < 4)       src = Z_ + row * ZC + Z_GQ + h * 32 + 8 * j;
        else if (j < 8)  src = Z_ + row * ZC + Z_GK + h * 32 + 8 * (j - 4);
        else if (j < 16) src = Z_ + row * ZC + Z_GV + h * 64 + 8 * (j - 8);
        else if (j < 24) src = EGF_ + row * 128 + h * 32 + 4 * (j - 16);
        else             src = EGB_ + row * 128 + h * 32 + 4 * (j - 24);
        st[k] = *(const u32x4*)src; }
}
__device__ __forceinline__ void gla_stage_write(Frame& F, const u32x4 (&st)[4]) {
    LAS float* sm = (LAS float*)(F.lds + RING_OFF);
#pragma unroll
    for (int k = 0; k < 4; ++k) { const int pid = F.tid + 512 * k, r = pid >> 5, j = pid & 31;
        if (j < 16) { LAS float* dst = j < 4 ? sm + GL_Q + r * 32 + 8 * j : j < 8 ? sm + GL_K + r * 32 + 8 * (j - 4) : sm + GL_V + r * 64 + 8 * (j - 8);
            const float sc = j < 4 ? 0.17677669529663687f : 1.0f; float f[4], g[4]; u32x2 lo, hi; lo.x = st[k].x; lo.y = st[k].y; hi.x = st[k].z; hi.y = st[k].w; up4(lo, f); up4(hi, g);
            *(LAS f32x4*)dst = (f32x4){f[0], f[1], f[2], f[3]} * sc; *(LAS f32x4*)(dst + 4) = (f32x4){g[0], g[1], g[2], g[3]} * sc; }
        else { LAS float* dst = j < 24 ? sm + GL_EF + r * 32 + 4 * (j - 16) : sm + GL_EB + r * 32 + 4 * (j - 24); *(LAS u32x4*)dst = st[k]; } }
}
constexpr int GB_O = 0, GB_QS = 49152, GB_KT = GB_QS + 2 * 5120, GB_QE = GB_KT + 2 * 5120, GB_VT = GB_QE + 2 * 5120, GB_S0 = GB_VT + 2 * 9216, GB_END = GB_S0 + 2 * 5120;
static_assert(GB_END <= MISC_OFF, "GLA LDS map");
template <int N> __device__ __forceinline__ float dpp_shr(float v) { return __int_as_float(__builtin_amdgcn_update_dpp(0, __float_as_int(v), 0x110 + N, 0xF, 0xF, false)); }
__device__ __forceinline__ void gla_compute(Frame& F, int l, int b, int h, int tc, bool outputs) {
    LAS float* sm = (LAS float*)(F.lds + RING_OFF); LAS unsigned char* sb = F.lds + RING_OFF;
    const size_t row0 = (size_t)b * TPB + (tc < 4 ? SEQ + 64 * tc : 64 * (tc - 4));
    const int lane = F.lane, wdir = F.wave >> 2, wsub = F.wave & 3;
    float s0pre[8]; u32x4 gpre = {0u, 0u, 0u, 0u}; f32x4 gnpre0 = {0.f, 0.f, 0.f, 0.f}, gnpre1 = gnpre0;
    if (outputs) { const int dir = F.tid >> 8, e = (F.tid >> 2) & 63, dq = F.tid & 3;
        const float* ps = OGF_ + ((size_t)((b * 4 + h) * 2 + dir) * 36 + gla_dirchunk(dir, tc)) * 2048 + (size_t)(8 * dq) * 64 + e;
#pragma unroll
        for (int i = 0; i < 8; ++i) s0pre[i] = __hip_atomic_load(ps + i * 64, __ATOMIC_RELAXED, __HIP_MEMORY_SCOPE_AGENT);
        gpre = *(const u32x4*)(Z_ + (row0 + (F.tid >> 3)) * ZC + Z_GO + h * 64 + (F.tid & 7) * 8);
        gnpre0 = *(const f32x4*)(gla_o_norm_ + l * 64 + (F.tid & 7) * 8); gnpre1 = *(const f32x4*)(gla_o_norm_ + l * 64 + (F.tid & 7) * 8 + 4); }
    { const int t = wdir ? 63 - lane : lane; LAS float* gp = sm + (wdir ? GL_EB : GL_EF) + t * 32 + 8 * wsub;
#pragma unroll
      for (int i = 0; i < 8; ++i) { float x = gp[i]; x += dpp_shr<1>(x); x += dpp_shr<2>(x); x += dpp_shr<4>(x); x += dpp_shr<8>(x);
          const float t0 = rl_f(x, 15), t1 = rl_f(x, 31), t2 = rl_f(x, 47);
          x += (lane >= 16 ? t0 : 0.f) + (lane >= 32 ? t1 : 0.f) + (lane >= 48 ? t2 : 0.f); gp[i] = x; } }
    LDS_WAIT(); __syncthreads();
    { const int dir = F.tid >> 8, o = (F.tid >> 2) & 63, dq = F.tid & 3, t = dir ? 63 - o : o;
      const LAS float* Bp = sm + (dir ? GL_EB : GL_EF) + 8 * dq; const int tm = dir ? 32 : 31, te = dir ? 0 : 63;
      float Bt[8], Bm[8], Be[8], qv[8], kv[8];
#pragma unroll
      for (int i = 0; i < 8; i += 4) { *(f32x4*)(Bt + i) = *(const LAS f32x4*)(Bp + t * 32 + i); *(f32x4*)(Bm + i) = *(const LAS f32x4*)(Bp + tm * 32 + i); *(f32x4*)(Be + i) = *(const LAS f32x4*)(Bp + te * 32 + i);
          *(f32x4*)(qv + i) = *(const LAS f32x4*)(sm + GL_Q + t * 32 + 8 * dq + i); *(f32x4*)(kv + i) = *(const LAS f32x4*)(sm + GL_K + t * 32 + 8 * dq + i); }
      if (outputs) {
          float qs[8], kt[8], qe[8];
#pragma unroll
          for (int i = 0; i < 8; ++i) { qs[i] = qv[i] * __expf(Bt[i] - Bm[i]); kt[i] = kv[i] * __expf(Bm[i] - Bt[i]); qe[i] = qv[i] * __expf(Bt[i]); }
          u32x4 w; w.x = pk2(qs[0], qs[1]); w.y = pk2(qs[2], qs[3]); w.z = pk2(qs[4], qs[5]); w.w = pk2(qs[6], qs[7]); *(LAS u32x4*)(sb + GB_QS + dir * 5120 + o * 80 + 16 * dq) = w;
          w.x = pk2(kt[0], kt[1]); w.y = pk2(kt[2], kt[3]); w.z = pk2(kt[4], kt[5]); w.w = pk2(kt[6], kt[7]); *(LAS u32x4*)(sb + GB_KT + dir * 5120 + o * 80 + 16 * dq) = w;
          w.x = pk2(qe[0], qe[1]); w.y = pk2(qe[2], qe[3]); w.z = pk2(qe[4], qe[5]); w.w = pk2(qe[6], qe[7]); *(LAS u32x4*)(sb + GB_QE + dir * 5120 + o * 80 + 16 * dq) = w;
      } else {
#pragma unroll
          for (int i = 0; i < 8; ++i) *(LAS bf16*)(sb + GB_KT + dir * 5120 + (8 * dq + i) * 144 + 2 * o) = (bf16)f2bf(kv[i] * __expf(Be[i] - Bt[i]));
          if (o == 63) { const size_t sidx = (size_t)((b * 4 + h) * 2 + dir) * 36 + gla_dirchunk(dir, tc); float* ad = AD_ + sidx * 32 + 8 * dq;
#pragma unroll
              for (int i = 0; i < 8; ++i) ad[i] = __expf(Be[i]); }
      } }
    { const int dir = F.tid >> 8, e = F.tid & 63, og = (F.tid >> 6) & 3;
      float vv[16];
#pragma unroll
      for (int k = 0; k < 16; ++k) { const int o = 16 * og + k, t = dir ? 63 - o : o; vv[k] = sm[GL_V + t * 64 + e]; }
      u32x4 w0, w1; w0.x = pk2(vv[0], vv[1]); w0.y = pk2(vv[2], vv[3]); w0.z = pk2(vv[4], vv[5]); w0.w = pk2(vv[6], vv[7]); w1.x = pk2(vv[8], vv[9]); w1.y = pk2(vv[10], vv[11]); w1.z = pk2(vv[12], vv[13]); w1.w = pk2(vv[14], vv[15]);
      LAS unsigned char* vp = sb + GB_VT + dir * 9216 + e * 144 + 32 * og; *(LAS u32x4*)vp = w0; *(LAS u32x4*)(vp + 16) = w1; }
    if (outputs) {
        const int dir = F.tid >> 8, e = (F.tid >> 2) & 63, dq = F.tid & 3;
        u32x4 w; w.x = pk2(s0pre[0], s0pre[1]); w.y = pk2(s0pre[2], s0pre[3]); w.z = pk2(s0pre[4], s0pre[5]); w.w = pk2(s0pre[6], s0pre[7]); *(LAS u32x4*)(sb + GB_S0 + dir * 5120 + e * 80 + 16 * dq) = w;
    }
    LDS_WAIT(); __syncthreads();
    const int r = lane & 15, q = lane >> 4;
    if (outputs) {
        const int dir = wdir, tt = wsub; const LAS unsigned char* qsb = sb + GB_QS + dir * 5120; const LAS unsigned char* ktb = sb + GB_KT + dir * 5120;
        const LAS unsigned char* vtb = sb + GB_VT + dir * 9216; const LAS unsigned char* s0b = sb + GB_S0 + dir * 5120;
        f32x4 acc[4];
#pragma unroll
        for (int n = 0; n < 4; ++n) acc[n] = (f32x4){0.f, 0.f, 0.f, 0.f};
        const bf16x8 qsf = *(const LAS bf16x8*)(qsb + (16 * tt + r) * 80 + 16 * q);
        const int to = 16 * tt + r;
        for (int sp = 0; sp <= (tt >> 1); ++sp) {
            const bf16x8 k0 = *(const LAS bf16x8*)(ktb + (32 * sp + r) * 80 + 16 * q), k1 = *(const LAS bf16x8*)(ktb + (32 * sp + 16 + r) * 80 + 16 * q);
            f32x4 s0 = MFMA16(k0, qsf, ((f32x4){0.f, 0.f, 0.f, 0.f})), s1 = MFMA16(k1, qsf, ((f32x4){0.f, 0.f, 0.f, 0.f}));
#pragma unroll
            for (int i = 0; i < 4; ++i) { const int so = 32 * sp + 4 * q + i; s0[i] = so <= to ? s0[i] : 0.f; s1[i] = so + 16 <= to ? s1[i] : 0.f; }
            u32x4 pw; pw.x = pk2(s0[0], s0[1]); pw.y = pk2(s0[2], s0[3]); pw.z = pk2(s1[0], s1[1]); pw.w = pk2(s1[2], s1[3]);
            const bf16x8 pf = __builtin_bit_cast(bf16x8, pw);
#pragma unroll
            for (int n = 0; n < 4; ++n) { const LAS unsigned char* vr = vtb + (16 * n + r) * 144 + (32 * sp + 4 * q) * 2; const u32x2 lo = *(const LAS u32x2*)vr, hi = *(const LAS u32x2*)(vr + 32);
                u32x4 aw; aw.x = lo.x; aw.y = lo.y; aw.z = hi.x; aw.w = hi.y; acc[n] = MFMA16(__builtin_bit_cast(bf16x8, aw), pf, acc[n]); }
        }
        const bf16x8 qef = *(const LAS bf16x8*)(sb + GB_QE + dir * 5120 + (16 * tt + r) * 80 + 16 * q);
#pragma unroll
        for (int n = 0; n < 4; ++n) acc[n] = MFMA16(*(const LAS bf16x8*)(s0b + (16 * n + r) * 80 + 16 * q), qef, acc[n]);
        const int t = dir ? 63 - to : to;
#pragma unroll
        for (int n = 0; n < 4; ++n) *(LAS f32x4*)(sb + GB_O + dir * 16384 + (t * 64 + 16 * n + 4 * q) * 4) = acc[n];
        LDS_WAIT(); __syncthreads();
        const int tk = F.tid >> 3, e8 = (F.tid & 7) * 8; const size_t row = row0 + tk; const LAS float* of = (const LAS float*)(sb + GB_O) + tk * 64 + e8;
        const f32x4 f0 = *(const LAS f32x4*)of, f1 = *(const LAS f32x4*)(of + 4), b0 = *(const LAS f32x4*)(of + 4096), b1 = *(const LAS f32x4*)(of + 4100);
        const f32x4 o0 = f0 + b0, o1 = f1 + b1;
        float ss = (o0[0] * o0[0] + o0[1] * o0[1]) + (o0[2] * o0[2] + o0[3] * o0[3]) + (o1[0] * o1[0] + o1[1] * o1[1]) + (o1[2] * o1[2] + o1[3] * o1[3]);
        ss = g8_sum(ss);
        const float rn = rsq(ss * (1.0f / 64) + EPS);
        const float gn[8] = {gnpre0[0], gnpre0[1], gnpre0[2], gnpre0[3], gnpre1[0], gnpre1[1], gnpre1[2], gnpre1[3]}; float g[4], g2[4]; { u32x2 glo, ghi; glo.x = gpre.x; glo.y = gpre.y; ghi.x = gpre.z; ghi.y = gpre.w; up4(glo, g); up4(ghi, g2); }
        float w[8];
#pragma unroll
        for (int i = 0; i < 4; ++i) { w[i] = o0[i] * rn * gn[i] * g[i] * __builtin_amdgcn_rcpf(1.0f + __expf(-g[i])); w[4 + i] = o1[i] * rn * gn[4 + i] * g2[i] * __builtin_amdgcn_rcpf(1.0f + __expf(-g2[i])); }
        u32x4 pw; pw.x = pk2(w[0], w[1]); pw.y = pk2(w[2], w[3]); pw.z = pk2(w[4], w[5]); pw.w = pk2(w[6], w[7]);
        *(u32x4*)(ATT_ + row * DM + 768 + h * 64 + e8) = pw;
    } else {
        const int dir = wdir, et = wsub; const LAS unsigned char* vtb = sb + GB_VT + dir * 9216; const LAS unsigned char* khb = sb + GB_KT + dir * 5120;
        float* cs = CS_ + ((size_t)((b * 4 + h) * 2 + dir) * 36 + gla_dirchunk(dir, tc)) * 2048;
#pragma unroll
        for (int dt = 0; dt < 2; ++dt) { f32x4 acc = (f32x4){0.f, 0.f, 0.f, 0.f};
#pragma unroll
            for (int ks = 0; ks < 2; ++ks) acc = MFMA16(*(const LAS bf16x8*)(vtb + (16 * et + r) * 144 + (32 * ks + 8 * q) * 2), *(const LAS bf16x8*)(khb + (16 * dt + r) * 144 + (32 * ks + 8 * q) * 2), acc);
            *(f32x4*)(cs + (size_t)(16 * dt + r) * 64 + 16 * et + 4 * q) = acc; }
    }
}
__device__ __forceinline__ void gla_pass(Frame& F, int l, bool outputs) {
    const int nch = (outputs && l == DEPTH - 1) ? 32 : 36, c0 = 36 - nch, ntot = BATCH * 4 * nch;
    const int upb = (ntot + F.G - 1) / F.G, u_lo = min(F.blk * upb, ntot), u_hi = min(u_lo + upb, ntot);
    if (outputs) {
        const int lane = F.lane, dir = F.wave >> 2, eblk = F.wave & 3, dq = lane >> 4, e = eblk * 16 + (lane & 15);
        float S[8];
#pragma unroll
        for (int i = 0; i < 8; ++i) S[i] = 0.f;
        int pbh = -1, pc = -2;
        for (int k = 0; k < u_hi - u_lo; ++k) {
            const int u = dir == 0 ? u_lo + k : u_hi - 1 - k, bh = u / nch, tc = c0 + (u - bh * nch), c = gla_dirchunk(dir, tc);
            const size_t sidx = (size_t)(bh * 2 + dir) * 36;
            int j0 = pc;
            if (!(bh == pbh && c == pc + 1)) { j0 = 0;
#pragma unroll
                for (int i = 0; i < 8; ++i) S[i] = 0.f; }
#pragma unroll 4
            for (int j = j0; j < c; ++j) { const float* ad = AD_ + (sidx + j) * 32 + 8 * dq; const float* csp = CS_ + (sidx + j) * 2048 + (size_t)(8 * dq) * 64 + e;
                const f32x4 a0 = *(const f32x4*)ad, a1 = *(const f32x4*)(ad + 4);
#pragma unroll
                for (int i = 0; i < 4; ++i) { S[i] = a0[i] * S[i] + csp[i * 64]; S[4 + i] = a1[i] * S[4 + i] + csp[(4 + i) * 64]; } }
            float* ps = OGF_ + (sidx + c) * 2048 + (size_t)(8 * dq) * 64 + e;
#pragma unroll
            for (int i = 0; i < 8; ++i) __hip_atomic_store(ps + i * 64, S[i], __ATOMIC_RELAXED, __HIP_MEMORY_SCOPE_AGENT);
            pbh = bh; pc = c;
        }
        VM_WAIT();
    }
    u32x4 st[4];
    if (u_lo < u_hi) { const int bh = u_lo / nch; gla_stage_load(F, st, bh >> 2, bh & 3, c0 + (u_lo - bh * nch)); }
    for (int u = u_lo; u < u_hi; ++u) {
        const int bh = u / nch, tc = c0 + (u - bh * nch);
        gla_stage_write(F, st);
        LDS_WAIT(); __syncthreads();
        if (u + 1 < u_hi) { const int bh2 = (u + 1) / nch; gla_stage_load(F, st, bh2 >> 2, bh2 & 3, c0 + (u + 1 - bh2 * nch)); }
        gla_compute(F, l, bh >> 2, bh & 3, tc, outputs);
        LDS_WAIT(); __syncthreads();
    }
}
__device__ __forceinline__ void pE1(Frame& F, int l) {
    for (int rp = 0; rp < NREP(14); ++rp) gla_pass(F, l, false);
    relane(F);
    float gq = fabsf(na_q_norm_[l * 64 + F.lane]), gk = fabsf(na_k_norm_[l * 64 + F.lane]), rb = 0.f;
#pragma unroll
    for (int k = 0; k < 8; ++k) { const int i4 = F.lane + 64 * k;
        if (i4 < 465) { const f32x4 v = *(const f32x4*)(na_rpb_ + (size_t)l * 4 * 15 * 31 + 4 * i4); rb = fmaxf(rb, fmaxf(fmaxf(fabsf(v[0]), fabsf(v[1])), fmaxf(fabsf(v[2]), fabsf(v[3])))); } }
    gq = wave_max(gq); gk = wave_max(gk); rb = wave_max(rb);
    const float mfix = (QS_NA * 64.0f * gq * gk + rb * LOG2E) * 1.01f + 0.125f;
    if (mfix <= 60.0f) {
        for (int rp = 0; rp < NREP(15); ++rp)
        for (int u = F.blk; u < BATCH * 4 * 8; u += F.G) na_block_unit<true>(F, l, u, mfix);
        if (l == 0) for (int u = F.G - 1 - F.blk; u < BATCH * 4; u += F.G) ctx_block_unit<false>(F, u, mfix);
    } else {
        for (int u = F.blk; u < BATCH * 4 * 8; u += F.G) na_block_unit<false>(F, l, u, 0.f);
        if (l == 0) for (int u = F.G - 1 - F.blk; u < BATCH * 4; u += F.G) ctx_block_unit<false>(F, u, 0.f);
    }
}
__device__ __forceinline__ void pE2(Frame& F, int l) {
    const int nlat = BATCH * 4 * 8, nall = nlat + (l == 0 ? BATCH * 4 : 0);
    for (int rp = 0; rp < NREP(16); ++rp) { BgConv bg{0, nullptr};
    for (int u = F.blk; u < nall; u += F.G) {
        int b, h, qp, klo, seq;
        if (u < nlat) { const int qb = u & 7, bh = u >> 3; b = bh >> 2; h = bh & 3; qp = 256 * qb; klo = 0; seq = TPB; }
        else { const int bh = u - nlat; b = bh >> 2; h = bh & 3; qp = SEQ; klo = SEQ; seq = CTXL; }
        const size_t qrow = (size_t)b * TPB + qp, krow = (size_t)b * TPB + klo;
        fa::attn_dense_body(MQ_ + qrow * 384 + h * 96, MK_ + krow * 384 + h * 96, MV_ + krow * 512 + h * 128, ATT_ + qrow * DM + 256 + h * 128, seq, (char*)(F.lds + RING_OFF), F.tid, F, l, bg);
    }
    bg_drain(F, l, bg); }
    relane(F);
    for (int rp = 0; rp < NREP(17); ++rp) gla_pass(F, l, true);
}

__device__ __forceinline__ int moe_rpb(const Frame& F) { return (((MROWS + F.G - 1) / F.G) + 15) & ~15; }
constexpr int G1_TP = 1028;
__device__ __forceinline__ void pG1(Frame& F, int l) {
    LAS float* T = (LAS float*)(F.lds + RING_OFF);
    LAS float* P = T + 16 * G1_TP;
    volatile LAS unsigned* wh = F.MISC + MW_WH + F.wave * 32;
    if (F.lane < 32) wh[F.lane] = 0u;
    const int lane = F.lane, c = lane & 15, q = lane >> 4, rpb = moe_rpb(F), row_lo = F.blk * rpb;
    float bw[32][2];
#pragma unroll
    for (int s = 0; s < 32; ++s) { const float* wp = w_router_ + ((size_t)l * 1024 + 128 * F.wave + 32 * q + s) * NEXP + c; bw[s][0] = wp[0]; bw[s][1] = wp[16]; }
    const float brl = b_router_[l * NEXP + (lane & 31)];
    const float* gf = g_ffn_ + l * DM;
    int mcC = -1; f32x4 gsC[4], shC[4];
    u32x2 n0[4], n1[4];
    { const size_t rr = (size_t)min(row_lo + 2 * F.wave, MROWS - 2);
#pragma unroll
      for (int j = 0; j < 4; ++j) { n0[j] = *(const u32x2*)(XU_ + rr * DM + 256 * j + 4 * lane); n1[j] = *(const u32x2*)(XU_ + (rr + 1) * DM + 256 * j + 4 * lane); } }
    for (int r0 = row_lo; r0 < row_lo + rpb && r0 < MROWS; r0 += 16) {
        const int b = r0 / TPB, p0 = r0 - b * TPB;
        const int mc = p0 < SEQ ? b : 16, row = r0 + 2 * F.wave;
        f32x4 h0[4], h1[4];
#pragma unroll
        for (int j = 0; j < 4; ++j) { h0[j] = bf4f(n0[j]); h1[j] = bf4f(n1[j]); }
        { const size_t rr = (size_t)min(row + 16, MROWS - 2);
#pragma unroll
          for (int j = 0; j < 4; ++j) { n0[j] = *(const u32x2*)(XU_ + rr * DM + 256 * j + 4 * lane); n1[j] = *(const u32x2*)(XU_ + (rr + 1) * DM + 256 * j + 4 * lane); } }
        if (l == DEPTH - 1 && p0 >= SEQ) continue;
        const float rs0 = rsq(wave_sum(sumsq4(h0)) * (1.0f / DM) + EPS), rs1 = rsq(wave_sum(sumsq4(h1)) * (1.0f / DM) + EPS);
        if (mc != mcC) { const float* mod = MOD_ + ((size_t)l * 17 + mc) * 6144; mcC = mc;
#pragma unroll
            for (int j = 0; j < 4; ++j) { const int col = 256 * j + 4 * lane; gsC[j] = *(const f32x4*)(gf + col) * (*(const f32x4*)(mod + 4 * 1024 + col) + 1.0f); shC[j] = *(const f32x4*)(mod + 3 * 1024 + col); } }
#pragma unroll
        for (int j = 0; j < 4; ++j) { const int col = 256 * j + 4 * lane; const f32x4 gs = gsC[j], sh = shC[j];
            h0[j] = h0[j] * rs0 * gs + sh; h1[j] = h1[j] * rs1 * gs + sh;
            *(unsigned*)((unsigned char*)H_ + (size_t)row * DM + col) = pk4f8(h0[j][0] * SC_X, h0[j][1] * SC_X, h0[j][2] * SC_X, h0[j][3] * SC_X);
            *(unsigned*)((unsigned char*)H_ + (size_t)(row + 1) * DM + col) = pk4f8(h1[j][0] * SC_X, h1[j][1] * SC_X, h1[j][2] * SC_X, h1[j][3] * SC_X);
            *(LAS f32x4*)(T + (2 * F.wave) * G1_TP + col) = h0[j]; *(LAS f32x4*)(T + (2 * F.wave + 1) * G1_TP + col) = h1[j]; }
        LDS_WAIT(); __syncthreads();
        f32x4 a0 = (f32x4){0.f, 0.f, 0.f, 0.f}, a1 = a0;
        { const LAS float* tp = T + c * G1_TP + 128 * F.wave + 32 * q;
#pragma unroll
          for (int s4 = 0; s4 < 8; ++s4) { const f32x4 av = *(const LAS f32x4*)(tp + 4 * s4);
#pragma unroll
              for (int i = 0; i < 4; ++i) { a0 = __builtin_amdgcn_mfma_f32_16x16x4f32(av[i], bw[4 * s4 + i][0], a0, 0, 0, 0); a1 = __builtin_amdgcn_mfma_f32_16x16x4f32(av[i], bw[4 * s4 + i][1], a1, 0, 0, 0); } } }
#pragma unroll
        for (int i = 0; i < 4; ++i) { P[(F.wave * 16 + 4 * q + i) * 32 + c] = a0[i]; P[(F.wave * 16 + 4 * q + i) * 32 + 16 + c] = a1[i]; }
        LDS_WAIT(); __syncthreads();
        { const int rr = 2 * F.wave + (lane >> 5), e = lane & 31; float lg = brl;
#pragma unroll
          for (int w = 0; w < 8; ++w) lg += P[(w * 16 + rr) * 32 + e];
          float tv[4]; int ti[4];
#pragma unroll
          for (int k = 0; k < 4; ++k) { float m = lg; m = fmaxf(m, dpp_f<0xB1>(m)); m = fmaxf(m, dpp_f<0x4E>(m)); m = fmaxf(m, dpp_f<0x141>(m)); m = fmaxf(m, dpp_f<0x140>(m)); m = fmaxf(m, swz_xor<16>(m));
              const unsigned long long bal = __builtin_amdgcn_ballot_w64(lg == m); const unsigned half = (lane >> 5) ? (unsigned)(bal >> 32) : (unsigned)bal;
              const int bi = __builtin_ctz(half);
              tv[k] = m; ti[k] = bi; lg = (e == bi) ? -INFINITY : lg; }
          const float e1 = __expf(tv[1] - tv[0]), e2 = __expf(tv[2] - tv[0]), e3 = __expf(tv[3] - tv[0]); const float isum = 1.0f / (1.0f + e1 + e2 + e3);
          if (e < 4) { const int ek = e == 0 ? ti[0] : e == 1 ? ti[1] : e == 2 ? ti[2] : ti[3]; const float gg = (e == 0 ? 1.0f : e == 1 ? e1 : e == 2 ? e2 : e3) * isum;
              unsigned rank = 0;
              if (lane < 32) rank = __hip_atomic_fetch_add((LAS unsigned*)(F.MISC + MW_WH + F.wave * 32 + ek), 1u, __ATOMIC_RELAXED, __HIP_MEMORY_SCOPE_WORKGROUP);
              __builtin_amdgcn_s_waitcnt(0xc07f);
              if (lane >= 32) rank = __hip_atomic_fetch_add((LAS unsigned*)(F.MISC + MW_WH + F.wave * 32 + ek), 1u, __ATOMIC_RELAXED, __HIP_MEMORY_SCOPE_WORKGROUP);
              TOPE_[(size_t)(r0 + rr) * 4 + e] = ek | (int)(rank << 8); TOPG_[(size_t)(r0 + rr) * 4 + e] = gg; } }
        LDS_WAIT(); __syncthreads();
    }
    LDS_WAIT(); __syncthreads();
    if (F.lane < 32) WHIST_[(size_t)F.gw * 32 + F.lane] = (int)wh[F.lane];
    if (F.tid < 32) { unsigned s = 0;
#pragma nounroll
        for (int w = 0; w < 8; ++w) s += F.MISC[MW_WH + w * 32 + F.tid];
        HISTB_[F.blk * 32 + F.tid] = (int)s; }
    __syncthreads();
}
__device__ __forceinline__ void moe_tables(Frame& F) {
    const int e = F.tid & 31, part = F.tid >> 5; unsigned s = 0, sb = 0;
#pragma unroll 8
    for (int bq = part; bq < F.G; bq += 16) { const unsigned hv = (unsigned)HISTB_[bq * 32 + e]; s += hv; sb += bq < F.blk ? hv : 0u; }
    F.MISC[MW_TMP + part * 32 + e] = s; F.MISC[MW_TMP + 512 + part * 32 + e] = sb;
    LDS_WAIT(); __syncthreads();
    if (F.tid < 32) { unsigned a = 0, bsum = 0;
#pragma nounroll
        for (int pq = 0; pq < 16; ++pq) { a += F.MISC[MW_TMP + pq * 32 + F.tid]; bsum += F.MISC[MW_TMP + 512 + pq * 32 + F.tid]; }
        F.MISC[MW_CNT + F.tid] = a; F.MISC[MW_BB + F.tid] = bsum; }
    LDS_WAIT(); __syncthreads();
    if (F.tid < 64) {
        const int ln = F.tid; const unsigned nt = ln < NEXP ? (F.MISC[MW_CNT + ln] + 255u) >> 8 : 0u; unsigned inc = nt;
#pragma unroll
        for (int d = 1; d < 32; d <<= 1) { const unsigned v = (unsigned)__shfl_up((int)inc, d, 64); if (ln >= d) inc += v; }
        if (ln < NEXP) F.MISC[MW_TS + ln] = inc - nt;
        if (ln == NEXP - 1) F.MISC[MW_TS + NEXP] = inc; }
    LDS_WAIT(); __syncthreads();
    { const int q = F.tid >> 4, r = F.tid & 15; const unsigned ts = F.MISC[MW_TS + q], nt = F.MISC[MW_TS + q + 1] - ts;
      volatile LAS unsigned char* te = (volatile LAS unsigned char*)(F.MISC + MW_TE);
      for (unsigned t = r; t < nt; t += 16) te[ts + t] = (unsigned char)q; }
    LDS_WAIT(); __syncthreads();
}
__device__ __forceinline__ void pG2(Frame& F, int l) {
    moe_tables(F);
    const int lane = F.lane, rpb = moe_rpb(F), row_lo = F.blk * rpb;
    if (F.tid < 256) { const int w = F.tid >> 5, e = F.tid & 31; unsigned wb = 0;
#pragma unroll
        for (int w2 = 0; w2 < 7; ++w2) { const unsigned v = (unsigned)WHIST_[(size_t)(F.blk * 8 + w2) * 32 + e]; wb += w2 < w ? v : 0u; }
        F.MISC[MW_TMP + w * 32 + e] = 256u * F.MISC[MW_TS + e] + F.MISC[MW_BB + e] + wb; }
    LDS_WAIT(); __syncthreads();
    for (int e = F.blk; e < NEXP; e += F.G) {
        const int c = (int)F.MISC[MW_CNT + e], base = 256 * (int)F.MISC[MW_TS + e], end = 256 * (int)(F.MISC[MW_TS + e + 1] - F.MISC[MW_TS + e]);
        for (int i = c + F.tid; i < end; i += 512) ROWMAP_[base + i] = 0; }
    for (int i = F.tid; i < rpb * 4; i += 512) {
        const int row = row_lo + (i >> 2), k = i & 3; if (row >= MROWS) break;
        const int p = row % TPB; if (l == DEPTH - 1 && p >= SEQ) continue;
        const int te = TOPE_[(size_t)row * 4 + k];
        const int ow = ((row - row_lo) & 15) >> 1, ek = te & 255, rank = te >> 8;
        const int dest = (int)F.MISC[MW_TMP + ow * 32 + (ek & 31)] + rank;
        DEST_[(size_t)row * 4 + k] = dest; ROWMAP_[dest] = row;
    }
}
struct JLoad { unsigned y[4][4]; u32x2 x[4]; };
__device__ __forceinline__ int pJ_row(int l, int a) { return l == DEPTH - 1 ? (a >> 11) * TPB + (a & (SEQ - 1)) : a; }
__device__ __forceinline__ void pJ_issue(Frame& F, JLoad& L, int row, int dk, int lane) {
#pragma unroll
    for (int k = 0; k < 4; ++k) { const int d = __builtin_amdgcn_readlane(dk, k);
#pragma unroll
        for (int j = 0; j < 4; ++j) L.y[k][j] = *(const unsigned*)((const unsigned char*)XS_   + (size_t)d * DM + 256 * j + 4 * lane); }
#pragma unroll
    for (int j = 0; j < 4; ++j) L.x[j] = *(const u32x2*)(XU_ + (size_t)row * DM + 256 * j + 4 * lane);
}
__device__ __forceinline__ void pJ(Frame& F, int l) {
    const int lane = F.lane, nrows = l == DEPTH - 1 ? BATCH * SEQ : MROWS, step = F.ngw;
    int a = F.gw; if (a >= nrows) return;
    auto route = [&](int aa, int& dk, float& gk) __attribute__((always_inline)) { if (aa < nrows) { const int r = pJ_row(l, aa); dk = DEST_[(size_t)r * 4 + (lane & 3)]; gk = TOPG_[(size_t)r * 4 + (lane & 3)]; } };
    auto one = [&](const JLoad& L, const int aa, const float gkA) __attribute__((always_inline)) {
        const int row = pJ_row(l, aa), b = row / TPB, p = row - b * TPB; const int mc = p < SEQ ? b : 16; const float* mod = MOD_ + ((size_t)l * 17 + mc) * 6144;
        f32x4 g2[4], s1[4], s0[4], gm[4];
#pragma unroll
        for (int j = 0; j < 4; ++j) { const int col = 256 * j + 4 * lane; g2[j] = *(const f32x4*)(mod + 5 * 1024 + col);
            if (l != DEPTH - 1) { const float* mod1 = MOD_ + ((size_t)(l + 1) * 17 + mc) * 6144; s1[j] = *(const f32x4*)(mod1 + 1024 + col); s0[j] = *(const f32x4*)(mod1 + col); gm[j] = *(const f32x4*)(g_mix_ + (l + 1) * DM + col); } }
        float g[4];
#pragma unroll
        for (int k = 0; k < 4; ++k) g[k] = rl_f(gkA, k) * (1.0f / SC_Y);
        f32x4 v[4];
#pragma unroll
        for (int j = 0; j < 4; ++j) { f32x4 acc = (f32x4){0.f, 0.f, 0.f, 0.f};
#pragma unroll
            for (int k = 0; k < 4; ++k) { const int w = (int)L.y[k][j]; acc += (f32x4){__builtin_amdgcn_cvt_f32_fp8(w, 0), __builtin_amdgcn_cvt_f32_fp8(w, 1), __builtin_amdgcn_cvt_f32_fp8(w, 2), __builtin_amdgcn_cvt_f32_fp8(w, 3)} * g[k]; }
            v[j] = bf4f(L.x[j]) + g2[j] * acc; }
        if (l == DEPTH - 1) {
#pragma unroll
            for (int j = 0; j < 4; ++j) *(f32x4*)(out_ + ((size_t)b * SEQ + p) * DM + 256 * j + 4 * lane) = v[j];
        } else {
#pragma unroll
            for (int j = 0; j < 4; ++j) { u32x2 o; o.x = pg8::cvt_pk_bf16(v[j][0], v[j][1]); o.y = pg8::cvt_pk_bf16(v[j][2], v[j][3]); *(u32x2*)(XU_ + (size_t)row * DM + 256 * j + 4 * lane) = o; v[j] = bf4f(o); }
            const float rstd = rsq(wave_sum(sumsq4(v)) * (1.0f / DM) + EPS);
            unsigned char* orow = (unsigned char*)H_ + (size_t)row * DM;
#pragma unroll
            for (int j = 0; j < 4; ++j) { const f32x4 h = (v[j] * rstd * gm[j] * (s1[j] + 1.0f) + s0[j]) * SC_X; *(unsigned*)(orow + 256 * j + 4 * lane) = pk4f8(h[0], h[1], h[2], h[3]); }
        }
    };
    int dk0 = 0, dk1 = 0, dk2 = 0, dk3 = 0; float gk0 = 0.f, gk1 = 0.f, gk2 = 0.f, gk3 = 0.f;
    route(a, dk0, gk0); route(a + step, dk1, gk1);
    JLoad A, B; pJ_issue(F, A, pJ_row(l, a), dk0, lane);
    for (; a < nrows; a += 2 * step) {
        route(a + 2 * step, dk2, gk2);
        if (a + step < nrows) pJ_issue(F, B, pJ_row(l, a + step), dk1, lane);
        one(A, a, gk0);
        if (a + step >= nrows) break;
        route(a + 3 * step, dk3, gk3);
        if (a + 2 * step < nrows) pJ_issue(F, A, pJ_row(l, a + 2 * step), dk2, lane);
        one(B, a + step, gk1);
        dk0 = dk2; gk0 = gk2; dk1 = dk3; gk1 = gk3;
    }
}

#ifndef PH_MASK
#define PH_MASK 0x3fff
#endif
#define IN(k) (lo <= (k) && (k) < hi)
#define EN(i) ((PH_MASK >> (i)) & 1)
#define RELOAD() do { int ln_; asm volatile("v_mbcnt_lo_u32_b32 %0, -1, 0\n\tv_mbcnt_hi_u32_b32 %0, -1, %0" : "=v"(ln_)); ln_ &= 63; F.lane = ln_; F.wave = wave0; F.tid = wave0 * 64 + ln_; \
    { int b_ = (int)blockIdx.x, g_ = (int)gridDim.x, w_ = wave0; asm volatile("" : "+s"(b_), "+s"(g_), "+s"(w_)); F.blk = b_; F.G = g_; F.wave = w_ & 7; F.tid = (w_ & 7) * 64 + ln_; F.gw = b_ * 8 + (w_ & 7); F.ngw = g_ * 8; } \
    int z_ = 0; asm volatile("" : "+s"(z_)); F.A = (const Args*)((const char*)&args + z_); } while (0)
#define SEAM(k) do { if ((k) + 1 < hi) { xcd_barrier(bar.bar, bar.x, bar.st, F.tid); if (NREP(18) > 1) xcd_barrier(bar.bar, bar.x, bar.st, F.tid); } } while (0)
template <int l>
__device__ __forceinline__ void layer_phases(Frame& F, const Args& args, const XcdBarrier& bar, const int lo, const int hi, const int wave0) {
        const int pb = 1 + 13 * l; const bool lastl = (l == DEPTH - 1);
        if (EN(1) && IN(pb + 0) && l == 0) { RELOAD(); pA_init(F); SEAM(pb + 0); }
        if (EN(2) && IN(pb + 1)) { RELOAD();
            pg8::Gemm g{H_  , (const bf16*)((const unsigned char*)WIN_ + (size_t)l * 2048 * 1024), nullptr}; DenseOrder S{MROWS / 256, ZC / 256, F.G, F.blk, 0, NREP(2)}; EpiBf16PlainT<true> E{Z_, ZC};
            pg8::gemm_phase<EpiBf16PlainT<true>, DenseOrder, 512, 512, true, true, true>(F.lds + RING_OFF, g, S, E, F.tid); SEAM(pb + 1); }
        if (EN(3) && IN(pb + 2)) { RELOAD();
            pg8::Gemm g{Z_ + Z_CQ, WSM_ + (size_t)l * 1280 * 384, nullptr}; DenseOrder S{MROWS / 256, YC / 256, F.G, F.blk, 0, NREP(3)}; EpiBf16Plain E{Y_, YC};
            pg8::gemm_phase<EpiBf16Plain, DenseOrder, 384, ZC, true, true>(F.lds + RING_OFF, g, S, E, F.tid); SEAM(pb + 2); }
        if (EN(4) && IN(pb + 3)) { for (int rp = 0; rp < NREP(4); ++rp) { RELOAD(); pD_tokens(F, l); } SEAM(pb + 3); }
        if (EN(5) && IN(pb + 4)) { for (int rp = 0; rp < NREP(5); ++rp) { RELOAD(); pE1(F, l); } SEAM(pb + 4); }
        if (EN(6) && IN(pb + 5)) { for (int rp = 0; rp < NREP(6); ++rp) { RELOAD(); pE2(F, l); } SEAM(pb + 5); }
        if (EN(8) && IN(pb + 7)) { RELOAD();
            pg8::Gemm g{ATT_, WOUT_ + (size_t)l * 1024 * 1024, nullptr}; DenseOrder S{lastl ? BATCH * 8 : MROWS / 256, DM / 256, F.G, F.blk, lastl ? 1 : 0, 1};
            EpiResid E{XU_, MOD_ + (size_t)l * 17 * 6144 + 2 * 1024, l == 0 ? x_ : nullptr, l == 0 ? ctx_ : nullptr};
            pg8::gemm_phase<EpiResid, DenseOrder, DM, DM, true, true>(F.lds + RING_OFF, g, S, E, F.tid); SEAM(pb + 7); }
        if (EN(9) && IN(pb + 8)) { for (int rp = 0; rp < NREP(9); ++rp) { RELOAD(); pG1(F, l); } SEAM(pb + 8); }
        if (EN(10) && IN(pb + 9)) { for (int rp = 0; rp < NREP(10); ++rp) { RELOAD(); pG2(F, l); } SEAM(pb + 9); }
        if (EN(11) && IN(pb + 10)) { RELOAD();
            pg8::Gemm g{H_  , (const bf16*)((const unsigned char*)W1_ + (size_t)l * NEXP * 2048 * 1024), ROWMAP_};
            MoeOrder S{(const volatile LAS int*)(F.MISC + MW_TS), (const volatile LAS unsigned char*)(F.MISC + MW_TE), 8, F.G, F.blk, NREP(11)};
            EpiSwiglu E{(unsigned char*)ACT_, b_moe1_ + (size_t)l * NEXP * 2048};
            pg8::gemm_phase<EpiSwiglu, MoeOrder, 512, 512, true, true, true, true>(F.lds + RING_OFF, g, S, E, F.tid); SEAM(pb + 10); }
        if (EN(12) && IN(pb + 11)) { RELOAD();
            pg8::Gemm g{ACT_, (const bf16*)((const unsigned char*)W2_ + (size_t)l * NEXP * 1024 * 1024), nullptr};
            MoeOrder S{(const volatile LAS int*)(F.MISC + MW_TS), (const volatile LAS unsigned char*)(F.MISC + MW_TE), 4, F.G, F.blk, NREP(12)};
            EpiFp8Bias E{(unsigned char*)XS_, b_moe2_ + (size_t)l * NEXP * 1024};
            pg8::gemm_phase<EpiFp8Bias, MoeOrder, 512, 512, true, true, true>(F.lds + RING_OFF, g, S, E, F.tid); SEAM(pb + 11); }
        if (EN(13) && IN(pb + 12)) { for (int rp = 0; rp < (lastl ? NREP(13) : 1); ++rp) { RELOAD(); pJ(F, l); } if (!lastl) SEAM(pb + 12); }
}
__global__ void __launch_bounds__(512, 2) fwd(Args args) {
    extern __shared__ __attribute__((aligned(16))) unsigned char lds[];
    Frame F;
    F.lds = (LAS unsigned char*)lds; F.MISC = (volatile LAS unsigned*)(F.lds + MISC_OFF);
    F.tid = threadIdx.x; F.lane = F.tid & 63; F.wave = __builtin_amdgcn_readfirstlane(F.tid >> 6); const int wave0 = F.wave & 7;
    F.G = gridDim.x; F.blk = blockIdx.x; F.gw = F.blk * 8 + F.wave; F.ngw = F.G * 8;
    F.A = &args; unsigned char* ws = args.ws;
    for (int u = F.tid; u < (LDS_BYTES - MISC_OFF) / 4; u += 512) F.MISC[u] = 0u;
    __syncthreads();
    XcdBarrier bar = xcd_barrier_post((unsigned*)(ws + WS_CTL) + CW_BAR + args.li * XCD_BAR_WORDS, F.MISC + MW_BAR);
    const int lo = args.ph_lo, hi = args.ph_hi;
    if (EN(0) && IN(0)) { for (int rp = 0; rp < NREP(0); ++rp) { RELOAD(); p0_prologue(F); } SEAM(0); }
    layer_phases<0>(F, args, bar, lo, hi, wave0);
    layer_phases<1>(F, args, bar, lo, hi, wave0);
    static_assert(DEPTH == 2, "two layer instantiations");
#undef IN
#undef SEAM
}

extern "C" void kernel_launch(void* const* d_in, const int* in_sizes, int n_in, void* d_out, int out_size, void* d_ws, size_t ws_size, hipStream_t stream) {
    static int grid = 0;
    if (grid == 0) {
        if (n_in != 28 || out_size != BATCH * SEQ * DM || ws_size < WS_END) { fprintf(stderr, "kernel_launch: unexpected problem (n_in %d out %d ws %zu)\n", n_in, out_size, ws_size); grid = -1; return; }
        int dev = 0, cus = 0, per_cu = 0;
        if (hipGetDevice(&dev) != hipSuccess || hipDeviceGetAttribute(&cus, hipDeviceAttributeMultiprocessorCount, dev) != hipSuccess) { grid = -1; return; }
        if (hipFuncSetAttribute((const void*)fwd, hipFuncAttributeMaxDynamicSharedMemorySize, LDS_BYTES) != hipSuccess) { fprintf(stderr, "kernel_launch: hipFuncSetAttribute failed\n"); grid = -1; return; }
        if (hipOccupancyMaxActiveBlocksPerMultiprocessor(&per_cu, (const void*)fwd, 512, LDS_BYTES) != hipSuccess || per_cu < 1) { fprintf(stderr, "kernel_launch: occupancy query says %d\n", per_cu); }
        (void)hipGetLastError();
        grid = cus & ~7;
        if (grid < 8) { grid = -1; return; }
    }
    if (grid < 0) return;
    (void)hipMemsetAsync((char*)d_ws + WS_CTL, 0, CTL_ZERO_BYTES, stream);
    Args a{};
    for (int i = 0; i < 28; ++i) a.in[i] = (const float*)d_in[i];
    a.out = (float*)d_out; a.ws = (unsigned char*)d_ws; a.pad = 0;
#if MK_N_LAUNCHES == 1
    a.ph_lo = 0; a.ph_hi = NPH; a.li = 0;
    hipLaunchKernelGGL(fwd, dim3(grid), dim3(512), LDS_BYTES, stream, a);
#else
    for (int ph = 0, li = 0; ph < NPH; ++ph) {
        if (ph == 1 + 13 || ph == 1 + 6 || ph == 1 + 13 + 6) continue;
        a.ph_lo = ph; a.ph_hi = ph + 1; a.li = li++;
        hipLaunchKernelGGL(fwd, dim3(grid), dim3(512), LDS_BYTES, stream, a);
    }
#endif
}
```

```cpp
#include <hip/hip_runtime.h>
#include <cstdio>
#include <cstdint>

#define GAS __attribute__((address_space(1)))
#define LAS __attribute__((address_space(3)))
typedef unsigned short bf16;
typedef short bf16x8 __attribute__((ext_vector_type(8)));
typedef short bf16x4 __attribute__((ext_vector_type(4)));
typedef float f32x4 __attribute__((ext_vector_type(4)));
typedef unsigned u32x4 __attribute__((ext_vector_type(4)));
typedef unsigned u32x2 __attribute__((ext_vector_type(2)));

#ifndef REP_MASK
#define REP_MASK 0
#endif
#define NREP(i) (((REP_MASK >> (i)) & 1) ? 2 : 1)
#ifndef MK_N_LAUNCHES
#define MK_N_LAUNCHES 1
#endif

namespace pg8 {
constexpr int BM = 256, BK = 64, HALF = 128, HTB = HALF * BK * 2, STAGE_BYTES = 8 * HTB;
__host__ __device__ __forceinline__ int lds_byte(int r, int c) { const int st = (r >> 4) * 2 + (c >> 5), rr = r & 15, cc = c & 31, ob = rr * 64 + cc * 2; return st * 1024 + (ob ^ (((ob >> 9) & 1) << 5)); }
__host__ __device__ __forceinline__ void stage_rc(int b, int& R, int& C) { const int st = b / 1024, sb = b % 1024, swz = sb ^ (((sb >> 9) & 1) << 5); R = (st >> 1) * 16 + swz / 64; C = (st & 1) * 32 + (swz % 64) / 2; }
__host__ __device__ __forceinline__ int perm32(int rho) { const int n = rho >> 4, i = rho & 15; return 8 * (i >> 2) + 4 * n + (i & 3); }

struct Unit { int pm, pn, pb, pa; };
struct Gemm { const bf16* A; const bf16* Bt; const int* rowmap; };

__device__ __forceinline__ unsigned cvt_pk_bf16(float lo, float hi) { unsigned r; asm volatile("v_cvt_pk_bf16_f32 %0, %1, %2" : "=v"(r) : "v"(lo), "v"(hi)); return r; }

typedef int i32x4v __attribute__((ext_vector_type(4)));
typedef int i32x8v __attribute__((ext_vector_type(8)));
template <class Epi, class Sched, int K, int LDA, bool ALIGN_EPI, bool SP2, bool FP8 = false, bool GATHER = false>
__device__ __forceinline__ void gemm_phase(LAS unsigned char* lds, const Gemm g, const Sched& S, const Epi& E, const int tid) {
    const int wid = __builtin_amdgcn_readfirstlane(tid >> 6), lane = tid & 63, wr = wid >> 2, wc = wid & 3, fr = lane & 15, fq = lane >> 4;
    constexpr int nt = K / BK;
    unsigned voffA[2], voffB[2]; int rA[2]; unsigned cA2[2];
#pragma unroll
    for (int i = 0; i < 2; ++i) { int R, C; stage_rc(tid * 16 + i * 8192, R, C); const int Rb = Epi::PERM ? ((R & ~31) + perm32(R & 31)) : R;
        voffA[i] = (unsigned)(R * LDA + C) * 2u; voffB[i] = (unsigned)(Rb * K + C) * 2u; rA[i] = R; cA2[i] = (unsigned)C * 2u; }
    constexpr size_t kstep = (size_t)(BK * 2);
    constexpr size_t hA = GATHER ? 0 : (size_t)HALF * LDA * 2, hB = (size_t)HALF * K * 2;
    constexpr size_t tA = 2 * hA, tB = 2 * hB;
    unsigned gC[2][2], gN[2][2];
#define PG8_GLOAD(dst, unit) do { if constexpr (GATHER) { _Pragma("unroll") for (int _h = 0; _h < 2; ++_h) _Pragma("unroll") for (int _i = 0; _i < 2; ++_i) \
        dst[_h][_i] = (unsigned)g.rowmap[(unit).pa * 256 + _h * 128 + rA[_i]] * (unsigned)(LDA * 2) + cA2[_i]; } } while (0)
#define PG8_STAGE_A(b, h, ptr, nx) do { if constexpr (GATHER) { _Pragma("unroll") for (int _i = 0; _i < 2; ++_i) \
        __builtin_amdgcn_global_load_lds((const unsigned*)((const char*)(ptr) + ((nx) ? gN[h][_i] : gC[h][_i])), (LAS unsigned*)(lds + PG8_SA(b, h) + ldsw + _i * 8192), 16, 0, 0); } \
        else PG8_STAGE(PG8_SA(b, h), (ptr) + (h) * hA, voffA); } while (0)
    const unsigned ldsw = (unsigned)wid * 1024u;
    const int aoff = FP8 ? lds_byte(wr * 64 + fr, (fq & 1) * 16) + (fq >> 1) * 1024 : lds_byte(wr * 64 + fr, fq * 8);
    const int boff = FP8 ? lds_byte(wc * 32 + fr, (fq & 1) * 16) + (fq >> 1) * 1024 : lds_byte(wc * 32 + fr, fq * 8);
#define PG8_SA(b, h) (((b) * 2 + (h)) * HTB)
#define PG8_SB(b, h) ((4 + (b) * 2 + (h)) * HTB)
#define PG8_STAGE(bufoff, gbase, voff) do { _Pragma("unroll") for (int _i = 0; _i < 2; ++_i) \
        __builtin_amdgcn_global_load_lds((const unsigned*)((const char*)(gbase) + (voff)[_i]), (LAS unsigned*)(lds + (bufoff) + ldsw + _i * 8192), 16, 0, 0); } while (0)
#define PG8_LDA(dst, b, h) do { _Pragma("unroll") for (int m = 0; m < 4; ++m) { if constexpr (FP8) { const i32x4v lo_ = *(const LAS i32x4v*)(lds + PG8_SA(b, h) + aoff + m * 2048), hi_ = *(const LAS i32x4v*)(lds + PG8_SA(b, h) + aoff + m * 2048 + 16); dst[m] = __builtin_shufflevector(lo_, hi_, 0, 1, 2, 3, 4, 5, 6, 7); } \
        else { dst[m].lo = *(const LAS i32x4v*)(lds + PG8_SA(b, h) + aoff + m * 2048); dst[m].hi = *(const LAS i32x4v*)(lds + PG8_SA(b, h) + aoff + m * 2048 + 1024); } } } while (0)
#define PG8_LDB(dst, b, h) do { _Pragma("unroll") for (int n = 0; n < 2; ++n) { if constexpr (FP8) { const i32x4v lo_ = *(const LAS i32x4v*)(lds + PG8_SB(b, h) + boff + n * 2048), hi_ = *(const LAS i32x4v*)(lds + PG8_SB(b, h) + boff + n * 2048 + 16); dst[n] = __builtin_shufflevector(lo_, hi_, 0, 1, 2, 3, 4, 5, 6, 7); } \
        else { dst[n].lo = *(const LAS i32x4v*)(lds + PG8_SB(b, h) + boff + n * 2048); dst[n].hi = *(const LAS i32x4v*)(lds + PG8_SB(b, h) + boff + n * 2048 + 1024); } } } while (0)
#define PG8_MMA(ai, bj, At, Bt) do { __builtin_amdgcn_s_setprio(1); _Pragma("unroll") for (int m = 0; m < 4; ++m) _Pragma("unroll") for (int n = 0; n < 2; ++n) { \
        if constexpr (FP8) asm volatile("v_mfma_scale_f32_16x16x128_f8f6f4 %0, %1, %2, %0, %3, %3 op_sel_hi:[0,0,0]" : "+v"(acc[ai][bj][m][n]) : "v"(Bt[n]), "v"(At[m]), "v"(sc8)); \
        else { const i32x4v bl_ = __builtin_shufflevector(Bt[n], Bt[n], 0, 1, 2, 3), bh_ = __builtin_shufflevector(Bt[n], Bt[n], 4, 5, 6, 7), al_ = __builtin_shufflevector(At[m], At[m], 0, 1, 2, 3), ah_ = __builtin_shufflevector(At[m], At[m], 4, 5, 6, 7); \
               acc[ai][bj][m][n] = __builtin_amdgcn_mfma_f32_16x16x32_bf16(__builtin_bit_cast(bf16x8, bl_), __builtin_bit_cast(bf16x8, al_), acc[ai][bj][m][n], 0, 0, 0);   \
               acc[ai][bj][m][n] = __builtin_amdgcn_mfma_f32_16x16x32_bf16(__builtin_bit_cast(bf16x8, bh_), __builtin_bit_cast(bf16x8, ah_), acc[ai][bj][m][n], 0, 0, 0); } } \
        __builtin_amdgcn_s_setprio(0); } while (0)
#define PG8_WAIT_V(n) asm volatile("s_waitcnt vmcnt(" #n ")" ::: "memory")
#define PG8_WAIT_L(n) asm volatile("s_waitcnt lgkmcnt(" #n ")" ::: "memory")
#define PG8_BAR __builtin_amdgcn_s_barrier()
#define PG8_SCHED __builtin_amdgcn_sched_barrier(0)
    int sc8 = 0x7f7f7f7f; asm volatile("" : "+v"(sc8));
    Unit cur, nxt; int ui = 0;
    if (!S.next(0, cur)) return;
    f32x4 acc[2][2][4][2];
#pragma unroll
    for (int a = 0; a < 2; ++a)
#pragma unroll
        for (int b = 0; b < 2; ++b)
#pragma unroll
            for (int m = 0; m < 4; ++m)
#pragma unroll
                for (int n = 0; n < 2; ++n) acc[a][b][m][n] = (f32x4){0.f, 0.f, 0.f, 0.f};
    i32x8v At[4], B0[2], B1[2];
    const char* cA = (const char*)g.A + (size_t)cur.pa * tA; const char* cB = (const char*)g.Bt + (size_t)cur.pb * tB;
    typename Epi::Pre pre = E.prefetch(cur, wc, fq);
    PG8_GLOAD(gC, cur);
#pragma unroll
    for (int _h = 0; _h < 2; ++_h)
#pragma unroll
        for (int _i = 0; _i < 2; ++_i) gN[_h][_i] = gC[_h][_i];
    if constexpr (SP2) {
        PG8_STAGE(PG8_SB(0, 0), cB, voffB); PG8_STAGE(PG8_SB(0, 1), cB + hB, voffB); PG8_STAGE_A(0, 0, cA, false); PG8_STAGE_A(0, 1, cA, false);
        if (wr == 1) PG8_BAR;
        PG8_WAIT_V(2); PG8_BAR;
        PG8_STAGE(PG8_SB(1, 0), cB + kstep, voffB); PG8_STAGE_A(1, 0, cA + kstep, false); PG8_STAGE(PG8_SB(1, 1), cB + hB + kstep, voffB);
        PG8_WAIT_V(6); PG8_BAR;
    } else {
        static_assert(!GATHER, "the gathered A operand is wired into the SP2 loop only");
        PG8_STAGE(PG8_SB(0, 0), cB, voffB); PG8_STAGE(PG8_SA(0, 0), cA, voffA); PG8_STAGE(PG8_SB(0, 1), cB + hB, voffB); PG8_STAGE(PG8_SA(0, 1), cA + hA, voffA);
        if (wr == 1) PG8_BAR;
        PG8_WAIT_V(4); PG8_BAR;
        PG8_STAGE(PG8_SB(1, 0), cB + kstep, voffB); PG8_STAGE(PG8_SA(1, 0), cA + kstep, voffA); PG8_STAGE(PG8_SB(1, 1), cB + hB + kstep, voffB);
        PG8_WAIT_V(6); PG8_BAR;
    }
    for (;;) {
        const bool has_next = S.next(ui + 1, nxt);
        const char* nA = has_next ? (const char*)g.A + (size_t)nxt.pa * tA : cA; const char* nB = has_next ? (const char*)g.Bt + (size_t)nxt.pb * tB : cB;
        if (has_next) PG8_GLOAD(gN, nxt);
#pragma nounroll
        for (int t = 0; t < nt; t += 2) {
            const bool last = (t == nt - 2);
            const char* a1 = cA + (size_t)(t + 1) * kstep;
            const char* a2 = last ? nA : cA + (size_t)(t + 2) * kstep; const char* b2 = last ? nB : cB + (size_t)(t + 2) * kstep;
            const char* a3 = a2 + kstep; const char* b3 = b2 + kstep;
            if constexpr (SP2) {
            PG8_LDB(B0, 0, 0); PG8_LDB(B1, 0, 1); PG8_SCHED; PG8_LDA(At, 0, 0); PG8_STAGE_A(1, 1, a1, false);
            PG8_WAIT_V(8); PG8_WAIT_L(0); PG8_BAR; PG8_MMA(0, 0, At, B0); PG8_MMA(0, 1, At, B1); PG8_BAR; PG8_SCHED;
            PG8_LDA(At, 0, 1); PG8_STAGE(PG8_SB(0, 0), b2, voffB); PG8_STAGE(PG8_SB(0, 1), b2 + hB, voffB); PG8_STAGE_A(0, 0, a2, last);
            PG8_WAIT_V(8); PG8_WAIT_L(0); PG8_BAR; PG8_MMA(1, 0, At, B0); PG8_MMA(1, 1, At, B1); PG8_BAR; PG8_SCHED;
            PG8_LDB(B0, 1, 0); PG8_LDB(B1, 1, 1); PG8_SCHED; PG8_LDA(At, 1, 0); PG8_STAGE_A(0, 1, a2, last);
            PG8_WAIT_V(8); PG8_WAIT_L(0); PG8_BAR; PG8_MMA(0, 0, At, B0); PG8_MMA(0, 1, At, B1); PG8_BAR; PG8_SCHED;
            PG8_LDA(At, 1, 1); PG8_STAGE(PG8_SB(1, 0), b3, voffB); PG8_STAGE(PG8_SB(1, 1), b3 + hB, voffB); PG8_STAGE_A(1, 0, a3, last);
            PG8_WAIT_V(8); PG8_WAIT_L(0); PG8_BAR; PG8_MMA(1, 0, At, B0); PG8_MMA(1, 1, At, B1); PG8_BAR; PG8_SCHED;
            } else {
            PG8_LDB(B0, 0, 0); PG8_SCHED; PG8_LDA(At, 0, 0); PG8_STAGE(PG8_SA(1, 1), a1 + hA, voffA);
            PG8_WAIT_L(8); PG8_BAR; PG8_WAIT_L(0); PG8_MMA(0, 0, At, B0); PG8_BAR; PG8_SCHED;
            PG8_LDB(B1, 0, 1); PG8_STAGE(PG8_SB(0, 0), b2, voffB);
            PG8_BAR; PG8_WAIT_L(0); PG8_MMA(0, 1, At, B1); PG8_BAR;
            PG8_LDA(At, 0, 1); PG8_STAGE(PG8_SA(0, 0), a2, voffA);
            PG8_BAR; PG8_WAIT_L(0); PG8_MMA(1, 0, At, B0); PG8_BAR; PG8_SCHED;
            PG8_STAGE(PG8_SB(0, 1), b2 + hB, voffB);
            PG8_WAIT_V(6); PG8_BAR; PG8_MMA(1, 1, At, B1); PG8_BAR;
            PG8_LDB(B0, 1, 0); PG8_SCHED; PG8_LDA(At, 1, 0); PG8_STAGE(PG8_SA(0, 1), a2 + hA, voffA);
            PG8_WAIT_L(8); PG8_BAR; PG8_WAIT_L(0); PG8_MMA(0, 0, At, B0); PG8_BAR; PG8_SCHED;
            PG8_LDB(B1, 1, 1); PG8_STAGE(PG8_SB(1, 0), b3, voffB);
            PG8_BAR; PG8_WAIT_L(0); PG8_MMA(0, 1, At, B1); PG8_BAR;
            PG8_LDA(At, 1, 1); PG8_STAGE(PG8_SA(1, 0), a3, voffA);
            PG8_BAR; PG8_WAIT_L(0); PG8_MMA(1, 0, At, B0); PG8_BAR; PG8_SCHED;
            PG8_STAGE(PG8_SB(1, 1), b3 + hB, voffB);
            PG8_WAIT_V(6); PG8_BAR; PG8_MMA(1, 1, At, B1); PG8_BAR;
            }
        }
        if constexpr (FP8) asm volatile("s_nop 15\n\ts_nop 15" ::: "memory");
        if constexpr (ALIGN_EPI) { if (wr == 0) PG8_BAR; }
        E(acc, cur, wr, wc, fr, fq, pre);
        if (!has_next) break;
        pre = E.prefetch(nxt, wc, fq);
#pragma unroll
        for (int a = 0; a < 2; ++a)
#pragma unroll
            for (int b = 0; b < 2; ++b)
#pragma unroll
                for (int m = 0; m < 4; ++m)
#pragma unroll
                    for (int n = 0; n < 2; ++n) acc[a][b][m][n] = (f32x4){0.f, 0.f, 0.f, 0.f};
        cur = nxt; cA = nA; cB = nB; ++ui;
#pragma unroll
        for (int _h = 0; _h < 2; ++_h)
#pragma unroll
            for (int _i = 0; _i < 2; ++_i) gC[_h][_i] = gN[_h][_i];
        if constexpr (ALIGN_EPI) { if (wr == 1) PG8_BAR; }
    }
    PG8_WAIT_V(0);
    if constexpr (!ALIGN_EPI) { if (wr == 0) PG8_BAR; }
    PG8_BAR;
#undef PG8_SA
#undef PG8_SB
#undef PG8_STAGE
#undef PG8_STAGE_A
#undef PG8_GLOAD
#undef PG8_LDA
#undef PG8_LDB
#undef PG8_MMA
#undef PG8_WAIT_V
#undef PG8_WAIT_L
#undef PG8_BAR
#undef PG8_SCHED
}
}

constexpr int BATCH = 16, SEQ = 2048, CTXL = 256, TPB = SEQ + CTXL, MROWS = BATCH * TPB, DM = 1024, DEPTH = 2;
constexpr int ZC = 2048, YC = 1280, INC = 1984;
constexpr int NEXP = 32, MAXTILES = 608, XSROWS = MAXTILES * 256;
constexpr float EPS = 1e-6f, LOG2E = 1.4426950408889634f;
constexpr float QS_NA = 0.125f * LOG2E;
constexpr float QS_MLA = 0.10206207261596575f * LOG2E;
constexpr int Z_NAQ = 0, Z_NAK = 256, Z_NAV = 512, Z_CQ = 768, Z_CKV = 1024, Z_KR = 1152, Z_GQ = 1184, Z_GK = 1312, Z_GV = 1440, Z_GO = 1696, Z_LF = 1952, Z_LB = 1968;
constexpr int NPH = 1 + 13 * DEPTH;

constexpr size_t MiB = 1u << 20;
constexpr size_t WS_CTL = 0, CTL_ZERO_BYTES = 1 * MiB;
constexpr size_t WS_MOD = 1 * MiB, WS_WSM = 2 * MiB, WS_WIN = 4 * MiB, WS_WOUT = 12 * MiB, WS_W1 = 16 * MiB, WS_W2 = 272 * MiB;
constexpr size_t WS_XU = 400 * MiB, WS_H = 544 * MiB, WS_ATT = 616 * MiB, WS_Z = 688 * MiB, WS_Y = 832 * MiB;
constexpr size_t WS_NAQ = 922 * MiB, WS_NAK = 940 * MiB, WS_NAVT = 958 * MiB, WS_MQ = 976 * MiB, WS_MK = 1012 * MiB, WS_MV = 1048 * MiB;
constexpr size_t WS_EGF = 1084 * MiB, WS_EGB = 1102 * MiB, WS_GQ = 1120 * MiB, WS_GK = 1138 * MiB, WS_GV = 1156 * MiB, WS_CS = 1192 * MiB, WS_AD = 1228 * MiB;
constexpr size_t WS_OGF = 1229 * MiB, WS_OGB = 1265 * MiB, WS_TOPE = 1301 * MiB, WS_TOPG = 1302 * MiB, WS_DEST = 1303 * MiB, WS_HIST = 1304 * MiB;
constexpr size_t WS_XS = 1305 * MiB, WS_ACT = 1609 * MiB, WS_END = 1913 * MiB;
static_assert((size_t)XSROWS * DM * 2 <= 304 * MiB && (size_t)MROWS * YC * 2 <= 90 * MiB && (size_t)MROWS * 384 * 2 <= 27 * MiB, "ws map");
constexpr int CW_BAR = 4096;

constexpr int RING_OFF = 0, MISC_OFF = 139264, LDS_BYTES = 147456;
constexpr int MW_BAR = 8, MW_CNT = 64, MW_BB = 96, MW_TS = 128, MW_TE = 192, MW_TMP = 384, MW_WH = 1536;
constexpr int WRT_PITCH = 1028;
constexpr int VT_PITCH = 1544;
static_assert(NEXP * WRT_PITCH * 4 <= MISC_OFF && 64 * VT_PITCH <= MISC_OFF, "LDS map");

#define RLX_AGENT __ATOMIC_RELAXED, __HIP_MEMORY_SCOPE_AGENT
#define LDS_WAIT() asm volatile("s_waitcnt lgkmcnt(0)" ::: "memory")
#define VM_WAIT() asm volatile("s_waitcnt vmcnt(0)" ::: "memory")
__device__ __forceinline__ float bf2f(unsigned u) { return __uint_as_float(u << 16); }
__device__ __forceinline__ unsigned pk2(float lo, float hi) { unsigned r; asm("v_cvt_pk_bf16_f32 %0, %1, %2" : "=v"(r) : "v"(lo), "v"(hi)); return r; }
__device__ __forceinline__ unsigned f2bf(float f) { return pk2(f, 0.f) & 0xffffu; }
__device__ __forceinline__ float clamp8(float v) { return fminf(fmaxf(v, -448.0f), 448.0f); }
__device__ __forceinline__ unsigned pk4f8(float a, float b, float c, float d) {
    int p = __builtin_amdgcn_cvt_pk_fp8_f32(clamp8(a), clamp8(b), 0, false); p = __builtin_amdgcn_cvt_pk_fp8_f32(clamp8(c), clamp8(d), p, true); return (unsigned)p; }
constexpr float SC_YC = 16.0f;
constexpr float SC_Y = 8.0f;
constexpr float SC_W = 256.0f, SC_X = 16.0f, SC_ACT = 4.0f;
__device__ __forceinline__ void ld4bf(const bf16* p, float (&f)[4]) { const u32x2 w = *(const u32x2*)p; f[0] = __uint_as_float(w.x << 16); f[1] = __uint_as_float(w.x & 0xffff0000u); f[2] = __uint_as_float(w.y << 16); f[3] = __uint_as_float(w.y & 0xffff0000u); }
__device__ __forceinline__ f32x4 bf4f(const u32x2 w) { return (f32x4){__uint_as_float(w.x << 16), __uint_as_float(w.x & 0xffff0000u), __uint_as_float(w.y << 16), __uint_as_float(w.y & 0xffff0000u)}; }
__device__ __forceinline__ void st4bf(bf16* p, float a, float b, float c, float d) { u32x2 w; w.x = pk2(a, b); w.y = pk2(c, d); *(u32x2*)p = w; }
template <int M> __device__ __forceinline__ float swz_xor(float v) { return __int_as_float(__builtin_amdgcn_ds_swizzle(__float_as_int(v), 0x1f | (M << 10))); }
__device__ __forceinline__ float half_sum(float v) { auto rr = __builtin_amdgcn_permlane32_swap(__float_as_uint(v), __float_as_uint(v), false, false); return __uint_as_float(rr[0]) + __uint_as_float(rr[1]); }
__device__ __forceinline__ float half_max(float v) { auto rr = __builtin_amdgcn_permlane32_swap(__float_as_uint(v), __float_as_uint(v), false, false); return fmaxf(__uint_as_float(rr[0]), __uint_as_float(rr[1])); }
template <int CTRL> __device__ __forceinline__ float dpp_f(float v) { return __int_as_float(__builtin_amdgcn_update_dpp(0, __float_as_int(v), CTRL, 0xF, 0xF, true)); }
__device__ __forceinline__ float g8_sum(float v) { v += dpp_f<0xB1>(v); v += dpp_f<0x4E>(v); v += dpp_f<0x141>(v); return v; }
__device__ __forceinline__ float g16_sum(float v) { v = g8_sum(v); v += dpp_f<0x140>(v); return v; }
__device__ __forceinline__ float rl_f(float v, int l) { return __int_as_float(__builtin_amdgcn_readlane(__float_as_int(v), l)); }
__device__ __forceinline__ float wave_sum(float v) { v = g16_sum(v); return (rl_f(v, 0) + rl_f(v, 16)) + (rl_f(v, 32) + rl_f(v, 48)); }
__device__ __forceinline__ float row_sum(float v) { auto rr = __builtin_amdgcn_permlane16_swap(__float_as_uint(v), __float_as_uint(v), false, false); return __uint_as_float(rr[0]) + __uint_as_float(rr[1]); }
__device__ __forceinline__ float row_max(float v) { auto rr = __builtin_amdgcn_permlane16_swap(__float_as_uint(v), __float_as_uint(v), false, false); return fmaxf(__uint_as_float(rr[0]), __uint_as_float(rr[1])); }
template <int CTRL> __device__ __forceinline__ float dpp_max(float v) { return fmaxf(v, dpp_f<CTRL>(v)); }
__device__ __forceinline__ float wave_max(float v) { v = dpp_max<0xB1>(v); v = dpp_max<0x4E>(v); v = dpp_max<0x141>(v); v = dpp_max<0x140>(v); return fmaxf(fmaxf(rl_f(v, 0), rl_f(v, 16)), fmaxf(rl_f(v, 32), rl_f(v, 48))); }
__device__ __forceinline__ float q4_sum(float v) { return half_sum(row_sum(v)); }
__device__ __forceinline__ float q4_max(float v) { return half_max(row_max(v)); }
__device__ __forceinline__ float rsq(float x) { return __builtin_amdgcn_rsqf(x); }

#define XB_TMO      128
#define XB_XCNT(j)  (256  + 64 * (j))
#define XB_XSUB(j)  (1280 + 64 * (j))
#define XB_XGEN(j)  (2304 + 64 * (j))
#define XB_TOP      3328
#define XB_TOPGEN   3392
#define XCD_BAR_WORDS 3456
#define XB_SPIN_CAP (1u << 18)
__device__ __forceinline__ unsigned xb_ld(unsigned* p)              { return __hip_atomic_load(p, __ATOMIC_RELAXED, __HIP_MEMORY_SCOPE_AGENT); }
__device__ __forceinline__ unsigned xb_add(unsigned* p, unsigned v) { return __hip_atomic_fetch_add(p, v, __ATOMIC_RELAXED, __HIP_MEMORY_SCOPE_AGENT); }
__device__ __forceinline__ unsigned xb_xcc_id() { return (unsigned)__builtin_amdgcn_s_getreg((3 << 11) | 20) & 0xFu; }
#define XB_SPIN(cond, bar) do { unsigned _sp = 0; while (cond) { __builtin_amdgcn_s_sleep(1); \
    if ((++_sp & 255u) == 0u) { if (xb_ld(&(bar)[XB_TMO])) break; if (_sp > XB_SPIN_CAP) { atomicAdd(&(bar)[XB_TMO], 1u); break; } } } } while (0)
struct XcdBarrier { unsigned* bar; unsigned x; volatile LAS unsigned* st; };
__device__ __forceinline__ XcdBarrier xcd_barrier_post(unsigned* bar, volatile LAS unsigned* st) {
    XcdBarrier b; b.bar = bar; b.x = xb_xcc_id(); b.st = st;
    if (threadIdx.x == 0) (void)xb_add(&bar[XB_XCNT(b.x)], 1u);
    return b;
}
__device__ __forceinline__ void xcd_barrier_complete(unsigned* bar, unsigned x, unsigned& nloc, unsigned& nx) {
    const unsigned G = gridDim.x * gridDim.y * gridDim.z;
    unsigned sum, cnt, mine, sp = 0u;
    for (;;) {
        sum = 0u; cnt = 0u; mine = 0u;
#pragma unroll
        for (unsigned j = 0; j < 16; ++j) { const unsigned c = xb_ld(&bar[XB_XCNT(j)]); sum += c; cnt += (c > 0u) ? 1u : 0u; }
        mine = xb_ld(&bar[XB_XCNT(x)]);
        if (sum == G) break;
        __builtin_amdgcn_s_sleep(1);
        if ((++sp & 255u) == 0u) { if (xb_ld(&bar[XB_TMO])) break; if (sp > XB_SPIN_CAP) { atomicAdd(&bar[XB_TMO], 1u); break; } }
    }
    nloc = mine > 0u ? mine : 1u; nx = cnt > 0u ? cnt : 1u;
}
__device__ __attribute__((noinline)) void xcd_barrier(unsigned* const bbar, const unsigned bx, volatile LAS unsigned* const bst, const int tid) {
    XcdBarrier b; b.bar = bbar; b.x = bx; b.st = bst;
    asm volatile("s_waitcnt vmcnt(0)" ::: "memory");
    __syncthreads();
    if (tid == 0) {
        unsigned* bar = b.bar;
        __builtin_amdgcn_s_waitcnt(0);
        unsigned nloc = b.st[0], nx = b.st[1];
        if (nloc == 0u) { xcd_barrier_complete(bar, b.x, nloc, nx); b.st[0] = nloc; b.st[1] = nx; }
        const unsigned old = xb_add(&bar[XB_XSUB(b.x)], 1u);
        const unsigned gen = old / nloc;
        if (old + 1u == (gen + 1u) * nloc) {
            __builtin_amdgcn_fence(__ATOMIC_RELEASE, "agent");
            asm volatile("s_waitcnt vmcnt(0)" ::: "memory");
            const unsigned og = xb_add(&bar[XB_TOP], 1u);
            const unsigned tg = og / nx;
            if (og + 1u == (tg + 1u) * nx) xb_add(&bar[XB_TOPGEN], 1u);
            else XB_SPIN(xb_ld(&bar[XB_TOPGEN]) == tg, bar);
            __builtin_amdgcn_fence(__ATOMIC_ACQUIRE, "agent");
            xb_add(&bar[XB_XGEN(b.x)], 1u);
            asm volatile("s_waitcnt vmcnt(0)" ::: "memory");
        } else {
            XB_SPIN(xb_ld(&bar[XB_XGEN(b.x)]) == gen, bar);
            __builtin_amdgcn_fence(__ATOMIC_ACQUIRE, "agent");
            asm volatile("s_waitcnt vmcnt(0)" ::: "memory");
        }
    }
    __syncthreads();
}

struct Args { const float* in[28]; float* out; unsigned char* ws; int ph_lo, ph_hi, li, pad; };
struct Frame {
    LAS unsigned char* lds;
    volatile LAS unsigned* MISC;
    int tid, lane, wave, G, blk, gw, ngw;
    const Args* A;
};
#define IN_F(F, i) ((F).A->in[i])
#define x_        IN_F(F, 0)
#define c_        IN_F(F, 1)
#define ctx_      IN_F(F, 2)
#define c_ctx_    IN_F(F, 3)
#define w_ada_    IN_F(F, 4)
#define b_ada_    IN_F(F, 5)
#define g_mix_    IN_F(F, 6)
#define w_in_     IN_F(F, 7)
#define na_q_norm_ IN_F(F, 8)
#define na_k_norm_ IN_F(F, 9)
#define na_rpb_   IN_F(F, 10)
#define mla_q_a_norm_ IN_F(F, 11)
#define mla_w_q_b_ IN_F(F, 12)
#define mla_kv_a_norm_ IN_F(F, 13)
#define mla_w_kv_b_ IN_F(F, 14)
#define mla_q_norm_ IN_F(F, 15)
#define mla_k_norm_ IN_F(F, 16)
#define gla_w_gate_ IN_F(F, 17)
#define gla_b_gate_ IN_F(F, 18)
#define gla_o_norm_ IN_F(F, 19)
#define w_out_    IN_F(F, 20)
#define g_ffn_    IN_F(F, 21)
#define w_router_ IN_F(F, 22)
#define b_router_ IN_F(F, 23)
#define w_moe1_   IN_F(F, 24)
#define b_moe1_   IN_F(F, 25)
#define w_moe2_   IN_F(F, 26)
#define b_moe2_   IN_F(F, 27)
#define out_      ((F).A->out)
#define WSP(F, T, off) ((T*)((F).A->ws + (off)))
#define MOD_  WSP(F, float, WS_MOD)
#define XU_   WSP(F, bf16, WS_XU)
#define EGF_  WSP(F, bf16, WS_EGF)
#define EGB_  WSP(F, bf16, WS_EGB)
#define GQ_   WSP(F, float, WS_GQ)
#define GK_   WSP(F, float, WS_GK)
#define GV_   WSP(F, float, WS_GV)
#define CS_   WSP(F, float, WS_CS)
#define AD_   WSP(F, float, WS_AD)
#define OGF_  WSP(F, float, WS_OGF)
#define OGB_  WSP(F, float, WS_OGB)
#define TOPG_ WSP(F, float, WS_TOPG)
#define WSM_  WSP(F, bf16, WS_WSM)
#define WIN_  WSP(F, bf16, WS_WIN)
#define WOUT_ WSP(F, bf16, WS_WOUT)
#define W1_   WSP(F, bf16, WS_W1)
#define W2_   WSP(F, bf16, WS_W2)
#define H_    WSP(F, bf16, WS_H)
#define ATT_  WSP(F, bf16, WS_ATT)
#define Z_    WSP(F, bf16, WS_Z)
#define Y_    WSP(F, bf16, WS_Y)
#define NAQ_  WSP(F, bf16, WS_NAQ)
#define NAK_  WSP(F, bf16, WS_NAK)
#define NAVT_ WSP(F, bf16, WS_NAVT)
#define MQ_   WSP(F, bf16, WS_MQ)
#define MK_   WSP(F, bf16, WS_MK)
#define MV_   WSP(F, bf16, WS_MV)
#define XS_   WSP(F, bf16, WS_XS)
#define ACT_  WSP(F, bf16, WS_ACT)
#define TOPE_ WSP(F, int, WS_TOPE)
#define DEST_ WSP(F, int, WS_DEST)
#define ROWMAP_ WSP(F, int, WS_GQ)
#define HISTB_ WSP(F, int, WS_HIST)
#define WHIST_ WSP(F, int, WS_HIST + 65536)

struct DenseOrder {
    int nMa, nN, G, c, skipctx, rep;
    __device__ __forceinline__ bool next(int i, pg8::Unit& u) const {
        const int x = c & 7, y = c >> 3, Y = G >> 3;
        if (rep > 1) i >>= 1;
        const int j = i * Y + y; const int mg = j / nN, pn = j - mg * nN, a = mg * 8 + x;
        if (a >= nMa) return false;
        u.pm = skipctx ? (a >> 3) * 9 + (a & 7) : a; u.pn = pn; u.pb = pn; u.pa = u.pm; return true;
    }
};
struct MoeOrder {
    const volatile LAS int* ts; const volatile LAS unsigned char* te; int nN, G, c, rep;
    __device__ __forceinline__ bool next(int i, pg8::Unit& u) const {
        const int x = c & 7, y = c >> 3, Y = G >> 3;
        const int i0 = i; if (rep > 1) i >>= 1;
        const int j = i * Y + y; const int mg = j / nN, pn = j - mg * nN, a = mg * 8 + x;
        if (a >= ts[NEXP]) return false;
        const int e = te[a]; u.pm = a; u.pn = pn; u.pb = e * nN + pn; u.pa = a;
        if (NREP(19) > 1 && rep > 1 && !(i0 & 1)) { const int a2 = (a + 296) % ts[NEXP]; u.pa = a2; u.pb = te[a2] * nN + pn; }
        return true;
    }
};

struct EpiNoPre { };
template <bool SCALED> struct EpiBf16PlainT {
    static constexpr bool PERM = true; typedef EpiNoPre Pre;
    bf16* O; int ldc;
    __device__ __forceinline__ Pre prefetch(const pg8::Unit&, int, int) const { return Pre{}; }
    __device__ __forceinline__ void operator()(const f32x4 (&acc)[2][2][4][2], const pg8::Unit& u, int wr, int wc, int fr, int fq, const Pre&) const {
        const int row0 = u.pm * 256 + wr * 64 + fr, col0 = u.pn * 256 + wc * 32 + 8 * fq;
#pragma unroll
        for (int ai = 0; ai < 2; ++ai)
#pragma unroll
            for (int m = 0; m < 4; ++m) { bf16* rowp = O + (size_t)(row0 + ai * 128 + m * 16) * ldc + col0;
#pragma unroll
                for (int bj = 0; bj < 2; ++bj) { f32x4 v0 = acc[ai][bj][m][0], v1 = acc[ai][bj][m][1];
                    if constexpr (SCALED) { v0 = v0 * (1.0f / (SC_W * SC_X)); v1 = v1 * (1.0f / (SC_W * SC_X)); }
                    u32x4 w; w.x = pg8::cvt_pk_bf16(v0[0], v0[1]); w.y = pg8::cvt_pk_bf16(v0[2], v0[3]); w.z = pg8::cvt_pk_bf16(v1[0], v1[1]); w.w = pg8::cvt_pk_bf16(v1[2], v1[3]);
                    *(u32x4*)(rowp + bj * 128) = w; } }
    }
};
typedef EpiBf16PlainT<false> EpiBf16Plain;
struct EpiFp8Plain {
    static constexpr bool PERM = true; typedef EpiNoPre Pre;
    unsigned char* O; int ldc;
    __device__ __forceinline__ Pre prefetch(const pg8::Unit&, int, int) const { return Pre{}; }
    __device__ __forceinline__ void operator()(const f32x4 (&acc)[2][2][4][2], const pg8::Unit& u, int wr, int wc, int fr, int fq, const Pre&) const {
        const int row0 = u.pm * 256 + wr * 64 + fr, col0 = u.pn * 256 + wc * 32 + 8 * fq;
#pragma unroll
        for (int ai = 0; ai < 2; ++ai)
#pragma unroll
            for (int m = 0; m < 4; ++m) { unsigned char* rowp = O + (size_t)(row0 + ai * 128 + m * 16) * ldc + col0;
#pragma unroll
                for (int bj = 0; bj < 2; ++bj) { const f32x4 v0 = acc[ai][bj][m][0] * SC_YC, v1 = acc[ai][bj][m][1] * SC_YC;
                    u32x2 w; w.x = pk4f8(v0[0], v0[1], v0[2], v0[3]); w.y = pk4f8(v1[0], v1[1], v1[2], v1[3]); *(u32x2*)(rowp + bj * 128) = w; } }
    }
};
struct EpiResid {
    static constexpr bool PERM = true; typedef EpiNoPre Pre;
    bf16* X; const float* gt;
    const float* xin; const float* cin;
    __device__ __forceinline__ Pre prefetch(const pg8::Unit&, int, int) const { return Pre{}; }
    __device__ __forceinline__ void operator()(const f32x4 (&acc)[2][2][4][2], const pg8::Unit& u, int wr, int wc, int fr, int fq, const Pre&) const {
        const int row0 = u.pm * 256 + wr * 64 + fr, col0 = u.pn * 256 + wc * 32 + 8 * fq;
        const int bi = u.pm / 9, t9 = u.pm - bi * 9, mc = (t9 == 8) ? 16 : bi; const float* g = gt + mc * 6144 + col0;
        const float* base = xin ? (t9 == 8 ? cin + (size_t)bi * CTXL * DM : xin + ((size_t)bi * SEQ + t9 * 256) * DM) + (size_t)(wr * 64 + fr) * DM + col0 : nullptr;
        f32x4 gv[2][2];
#pragma unroll
        for (int bj = 0; bj < 2; ++bj)
#pragma unroll
            for (int n = 0; n < 2; ++n) gv[bj][n] = *(const f32x4*)(g + bj * 128 + 4 * n);
#pragma unroll
        for (int ai = 0; ai < 2; ++ai)
#pragma unroll
            for (int m = 0; m < 4; ++m) { bf16* rowp = X + (size_t)(row0 + ai * 128 + m * 16) * DM + col0;
#pragma unroll
                for (int bj = 0; bj < 2; ++bj) { f32x4 b0, b1;
                    if (xin) { const float* bp = base + (size_t)(ai * 128 + m * 16) * DM + bj * 128; b0 = *(const f32x4*)bp; b1 = *(const f32x4*)(bp + 4); }
                    else { const u32x4 w = *(const u32x4*)(rowp + bj * 128); u32x2 lo, hi; lo.x = w.x; lo.y = w.y; hi.x = w.z; hi.y = w.w; b0 = bf4f(lo); b1 = bf4f(hi); }
                    const f32x4 v0 = b0 + gv[bj][0] * acc[ai][bj][m][0], v1 = b1 + gv[bj][1] * acc[ai][bj][m][1];
                    u32x4 o; o.x = pg8::cvt_pk_bf16(v0[0], v0[1]); o.y = pg8::cvt_pk_bf16(v0[2], v0[3]); o.z = pg8::cvt_pk_bf16(v1[0], v1[1]); o.w = pg8::cvt_pk_bf16(v1[2], v1[3]);
                    *(u32x4*)(rowp + bj * 128) = o; } }
    }
};
struct EpiSwiglu {
    static constexpr bool PERM = true; struct Pre { f32x4 bg[2], bl[2]; };
    unsigned char* O; const float* b1;
    __device__ __forceinline__ Pre prefetch(const pg8::Unit& u, int wc, int fq) const { Pre p; const float* bb = b1 + (u.pb >> 3) * 2048 + u.pn * 128 + wc * 32 + 8 * fq;
#pragma unroll
        for (int n = 0; n < 2; ++n) { p.bg[n] = *(const f32x4*)(bb + 4 * n); p.bl[n] = *(const f32x4*)(bb + 1024 + 4 * n); }
        return p; }
    __device__ __forceinline__ void operator()(const f32x4 (&acc)[2][2][4][2], const pg8::Unit& u, int wr, int wc, int fr, int fq, const Pre& pre) const {
        const int row0 = u.pm * 256 + wr * 64 + fr, oc0 = u.pn * 128 + wc * 32 + 8 * fq;
        const f32x4 (&bg)[2] = pre.bg; const f32x4 (&bl)[2] = pre.bl;
        constexpr float S = 1.0f / (SC_W * SC_X);
#pragma unroll
        for (int ai = 0; ai < 2; ++ai)
#pragma unroll
            for (int m = 0; m < 4; ++m) { u32x2 w;
#pragma unroll
                for (int n = 0; n < 2; ++n) { f32x4 gl = acc[ai][0][m][n] * S + bg[n], li = acc[ai][1][m][n] * S + bl[n];
#pragma unroll
                    for (int i = 0; i < 4; ++i) { gl[i] = fminf(gl[i], 7.0f); li[i] = __builtin_amdgcn_fmed3f(li[i], -7.0f, 7.0f); }
                    f32x4 e = gl * (-1.702f * LOG2E);
#pragma unroll
                    for (int i = 0; i < 4; ++i) e[i] = __builtin_amdgcn_exp2f(e[i]);
                    e = e + 1.0f;
#pragma unroll
                    for (int i = 0; i < 4; ++i) e[i] = __builtin_amdgcn_rcpf(e[i]);
                    const f32x4 o = (li * SC_ACT + SC_ACT) * (gl * e);
                    int p = __builtin_amdgcn_cvt_pk_fp8_f32(o[0], o[1], 0, false); p = __builtin_amdgcn_cvt_pk_fp8_f32(o[2], o[3], p, true);
                    if (n == 0) w.x = (unsigned)p; else w.y = (unsigned)p; }
                *(u32x2*)(O + (size_t)(row0 + ai * 128 + m * 16) * DM + oc0) = w; }
    }
};
struct EpiFp8Bias {
    static constexpr bool PERM = true; struct Pre { f32x4 bv[2][2]; };
    unsigned char* O; const float* b2;
    __device__ __forceinline__ Pre prefetch(const pg8::Unit& u, int wc, int fq) const { Pre p; const float* bb = b2 + (u.pb >> 2) * 1024 + u.pn * 256 + wc * 32 + 8 * fq;
#pragma unroll
        for (int bj = 0; bj < 2; ++bj)
#pragma unroll
            for (int n = 0; n < 2; ++n) p.bv[bj][n] = *(const f32x4*)(bb + bj * 128 + 4 * n);
        return p; }
    __device__ __forceinline__ void operator()(const f32x4 (&acc)[2][2][4][2], const pg8::Unit& u, int wr, int wc, int fr, int fq, const Pre& pre) const {
        const int row0 = u.pm * 256 + wr * 64 + fr, col0 = u.pn * 256 + wc * 32 + 8 * fq;
        const f32x4 (&bv)[2][2] = pre.bv;
#pragma unroll
        for (int ai = 0; ai < 2; ++ai)
#pragma unroll
            for (int m = 0; m < 4; ++m) { unsigned char* rowp = O + (size_t)(row0 + ai * 128 + m * 16) * DM + col0;
#pragma unroll
                for (int bj = 0; bj < 2; ++bj) { const f32x4 v0 = acc[ai][bj][m][0] * (SC_Y / (SC_W * SC_ACT)) + bv[bj][0] * SC_Y, v1 = acc[ai][bj][m][1] * (SC_Y / (SC_W * SC_ACT)) + bv[bj][1] * SC_Y;
                    u32x2 w; w.x = pk4f8(v0[0], v0[1], v0[2], v0[3]); w.y = pk4f8(v1[0], v1[1], v1[2], v1[3]);
                    *(u32x2*)(rowp + bj * 128) = w; } }
    }
};

__device__ __forceinline__ void relane(Frame& F) { int ln_; asm volatile("v_mbcnt_lo_u32_b32 %0, -1, 0\n\tv_mbcnt_hi_u32_b32 %0, -1, %0" : "=v"(ln_)); ln_ &= 63; F.lane = ln_; F.tid = F.wave * 64 + ln_; }

__device__ __forceinline__ void tr_item(const float* src, int ldsrc, bool valid, const float* ksc, bf16* dst, int lddst, LAS float* scr, int lane) {
    float v[32];
#pragma unroll
    for (int i = 0; i < 32; ++i) { const int kk = 2 * i + (lane >> 5); v[i] = valid ? src[(size_t)kk * ldsrc + (lane & 31)] : 0.f; }
    if (valid && ksc) {
#pragma unroll
        for (int i = 0; i < 32; ++i) v[i] *= ksc[2 * i + (lane >> 5)];
    }
#pragma unroll
    for (int i = 0; i < 32; ++i) { const int kk = 2 * i + (lane >> 5); scr[kk * 33 + (lane & 31)] = v[i]; }
    LDS_WAIT(); asm volatile("" ::: "memory");
    const int c = lane & 7;
#pragma unroll
    for (int j = 0; j < 4; ++j) { const int n = (lane >> 3) + 8 * j; const LAS float* s = scr + (8 * c) * 33 + n;
        u32x4 o; o.x = pk2(s[0 * 33], s[1 * 33]); o.y = pk2(s[2 * 33], s[3 * 33]); o.z = pk2(s[4 * 33], s[5 * 33]); o.w = pk2(s[6 * 33], s[7 * 33]);
        *(u32x4*)(dst + (size_t)n * lddst + 8 * c) = o; }
    LDS_WAIT(); asm volatile("" ::: "memory");
}
__device__ __forceinline__ void tr_item8(const float* src, int ldsrc, unsigned char* dst, int lddst, LAS float* scr, int lane) {
    float v[32];
#pragma unroll
    for (int i = 0; i < 32; ++i) { const int kk = 2 * i + (lane >> 5); v[i] = src[(size_t)kk * ldsrc + (lane & 31)] * SC_W; }
#pragma unroll
    for (int i = 0; i < 32; ++i) { const int kk = 2 * i + (lane >> 5); scr[kk * 33 + (lane & 31)] = v[i]; }
    LDS_WAIT(); asm volatile("" ::: "memory");
    const int c = lane & 7;
#pragma unroll
    for (int j = 0; j < 4; ++j) { const int n = (lane >> 3) + 8 * j; const LAS float* s = scr + (8 * c) * 33 + n;
        u32x2 o; o.x = pk4f8(s[0 * 33], s[1 * 33], s[2 * 33], s[3 * 33]); o.y = pk4f8(s[4 * 33], s[5 * 33], s[6 * 33], s[7 * 33]);
        *(u32x2*)(dst + (size_t)n * lddst + 8 * c) = o; }
    LDS_WAIT(); asm volatile("" ::: "memory");
}
__device__ __forceinline__ void tr_item8w(const float* src, int ldsrc, unsigned char* dst, LAS float* scr, int lane) {
    const int kr = lane >> 4, nc = (lane & 15) * 4;
    f32x4 v[16];
#pragma unroll
    for (int i = 0; i < 16; ++i) v[i] = *(const f32x4*)(src + (size_t)(4 * i + kr) * ldsrc + nc);
#pragma unroll
    for (int i = 0; i < 16; ++i) *(LAS f32x4*)(scr + (4 * i + kr) * 68 + nc) = v[i] * SC_W;
    LDS_WAIT(); asm volatile("" ::: "memory");
#pragma unroll
    for (int c = 0; c < 4; ++c) { const LAS float* s = scr + (16 * c) * 68 + lane; u32x4 o;
        o.x = pk4f8(s[0 * 68], s[1 * 68], s[2 * 68], s[3 * 68]); o.y = pk4f8(s[4 * 68], s[5 * 68], s[6 * 68], s[7 * 68]);
        o.z = pk4f8(s[8 * 68], s[9 * 68], s[10 * 68], s[11 * 68]); o.w = pk4f8(s[12 * 68], s[13 * 68], s[14 * 68], s[15 * 68]);
        *(u32x4*)(dst + (size_t)lane * 1024 + 16 * c) = o; }
    LDS_WAIT(); asm volatile("" ::: "memory");
}
__device__ __forceinline__ void p0_prologue(Frame& F) {
    for (int ch = F.blk; ch < 192; ch += F.G) {
        LAS float* s = (LAS float*)(F.lds + RING_OFF);
        LAS float* red = s + 17 * 1024;
        for (int idx = F.tid; idx < 17 * 1024; idx += 512) { const int m = idx >> 10, k = idx & 1023; const float cv = m < 16 ? c_[m * 1024 + k] : c_ctx_[k]; s[idx] = cv / (1.0f + __expf(-cv)); }
        __syncthreads();
        const int l = ch / 96, col0 = (ch % 96) * 64;
        const float* W = w_ada_ + (size_t)l * 1024 * 6144 + col0 + F.lane;
        float acc[17];
#pragma unroll
        for (int m = 0; m < 17; ++m) acc[m] = 0.f;
#pragma unroll 8
        for (int kk = 0; kk < 128; ++kk) { const int k = F.wave * 128 + kk; const float w = W[(size_t)k * 6144];
#pragma unroll
            for (int m = 0; m < 17; ++m) acc[m] += s[m * 1024 + k] * w; }
#pragma unroll
        for (int m = 0; m < 17; ++m) red[(F.wave * 17 + m) * 64 + F.lane] = acc[m];
        __syncthreads();
        for (int idx = F.tid; idx < 17 * 64; idx += 512) { const int m = idx >> 6, cc = idx & 63; float a = b_ada_[l * 6144 + col0 + cc];
#pragma unroll
            for (int w = 0; w < 8; ++w) a += red[(w * 17 + m) * 64 + cc];
            MOD_[((size_t)l * 17 + m) * 6144 + col0 + cc] = a; }
        __syncthreads();
    }
    LAS float* scr = (LAS float*)(F.lds + RING_OFF + F.wave * 17408);
    constexpr int IT_W1 = 64 * 512, IT_W2 = 64 * 256, IT_WIN = 2 * 512, IT_WOUT = 2 * 512, IT_SM = 2 * 240;
    static_assert(8 * 17408 <= MISC_OFF, "prologue LDS tiles");
    constexpr int NIT = IT_W1 + IT_W2 + IT_WIN + IT_WOUT + IT_SM;
    for (int it = IT_W1 + IT_W2 + F.gw; it < NIT; it += F.ngw) {
        int r = it;
        if (r < IT_W1) { const int le = r >> 9, q = r & 511, kb = q >> 5, nb = q & 31, n0 = nb * 64, pn = n0 >> 8, j = n0 & 255; const int sc = j < 128 ? 128 * pn + j : 1024 + 128 * pn + (j - 128);
            tr_item8w(w_moe1_ + ((size_t)le * 1024 + kb * 64) * 2048 + sc, 2048, (unsigned char*)W1_ + ((size_t)le * 2048 + n0) * 1024 + kb * 64, scr, F.lane); continue; }
        r -= IT_W1;
        if (r < IT_W2) { const int le = r >> 8, q = r & 255, kb = q >> 4, nb = q & 15, n0 = nb * 64;
            tr_item8w(w_moe2_ + ((size_t)le * 1024 + kb * 64) * 1024 + n0, 1024, (unsigned char*)W2_ + ((size_t)le * 1024 + n0) * 1024 + kb * 64, scr, F.lane); continue; }
        r -= IT_W2;
        if (r < IT_WIN) { const int l = r >> 9, q = r & 511, kb = q >> 5, nb = q & 31, n0 = nb * 64;
            unsigned char* dst = (unsigned char*)WIN_ + ((size_t)l * 2048 + n0) * 1024 + kb * 64;
            if (n0 < INC) tr_item8w(w_in_ + ((size_t)l * 1024 + kb * 64) * INC + n0, INC, dst, scr, F.lane);
            else { const u32x4 z = {0u, 0u, 0u, 0u};
#pragma unroll
                for (int c = 0; c < 4; ++c) *(u32x4*)(dst + (size_t)F.lane * 1024 + 16 * c) = z; }
            continue; }
        r -= IT_WIN;
        if (r < IT_WOUT) { const int l = r >> 9, q = r & 511, kb = q >> 5, nb = q & 31, n0 = nb * 32;
            tr_item(w_out_ + ((size_t)l * 1024 + kb * 64) * 1024 + n0, 1024, true, nullptr, WOUT_ + ((size_t)l * 1024 + n0) * 1024 + kb * 64, 1024, scr, F.lane); continue; }
        r -= IT_WOUT;
        { const int l = r / 240, q = r - l * 240, kb = q / 40, nb = q - kb * 40, n0 = nb * 32, k0 = kb * 64;
            bf16* dst = WSM_ + ((size_t)l * 1280 + n0) * 384 + k0;
            if (n0 < 384) tr_item(mla_w_q_b_ + ((size_t)l * 256 + (k0 & 255)) * 384 + n0, 384, k0 < 256, mla_q_a_norm_ + l * 256 + (k0 & 255), dst, 384, scr, F.lane);
            else if (n0 < 1152) tr_item(mla_w_kv_b_ + ((size_t)l * 128 + ((k0 - 256) & 127)) * 768 + (n0 - 384), 768, k0 >= 256, mla_kv_a_norm_ + l * 128 + ((k0 - 256) & 127), dst, 384, scr, F.lane);
            else tr_item(w_out_, 1024, false, nullptr, dst, 384, scr, F.lane); }
    }
    __syncthreads();
}

__device__ __forceinline__ void norm_mod_store(const f32x4 (&v)[4], float rstd, const float* g, const float* sc, const float* sh, unsigned char* orow  , int lane) {
#pragma unroll
    for (int j = 0; j < 4; ++j) { const int col = 256 * j + 4 * lane; const f32x4 gg = *(const f32x4*)(g + col), s1 = *(const f32x4*)(sc + col), s0 = *(const f32x4*)(sh + col);
        const f32x4 h = (v[j] * rstd * gg * (s1 + 1.0f) + s0) * SC_X; *(unsigned*)(orow + col) = pk4f8(h[0], h[1], h[2], h[3]); }
}
__device__ __forceinline__ float sumsq4(const f32x4 (&v)[4]) { float s = 0.f;
#pragma unroll
    for (int j = 0; j < 4; ++j) s += (v[j][0] * v[j][0] + v[j][1] * v[j][1]) + (v[j][2] * v[j][2] + v[j][3] * v[j][3]);
    return s; }

__device__ __forceinline__ const float* pA_src(Frame& F, int row) { const int b = row / TPB, p = row - b * TPB; return p < SEQ ? x_ + ((size_t)b * SEQ + p) * DM : ctx_ + ((size_t)b * CTXL + (p - SEQ)) * DM; }
__device__ __forceinline__ void pA_init(Frame& F) {
    const int lane = F.lane, step = F.ngw;
    int row = F.gw; if (row >= MROWS) return;
    f32x4 gm[4];
#pragma unroll
    for (int j = 0; j < 4; ++j) gm[j] = *(const f32x4*)(g_mix_ + 256 * j + 4 * lane);
    auto load = [&](f32x4 (&v)[4], int r) __attribute__((always_inline)) { const float* src = pA_src(F, r);
#pragma unroll
        for (int j = 0; j < 4; ++j) v[j] = *(const f32x4*)(src + 256 * j + 4 * lane); };
    auto one = [&](const f32x4 (&v)[4], int r) __attribute__((always_inline)) {
        const int b = r / TPB, p = r - b * TPB; const int mc = p < SEQ ? b : 16; const float* mod = MOD_ + (size_t)mc * 6144;
        f32x4 s1[4], s0[4];
#pragma unroll
        for (int j = 0; j < 4; ++j) { s1[j] = *(const f32x4*)(mod + 1024 + 256 * j + 4 * lane); s0[j] = *(const f32x4*)(mod + 256 * j + 4 * lane); }
        const float rstd = rsq(wave_sum(sumsq4(v)) * (1.0f / DM) + EPS);
        unsigned char* orow = (unsigned char*)H_ + (size_t)r * DM;
#pragma unroll
        for (int j = 0; j < 4; ++j) { const f32x4 h = (v[j] * rstd * gm[j] * (s1[j] + 1.0f) + s0[j]) * SC_X; *(unsigned*)(orow + 256 * j + 4 * lane) = pk4f8(h[0], h[1], h[2], h[3]); }
    };
    f32x4 A[4], B[4]; load(A, row);
    for (; row < MROWS; row += 2 * step) {
        if (row + step < MROWS) load(B, row + step);
        one(A, row);
        if (row + step >= MROWS) break;
        if (row + 2 * step < MROWS) load(A, row + 2 * step);
        one(B, row + step);
    }
}

__device__ __forceinline__ float logsigmoid(float x) { return fminf(x, 0.f) - __logf(1.0f + __expf(-fabsf(x))); }
__device__ __forceinline__ void up4(const u32x2 w, float (&f)[4]) { f[0] = __uint_as_float(w.x << 16); f[1] = __uint_as_float(w.x & 0xffff0000u); f[2] = __uint_as_float(w.y << 16); f[3] = __uint_as_float(w.y & 0xffff0000u); }
__device__ __forceinline__ void up4f8(unsigned w, float (&f)[4]) { f[0] = __builtin_amdgcn_cvt_f32_fp8((int)w, 0); f[1] = __builtin_amdgcn_cvt_f32_fp8((int)w, 1); f[2] = __builtin_amdgcn_cvt_f32_fp8((int)w, 2); f[3] = __builtin_amdgcn_cvt_f32_fp8((int)w, 3); }
__device__ __forceinline__ float f8f(unsigned char b) { return __builtin_amdgcn_cvt_f32_fp8((int)b, 0); }
struct DIn { u32x2 naq, nak, nav, cq, ckv, yv; unsigned yq, yk; u32x4 lf0, lf1, lb0, lb1; bf16 kr0, kr1; unsigned char yq0, yq1; };
__device__ __forceinline__ void pD_load(Frame& F, DIn& d, int row, int lane) {
    const int c4 = 4 * lane, hh = lane >> 4, jj = lane & 15, ra = jj >> 3, j8 = jj & 7, ri = 64 + ra * 16 + j8;
    const bf16* z = Z_ + (size_t)row * ZC; const unsigned char* y = (const unsigned char*)Y_ + (size_t)row * YC; const u32x2 zero2 = {0u, 0u};
    d.naq = *(const u32x2*)(z + Z_NAQ + c4); d.nak = *(const u32x2*)(z + Z_NAK + c4); d.nav = *(const u32x2*)(z + Z_NAV + c4); d.cq = *(const u32x2*)(z + Z_CQ + c4);
    d.ckv = lane < 32 ? *(const u32x2*)(z + Z_CKV + c4) : zero2;
    d.lf0 = *(const u32x4*)(z + Z_LF); d.lf1 = *(const u32x4*)(z + Z_LF + 8); d.lb0 = *(const u32x4*)(z + Z_LB); d.lb1 = *(const u32x4*)(z + Z_LB + 8);
    d.kr0 = z[Z_KR + ra * 16 + j8]; d.kr1 = z[Z_KR + ra * 16 + j8 + 8];
    d.yq = *(const unsigned*)(y + hh * 96 + 4 * jj); d.yq0 = y[hh * 96 + ri]; d.yq1 = y[hh * 96 + ri + 8];
    d.yk = *(const unsigned*)(y + 384 + hh * 192 + 4 * jj); d.yv = *(const u32x2*)(y + 384 + hh * 192 + 64 + 8 * jj);
}
__device__ __forceinline__ int pD_row(const Frame& F, int g) { const int tile = min(F.blk + (g >> 2) * F.G, MROWS / 32 - 1); return tile * 32 + F.wave + 8 * (g & 3); }
__device__ __forceinline__ void pD_tokens(Frame& F, int l) {
    const int lane = F.lane, c4 = 4 * lane, hh = lane >> 4, jj = lane & 15, ra = jj >> 3, j8 = jj & 7;
    LAS float* wgs = (LAS float*)(F.lds + RING_OFF + 65536);
    for (int i = F.tid; i < 2 * 16 * 128; i += 512) wgs[i] = gla_w_gate_[(size_t)l * 2 * 16 * 128 + i];
    LDS_WAIT(); __syncthreads();
    typedef float f32x2v __attribute__((ext_vector_type(2)));
    const LAS float* wgl = wgs + 2 * lane;
    const float bgf0 = gla_b_gate_[(l * 2 + 0) * 128 + 2 * lane], bgf1 = gla_b_gate_[(l * 2 + 0) * 128 + 2 * lane + 1];
    const float bgb0 = gla_b_gate_[(l * 2 + 1) * 128 + 2 * lane], bgb1 = gla_b_gate_[(l * 2 + 1) * 128 + 2 * lane + 1];
    const float inv = exp2f(-(float)j8 * 1.6609640474436813f);
    const float* qn_g = na_q_norm_ + l * 64 + (c4 & 63); const float* kn_g = na_k_norm_ + l * 64 + (c4 & 63);
    const float* mq_g = mla_q_norm_ + l * 96; const float* mk_g = mla_k_norm_ + l * 96;
    const int ri = 64 + ra * 16 + j8;
    const float qg0 = qn_g[0], qg1 = qn_g[1], qg2 = qn_g[2], qg3 = qn_g[3], kg0 = kn_g[0], kg1 = kn_g[1], kg2 = kn_g[2], kg3 = kn_g[3];
    const float mqn0 = mq_g[4 * jj], mqn1 = mq_g[4 * jj + 1], mqn2 = mq_g[4 * jj + 2], mqn3 = mq_g[4 * jj + 3], mqr0 = mq_g[ri], mqr1 = mq_g[ri + 8];
    const float mkn0 = mk_g[4 * jj], mkn1 = mk_g[4 * jj + 1], mkn2 = mk_g[4 * jj + 2], mkn3 = mk_g[4 * jj + 3], mkr0 = mk_g[ri], mkr1 = mk_g[ri + 8];
    LAS unsigned char* vt = F.lds + RING_OFF;
    const int ntok = 4 * ((MROWS / 32 - F.blk + F.G - 1) / F.G);
    auto one = [&](const DIn& cur, const int g) __attribute__((always_inline)) {
        {
            const int tile = F.blk + (g >> 2) * F.G, it = g & 3, b = tile / 72, p0 = (tile - b * 72) * 32;
            const int tl = F.wave + 8 * it, row = tile * 32 + tl, p = p0 + tl; const bool lat = p < SEQ;
            float f[4];
            { up4(cur.naq, f); const float r = rsq(g16_sum(f[0] * f[0] + f[1] * f[1] + f[2] * f[2] + f[3] * f[3]) * (1.0f / 64) + EPS) * QS_NA;
              st4bf(NAQ_ + (size_t)row * 256 + c4, f[0] * r * qg0, f[1] * r * qg1, f[2] * r * qg2, f[3] * r * qg3); }
            { up4(cur.nak, f); const float r = rsq(g16_sum(f[0] * f[0] + f[1] * f[1] + f[2] * f[2] + f[3] * f[3]) * (1.0f / 64) + EPS);
              st4bf(NAK_ + (size_t)row * 256 + c4, f[0] * r * kg0, f[1] * r * kg1, f[2] * r * kg2, f[3] * r * kg3); }
            *(LAS u32x2*)(vt + tl * VT_PITCH + c4 * 2) = cur.nav;
            up4(cur.cq, f); const float rq = rsq(wave_sum(f[0] * f[0] + f[1] * f[1] + f[2] * f[2] + f[3] * f[3]) * (1.0f / 256) + EPS);
            up4(cur.ckv, f); const float rkv = rsq(wave_sum(f[0] * f[0] + f[1] * f[1] + f[2] * f[2] + f[3] * f[3]) * (1.0f / 128) + EPS);
            const float ang = lat ? (float)(ra == 0 ? (p >> 6) : (p & 63)) * inv : 0.f;
            const float cs = __cosf(ang), sn = __sinf(ang);
            const float rqy = rq * (1.0f / SC_YC), rkvy = rkv * (1.0f / SC_YC);
            { up4f8(cur.yq, f); float a0 = f8f(cur.yq0) * rqy, a1 = f8f(cur.yq1) * rqy;
#pragma unroll
              for (int i = 0; i < 4; ++i) f[i] *= rqy;
              const float r = rsq(g16_sum(f[0] * f[0] + f[1] * f[1] + f[2] * f[2] + f[3] * f[3] + a0 * a0 + a1 * a1) * (1.0f / 96) + EPS);
              a0 *= r * mqr0; a1 *= r * mqr1;
              bf16* o = MQ_ + (size_t)row * 384 + hh * 96;
              st4bf(o + 4 * jj, f[0] * r * mqn0, f[1] * r * mqn1, f[2] * r * mqn2, f[3] * r * mqn3);
              o[ri] = (bf16)f2bf(a0 * cs - a1 * sn); o[ri + 8] = (bf16)f2bf(a1 * cs + a0 * sn); }
            { up4f8(cur.yk, f); float a0 = bf2f(cur.kr0), a1 = bf2f(cur.kr1);
#pragma unroll
              for (int i = 0; i < 4; ++i) f[i] *= rkvy;
              const float r = rsq(g16_sum(f[0] * f[0] + f[1] * f[1] + f[2] * f[2] + f[3] * f[3] + a0 * a0 + a1 * a1) * (1.0f / 96) + EPS);
              a0 *= r * mkr0; a1 *= r * mkr1;
              bf16* o = MK_ + (size_t)row * 384 + hh * 96;
              st4bf(o + 4 * jj, f[0] * r * mkn0, f[1] * r * mkn1, f[2] * r * mkn2, f[3] * r * mkn3);
              o[ri] = (bf16)f2bf(a0 * cs - a1 * sn); o[ri + 8] = (bf16)f2bf(a1 * cs + a0 * sn); }
            { float g[4]; up4f8(cur.yv.x, f); up4f8(cur.yv.y, g);
              u32x4 w; w.x = pk2(f[0] * rkvy, f[1] * rkvy); w.y = pk2(f[2] * rkvy, f[3] * rkvy); w.z = pk2(g[0] * rkvy, g[1] * rkvy); w.w = pk2(g[2] * rkvy, g[3] * rkvy);
              *(u32x4*)(MV_ + (size_t)row * 512 + hh * 128 + 8 * jj) = w; }
            { float xf0 = bgf0, xf1 = bgf1, xb0 = bgb0, xb1 = bgb1;
              const unsigned lfw[8] = {cur.lf0.x, cur.lf0.y, cur.lf0.z, cur.lf0.w, cur.lf1.x, cur.lf1.y, cur.lf1.z, cur.lf1.w};
              const unsigned lbw[8] = {cur.lb0.x, cur.lb0.y, cur.lb0.z, cur.lb0.w, cur.lb1.x, cur.lb1.y, cur.lb1.z, cur.lb1.w};
#pragma unroll
              for (int k2 = 0; k2 < 8; ++k2) { const float a0 = __uint_as_float(lfw[k2] << 16), a1 = __uint_as_float(lfw[k2] & 0xffff0000u), b0 = __uint_as_float(lbw[k2] << 16), b1 = __uint_as_float(lbw[k2] & 0xffff0000u);
                  const f32x2v wf0 = *(const LAS f32x2v*)(wgl + (2 * k2) * 128), wf1 = *(const LAS f32x2v*)(wgl + (2 * k2 + 1) * 128), wb0 = *(const LAS f32x2v*)(wgl + (16 + 2 * k2) * 128), wb1 = *(const LAS f32x2v*)(wgl + (17 + 2 * k2) * 128);
                  xf0 += a0 * wf0.x + a1 * wf1.x; xf1 += a0 * wf0.y + a1 * wf1.y; xb0 += b0 * wb0.x + b1 * wb1.x; xb1 += b0 * wb0.y + b1 * wb1.y; }
              *(unsigned*)(EGF_ + (size_t)row * 128 + 2 * lane) = pk2(logsigmoid(xf0) * (1.0f / 16), logsigmoid(xf1) * (1.0f / 16));
              *(unsigned*)(EGB_ + (size_t)row * 128 + 2 * lane) = pk2(logsigmoid(xb0) * (1.0f / 16), logsigmoid(xb1) * (1.0f / 16)); }
        }
        if ((g & 3) == 3) {
            const int tile = F.blk + (g >> 2) * F.G, b = tile / 72, p0 = (tile - b * 72) * 32;
            LDS_WAIT(); __syncthreads();
            for (int cI = 0; cI < 16; ++cI) { const int cc = F.wave * 32 + 2 * cI + (lane >> 5), tk = lane & 31; const bf16 val = *(const LAS bf16*)(vt + tk * VT_PITCH + cc * 2);
                NAVT_[((size_t)(b * 4 + (cc >> 6)) * 64 + (cc & 63)) * TPB + p0 + tk] = val; }
            LDS_WAIT(); __syncthreads();
        }
    };
    DIn b0, b1, b2;
    pD_load(F, b0, pD_row(F, 0), lane); pD_load(F, b1, pD_row(F, 1), lane);
    for (int g = 0; g < ntok; g += 3) {
        pD_load(F, b2, pD_row(F, g + 2), lane); one(b0, g);
        if (g + 1 < ntok) { pD_load(F, b0, pD_row(F, g + 3), lane); one(b1, g + 1); }
        if (g + 2 < ntok) { pD_load(F, b1, pD_row(F, g + 4), lane); one(b2, g + 2); }
    }
}

template <int DV> struct AttnSt { f32x4 o[DV / 16]; float m, l; };
#define MFMA16(a, b, c) __builtin_amdgcn_mfma_f32_16x16x32_bf16((a), (b), (c), 0, 0, 0)
template <int DQK, int DV> struct KvFrag { bf16x8 k0[DQK / 32], k1[DQK / 32]; u32x2 vlo[DV / 16], vhi[DV / 16]; };
template <int DQK, int DV, bool NA, bool FIXM, class RP = const float*>
__device__ __forceinline__ void attn_math32(AttnSt<DV>& st, const bf16x8 (&qf)[DQK / 32], const KvFrag<DQK, DV>& f, int q, RP rpbrow, int kcol0, int qc, int cs) {
    const float c0 = FIXM ? -st.m : 0.f;
    f32x4 s0 = (f32x4){c0, c0, c0, c0}, s1 = s0;
#pragma unroll
    for (int s = 0; s < DQK / 32; ++s) { s0 = MFMA16(f.k0[s], qf[s], s0); s1 = MFMA16(f.k1[s], qf[s], s1); }
    if constexpr (NA) {
        float bs[8];
#pragma unroll
        for (int i = 0; i < 4; ++i) { bs[i] = rpbrow[kcol0 + 4 * q - qc + 15 + i]; bs[4 + i] = rpbrow[kcol0 + 4 * q - qc + 31 + i]; }
#pragma unroll
        for (int i = 0; i < 4; ++i) {
            const int k0 = kcol0 + 4 * q + i, k1 = k0 + 16;
            const float t0 = s0[i] + bs[i], t1 = s1[i] + bs[4 + i];
            s0[i] = (k0 >= cs && k0 < cs + 16) ? t0 : -INFINITY;
            s1[i] = (k1 >= cs && k1 < cs + 16) ? t1 : -INFINITY;
        }
    }
    float p0[4], p1[4], ps = 0.f, al = 1.f;
    if constexpr (FIXM) {
#pragma unroll
        for (int i = 0; i < 4; ++i) { p0[i] = __builtin_amdgcn_exp2f(s0[i]); p1[i] = __builtin_amdgcn_exp2f(s1[i]); ps += p0[i] + p1[i]; }
        st.l += ps;
    } else {
        float mx = fmaxf(fmaxf(fmaxf(s0[0], s0[1]), fmaxf(s0[2], s0[3])), fmaxf(fmaxf(s1[0], s1[1]), fmaxf(s1[2], s1[3])));
        mx = q4_max(mx);
        const float mn = fmaxf(st.m, mx); al = __builtin_amdgcn_exp2f(st.m - mn); st.m = mn;
#pragma unroll
        for (int i = 0; i < 4; ++i) { p0[i] = __builtin_amdgcn_exp2f(s0[i] - mn); p1[i] = __builtin_amdgcn_exp2f(s1[i] - mn); ps += p0[i] + p1[i]; }
        st.l = st.l * al + ps;
    }
    u32x4 pw; pw.x = pg8::cvt_pk_bf16(p0[0], p0[1]); pw.y = pg8::cvt_pk_bf16(p0[2], p0[3]); pw.z = pg8::cvt_pk_bf16(p1[0], p1[1]); pw.w = pg8::cvt_pk_bf16(p1[2], p1[3]);
    const bf16x8 pf = __builtin_bit_cast(bf16x8, pw);
#pragma unroll
    for (int n = 0; n < DV / 16; ++n) {
        u32x4 aw; aw.x = f.vlo[n].x; aw.y = f.vlo[n].y; aw.z = f.vhi[n].x; aw.w = f.vhi[n].y;
        if constexpr (FIXM) st.o[n] = MFMA16(__builtin_bit_cast(bf16x8, aw), pf, st.o[n]); else st.o[n] = MFMA16(__builtin_bit_cast(bf16x8, aw), pf, st.o[n] * al);
    }
}
template <int DV> __device__ __forceinline__ void attn_init(AttnSt<DV>& st, float mfix  ) { st.m = mfix; st.l = 0.f;
#pragma unroll
    for (int n = 0; n < DV / 16; ++n) st.o[n] = (f32x4){0.f, 0.f, 0.f, 0.f}; }
template <int DV> __device__ __forceinline__ void attn_store(AttnSt<DV>& st, bf16* orow  , int q) {
    const float il = __builtin_amdgcn_rcpf(q4_sum(st.l));
#pragma unroll
    for (int n = 0; n < DV / 16; ++n) st4bf(orow + 16 * n + 4 * q, st.o[n][0] * il, st.o[n][1] * il, st.o[n][2] * il, st.o[n][3] * il);
}
constexpr int NA_TILE = 2 * 9216;
__device__ __forceinline__ void na_tile_load(Frame& F, u32x4 (&st)[2], int b, int h, int key0) {
    const int kr = F.tid >> 3, kc = (F.tid & 7) * 8;
    st[0] = *(const u32x4*)(NAK_ + ((size_t)b * TPB + key0 + kr) * 256 + h * 64 + kc);
    st[1] = *(const u32x4*)(NAVT_ + ((size_t)(b * 4 + h) * 64 + kr) * TPB + key0 + kc);
}
__device__ __forceinline__ void na_tile_write(Frame& F, const u32x4 (&st)[2], int buf) {
    const int kr = F.tid >> 3, kc = (F.tid & 7) * 8; LAS unsigned char* tb = F.lds + RING_OFF + buf * NA_TILE;
    *(LAS u32x4*)(tb + kr * 144 + kc * 2) = st[0]; *(LAS u32x4*)(tb + 9216 + kr * 144 + kc * 2) = st[1];
}
__device__ __forceinline__ void na_frag_lds(KvFrag<64, 64>& f, const LAS unsigned char* tb, int kl  , int r, int q) {
#pragma unroll
    for (int s = 0; s < 2; ++s) { f.k0[s] = *(const LAS bf16x8*)(tb + (kl + r) * 144 + 64 * s + 16 * q); f.k1[s] = *(const LAS bf16x8*)(tb + (kl + 16 + r) * 144 + 64 * s + 16 * q); }
#pragma unroll
    for (int n = 0; n < 4; ++n) { const LAS unsigned char* vr = tb + 9216 + (16 * n + r) * 144 + (kl + 4 * q) * 2; f.vlo[n] = *(const LAS u32x2*)vr; f.vhi[n] = *(const LAS u32x2*)(vr + 32); }
}
template <bool FIXM> __device__ __forceinline__ void na_block_unit(Frame& F, int l, int u, float mfix) {
    const int lane = F.lane, r = lane & 15, q = lane >> 4, rp = u & 7, h = (u >> 3) & 3, b = u >> 5;
    const int g0 = 4 * rp + 2 * (F.wave >> 2), cb = F.wave & 3;
    const size_t qrow = (size_t)b * TPB + g0 * 64 + cb * 16 + r;
    bf16x8 qa[2], qb[2];
#pragma unroll
    for (int s = 0; s < 2; ++s) { qa[s] = *(const bf16x8*)(NAQ_ + qrow * 256 + h * 64 + 32 * s + 8 * q); qb[s] = *(const bf16x8*)(NAQ_ + (qrow + 64) * 256 + h * 64 + 32 * s + 8 * q); }
    AttnSt<64> sa, sb2; attn_init(sa, FIXM ? mfix : -INFINITY); attn_init(sb2, FIXM ? mfix : -INFINITY);
    const int rsA = min(max(g0 - 4, 0), 24), rsB = min(max(g0 - 3, 0), 24), kb = min(max(cb * 16 - 8, 0), 32), qc = cb * 16 + r, cs = min(max(qc - 8, 0), 48);
    const int rs_lo = min(max(4 * rp - 4, 0), 24), rs_hi = min(max(4 * rp - 1, 0), 24), nloc = rs_hi + 8 - rs_lo, nst = nloc + 4;
    LAS float* rpbs = (LAS float*)(F.lds + RING_OFF + 2 * NA_TILE);
    for (int i = F.tid; i < 15 * 31; i += 512) rpbs[i] = na_rpb_[(size_t)(l * 4 + h) * 15 * 31 + i] * LOG2E;
    const LAS float* rpbA = rpbs + (7 - g0) * 31;
    u32x4 stg[2], stg1[2], stg2[2];
#define NA_KEY0(jj) ((jj) < nloc ? (rs_lo + (jj)) * 64 : SEQ + 64 * ((jj) - nloc))
    na_tile_load(F, stg, b, h, NA_KEY0(0)); na_tile_load(F, stg1, b, h, NA_KEY0(1)); na_tile_load(F, stg2, b, h, NA_KEY0(2));
    for (int j = 0; j < nst; ++j) {
        na_tile_write(F, stg, j & 1);
        LDS_WAIT(); __syncthreads();
        stg[0] = stg1[0]; stg[1] = stg1[1]; stg1[0] = stg2[0]; stg1[1] = stg2[1];
        if (j + 3 < nst) na_tile_load(F, stg2, b, h, NA_KEY0(j + 3));
        const LAS unsigned char* tb = F.lds + RING_OFF + (j & 1) * NA_TILE;
        KvFrag<64, 64> f;
        if (j < nloc) { const int kr = rs_lo + j; const bool inA = kr >= rsA && kr < rsA + 8, inB = kr >= rsB && kr < rsB + 8;
            if (inA || inB) { na_frag_lds(f, tb, kb, r, q);
                if (inA) attn_math32<64, 64, true, FIXM, const LAS float*>(sa, qa, f, q, rpbA + kr * 31, kb, qc, cs);
                if (inB) attn_math32<64, 64, true, FIXM, const LAS float*>(sb2, qb, f, q, rpbA + (kr - 1) * 31, kb, qc, cs); }
        } else {
            na_frag_lds(f, tb, 0, r, q); attn_math32<64, 64, false, FIXM>(sa, qa, f, q, nullptr, 0, 0, 0); attn_math32<64, 64, false, FIXM>(sb2, qb, f, q, nullptr, 0, 0, 0);
            na_frag_lds(f, tb, 32, r, q); attn_math32<64, 64, false, FIXM>(sa, qa, f, q, nullptr, 0, 0, 0); attn_math32<64, 64, false, FIXM>(sb2, qb, f, q, nullptr, 0, 0, 0);
        }
    }
    attn_store(sa, ATT_ + qrow * DM + h * 64, q); attn_store(sb2, ATT_ + (qrow + 64) * DM + h * 64, q);
    LDS_WAIT(); __syncthreads();
#undef NA_KEY0
}
template <bool FIXM> __device__ __forceinline__ void ctx_block_unit(Frame& F, int u, float mfix) {
    const int lane = F.lane, r = lane & 15, q = lane >> 4, h = u & 3, b = u >> 2;
    const size_t qrow0 = (size_t)b * TPB + SEQ + 32 * F.wave + r;
    bf16x8 qa[2], qb[2];
#pragma unroll
    for (int s = 0; s < 2; ++s) { qa[s] = *(const bf16x8*)(NAQ_ + qrow0 * 256 + h * 64 + 32 * s + 8 * q); qb[s] = *(const bf16x8*)(NAQ_ + (qrow0 + 16) * 256 + h * 64 + 32 * s + 8 * q); }
    AttnSt<64> sa, sb2; attn_init(sa, FIXM ? mfix : -INFINITY); attn_init(sb2, FIXM ? mfix : -INFINITY);
    u32x4 stg[2], stg1[2], stg2[2];
    na_tile_load(F, stg, b, h, SEQ); na_tile_load(F, stg1, b, h, SEQ + 64); na_tile_load(F, stg2, b, h, SEQ + 128);
    for (int j = 0; j < 4; ++j) {
        na_tile_write(F, stg, j & 1);
        LDS_WAIT(); __syncthreads();
        stg[0] = stg1[0]; stg[1] = stg1[1]; stg1[0] = stg2[0]; stg1[1] = stg2[1];
        if (j == 0) na_tile_load(F, stg2, b, h, SEQ + 192);
        const LAS unsigned char* tb = F.lds + RING_OFF + (j & 1) * NA_TILE;
        KvFrag<64, 64> f;
        na_frag_lds(f, tb, 0, r, q); attn_math32<64, 64, false, FIXM>(sa, qa, f, q, nullptr, 0, 0, 0); attn_math32<64, 64, false, FIXM>(sb2, qb, f, q, nullptr, 0, 0, 0);
        na_frag_lds(f, tb, 32, r, q); attn_math32<64, 64, false, FIXM>(sa, qa, f, q, nullptr, 0, 0, 0); attn_math32<64, 64, false, FIXM>(sb2, qb, f, q, nullptr, 0, 0, 0);
    }
    attn_store(sa, ATT_ + qrow0 * DM + h * 64, q); attn_store(sb2, ATT_ + (qrow0 + 16) * DM + h * 64, q);
    LDS_WAIT(); __syncthreads();
}

struct BgConv { int next; unsigned char* pend; };
constexpr int BG_G1 = NEXP * 32 * 16, BG_G2 = NEXP * 16 * 16, BG_NG = BG_G1 + BG_G2;
constexpr int BG_LDS = 69632;
static_assert(BG_LDS + 8 * 8192 <= MISC_OFF, "background slots");
__device__ __forceinline__ void bg_issue(Frame& F, int l, BgConv& bg, int lane) {
    const int G = F.gw + (bg.next >> 1) * F.ngw, sub = bg.next & 1;
    if (G >= BG_NG) return;
    ++bg.next;
    const float* src; int ld;
    if (G < BG_G1) { const int le = G >> 9, q = G & 511, k0 = (q >> 5) * 64 + sub * 32, nb = q & 31, n0 = nb * 64, pn = n0 >> 8, j = n0 & 255; const int sc = j < 128 ? 128 * pn + j : 1024 + 128 * pn + (j - 128);
        src = w_moe1_ + ((size_t)(l * NEXP + le) * 1024 + k0 + (lane >> 4)) * 2048 + sc + (lane & 15) * 4; ld = 2048;
        bg.pend = (unsigned char*)W1_ + ((size_t)(l * NEXP + le) * 2048 + n0 + lane) * 1024 + k0; }
    else { const int G2 = G - BG_G1, le = G2 >> 8, q = G2 & 255, k0 = (q >> 4) * 64 + sub * 32, nb = q & 15, n0 = nb * 64;
        src = w_moe2_ + ((size_t)(l * NEXP + le) * 1024 + k0 + (lane >> 4)) * 1024 + n0 + (lane & 15) * 4; ld = 1024;
        bg.pend = (unsigned char*)W2_ + ((size_t)(l * NEXP + le) * 1024 + n0 + lane) * 1024 + k0; }
    LAS unsigned char* lb = F.lds + RING_OFF + BG_LDS + F.wave * 8192;
#pragma unroll
    for (int i = 0; i < 8; ++i) __builtin_amdgcn_global_load_lds((const unsigned*)(src + (size_t)(4 * i) * ld), (LAS unsigned*)(lb + i * 1024), 16, 0, 0);
}
__device__ __forceinline__ void bg_finish(Frame& F, BgConv& bg, int lane) {
    if (!bg.pend) return;
    const LAS float* lb = (const LAS float*)(F.lds + RING_OFF + BG_LDS + F.wave * 8192) + lane;
#pragma unroll
    for (int h = 0; h < 2; ++h) { float v[16];
#pragma unroll
        for (int i = 0; i < 16; ++i) v[i] = lb[(16 * h + i) * 64] * SC_W;
        u32x4 o; o.x = pk4f8(v[0], v[1], v[2], v[3]); o.y = pk4f8(v[4], v[5], v[6], v[7]); o.z = pk4f8(v[8], v[9], v[10], v[11]); o.w = pk4f8(v[12], v[13], v[14], v[15]);
        *(u32x4*)(bg.pend + 16 * h) = o; }
    bg.pend = nullptr;
    LDS_WAIT(); __builtin_amdgcn_sched_barrier(0);
}
__device__ __forceinline__ void bg_drain(Frame& F, int l, BgConv& bg) {
    for (;;) { VM_WAIT(); bg_finish(F, bg, F.lane); bg_issue(F, l, bg, F.lane); if (!bg.pend) break; }
}

namespace fa {
constexpr int   D = 128, NW = 8, QBLK = 32, KVBLK = 64;
constexpr float SCALE = 0.10206207261596575f;
constexpr float THR = 8.f;
constexpr int   SDEPTH = 2;
constexpr int   DQK = 96, LDQ = 384, LDKK = 384, LDK = 512, LDO = 1024;
constexpr size_t SHM_V = KVBLK * D * 2, SHM_K = KVBLK * D * 2, SHM_ATTN = 2 * SHM_V + 2 * SHM_K + NW * 64 * 4;
using s16x4  = __attribute__((ext_vector_type(4))) short;
using f32x16 = __attribute__((ext_vector_type(16))) float;
#define KSWZ(row, colB) ((row) * 256 + ((colB) ^ (((row) & 7) << 4)))
#define SBAR() __builtin_amdgcn_sched_barrier(0)
__device__ __forceinline__ int crow(int r, int hi) { return (r & 3) + 8 * (r >> 2) + 4 * hi; }
__device__ __forceinline__ unsigned cvtpk(float lo, float hi) { unsigned r; asm volatile("v_cvt_pk_bf16_f32 %0, %1, %2" : "=v"(r) : "v"(lo), "v"(hi)); return r; }
__device__ __forceinline__ void partialSM(f32x16& p0, f32x16& p1, float& m_reg, float& mn, float& alpha) {
  constexpr float C = SCALE * 1.4426950408889634f;
  float pmax = p0[0]; for (int r = 1; r < 16; ++r) pmax = fmaxf(pmax, p0[r]); for (int r = 0; r < 16; ++r) pmax = fmaxf(pmax, p1[r]);
  { auto rr = __builtin_amdgcn_permlane32_swap(__float_as_uint(pmax), __float_as_uint(pmax), false, false);
    pmax = fmaxf(__uint_as_float(rr[0]), __uint_as_float(rr[1])); }
  if (__builtin_expect(__all(pmax - m_reg <= THR / SCALE), 1)) { mn = m_reg; alpha = 1.f; }
  else { mn = fmaxf(m_reg, pmax); alpha = __builtin_amdgcn_exp2f((m_reg - mn) * C); m_reg = mn; }
  float mnC = -mn * C;
  for (int r = 0; r < 16; ++r) p0[r] = fmaf(p0[r], C, mnC); for (int r = 0; r < 16; ++r) p1[r] = fmaf(p1[r], C, mnC);
  for (int r = 0; r < 16; ++r) p0[r] = __builtin_amdgcn_exp2f(p0[r]);
}
__device__ __forceinline__ void finishSM(f32x16& p0, f32x16& p1, float alpha, float& l_reg, bf16x8& pa0, bf16x8& pa1, bf16x8& pa2, bf16x8& pa3) {
  for (int r = 0; r < 16; ++r) p1[r] = __builtin_amdgcn_exp2f(p1[r]);
  float ps = 0; for (int r = 0; r < 16; ++r) ps += p0[r]; for (int r = 0; r < 16; ++r) ps += p1[r];
  { auto rr = __builtin_amdgcn_permlane32_swap(__float_as_uint(ps), __float_as_uint(ps), false, false);
    ps = __uint_as_float(rr[0]) + __uint_as_float(rr[1]); }
  l_reg = l_reg * alpha + ps;
#define PK4(P, BASE, OUT) do { unsigned a0 = cvtpk(P[BASE + 0], P[BASE + 1]), a1 = cvtpk(P[BASE + 2], P[BASE + 3]);   \
    unsigned b0 = cvtpk(P[BASE + 4], P[BASE + 5]), b1 = cvtpk(P[BASE + 6], P[BASE + 7]);                              \
    auto r0 = __builtin_amdgcn_permlane32_swap(a0, b0, false, false); auto r1 = __builtin_amdgcn_permlane32_swap(a1, b1, false, false); \
    u32x4 w = {r0[0], r1[0], r0[1], r1[1]}; OUT = *reinterpret_cast<bf16x8*>(&w); } while (0)
  PK4(p0, 0, pa0); PK4(p0, 8, pa1); PK4(p1, 0, pa2); PK4(p1, 8, pa3);
#undef PK4
}
__device__ __forceinline__ void qkt(f32x16& p0, f32x16& p1, const bf16* Ks, const bf16x8* qr, int r32, int hi) {
  p0 = f32x16{}; p1 = f32x16{};
  for (int d0 = 0; d0 < DQK / 16; ++d0) { int cb = (d0 * 16 + hi * 8) * 2;
    bf16x8 b0 = *reinterpret_cast<const bf16x8*>((const char*)Ks + KSWZ(r32, cb));
    bf16x8 b1 = *reinterpret_cast<const bf16x8*>((const char*)Ks + KSWZ(32 + r32, cb));
    p0 = __builtin_amdgcn_mfma_f32_32x32x16_bf16(b0, qr[d0], p0, 0, 0, 0);
    p1 = __builtin_amdgcn_mfma_f32_32x32x16_bf16(b1, qr[d0], p1, 0, 0, 0); }
}
__device__ __forceinline__ int v_st(int k, int c) { const int kk = (k & ~0xC) | ((k & 4) << 1) | ((k & 8) >> 1); return ((kk >> 3) * 4 + (c >> 5)) * 512 + ((kk & 7) * 32 + (c & 31)) * 2; }
__device__ __forceinline__ int v_rd_base(int lane) { return ((lane & 3) << 3) | (((lane >> 2) & 3) << 6) | (((lane >> 4) & 1) << 5) | (((lane >> 5) & 1) << 8); }
constexpr int v_rd_off(int d0, int ks, int half) { return d0 * 512 + ks * 4096 + half * 2048; }
template <int OFF> __device__ __forceinline__ s16x4 tr_read(int vb) {
  s16x4 r; asm volatile("ds_read_b64_tr_b16 %0, %1 offset:%2" : "=&v"(r) : "v"(vb), "i"(OFF) : "memory"); return r;
}
template <int D0> __device__ __forceinline__ void pv_one(f32x16& od, int vb, bf16x8 pa0, bf16x8 pa1, bf16x8 pa2, bf16x8 pa3) {
  const s16x4 l0 = tr_read<v_rd_off(D0, 0, 0)>(vb), h0 = tr_read<v_rd_off(D0, 0, 1)>(vb), l1 = tr_read<v_rd_off(D0, 1, 0)>(vb), h1 = tr_read<v_rd_off(D0, 1, 1)>(vb);
  const s16x4 l2 = tr_read<v_rd_off(D0, 2, 0)>(vb), h2 = tr_read<v_rd_off(D0, 2, 1)>(vb), l3 = tr_read<v_rd_off(D0, 3, 0)>(vb), h3 = tr_read<v_rd_off(D0, 3, 1)>(vb);
  asm volatile("s_waitcnt lgkmcnt(0)" ::: "memory"); SBAR();
#define PK(L, H) (bf16x8){L[0], L[1], L[2], L[3], H[0], H[1], H[2], H[3]}
  od = __builtin_amdgcn_mfma_f32_32x32x16_bf16(pa0, PK(l0, h0), od, 0, 0, 0);
  od = __builtin_amdgcn_mfma_f32_32x32x16_bf16(pa1, PK(l1, h1), od, 0, 0, 0);
  od = __builtin_amdgcn_mfma_f32_32x32x16_bf16(pa2, PK(l2, h2), od, 0, 0, 0);
  od = __builtin_amdgcn_mfma_f32_32x32x16_bf16(pa3, PK(l3, h3), od, 0, 0, 0);
#undef PK
}
__device__ __forceinline__ void pv_d0(f32x16* o, int vb, bf16x8 pa0, bf16x8 pa1, bf16x8 pa2, bf16x8 pa3) {
  pv_one<0>(o[0], vb, pa0, pa1, pa2, pa3); pv_one<1>(o[1], vb, pa0, pa1, pa2, pa3); pv_one<2>(o[2], vb, pa0, pa1, pa2, pa3); pv_one<3>(o[3], vb, pa0, pa1, pa2, pa3);
}
__device__ __forceinline__ void attn_dense_body(const bf16* __restrict__ Qb, const bf16* __restrict__ Kh, const bf16* __restrict__ Vh, bf16* __restrict__ Ob, int seq, char* lds, const int tid, Frame& F, const int lyr, BgConv& bg) {
  const int wid = tid >> 6, lane = tid & 63, r32 = lane & 31, hi = lane >> 5;
  bf16* V_lds = (bf16*)lds; bf16* K_lds = (bf16*)(lds + 2 * SHM_V);
  float* ws = (float*)(lds + 2 * SHM_V + 2 * SHM_K) + wid * 64; float* li_l = ws; float* al_l = ws + 32;
  float m_reg = -1e30f, l_reg = 0; f32x16 o[4] = {}; bf16x8 qr[DQK / 16];
  const bf16* Qw = Qb + (long)(wid * QBLK + r32) * LDQ + hi * 8;
#pragma unroll
  for (int d0 = 0; d0 < DQK / 16; ++d0) qr[d0] = *reinterpret_cast<const bf16x8*>(Qw + d0 * 16);
  const int sr = tid >> 4, sc = (tid & 15) * 8, vst0 = v_st(sr, sc), vst1 = v_st(32 + sr, sc);
  const int vb0 = (int)(uintptr_t)V_lds + v_rd_base(lane);
  struct { bf16x8 vs0, vs1, ks0, ks1; } sr_[SDEPTH];
  const unsigned soff = (unsigned)(sr * LDK + sc) * 2u, soffk = (unsigned)(sr * LDKK + (sc < DQK ? sc : 0)) * 2u;
#define SLOAD(i, k0) do { const char* vt_ = (const char*)Vh + (size_t)(k0) * (LDK * 2); const char* kt_ = (const char*)Kh + (size_t)(k0) * (LDKK * 2);   \
    sr_[i].vs0 = *reinterpret_cast<const bf16x8*>(vt_ + soff); sr_[i].vs1 = *reinterpret_cast<const bf16x8*>(vt_ + 32 * LDK * 2 + soff); \
    sr_[i].ks0 = *reinterpret_cast<const bf16x8*>(kt_ + soffk); sr_[i].ks1 = *reinterpret_cast<const bf16x8*>(kt_ + 32 * LDKK * 2 + soffk); } while (0)
#define SWRITE(b, i) do { *(bf16x8*)((char*)V_lds + (b) * SHM_V + vst0) = sr_[i].vs0;          \
    *(bf16x8*)((char*)V_lds + (b) * SHM_V + vst1) = sr_[i].vs1; int kc = sc * 2;               \
    *(bf16x8*)((char*)K_lds + (b) * SHM_K + KSWZ(sr, kc)) = sr_[i].ks0;                       \
    *(bf16x8*)((char*)K_lds + (b) * SHM_K + KSWZ(32 + sr, kc)) = sr_[i].ks1; } while (0)
#define SWAIT() do { if constexpr (SDEPTH == 2) asm volatile("s_waitcnt vmcnt(4)" ::: "memory"); else asm volatile("s_waitcnt vmcnt(0)" ::: "memory"); } while (0)
#define RESC(a) do { if (__any((a) < 1.f)) { if (hi == 0) al_l[r32] = (a); asm volatile("s_waitcnt lgkmcnt(0)" ::: "memory"); \
    for (int d = 0; d < 4; ++d) for (int r = 0; r < 16; ++r) o[d][r] *= al_l[crow(r, hi)]; } } while (0)
  f32x16 pA0, pA1, pB0, pB1; float mnA, mnB, alA, alB; bf16x8 pa0, pa1, pa2, pa3; const int NT = seq / KVBLK;
  constexpr int SE = 0, SO = SDEPTH - 1;
  SLOAD(SE, 0); asm volatile("s_waitcnt vmcnt(0)" ::: "memory"); SWRITE(0, SE); __syncthreads();
  qkt(pA0, pA1, K_lds, qr, r32, hi); partialSM(pA0, pA1, m_reg, mnA, alA);
  SLOAD(SO, KVBLK); if constexpr (SDEPTH == 2) { if (2 < NT) SLOAD(SE, 2 * KVBLK); }
  SWAIT(); SWRITE(1, SO); __syncthreads();
  for (int j = 1; j + 1 < NT; j += 2) {
    bg_finish(F, bg, lane);
    if ((j >> 1) % 3 != 2) bg_issue(F, lyr, bg, lane);
    SBAR(); qkt(pB0, pB1, (bf16*)((char*)K_lds + SHM_K), qr, r32, hi);
    finishSM(pA0, pA1, alA, l_reg, pa0, pa1, pa2, pa3); SBAR();
    SLOAD(SO, (j + SDEPTH) * KVBLK); SBAR();
    pv_d0(o, vb0, pa0, pa1, pa2, pa3); partialSM(pB0, pB1, m_reg, mnB, alB);
    __syncthreads(); SWAIT(); SWRITE(0, SE);
    RESC(alB); __syncthreads();
    SBAR(); qkt(pA0, pA1, K_lds, qr, r32, hi);
    finishSM(pB0, pB1, alB, l_reg, pa0, pa1, pa2, pa3); SBAR();
    if (SDEPTH == 1 || j + 3 < NT) SLOAD(SE, (j + 1 + SDEPTH) * KVBLK); SBAR();
    pv_d0(o, vb0 + (int)SHM_V, pa0, pa1, pa2, pa3); partialSM(pA0, pA1, m_reg, mnA, alA);
    __syncthreads(); SWAIT(); SWRITE(1, SO);
    RESC(alA); __syncthreads();
  }
  SBAR(); qkt(pB0, pB1, (bf16*)((char*)K_lds + SHM_K), qr, r32, hi);
  finishSM(pA0, pA1, alA, l_reg, pa0, pa1, pa2, pa3); SBAR();
  pv_d0(o, vb0, pa0, pa1, pa2, pa3); partialSM(pB0, pB1, m_reg, mnB, alB);
  __syncthreads(); RESC(alB);
  finishSM(pB0, pB1, alB, l_reg, pa0, pa1, pa2, pa3); SBAR();
  pv_d0(o, vb0 + (int)SHM_V, pa0, pa1, pa2, pa3);
  if (hi == 0) li_l[r32] = l_reg; asm volatile("s_waitcnt lgkmcnt(0)" ::: "memory");
  int ln2; asm volatile("v_mbcnt_lo_u32_b32 %0, -1, 0\n\tv_mbcnt_hi_u32_b32 %0, -1, %0" : "=v"(ln2)); ln2 &= 63;
  const int r32e = ln2 & 31, hie = ln2 >> 5;
  float rli[16];
#pragma unroll
  for (int r = 0; r < 16; ++r) rli[r] = __builtin_amdgcn_rcpf(li_l[crow(r, hie)]);
  bf16* Ow = Ob + (long)(wid * QBLK) * LDO;
#pragma unroll
  for (int r = 0; r < 16; ++r) { const unsigned eo = (unsigned)(crow(r, hie) * LDO + r32e);
    for (int d0 = 0; d0 < 4; ++d0) Ow[eo + d0 * 32] = (bf16)(cvtpk(o[d0][r] * rli[r], 0.f) & 0xffffu); }
  if (bg.pend) { asm volatile("s_waitcnt vmcnt(0)" ::: "memory"); bg_finish(F, bg, lane); }
  __syncthreads();
#undef SLOAD
#undef SWRITE
#undef SWAIT
#undef RESC
}
#undef KSWZ
#undef SBAR
}

constexpr int GL_Q = 0, GL_K = 2048, GL_V = 4096, GL_EF = 8192, GL_EB = 10240, GL_OF = 12288, GL_OB = 16384;
__device__ __forceinline__ int gla_dirchunk(int dir, int tc) { return dir == 0 ? tc : (tc < 4 ? 3 - tc : 39 - tc); }
__device__ __forceinline__ void gla_stage_load(Frame& F, u32x4 (&st)[3], int b, int h, int tc) {
    const size_t row0 = (size_t)b * TPB + (tc < 4 ? SEQ + 64 * tc : 64 * (tc - 4));
#pragma unroll
    for (int k = 0; k < 3; ++k) { const int pid = F.tid + 512 * k, r = pid / 24, j = pid - r * 24; const size_t row = row0 + r; const bf16* src;
        if (j < 4)       src = Z_ + row * ZC + Z_GQ + h * 32 + 8 * j;
        else if (j < 8)  src = Z_ + row * ZC + Z_GK + h * 32 + 8 * (j - 4);
        else if (j < 16) src = Z_ + row * ZC + Z_GV + h * 64 + 8 * (j - 8);
        else if (j < 20) src = EGF_ + row * 128 + h * 32 + 8 * (j - 16);
        else             src = EGB_ + row * 128 + h * 32 + 8 * (j - 20);
        st[k] = *(const u32x4*)src; }
}
__device__ __forceinline__ void gla_stage_write(Frame& F, const u32x4 (&st)[3]) {
    LAS float* sm = (LAS float*)(F.lds + RING_OFF);
#pragma unroll
    for (int k = 0; k < 3; ++k) { const int pid = F.tid + 512 * k, r = pid / 24, j = pid - r * 24;
        LAS float* dst = j < 4 ? sm + GL_Q + r * 32 + 8 * j : j < 8 ? sm + GL_K + r * 32 + 8 * (j - 4) : j < 16 ? sm + GL_V + r * 64 + 8 * (j - 8) : j < 20 ? sm + GL_EF + r * 32 + 8 * (j - 16) : sm + GL_EB + r * 32 + 8 * (j - 20);
        const float sc = j < 4 ? 0.17677669529663687f : 1.0f; float f[4], g[4]; u32x2 lo, hi; lo.x = st[k].x; lo.y = st[k].y; hi.x = st[k].z; hi.y = st[k].w; up4(lo, f); up4(hi, g);
        *(LAS f32x4*)dst = (f32x4){f[0], f[1], f[2], f[3]} * sc; *(LAS f32x4*)(dst + 4) = (f32x4){g[0], g[1], g[2], g[3]} * sc; }
}
constexpr int GB_O = 0, GB_QS = 49152, GB_KT = GB_QS + 2 * 5120, GB_QE = GB_KT + 2 * 5120, GB_VT = GB_QE + 2 * 5120, GB_S0 = GB_VT + 2 * 9216, GB_END = GB_S0 + 2 * 5120;
static_assert(GB_END <= MISC_OFF, "GLA LDS map");
template <int N> __device__ __forceinline__ float dpp_shr(float v) { return __int_as_float(__builtin_amdgcn_update_dpp(0, __float_as_int(v), 0x110 + N, 0xF, 0xF, false)); }
__device__ __forceinline__ void gla_compute(Frame& F, int l, int b, int h, int tc, bool outputs) {
    LAS float* sm = (LAS float*)(F.lds + RING_OFF); LAS unsigned char* sb = F.lds + RING_OFF;
    const size_t row0 = (size_t)b * TPB + (tc < 4 ? SEQ + 64 * tc : 64 * (tc - 4));
    const int lane = F.lane, wdir = F.wave >> 2, wsub = F.wave & 3;
    float s0pre[8]; u32x4 gpre = {0u, 0u, 0u, 0u}; f32x4 gnpre0 = {0.f, 0.f, 0.f, 0.f}, gnpre1 = gnpre0;
    if (outputs) { const int dir = F.tid >> 8, e = (F.tid >> 2) & 63, dq = F.tid & 3;
        const float* ps = OGF_ + ((size_t)((b * 4 + h) * 2 + dir) * 36 + gla_dirchunk(dir, tc)) * 2048 + (size_t)(8 * dq) * 64 + e;
#pragma unroll
        for (int i = 0; i < 8; ++i) s0pre[i] = __hip_atomic_load(ps + i * 64, __ATOMIC_RELAXED, __HIP_MEMORY_SCOPE_AGENT);
        gpre = *(const u32x4*)(Z_ + (row0 + (F.tid >> 3)) * ZC + Z_GO + h * 64 + (F.tid & 7) * 8);
        gnpre0 = *(const f32x4*)(gla_o_norm_ + l * 64 + (F.tid & 7) * 8); gnpre1 = *(const f32x4*)(gla_o_norm_ + l * 64 + (F.tid & 7) * 8 + 4); }
    { const int t = wdir ? 63 - lane : lane; LAS float* gp = sm + (wdir ? GL_EB : GL_EF) + t * 32 + 8 * wsub;
#pragma unroll
      for (int i = 0; i < 8; ++i) { float x = gp[i]; x += dpp_shr<1>(x); x += dpp_shr<2>(x); x += dpp_shr<4>(x); x += dpp_shr<8>(x);
          const float t0 = rl_f(x, 15), t1 = rl_f(x, 31), t2 = rl_f(x, 47);
          x += (lane >= 16 ? t0 : 0.f) + (lane >= 32 ? t1 : 0.f) + (lane >= 48 ? t2 : 0.f); gp[i] = x; } }
    LDS_WAIT(); __syncthreads();
    { const int dir = F.tid >> 8, o = (F.tid >> 2) & 63, dq = F.tid & 3, t = dir ? 63 - o : o;
      const LAS float* Bp = sm + (dir ? GL_EB : GL_EF) + 8 * dq; const int tm = dir ? 32 : 31, te = dir ? 0 : 63;
      float Bt[8], Bm[8], Be[8], qv[8], kv[8];
#pragma unroll
      for (int i = 0; i < 8; i += 4) { *(f32x4*)(Bt + i) = *(const LAS f32x4*)(Bp + t * 32 + i); *(f32x4*)(Bm + i) = *(const LAS f32x4*)(Bp + tm * 32 + i); *(f32x4*)(Be + i) = *(const LAS f32x4*)(Bp + te * 32 + i);
          *(f32x4*)(qv + i) = *(const LAS f32x4*)(sm + GL_Q + t * 32 + 8 * dq + i); *(f32x4*)(kv + i) = *(const LAS f32x4*)(sm + GL_K + t * 32 + 8 * dq + i); }
      if (outputs) {
          float qs[8], kt[8], qe[8];
#pragma unroll
          for (int i = 0; i < 8; ++i) { qs[i] = qv[i] * __expf(Bt[i] - Bm[i]); kt[i] = kv[i] * __expf(Bm[i] - Bt[i]); qe[i] = qv[i] * __expf(Bt[i]); }
          u32x4 w; w.x = pk2(qs[0], qs[1]); w.y = pk2(qs[2], qs[3]); w.z = pk2(qs[4], qs[5]); w.w = pk2(qs[6], qs[7]); *(LAS u32x4*)(sb + GB_QS + dir * 5120 + o * 80 + 16 * dq) = w;
          w.x = pk2(kt[0], kt[1]); w.y = pk2(kt[2], kt[3]); w.z = pk2(kt[4], kt[5]); w.w = pk2(kt[6], kt[7]); *(LAS u32x4*)(sb + GB_KT + dir * 5120 + o * 80 + 16 * dq) = w;
          w.x = pk2(qe[0], qe[1]); w.y = pk2(qe[2], qe[3]); w.z = pk2(qe[4], qe[5]); w.w = pk2(qe[6], qe[7]); *(LAS u32x4*)(sb + GB_QE + dir * 5120 + o * 80 + 16 * dq) = w;
      } else {
#pragma unroll
          for (int i = 0; i < 8; ++i) *(LAS bf16*)(sb + GB_KT + dir * 5120 + (8 * dq + i) * 144 + 2 * o) = (bf16)f2bf(kv[i] * __expf(Be[i] - Bt[i]));
          if (o == 63) { const size_t sidx = (size_t)((b * 4 + h) * 2 + dir) * 36 + gla_dirchunk(dir, tc); float* ad = AD_ + sidx * 32 + 8 * dq;
#pragma unroll
              for (int i = 0; i < 8; ++i) ad[i] = __expf(Be[i]); }
      } }
    { const int dir = F.tid >> 8, e = F.tid & 63, og = (F.tid >> 6) & 3;
      float vv[16];
#pragma unroll
      for (int k = 0; k < 16; ++k) { const int o = 16 * og + k, t = dir ? 63 - o : o; vv[k] = sm[GL_V + t * 64 + e]; }
      u32x4 w0, w1; w0.x = pk2(vv[0], vv[1]); w0.y = pk2(vv[2], vv[3]); w0.z = pk2(vv[4], vv[5]); w0.w = pk2(vv[6], vv[7]); w1.x = pk2(vv[8], vv[9]); w1.y = pk2(vv[10], vv[11]); w1.z = pk2(vv[12], vv[13]); w1.w = pk2(vv[14], vv[15]);
      LAS unsigned char* vp = sb + GB_VT + dir * 9216 + e * 144 + 32 * og; *(LAS u32x4*)vp = w0; *(LAS u32x4*)(vp + 16) = w1; }
    if (outputs) {
        const int dir = F.tid >> 8, e = (F.tid >> 2) & 63, dq = F.tid & 3;
        u32x4 w; w.x = pk2(s0pre[0], s0pre[1]); w.y = pk2(s0pre[2], s0pre[3]); w.z = pk2(s0pre[4], s0pre[5]); w.w = pk2(s0pre[6], s0pre[7]); *(LAS u32x4*)(sb + GB_S0 + dir * 5120 + e * 80 + 16 * dq) = w;
    }
    LDS_WAIT(); __syncthreads();
    const int r = lane & 15, q = lane >> 4;
    if (outputs) {
        const int dir = wdir, tt = wsub; const LAS unsigned char* qsb = sb + GB_QS + dir * 5120; const LAS unsigned char* ktb = sb + GB_KT + dir * 5120;
        const LAS unsigned char* vtb = sb + GB_VT + dir * 9216; const LAS unsigned char* s0b = sb + GB_S0 + dir * 5120;
        f32x4 acc[4];
#pragma unroll
        for (int n = 0; n < 4; ++n) acc[n] = (f32x4){0.f, 0.f, 0.f, 0.f};
        const bf16x8 qsf = *(const LAS bf16x8*)(qsb + (16 * tt + r) * 80 + 16 * q);
        const int to = 16 * tt + r;
        for (int sp = 0; sp <= (tt >> 1); ++sp) {
            const bf16x8 k0 = *(const LAS bf16x8*)(ktb + (32 * sp + r) * 80 + 16 * q), k1 = *(const LAS bf16x8*)(ktb + (32 * sp + 16 + r) * 80 + 16 * q);
            f32x4 s0 = MFMA16(k0, qsf, ((f32x4){0.f, 0.f, 0.f, 0.f})), s1 = MFMA16(k1, qsf, ((f32x4){0.f, 0.f, 0.f, 0.f}));
#pragma unroll
            for (int i = 0; i < 4; ++i) { const int so = 32 * sp + 4 * q + i; s0[i] = so <= to ? s0[i] : 0.f; s1[i] = so + 16 <= to ? s1[i] : 0.f; }
            u32x4 pw; pw.x = pk2(s0[0], s0[1]); pw.y = pk2(s0[2], s0[3]); pw.z = pk2(s1[0], s1[1]); pw.w = pk2(s1[2], s1[3]);
            const bf16x8 pf = __builtin_bit_cast(bf16x8, pw);
#pragma unroll
            for (int n = 0; n < 4; ++n) { const LAS unsigned char* vr = vtb + (16 * n + r) * 144 + (32 * sp + 4 * q) * 2; const u32x2 lo = *(const LAS u32x2*)vr, hi = *(const LAS u32x2*)(vr + 32);
                u32x4 aw; aw.x = lo.x; aw.y = lo.y; aw.z = hi.x; aw.w = hi.y; acc[n] = MFMA16(__builtin_bit_cast(bf16x8, aw), pf, acc[n]); }
        }
        const bf16x8 qef = *(const LAS bf16x8*)(sb + GB_QE + dir * 5120 + (16 * tt + r) * 80 + 16 * q);
#pragma unroll
        for (int n = 0; n < 4; ++n) acc[n] = MFMA16(*(const LAS bf16x8*)(s0b + (16 * n + r) * 80 + 16 * q), qef, acc[n]);
        const int t = dir ? 63 - to : to;
#pragma unroll
        for (int n = 0; n < 4; ++n) *(LAS f32x4*)(sb + GB_O + dir * 16384 + (t * 64 + 16 * n + 4 * q) * 4) = acc[n];
        LDS_WAIT(); __syncthreads();
        const int tk = F.tid >> 3, e8 = (F.tid & 7) * 8; const size_t row = row0 + tk; const LAS float* of = (const LAS float*)(sb + GB_O) + tk * 64 + e8;
        const f32x4 f0 = *(const LAS f32x4*)of, f1 = *(const LAS f32x4*)(of + 4), b0 = *(const LAS f32x4*)(of + 4096), b1 = *(const LAS f32x4*)(of + 4100);
        const f32x4 o0 = f0 + b0, o1 = f1 + b1;
        float ss = (o0[0] * o0[0] + o0[1] * o0[1]) + (o0[2] * o0[2] + o0[3] * o0[3]) + (o1[0] * o1[0] + o1[1] * o1[1]) + (o1[2] * o1[2] + o1[3] * o1[3]);
        ss = g8_sum(ss);
        const float rn = rsq(ss * (1.0f / 64) + EPS);
        const float gn[8] = {gnpre0[0], gnpre0[1], gnpre0[2], gnpre0[3], gnpre1[0], gnpre1[1], gnpre1[2], gnpre1[3]}; float g[4], g2[4]; { u32x2 glo, ghi; glo.x = gpre.x; glo.y = gpre.y; ghi.x = gpre.z; ghi.y = gpre.w; up4(glo, g); up4(ghi, g2); }
        float w[8];
#pragma unroll
        for (int i = 0; i < 4; ++i) { w[i] = o0[i] * rn * gn[i] * g[i] * __builtin_amdgcn_rcpf(1.0f + __expf(-g[i])); w[4 + i] = o1[i] * rn * gn[4 + i] * g2[i] * __builtin_amdgcn_rcpf(1.0f + __expf(-g2[i])); }
        u32x4 pw; pw.x = pk2(w[0], w[1]); pw.y = pk2(w[2], w[3]); pw.z = pk2(w[4], w[5]); pw.w = pk2(w[6], w[7]);
        *(u32x4*)(ATT_ + row * DM + 768 + h * 64 + e8) = pw;
    } else {
        const int dir = wdir, et = wsub; const LAS unsigned char* vtb = sb + GB_VT + dir * 9216; const LAS unsigned char* khb = sb + GB_KT + dir * 5120;
        float* cs = CS_ + ((size_t)((b * 4 + h) * 2 + dir) * 36 + gla_dirchunk(dir, tc)) * 2048;
#pragma unroll
        for (int dt = 0; dt < 2; ++dt) { f32x4 acc = (f32x4){0.f, 0.f, 0.f, 0.f};
#pragma unroll
            for (int ks = 0; ks < 2; ++ks) acc = MFMA16(*(const LAS bf16x8*)(vtb + (16 * et + r) * 144 + (32 * ks + 8 * q) * 2), *(const LAS bf16x8*)(khb + (16 * dt + r) * 144 + (32 * ks + 8 * q) * 2), acc);
            *(f32x4*)(cs + (size_t)(16 * dt + r) * 64 + 16 * et + 4 * q) = acc; }
    }
}
__device__ __forceinline__ void gla_pass(Frame& F, int l, bool outputs) {
    const int nch = (outputs && l == DEPTH - 1) ? 32 : 36, c0 = 36 - nch, ntot = BATCH * 4 * nch;
    const int upb = (ntot + F.G - 1) / F.G, u_lo = min(F.blk * upb, ntot), u_hi = min(u_lo + upb, ntot);
    if (outputs) {
        const int lane = F.lane, dir = F.wave >> 2, eblk = F.wave & 3, dq = lane >> 4, e = eblk * 16 + (lane & 15);
        float S[8];
#pragma unroll
        for (int i = 0; i < 8; ++i) S[i] = 0.f;
        int pbh = -1, pc = -2;
        for (int k = 0; k < u_hi - u_lo; ++k) {
            const int u = dir == 0 ? u_lo + k : u_hi - 1 - k, bh = u / nch, tc = c0 + (u - bh * nch), c = gla_dirchunk(dir, tc);
            const size_t sidx = (size_t)(bh * 2 + dir) * 36;
            int j0 = pc;
            if (!(bh == pbh && c == pc + 1)) { j0 = 0;
#pragma unroll
                for (int i = 0; i < 8; ++i) S[i] = 0.f; }
#pragma unroll 4
            for (int j = j0; j < c; ++j) { const float* ad = AD_ + (sidx + j) * 32 + 8 * dq; const float* csp = CS_ + (sidx + j) * 2048 + (size_t)(8 * dq) * 64 + e;
                const f32x4 a0 = *(const f32x4*)ad, a1 = *(const f32x4*)(ad + 4);
#pragma unroll
                for (int i = 0; i < 4; ++i) { S[i] = a0[i] * S[i] + csp[i * 64]; S[4 + i] = a1[i] * S[4 + i] + csp[(4 + i) * 64]; } }
            float* ps = OGF_ + (sidx + c) * 2048 + (size_t)(8 * dq) * 64 + e;
#pragma unroll
            for (int i = 0; i < 8; ++i) __hip_atomic_store(ps + i * 64, S[i], __ATOMIC_RELAXED, __HIP_MEMORY_SCOPE_AGENT);
            pbh = bh; pc = c;
        }
        VM_WAIT();
    }
    u32x4 st[3];
    if (u_lo < u_hi) { const int bh = u_lo / nch; gla_stage_load(F, st, bh >> 2, bh & 3, c0 + (u_lo - bh * nch)); }
    for (int u = u_lo; u < u_hi; ++u) {
        const int bh = u / nch, tc = c0 + (u - bh * nch);
        gla_stage_write(F, st);
        LDS_WAIT(); __syncthreads();
        if (u + 1 < u_hi) { const int bh2 = (u + 1) / nch; gla_stage_load(F, st, bh2 >> 2, bh2 & 3, c0 + (u + 1 - bh2 * nch)); }
        gla_compute(F, l, bh >> 2, bh & 3, tc, outputs);
        LDS_WAIT(); __syncthreads();
    }
}
__device__ __forceinline__ void pE1(Frame& F, int l) {
    for (int rp = 0; rp < NREP(14); ++rp) gla_pass(F, l, false);
    relane(F);
    float gq = fabsf(na_q_norm_[l * 64 + F.lane]), gk = fabsf(na_k_norm_[l * 64 + F.lane]), rb = 0.f;
#pragma unroll
    for (int k = 0; k < 8; ++k) { const int i4 = F.lane + 64 * k;
        if (i4 < 465) { const f32x4 v = *(const f32x4*)(na_rpb_ + (size_t)l * 4 * 15 * 31 + 4 * i4); rb = fmaxf(rb, fmaxf(fmaxf(fabsf(v[0]), fabsf(v[1])), fmaxf(fabsf(v[2]), fabsf(v[3])))); } }
    gq = wave_max(gq); gk = wave_max(gk); rb = wave_max(rb);
    const float mfix = (QS_NA * 64.0f * gq * gk + rb * LOG2E) * 1.01f + 0.125f;
    if (mfix <= 60.0f) {
        for (int rp = 0; rp < NREP(15); ++rp)
        for (int u = F.blk; u < BATCH * 4 * 8; u += F.G) na_block_unit<true>(F, l, u, mfix);
        if (l == 0) for (int u = F.G - 1 - F.blk; u < BATCH * 4; u += F.G) ctx_block_unit<false>(F, u, mfix);
    } else {
        for (int u = F.blk; u < BATCH * 4 * 8; u += F.G) na_block_unit<false>(F, l, u, 0.f);
        if (l == 0) for (int u = F.G - 1 - F.blk; u < BATCH * 4; u += F.G) ctx_block_unit<false>(F, u, 0.f);
    }
}
__device__ __forceinline__ void pE2(Frame& F, int l) {
    const int nlat = BATCH * 4 * 8, nall = nlat + (l == 0 ? BATCH * 4 : 0);
    for (int rp = 0; rp < NREP(16); ++rp) { BgConv bg{0, nullptr};
    for (int u = F.blk; u < nall; u += F.G) {
        int b, h, qp, klo, seq;
        if (u < nlat) { const int qb = u & 7, bh = u >> 3; b = bh >> 2; h = bh & 3; qp = 256 * qb; klo = 0; seq = TPB; }
        else { const int bh = u - nlat; b = bh >> 2; h = bh & 3; qp = SEQ; klo = SEQ; seq = CTXL; }
        const size_t qrow = (size_t)b * TPB + qp, krow = (size_t)b * TPB + klo;
        fa::attn_dense_body(MQ_ + qrow * 384 + h * 96, MK_ + krow * 384 + h * 96, MV_ + krow * 512 + h * 128, ATT_ + qrow * DM + 256 + h * 128, seq, (char*)(F.lds + RING_OFF), F.tid, F, l, bg);
    }
    bg_drain(F, l, bg); }
    relane(F);
    for (int rp = 0; rp < NREP(17); ++rp) gla_pass(F, l, true);
}

__device__ __forceinline__ int moe_rpb(const Frame& F) { return (((MROWS + F.G - 1) / F.G) + 15) & ~15; }
constexpr int G1_TP = 1028;
__device__ __forceinline__ void pG1(Frame& F, int l) {
    LAS float* T = (LAS float*)(F.lds + RING_OFF);
    LAS float* P = T + 16 * G1_TP;
    volatile LAS unsigned* wh = F.MISC + MW_WH + F.wave * 32;
    if (F.lane < 32) wh[F.lane] = 0u;
    const int lane = F.lane, c = lane & 15, q = lane >> 4, rpb = moe_rpb(F), row_lo = F.blk * rpb;
    float bw[32][2];
#pragma unroll
    for (int s = 0; s < 32; ++s) { const float* wp = w_router_ + ((size_t)l * 1024 + 128 * F.wave + 32 * q + s) * NEXP + c; bw[s][0] = wp[0]; bw[s][1] = wp[16]; }
    const float brl = b_router_[l * NEXP + (lane & 31)];
    const float* gf = g_ffn_ + l * DM;
    int mcC = -1; f32x4 gsC[4], shC[4];
    u32x2 n0[4], n1[4];
    { const size_t rr = (size_t)min(row_lo + 2 * F.wave, MROWS - 2);
#pragma unroll
      for (int j = 0; j < 4; ++j) { n0[j] = *(const u32x2*)(XU_ + rr * DM + 256 * j + 4 * lane); n1[j] = *(const u32x2*)(XU_ + (rr + 1) * DM + 256 * j + 4 * lane); } }
    for (int r0 = row_lo; r0 < row_lo + rpb && r0 < MROWS; r0 += 16) {
        const int b = r0 / TPB, p0 = r0 - b * TPB;
        const int mc = p0 < SEQ ? b : 16, row = r0 + 2 * F.wave;
        f32x4 h0[4], h1[4];
#pragma unroll
        for (int j = 0; j < 4; ++j) { h0[j] = bf4f(n0[j]); h1[j] = bf4f(n1[j]); }
        { const size_t rr = (size_t)min(row + 16, MROWS - 2);
#pragma unroll
          for (int j = 0; j < 4; ++j) { n0[j] = *(const u32x2*)(XU_ + rr * DM + 256 * j + 4 * lane); n1[j] = *(const u32x2*)(XU_ + (rr + 1) * DM + 256 * j + 4 * lane); } }
        if (l == DEPTH - 1 && p0 >= SEQ) continue;
        const float rs0 = rsq(wave_sum(sumsq4(h0)) * (1.0f / DM) + EPS), rs1 = rsq(wave_sum(sumsq4(h1)) * (1.0f / DM) + EPS);
        if (mc != mcC) { const float* mod = MOD_ + ((size_t)l * 17 + mc) * 6144; mcC = mc;
#pragma unroll
            for (int j = 0; j < 4; ++j) { const int col = 256 * j + 4 * lane; gsC[j] = *(const f32x4*)(gf + col) * (*(const f32x4*)(mod + 4 * 1024 + col) + 1.0f); shC[j] = *(const f32x4*)(mod + 3 * 1024 + col); } }
#pragma unroll
        for (int j = 0; j < 4; ++j) { const int col = 256 * j + 4 * lane; const f32x4 gs = gsC[j], sh = shC[j];
            h0[j] = h0[j] * rs0 * gs + sh; h1[j] = h1[j] * rs1 * gs + sh;
            *(unsigned*)((unsigned char*)H_ + (size_t)row * DM + col) = pk4f8(h0[j][0] * SC_X, h0[j][1] * SC_X, h0[j][2] * SC_X, h0[j][3] * SC_X);
            *(unsigned*)((unsigned char*)H_ + (size_t)(row + 1) * DM + col) = pk4f8(h1[j][0] * SC_X, h1[j][1] * SC_X, h1[j][2] * SC_X, h1[j][3] * SC_X);
            *(LAS f32x4*)(T + (2 * F.wave) * G1_TP + col) = h0[j]; *(LAS f32x4*)(T + (2 * F.wave + 1) * G1_TP + col) = h1[j]; }
        LDS_WAIT(); __syncthreads();
        f32x4 a0 = (f32x4){0.f, 0.f, 0.f, 0.f}, a1 = a0;
        { const LAS float* tp = T + c * G1_TP + 128 * F.wave + 32 * q;
#pragma unroll
          for (int s4 = 0; s4 < 8; ++s4) { const f32x4 av = *(const LAS f32x4*)(tp + 4 * s4);
#pragma unroll
              for (int i = 0; i < 4; ++i) { a0 = __builtin_amdgcn_mfma_f32_16x16x4f32(av[i], bw[4 * s4 + i][0], a0, 0, 0, 0); a1 = __builtin_amdgcn_mfma_f32_16x16x4f32(av[i], bw[4 * s4 + i][1], a1, 0, 0, 0); } } }
#pragma unroll
        for (int i = 0; i < 4; ++i) { P[(F.wave * 16 + 4 * q + i) * 32 + c] = a0[i]; P[(F.wave * 16 + 4 * q + i) * 32 + 16 + c] = a1[i]; }
        LDS_WAIT(); __syncthreads();
        { const int rr = 2 * F.wave + (lane >> 5), e = lane & 31; float lg = brl;
#pragma unroll
          for (int w = 0; w < 8; ++w) lg += P[(w * 16 + rr) * 32 + e];
          float tv[4]; int ti[4];
#pragma unroll
          for (int k = 0; k < 4; ++k) { float m = lg; m = fmaxf(m, dpp_f<0xB1>(m)); m = fmaxf(m, dpp_f<0x4E>(m)); m = fmaxf(m, dpp_f<0x141>(m)); m = fmaxf(m, dpp_f<0x140>(m)); m = fmaxf(m, swz_xor<16>(m));
              const unsigned long long bal = __builtin_amdgcn_ballot_w64(lg == m); const unsigned half = (lane >> 5) ? (unsigned)(bal >> 32) : (unsigned)bal;
              const int bi = __builtin_ctz(half);
              tv[k] = m; ti[k] = bi; lg = (e == bi) ? -INFINITY : lg; }
          const float e1 = __expf(tv[1] - tv[0]), e2 = __expf(tv[2] - tv[0]), e3 = __expf(tv[3] - tv[0]); const float isum = 1.0f / (1.0f + e1 + e2 + e3);
          if (e < 4) { const int ek = e == 0 ? ti[0] : e == 1 ? ti[1] : e == 2 ? ti[2] : ti[3]; const float gg = (e == 0 ? 1.0f : e == 1 ? e1 : e == 2 ? e2 : e3) * isum;
              unsigned rank = 0;
              if (lane < 32) rank = __hip_atomic_fetch_add((LAS unsigned*)(F.MISC + MW_WH + F.wave * 32 + ek), 1u, __ATOMIC_RELAXED, __HIP_MEMORY_SCOPE_WORKGROUP);
              __builtin_amdgcn_s_waitcnt(0xc07f);
              if (lane >= 32) rank = __hip_atomic_fetch_add((LAS unsigned*)(F.MISC + MW_WH + F.wave * 32 + ek), 1u, __ATOMIC_RELAXED, __HIP_MEMORY_SCOPE_WORKGROUP);
              TOPE_[(size_t)(r0 + rr) * 4 + e] = ek | (int)(rank << 8); TOPG_[(size_t)(r0 + rr) * 4 + e] = gg; } }
        LDS_WAIT(); __syncthreads();
    }
    LDS_WAIT(); __syncthreads();
    if (F.lane < 32) WHIST_[(size_t)F.gw * 32 + F.lane] = (int)wh[F.lane];
    if (F.tid < 32) { unsigned s = 0;
#pragma nounroll
        for (int w = 0; w < 8; ++w) s += F.MISC[MW_WH + w * 32 + F.tid];
        HISTB_[F.blk * 32 + F.tid] = (int)s; }
    __syncthreads();
}
__device__ __forceinline__ void moe_tables(Frame& F) {
    const int e = F.tid & 31, part = F.tid >> 5; unsigned s = 0, sb = 0;
#pragma unroll 8
    for (int bq = part; bq < F.G; bq += 16) { const unsigned hv = (unsigned)HISTB_[bq * 32 + e]; s += hv; sb += bq < F.blk ? hv : 0u; }
    F.MISC[MW_TMP + part * 32 + e] = s; F.MISC[MW_TMP + 512 + part * 32 + e] = sb;
    LDS_WAIT(); __syncthreads();
    if (F.tid < 32) { unsigned a = 0, bsum = 0;
#pragma nounroll
        for (int pq = 0; pq < 16; ++pq) { a += F.MISC[MW_TMP + pq * 32 + F.tid]; bsum += F.MISC[MW_TMP + 512 + pq * 32 + F.tid]; }
        F.MISC[MW_CNT + F.tid] = a; F.MISC[MW_BB + F.tid] = bsum; }
    LDS_WAIT(); __syncthreads();
    if (F.tid < 64) {
        const int ln = F.tid; const unsigned nt = ln < NEXP ? (F.MISC[MW_CNT + ln] + 255u) >> 8 : 0u; unsigned inc = nt;
#pragma unroll
        for (int d = 1; d < 32; d <<= 1) { const unsigned v = (unsigned)__shfl_up((int)inc, d, 64); if (ln >= d) inc += v; }
        if (ln < NEXP) F.MISC[MW_TS + ln] = inc - nt;
        if (ln == NEXP - 1) F.MISC[MW_TS + NEXP] = inc; }
    LDS_WAIT(); __syncthreads();
    { const int q = F.tid >> 4, r = F.tid & 15; const unsigned ts = F.MISC[MW_TS + q], nt = F.MISC[MW_TS + q + 1] - ts;
      volatile LAS unsigned char* te = (volatile LAS unsigned char*)(F.MISC + MW_TE);
      for (unsigned t = r; t < nt; t += 16) te[ts + t] = (unsigned char)q; }
    LDS_WAIT(); __syncthreads();
}
__device__ __forceinline__ void pG2(Frame& F, int l) {
    moe_tables(F);
    const int lane = F.lane, rpb = moe_rpb(F), row_lo = F.blk * rpb;
    if (F.tid < 256) { const int w = F.tid >> 5, e = F.tid & 31; unsigned wb = 0;
#pragma unroll
        for (int w2 = 0; w2 < 7; ++w2) { const unsigned v = (unsigned)WHIST_[(size_t)(F.blk * 8 + w2) * 32 + e]; wb += w2 < w ? v : 0u; }
        F.MISC[MW_TMP + w * 32 + e] = 256u * F.MISC[MW_TS + e] + F.MISC[MW_BB + e] + wb; }
    LDS_WAIT(); __syncthreads();
    for (int e = F.blk; e < NEXP; e += F.G) {
        const int c = (int)F.MISC[MW_CNT + e], base = 256 * (int)F.MISC[MW_TS + e], end = 256 * (int)(F.MISC[MW_TS + e + 1] - F.MISC[MW_TS + e]);
        for (int i = c + F.tid; i < end; i += 512) ROWMAP_[base + i] = 0; }
    for (int i = F.tid; i < rpb * 4; i += 512) {
        const int row = row_lo + (i >> 2), k = i & 3; if (row >= MROWS) break;
        const int p = row % TPB; if (l == DEPTH - 1 && p >= SEQ) continue;
        const int te = TOPE_[(size_t)row * 4 + k];
        const int ow = ((row - row_lo) & 15) >> 1, ek = te & 255, rank = te >> 8;
        const int dest = (int)F.MISC[MW_TMP + ow * 32 + (ek & 31)] + rank;
        DEST_[(size_t)row * 4 + k] = dest; ROWMAP_[dest] = row;
    }
}
struct JLoad { unsigned y[4][4]; u32x2 x[4]; };
__device__ __forceinline__ int pJ_row(int l, int a) { return l == DEPTH - 1 ? (a >> 11) * TPB + (a & (SEQ - 1)) : a; }
__device__ __forceinline__ void pJ_issue(Frame& F, JLoad& L, int row, int dk, int lane) {
#pragma unroll
    for (int k = 0; k < 4; ++k) { const int d = __builtin_amdgcn_readlane(dk, k);
#pragma unroll
        for (int j = 0; j < 4; ++j) L.y[k][j] = *(const unsigned*)((const unsigned char*)XS_   + (size_t)d * DM + 256 * j + 4 * lane); }
#pragma unroll
    for (int j = 0; j < 4; ++j) L.x[j] = *(const u32x2*)(XU_ + (size_t)row * DM + 256 * j + 4 * lane);
}
__device__ __forceinline__ void pJ(Frame& F, int l) {
    const int lane = F.lane, nrows = l == DEPTH - 1 ? BATCH * SEQ : MROWS, step = F.ngw;
    int a = F.gw; if (a >= nrows) return;
    auto route = [&](int aa, int& dk, float& gk) __attribute__((always_inline)) { if (aa < nrows) { const int r = pJ_row(l, aa); dk = DEST_[(size_t)r * 4 + (lane & 3)]; gk = TOPG_[(size_t)r * 4 + (lane & 3)]; } };
    auto one = [&](const JLoad& L, const int aa, const float gkA) __attribute__((always_inline)) {
        const int row = pJ_row(l, aa), b = row / TPB, p = row - b * TPB; const int mc = p < SEQ ? b : 16; const float* mod = MOD_ + ((size_t)l * 17 + mc) * 6144;
        f32x4 g2[4], s1[4], s0[4], gm[4];
#pragma unroll
        for (int j = 0; j < 4; ++j) { const int col = 256 * j + 4 * lane; g2[j] = *(const f32x4*)(mod + 5 * 1024 + col);
            if (l != DEPTH - 1) { const float* mod1 = MOD_ + ((size_t)(l + 1) * 17 + mc) * 6144; s1[j] = *(const f32x4*)(mod1 + 1024 + col); s0[j] = *(const f32x4*)(mod1 + col); gm[j] = *(const f32x4*)(g_mix_ + (l + 1) * DM + col); } }
        float g[4];
#pragma unroll
        for (int k = 0; k < 4; ++k) g[k] = rl_f(gkA, k) * (1.0f / SC_Y);
        f32x4 v[4];
#pragma unroll
        for (int j = 0; j < 4; ++j) { f32x4 acc = (f32x4){0.f, 0.f, 0.f, 0.f};
#pragma unroll
            for (int k = 0; k < 4; ++k) { const int w = (int)L.y[k][j]; acc += (f32x4){__builtin_amdgcn_cvt_f32_fp8(w, 0), __builtin_amdgcn_cvt_f32_fp8(w, 1), __builtin_amdgcn_cvt_f32_fp8(w, 2), __builtin_amdgcn_cvt_f32_fp8(w, 3)} * g[k]; }
            v[j] = bf4f(L.x[j]) + g2[j] * acc; }
        if (l == DEPTH - 1) {
#pragma unroll
            for (int j = 0; j < 4; ++j) *(f32x4*)(out_ + ((size_t)b * SEQ + p) * DM + 256 * j + 4 * lane) = v[j];
        } else {
#pragma unroll
            for (int j = 0; j < 4; ++j) { u32x2 o; o.x = pg8::cvt_pk_bf16(v[j][0], v[j][1]); o.y = pg8::cvt_pk_bf16(v[j][2], v[j][3]); *(u32x2*)(XU_ + (size_t)row * DM + 256 * j + 4 * lane) = o; v[j] = bf4f(o); }
            const float rstd = rsq(wave_sum(sumsq4(v)) * (1.0f / DM) + EPS);
            unsigned char* orow = (unsigned char*)H_ + (size_t)row * DM;
#pragma unroll
            for (int j = 0; j < 4; ++j) { const f32x4 h = (v[j] * rstd * gm[j] * (s1[j] + 1.0f) + s0[j]) * SC_X; *(unsigned*)(orow + 256 * j + 4 * lane) = pk4f8(h[0], h[1], h[2], h[3]); }
        }
    };
    int dk0 = 0, dk1 = 0, dk2 = 0, dk3 = 0; float gk0 = 0.f, gk1 = 0.f, gk2 = 0.f, gk3 = 0.f;
    route(a, dk0, gk0); route(a + step, dk1, gk1);
    JLoad A, B; pJ_issue(F, A, pJ_row(l, a), dk0, lane);
    for (; a < nrows; a += 2 * step) {
        route(a + 2 * step, dk2, gk2);
        if (a + step < nrows) pJ_issue(F, B, pJ_row(l, a + step), dk1, lane);
        one(A, a, gk0);
        if (a + step >= nrows) break;
        route(a + 3 * step, dk3, gk3);
        if (a + 2 * step < nrows) pJ_issue(F, A, pJ_row(l, a + 2 * step), dk2, lane);
        one(B, a + step, gk1);
        dk0 = dk2; gk0 = gk2; dk1 = dk3; gk1 = gk3;
    }
}

#ifndef PH_MASK
#define PH_MASK 0x3fff
#endif
#define IN(k) (lo <= (k) && (k) < hi)
#define EN(i) ((PH_MASK >> (i)) & 1)
#define RELOAD() do { int ln_; asm volatile("v_mbcnt_lo_u32_b32 %0, -1, 0\n\tv_mbcnt_hi_u32_b32 %0, -1, %0" : "=v"(ln_)); ln_ &= 63; F.lane = ln_; F.wave = wave0; F.tid = wave0 * 64 + ln_; \
    { int b_ = (int)blockIdx.x, g_ = (int)gridDim.x, w_ = wave0; asm volatile("" : "+s"(b_), "+s"(g_), "+s"(w_)); F.blk = b_; F.G = g_; F.wave = w_ & 7; F.tid = (w_ & 7) * 64 + ln_; F.gw = b_ * 8 + (w_ & 7); F.ngw = g_ * 8; } \
    int z_ = 0; asm volatile("" : "+s"(z_)); F.A = (const Args*)((const char*)&args + z_); } while (0)
#define SEAM(k) do { if ((k) + 1 < hi) { xcd_barrier(bar.bar, bar.x, bar.st, F.tid); if (NREP(18) > 1) xcd_barrier(bar.bar, bar.x, bar.st, F.tid); } } while (0)
template <int l>
__device__ __forceinline__ void layer_phases(Frame& F, const Args& args, const XcdBarrier& bar, const int lo, const int hi, const int wave0) {
        const int pb = 1 + 13 * l; const bool lastl = (l == DEPTH - 1);
        if (EN(1) && IN(pb + 0) && l == 0) { RELOAD(); pA_init(F); SEAM(pb + 0); }
        if (EN(2) && IN(pb + 1)) { RELOAD();
            pg8::Gemm g{H_  , (const bf16*)((const unsigned char*)WIN_ + (size_t)l * 2048 * 1024), nullptr}; DenseOrder S{MROWS / 256, ZC / 256, F.G, F.blk, 0, NREP(2)}; EpiBf16PlainT<true> E{Z_, ZC};
            pg8::gemm_phase<EpiBf16PlainT<true>, DenseOrder, 512, 512, true, true, true>(F.lds + RING_OFF, g, S, E, F.tid); SEAM(pb + 1); }
        if (EN(3) && IN(pb + 2)) { RELOAD();
            pg8::Gemm g{Z_ + Z_CQ, WSM_ + (size_t)l * 1280 * 384, nullptr}; DenseOrder S{MROWS / 256, YC / 256, F.G, F.blk, 0, NREP(3)}; EpiFp8Plain E{(unsigned char*)Y_, YC};
            pg8::gemm_phase<EpiFp8Plain, DenseOrder, 384, ZC, true, true>(F.lds + RING_OFF, g, S, E, F.tid); SEAM(pb + 2); }
        if (EN(4) && IN(pb + 3)) { for (int rp = 0; rp < NREP(4); ++rp) { RELOAD(); pD_tokens(F, l); } SEAM(pb + 3); }
        if (EN(5) && IN(pb + 4)) { for (int rp = 0; rp < NREP(5); ++rp) { RELOAD(); pE1(F, l); } SEAM(pb + 4); }
        if (EN(6) && IN(pb + 5)) { for (int rp = 0; rp < NREP(6); ++rp) { RELOAD(); pE2(F, l); } SEAM(pb + 5); }
        if (EN(8) && IN(pb + 7)) { RELOAD();
            pg8::Gemm g{ATT_, WOUT_ + (size_t)l * 1024 * 1024, nullptr}; DenseOrder S{lastl ? BATCH * 8 : MROWS / 256, DM / 256, F.G, F.blk, lastl ? 1 : 0, 1};
            EpiResid E{XU_, MOD_ + (size_t)l * 17 * 6144 + 2 * 1024, l == 0 ? x_ : nullptr, l == 0 ? ctx_ : nullptr};
            pg8::gemm_phase<EpiResid, DenseOrder, DM, DM, true, true>(F.lds + RING_OFF, g, S, E, F.tid); SEAM(pb + 7); }
        if (EN(9) && IN(pb + 8)) { for (int rp = 0; rp < NREP(9); ++rp) { RELOAD(); pG1(F, l); } SEAM(pb + 8); }
        if (EN(10) && IN(pb + 9)) { for (int rp = 0; rp < NREP(10); ++rp) { RELOAD(); pG2(F, l); } SEAM(pb + 9); }
        if (EN(11) && IN(pb + 10)) { RELOAD();
            pg8::Gemm g{H_  , (const bf16*)((const unsigned char*)W1_ + (size_t)l * NEXP * 2048 * 1024), ROWMAP_};
            MoeOrder S{(const volatile LAS int*)(F.MISC + MW_TS), (const volatile LAS unsigned char*)(F.MISC + MW_TE), 8, F.G, F.blk, NREP(11)};
            EpiSwiglu E{(unsigned char*)ACT_, b_moe1_ + (size_t)l * NEXP * 2048};
            pg8::gemm_phase<EpiSwiglu, MoeOrder, 512, 512, true, true, true, true>(F.lds + RING_OFF, g, S, E, F.tid); SEAM(pb + 10); }
        if (EN(12) && IN(pb + 11)) { RELOAD();
            pg8::Gemm g{ACT_, (const bf16*)((const unsigned char*)W2_ + (size_t)l * NEXP * 1024 * 1024), nullptr};
            MoeOrder S{(const volatile LAS int*)(F.MISC + MW_TS), (const volatile LAS unsigned char*)(F.MISC + MW_TE), 4, F.G, F.blk, NREP(12)};
            EpiFp8Bias E{(unsigned char*)XS_, b_moe2_ + (size_t)l * NEXP * 1024};
            pg8::gemm_phase<EpiFp8Bias, MoeOrder, 512, 512, true, true, true>(F.lds + RING_OFF, g, S, E, F.tid); SEAM(pb + 11); }
        if (EN(13) && IN(pb + 12)) { for (int rp = 0; rp < (lastl ? NREP(13) : 1); ++rp) { RELOAD(); pJ(F, l); } if (!lastl) SEAM(pb + 12); }
}
__global__ void __launch_bounds__(512, 2) fwd(Args args) {
    extern __shared__ __attribute__((aligned(16))) unsigned char lds[];
    Frame F;
    F.lds = (LAS unsigned char*)lds; F.MISC = (volatile LAS unsigned*)(F.lds + MISC_OFF);
    F.tid = threadIdx.x; F.lane = F.tid & 63; F.wave = __builtin_amdgcn_readfirstlane(F.tid >> 6); const int wave0 = F.wave & 7;
    F.G = gridDim.x; F.blk = blockIdx.x; F.gw = F.blk * 8 + F.wave; F.ngw = F.G * 8;
    F.A = &args; unsigned char* ws = args.ws;
    for (int u = F.tid; u < (LDS_BYTES - MISC_OFF) / 4; u += 512) F.MISC[u] = 0u;
    __syncthreads();
    XcdBarrier bar = xcd_barrier_post((unsigned*)(ws + WS_CTL) + CW_BAR + args.li * XCD_BAR_WORDS, F.MISC + MW_BAR);
    const int lo = args.ph_lo, hi = args.ph_hi;
    if (EN(0) && IN(0)) { for (int rp = 0; rp < NREP(0); ++rp) { RELOAD(); p0_prologue(F); } SEAM(0); }
    layer_phases<0>(F, args, bar, lo, hi, wave0);
    layer_phases<1>(F, args, bar, lo, hi, wave0);
    static_assert(DEPTH == 2, "two layer instantiations");
#undef IN
#undef SEAM
}

extern "C" void kernel_launch(void* const* d_in, const int* in_sizes, int n_in, void* d_out, int out_size, void* d_ws, size_t ws_size, hipStream_t stream) {
    static int grid = 0;
    if (grid == 0) {
        if (n_in != 28 || out_size != BATCH * SEQ * DM || ws_size < WS_END) { fprintf(stderr, "kernel_launch: unexpected problem (n_in %d out %d ws %zu)\n", n_in, out_size, ws_size); grid = -1; return; }
        int dev = 0, cus = 0, per_cu = 0;
        if (hipGetDevice(&dev) != hipSuccess || hipDeviceGetAttribute(&cus, hipDeviceAttributeMultiprocessorCount, dev) != hipSuccess) { grid = -1; return; }
        if (hipFuncSetAttribute((const void*)fwd, hipFuncAttributeMaxDynamicSharedMemorySize, LDS_BYTES) != hipSuccess) { fprintf(stderr, "kernel_launch: hipFuncSetAttribute failed\n"); grid = -1; return; }
        if (hipOccupancyMaxActiveBlocksPerMultiprocessor(&per_cu, (const void*)fwd, 512, LDS_BYTES) != hipSuccess || per_cu < 1) { fprintf(stderr, "kernel_launch: occupancy query says %d\n", per_cu); }
        (void)hipGetLastError();
        grid = cus & ~7;
        if (grid < 8) { grid = -1; return; }
    }
    if (grid < 0) return;
    (void)hipMemsetAsync((char*)d_ws + WS_CTL, 0, CTL_ZERO_BYTES, stream);
    Args a{};
    for (int i = 0; i < 28; ++i) a.in[i] = (const float*)d_in[i];
    a.out = (float*)d_out; a.ws = (unsigned char*)d_ws; a.pad = 0;
#if MK_N_LAUNCHES == 1
    a.ph_lo = 0; a.ph_hi = NPH; a.li = 0;
    hipLaunchKernelGGL(fwd, dim3(grid), dim3(512), LDS_BYTES, stream, a);
#else
    for (int ph = 0, li = 0; ph < NPH; ++ph) {
        if (ph == 1 + 13 || ph == 1 + 6 || ph == 1 + 13 + 6) continue;
        a.ph_lo = ph; a.ph_hi = ph + 1; a.li = li++;
        hipLaunchKernelGGL(fwd, dim3(grid), dim3(512), LDS_BYTES, stream, a);
    }
#endif
}
```

```cpp
#include <hip/hip_runtime.h>
#include <cstdio>
#include <cstdint>

#define GAS __attribute__((address_space(1)))
#define LAS __attribute__((address_space(3)))
typedef unsigned short bf16;
typedef short bf16x8 __attribute__((ext_vector_type(8)));
typedef short bf16x4 __attribute__((ext_vector_type(4)));
typedef float f32x4 __attribute__((ext_vector_type(4)));
typedef unsigned u32x4 __attribute__((ext_vector_type(4)));
typedef unsigned u32x2 __attribute__((ext_vector_type(2)));

#ifndef REP_MASK
#define REP_MASK 0
#endif
#define NREP(i) (((REP_MASK >> (i)) & 1) ? 2 : 1)
#ifndef MK_N_LAUNCHES
#define MK_N_LAUNCHES 1
#endif

namespace pg8 {
constexpr int BM = 256, BK = 64, HALF = 128, HTB = HALF * BK * 2, STAGE_BYTES = 8 * HTB;
__host__ __device__ __forceinline__ int lds_byte(int r, int c) { const int st = (r >> 4) * 2 + (c >> 5), rr = r & 15, cc = c & 31, ob = rr * 64 + cc * 2; return st * 1024 + (ob ^ (((ob >> 9) & 1) << 5)); }
__host__ __device__ __forceinline__ void stage_rc(int b, int& R, int& C) { const int st = b / 1024, sb = b % 1024, swz = sb ^ (((sb >> 9) & 1) << 5); R = (st >> 1) * 16 + swz / 64; C = (st & 1) * 32 + (swz % 64) / 2; }
__host__ __device__ __forceinline__ int perm32(int rho) { const int n = rho >> 4, i = rho & 15; return 8 * (i >> 2) + 4 * n + (i & 3); }

struct Unit { int pm, pn, pb, pa; };
struct Gemm { const bf16* A; const bf16* Bt; const int* rowmap; };

__device__ __forceinline__ unsigned cvt_pk_bf16(float lo, float hi) { unsigned r; asm volatile("v_cvt_pk_bf16_f32 %0, %1, %2" : "=v"(r) : "v"(lo), "v"(hi)); return r; }

typedef int i32x4v __attribute__((ext_vector_type(4)));
typedef int i32x8v __attribute__((ext_vector_type(8)));
template <class Epi, class Sched, int K, int LDA, bool ALIGN_EPI, bool SP2, bool FP8 = false, bool GATHER = false>
__device__ __forceinline__ void gemm_phase(LAS unsigned char* lds, const Gemm g, const Sched& S, const Epi& E, const int tid) {
    const int wid = __builtin_amdgcn_readfirstlane(tid >> 6), lane = tid & 63, wr = wid >> 2, wc = wid & 3, fr = lane & 15, fq = lane >> 4;
    constexpr int nt = K / BK;
    unsigned voffA[2], voffB[2]; int rA[2]; unsigned cA2[2];
#pragma unroll
    for (int i = 0; i < 2; ++i) { int R, C; stage_rc(tid * 16 + i * 8192, R, C); const int Rb = Epi::PERM ? ((R & ~31) + perm32(R & 31)) : R;
        voffA[i] = (unsigned)(R * LDA + C) * 2u; voffB[i] = (unsigned)(Rb * K + C) * 2u; rA[i] = R; cA2[i] = (unsigned)C * 2u; }
    constexpr size_t kstep = (size_t)(BK * 2);
    constexpr size_t hA = GATHER ? 0 : (size_t)HALF * LDA * 2, hB = (size_t)HALF * K * 2;
    constexpr size_t tA = 2 * hA, tB = 2 * hB;
    unsigned gC[2][2], gN[2][2];
#define PG8_GLOAD(dst, unit) do { if constexpr (GATHER) { _Pragma("unroll") for (int _h = 0; _h < 2; ++_h) _Pragma("unroll") for (int _i = 0; _i < 2; ++_i) \
        dst[_h][_i] = (unsigned)g.rowmap[(unit).pa * 256 + _h * 128 + rA[_i]] * (unsigned)(LDA * 2) + cA2[_i]; } } while (0)
#define PG8_STAGE_A(b, h, ptr, nx) do { if constexpr (GATHER) { _Pragma("unroll") for (int _i = 0; _i < 2; ++_i) \
        __builtin_amdgcn_global_load_lds((const unsigned*)((const char*)(ptr) + ((nx) ? gN[h][_i] : gC[h][_i])), (LAS unsigned*)(lds + PG8_SA(b, h) + ldsw + _i * 8192), 16, 0, 0); } \
        else PG8_STAGE(PG8_SA(b, h), (ptr) + (h) * hA, voffA); } while (0)
    const unsigned ldsw = (unsigned)wid * 1024u;
    const int aoff = FP8 ? lds_byte(wr * 64 + fr, (fq & 1) * 16) + (fq >> 1) * 1024 : lds_byte(wr * 64 + fr, fq * 8);
    const int boff = FP8 ? lds_byte(wc * 32 + fr, (fq & 1) * 16) + (fq >> 1) * 1024 : lds_byte(wc * 32 + fr, fq * 8);
#define PG8_SA(b, h) (((b) * 2 + (h)) * HTB)
#define PG8_SB(b, h) ((4 + (b) * 2 + (h)) * HTB)
#define PG8_STAGE(bufoff, gbase, voff) do { _Pragma("unroll") for (int _i = 0; _i < 2; ++_i) \
        __builtin_amdgcn_global_load_lds((const unsigned*)((const char*)(gbase) + (voff)[_i]), (LAS unsigned*)(lds + (bufoff) + ldsw + _i * 8192), 16, 0, 0); } while (0)
#define PG8_LDA(dst, b, h) do { _Pragma("unroll") for (int m = 0; m < 4; ++m) { if constexpr (FP8) { const i32x4v lo_ = *(const LAS i32x4v*)(lds + PG8_SA(b, h) + aoff + m * 2048), hi_ = *(const LAS i32x4v*)(lds + PG8_SA(b, h) + aoff + m * 2048 + 16); dst[m] = __builtin_shufflevector(lo_, hi_, 0, 1, 2, 3, 4, 5, 6, 7); } \
        else { dst[m].lo = *(const LAS i32x4v*)(lds + PG8_SA(b, h) + aoff + m * 2048); dst[m].hi = *(const LAS i32x4v*)(lds + PG8_SA(b, h) + aoff + m * 2048 + 1024); } } } while (0)
#define PG8_LDB(dst, b, h) do { _Pragma("unroll") for (int n = 0; n < 2; ++n) { if constexpr (FP8) { const i32x4v lo_ = *(const LAS i32x4v*)(lds + PG8_SB(b, h) + boff + n * 2048), hi_ = *(const LAS i32x4v*)(lds + PG8_SB(b, h) + boff + n * 2048 + 16); dst[n] = __builtin_shufflevector(lo_, hi_, 0, 1, 2, 3, 4, 5, 6, 7); } \
        else { dst[n].lo = *(const LAS i32x4v*)(lds + PG8_SB(b, h) + boff + n * 2048); dst[n].hi = *(const LAS i32x4v*)(lds + PG8_SB(b, h) + boff + n * 2048 + 1024); } } } while (0)
#define PG8_MMA(ai, bj, At, Bt) do { __builtin_amdgcn_s_setprio(1); _Pragma("unroll") for (int m = 0; m < 4; ++m) _Pragma("unroll") for (int n = 0; n < 2; ++n) { \
        if constexpr (FP8) asm volatile("v_mfma_scale_f32_16x16x128_f8f6f4 %0, %1, %2, %0, %3, %3 op_sel_hi:[0,0,0]" : "+v"(acc[ai][bj][m][n]) : "v"(Bt[n]), "v"(At[m]), "v"(sc8)); \
        else { const i32x4v bl_ = __builtin_shufflevector(Bt[n], Bt[n], 0, 1, 2, 3), bh_ = __builtin_shufflevector(Bt[n], Bt[n], 4, 5, 6, 7), al_ = __builtin_shufflevector(At[m], At[m], 0, 1, 2, 3), ah_ = __builtin_shufflevector(At[m], At[m], 4, 5, 6, 7); \
               acc[ai][bj][m][n] = __builtin_amdgcn_mfma_f32_16x16x32_bf16(__builtin_bit_cast(bf16x8, bl_), __builtin_bit_cast(bf16x8, al_), acc[ai][bj][m][n], 0, 0, 0);   \
               acc[ai][bj][m][n] = __builtin_amdgcn_mfma_f32_16x16x32_bf16(__builtin_bit_cast(bf16x8, bh_), __builtin_bit_cast(bf16x8, ah_), acc[ai][bj][m][n], 0, 0, 0); } } \
        __builtin_amdgcn_s_setprio(0); } while (0)
#define PG8_WAIT_V(n) asm volatile("s_waitcnt vmcnt(" #n ")" ::: "memory")
#define PG8_WAIT_L(n) asm volatile("s_waitcnt lgkmcnt(" #n ")" ::: "memory")
#define PG8_BAR __builtin_amdgcn_s_barrier()
#define PG8_SCHED __builtin_amdgcn_sched_barrier(0)
    int sc8 = 0x7f7f7f7f; asm volatile("" : "+v"(sc8));
    Unit cur, nxt; int ui = 0;
    if (!S.next(0, cur)) return;
    f32x4 acc[2][2][4][2];
#pragma unroll
    for (int a = 0; a < 2; ++a)
#pragma unroll
        for (int b = 0; b < 2; ++b)
#pragma unroll
            for (int m = 0; m < 4; ++m)
#pragma unroll
                for (int n = 0; n < 2; ++n) acc[a][b][m][n] = (f32x4){0.f, 0.f, 0.f, 0.f};
    i32x8v At[4], B0[2], B1[2];
    const char* cA = (const char*)g.A + (size_t)cur.pa * tA; const char* cB = (const char*)g.Bt + (size_t)cur.pb * tB;
    typename Epi::Pre pre = E.prefetch(cur, wc, fq);
    PG8_GLOAD(gC, cur);
#pragma unroll
    for (int _h = 0; _h < 2; ++_h)
#pragma unroll
        for (int _i = 0; _i < 2; ++_i) gN[_h][_i] = gC[_h][_i];
    if constexpr (SP2) {
        PG8_STAGE(PG8_SB(0, 0), cB, voffB); PG8_STAGE(PG8_SB(0, 1), cB + hB, voffB); PG8_STAGE_A(0, 0, cA, false); PG8_STAGE_A(0, 1, cA, false);
        if (wr == 1) PG8_BAR;
        PG8_WAIT_V(2); PG8_BAR;
        PG8_STAGE(PG8_SB(1, 0), cB + kstep, voffB); PG8_STAGE_A(1, 0, cA + kstep, false); PG8_STAGE(PG8_SB(1, 1), cB + hB + kstep, voffB);
        PG8_WAIT_V(6); PG8_BAR;
    } else {
        static_assert(!GATHER, "the gathered A operand is wired into the SP2 loop only");
        PG8_STAGE(PG8_SB(0, 0), cB, voffB); PG8_STAGE(PG8_SA(0, 0), cA, voffA); PG8_STAGE(PG8_SB(0, 1), cB + hB, voffB); PG8_STAGE(PG8_SA(0, 1), cA + hA, voffA);
        if (wr == 1) PG8_BAR;
        PG8_WAIT_V(4); PG8_BAR;
        PG8_STAGE(PG8_SB(1, 0), cB + kstep, voffB); PG8_STAGE(PG8_SA(1, 0), cA + kstep, voffA); PG8_STAGE(PG8_SB(1, 1), cB + hB + kstep, voffB);
        PG8_WAIT_V(6); PG8_BAR;
    }
    for (;;) {
        const bool has_next = S.next(ui + 1, nxt);
        const char* nA = has_next ? (const char*)g.A + (size_t)nxt.pa * tA : cA; const char* nB = has_next ? (const char*)g.Bt + (size_t)nxt.pb * tB : cB;
        if (has_next) PG8_GLOAD(gN, nxt);
#pragma nounroll
        for (int t = 0; t < nt; t += 2) {
            const bool last = (t == nt - 2);
            const char* a1 = cA + (size_t)(t + 1) * kstep;
            const char* a2 = last ? nA : cA + (size_t)(t + 2) * kstep; const char* b2 = last ? nB : cB + (size_t)(t + 2) * kstep;
            const char* a3 = a2 + kstep; const char* b3 = b2 + kstep;
            if constexpr (SP2) {
            PG8_LDB(B0, 0, 0); PG8_LDB(B1, 0, 1); PG8_SCHED; PG8_LDA(At, 0, 0); PG8_STAGE_A(1, 1, a1, false);
            PG8_WAIT_V(8); PG8_WAIT_L(0); PG8_BAR; PG8_MMA(0, 0, At, B0); PG8_MMA(0, 1, At, B1); PG8_BAR; PG8_SCHED;
            PG8_LDA(At, 0, 1); PG8_STAGE(PG8_SB(0, 0), b2, voffB); PG8_STAGE(PG8_SB(0, 1), b2 + hB, voffB); PG8_STAGE_A(0, 0, a2, last);
            PG8_WAIT_V(8); PG8_WAIT_L(0); PG8_BAR; PG8_MMA(1, 0, At, B0); PG8_MMA(1, 1, At, B1); PG8_BAR; PG8_SCHED;
            PG8_LDB(B0, 1, 0); PG8_LDB(B1, 1, 1); PG8_SCHED; PG8_LDA(At, 1, 0); PG8_STAGE_A(0, 1, a2, last);
            PG8_WAIT_V(8); PG8_WAIT_L(0); PG8_BAR; PG8_MMA(0, 0, At, B0); PG8_MMA(0, 1, At, B1); PG8_BAR; PG8_SCHED;
            PG8_LDA(At, 1, 1); PG8_STAGE(PG8_SB(1, 0), b3, voffB); PG8_STAGE(PG8_SB(1, 1), b3 + hB, voffB); PG8_STAGE_A(1, 0, a3, last);
            PG8_WAIT_V(8); PG8_WAIT_L(0); PG8_BAR; PG8_MMA(1, 0, At, B0); PG8_MMA(1, 1, At, B1); PG8_BAR; PG8_SCHED;
            } else {
            PG8_LDB(B0, 0, 0); PG8_SCHED; PG8_LDA(At, 0, 0); PG8_STAGE(PG8_SA(1, 1), a1 + hA, voffA);
            PG8_WAIT_L(8); PG8_BAR; PG8_WAIT_L(0); PG8_MMA(0, 0, At, B0); PG8_BAR; PG8_SCHED;
            PG8_LDB(B1, 0, 1); PG8_STAGE(PG8_SB(0, 0), b2, voffB);
            PG8_BAR; PG8_WAIT_L(0); PG8_MMA(0, 1, At, B1); PG8_BAR;
            PG8_LDA(At, 0, 1); PG8_STAGE(PG8_SA(0, 0), a2, voffA);
            PG8_BAR; PG8_WAIT_L(0); PG8_MMA(1, 0, At, B0); PG8_BAR; PG8_SCHED;
            PG8_STAGE(PG8_SB(0, 1), b2 + hB, voffB);
            PG8_WAIT_V(6); PG8_BAR; PG8_MMA(1, 1, At, B1); PG8_BAR;
            PG8_LDB(B0, 1, 0); PG8_SCHED; PG8_LDA(At, 1, 0); PG8_STAGE(PG8_SA(0, 1), a2 + hA, voffA);
            PG8_WAIT_L(8); PG8_BAR; PG8_WAIT_L(0); PG8_MMA(0, 0, At, B0); PG8_BAR; PG8_SCHED;
            PG8_LDB(B1, 1, 1); PG8_STAGE(PG8_SB(1, 0), b3, voffB);
            PG8_BAR; PG8_WAIT_L(0); PG8_MMA(0, 1, At, B1); PG8_BAR;
            PG8_LDA(At, 1, 1); PG8_STAGE(PG8_SA(1, 0), a3, voffA);
            PG8_BAR; PG8_WAIT_L(0); PG8_MMA(1, 0, At, B0); PG8_BAR; PG8_SCHED;
            PG8_STAGE(PG8_SB(1, 1), b3 + hB, voffB);
            PG8_WAIT_V(6); PG8_BAR; PG8_MMA(1, 1, At, B1); PG8_BAR;
            }
        }
        if constexpr (FP8) asm volatile("s_nop 15\n\ts_nop 15" ::: "memory");
        if constexpr (ALIGN_EPI) { if (wr == 0) PG8_BAR; }
        E(acc, cur, wr, wc, fr, fq, pre);
        if (!has_next) break;
        pre = E.prefetch(nxt, wc, fq);
#pragma unroll
        for (int a = 0; a < 2; ++a)
#pragma unroll
            for (int b = 0; b < 2; ++b)
#pragma unroll
                for (int m = 0; m < 4; ++m)
#pragma unroll
                    for (int n = 0; n < 2; ++n) acc[a][b][m][n] = (f32x4){0.f, 0.f, 0.f, 0.f};
        cur = nxt; cA = nA; cB = nB; ++ui;
#pragma unroll
        for (int _h = 0; _h < 2; ++_h)
#pragma unroll
            for (int _i = 0; _i < 2; ++_i) gC[_h][_i] = gN[_h][_i];
        if constexpr (ALIGN_EPI) { if (wr == 1) PG8_BAR; }
    }
    PG8_WAIT_V(0);
    if constexpr (!ALIGN_EPI) { if (wr == 0) PG8_BAR; }
    PG8_BAR;
#undef PG8_SA
#undef PG8_SB
#undef PG8_STAGE
#undef PG8_STAGE_A
#undef PG8_GLOAD
#undef PG8_LDA
#undef PG8_LDB
#undef PG8_MMA
#undef PG8_WAIT_V
#undef PG8_WAIT_L
#undef PG8_BAR
#undef PG8_SCHED
}
}

constexpr int BATCH = 16, SEQ = 2048, CTXL = 256, TPB = SEQ + CTXL, MROWS = BATCH * TPB, DM = 1024, DEPTH = 2;
constexpr int ZC = 2048, YC = 1280, INC = 1984;
constexpr int NEXP = 32, MAXTILES = 608, XSROWS = MAXTILES * 256;
constexpr float EPS = 1e-6f, LOG2E = 1.4426950408889634f;
constexpr float QS_NA = 0.125f * LOG2E;
constexpr float QS_MLA = 0.10206207261596575f * LOG2E;
constexpr int Z_NAQ = 0, Z_NAK = 256, Z_NAV = 512, Z_CQ = 768, Z_CKV = 1024, Z_KR = 1152, Z_GQ = 1184, Z_GK = 1312, Z_GV = 1440, Z_GO = 1696, Z_LF = 1952, Z_LB = 1968;
constexpr int NPH = 1 + 13 * DEPTH;

constexpr size_t MiB = 1u << 20;
constexpr size_t WS_CTL = 0, CTL_ZERO_BYTES = 1 * MiB;
constexpr size_t WS_MOD = 1 * MiB, WS_WSM = 2 * MiB, WS_WIN = 4 * MiB, WS_WOUT = 12 * MiB, WS_W1 = 16 * MiB, WS_W2 = 272 * MiB;
constexpr size_t WS_XU = 400 * MiB, WS_H = 544 * MiB, WS_ATT = 616 * MiB, WS_Z = 688 * MiB, WS_Y = 832 * MiB;
constexpr size_t WS_NAQ = 922 * MiB, WS_NAK = 940 * MiB, WS_NAVT = 958 * MiB, WS_MQ = 976 * MiB, WS_MK = 1012 * MiB, WS_MV = 1048 * MiB;
constexpr size_t WS_EGF = 1084 * MiB, WS_EGB = 1102 * MiB, WS_GQ = 1120 * MiB, WS_GK = 1138 * MiB, WS_GV = 1156 * MiB, WS_CS = 1192 * MiB, WS_AD = 1228 * MiB;
constexpr size_t WS_OGF = 1229 * MiB, WS_OGB = 1265 * MiB, WS_TOPE = 1301 * MiB, WS_TOPG = 1302 * MiB, WS_DEST = 1303 * MiB, WS_HIST = 1304 * MiB;
constexpr size_t WS_XS = 1305 * MiB, WS_ACT = 1609 * MiB, WS_Z8 = 1913 * MiB, WS_END = 1941 * MiB;
static_assert((size_t)XSROWS * DM * 2 <= 304 * MiB && (size_t)MROWS * YC * 2 <= 90 * MiB && (size_t)MROWS * 384 * 2 <= 27 * MiB, "ws map");
constexpr int CW_BAR = 4096;

constexpr int RING_OFF = 0, MISC_OFF = 139264, LDS_BYTES = 147456;
constexpr int MW_BAR = 8, MW_CNT = 64, MW_BB = 96, MW_TS = 128, MW_TE = 192, MW_TMP = 384, MW_WH = 1536;
constexpr int WRT_PITCH = 1028;
constexpr int VT_PITCH = 1544;
static_assert(NEXP * WRT_PITCH * 4 <= MISC_OFF && 64 * VT_PITCH <= MISC_OFF, "LDS map");

#define RLX_AGENT __ATOMIC_RELAXED, __HIP_MEMORY_SCOPE_AGENT
#define LDS_WAIT() asm volatile("s_waitcnt lgkmcnt(0)" ::: "memory")
#define VM_WAIT() asm volatile("s_waitcnt vmcnt(0)" ::: "memory")
__device__ __forceinline__ float bf2f(unsigned u) { return __uint_as_float(u << 16); }
__device__ __forceinline__ unsigned pk2(float lo, float hi) { unsigned r; asm("v_cvt_pk_bf16_f32 %0, %1, %2" : "=v"(r) : "v"(lo), "v"(hi)); return r; }
__device__ __forceinline__ unsigned f2bf(float f) { return pk2(f, 0.f) & 0xffffu; }
__device__ __forceinline__ float clamp8(float v) { return fminf(fmaxf(v, -448.0f), 448.0f); }
__device__ __forceinline__ unsigned pk4f8(float a, float b, float c, float d) {
    int p = __builtin_amdgcn_cvt_pk_fp8_f32(clamp8(a), clamp8(b), 0, false); p = __builtin_amdgcn_cvt_pk_fp8_f32(clamp8(c), clamp8(d), p, true); return (unsigned)p; }
constexpr float SC_YC = 16.0f;
constexpr float SC_Y = 8.0f;
constexpr float SC_W = 256.0f, SC_X = 16.0f, SC_ACT = 4.0f;
__device__ __forceinline__ void ld4bf(const bf16* p, float (&f)[4]) { const u32x2 w = *(const u32x2*)p; f[0] = __uint_as_float(w.x << 16); f[1] = __uint_as_float(w.x & 0xffff0000u); f[2] = __uint_as_float(w.y << 16); f[3] = __uint_as_float(w.y & 0xffff0000u); }
__device__ __forceinline__ f32x4 bf4f(const u32x2 w) { return (f32x4){__uint_as_float(w.x << 16), __uint_as_float(w.x & 0xffff0000u), __uint_as_float(w.y << 16), __uint_as_float(w.y & 0xffff0000u)}; }
__device__ __forceinline__ void st4bf(bf16* p, float a, float b, float c, float d) { u32x2 w; w.x = pk2(a, b); w.y = pk2(c, d); *(u32x2*)p = w; }
template <int M> __device__ __forceinline__ float swz_xor(float v) { return __int_as_float(__builtin_amdgcn_ds_swizzle(__float_as_int(v), 0x1f | (M << 10))); }
__device__ __forceinline__ float half_sum(float v) { auto rr = __builtin_amdgcn_permlane32_swap(__float_as_uint(v), __float_as_uint(v), false, false); return __uint_as_float(rr[0]) + __uint_as_float(rr[1]); }
__device__ __forceinline__ float half_max(float v) { auto rr = __builtin_amdgcn_permlane32_swap(__float_as_uint(v), __float_as_uint(v), false, false); return fmaxf(__uint_as_float(rr[0]), __uint_as_float(rr[1])); }
template <int CTRL> __device__ __forceinline__ float dpp_f(float v) { return __int_as_float(__builtin_amdgcn_update_dpp(0, __float_as_int(v), CTRL, 0xF, 0xF, true)); }
__device__ __forceinline__ float g8_sum(float v) { v += dpp_f<0xB1>(v); v += dpp_f<0x4E>(v); v += dpp_f<0x141>(v); return v; }
__device__ __forceinline__ float g16_sum(float v) { v = g8_sum(v); v += dpp_f<0x140>(v); return v; }
__device__ __forceinline__ float rl_f(float v, int l) { return __int_as_float(__builtin_amdgcn_readlane(__float_as_int(v), l)); }
__device__ __forceinline__ float wave_sum(float v) { v = g16_sum(v); return (rl_f(v, 0) + rl_f(v, 16)) + (rl_f(v, 32) + rl_f(v, 48)); }
__device__ __forceinline__ float row_sum(float v) { auto rr = __builtin_amdgcn_permlane16_swap(__float_as_uint(v), __float_as_uint(v), false, false); return __uint_as_float(rr[0]) + __uint_as_float(rr[1]); }
__device__ __forceinline__ float row_max(float v) { auto rr = __builtin_amdgcn_permlane16_swap(__float_as_uint(v), __float_as_uint(v), false, false); return fmaxf(__uint_as_float(rr[0]), __uint_as_float(rr[1])); }
template <int CTRL> __device__ __forceinline__ float dpp_max(float v) { return fmaxf(v, dpp_f<CTRL>(v)); }
__device__ __forceinline__ float wave_max(float v) { v = dpp_max<0xB1>(v); v = dpp_max<0x4E>(v); v = dpp_max<0x141>(v); v = dpp_max<0x140>(v); return fmaxf(fmaxf(rl_f(v, 0), rl_f(v, 16)), fmaxf(rl_f(v, 32), rl_f(v, 48))); }
__device__ __forceinline__ float q4_sum(float v) { return half_sum(row_sum(v)); }
__device__ __forceinline__ float q4_max(float v) { return half_max(row_max(v)); }
__device__ __forceinline__ float rsq(float x) { return __builtin_amdgcn_rsqf(x); }

#define XB_TMO      128
#define XB_XCNT(j)  (256  + 64 * (j))
#define XB_XSUB(j)  (1280 + 64 * (j))
#define XB_XGEN(j)  (2304 + 64 * (j))
#define XB_TOP      3328
#define XB_TOPGEN   3392
#define XCD_BAR_WORDS 3456
#define XB_SPIN_CAP (1u << 18)
__device__ __forceinline__ unsigned xb_ld(unsigned* p)              { return __hip_atomic_load(p, __ATOMIC_RELAXED, __HIP_MEMORY_SCOPE_AGENT); }
__device__ __forceinline__ unsigned xb_add(unsigned* p, unsigned v) { return __hip_atomic_fetch_add(p, v, __ATOMIC_RELAXED, __HIP_MEMORY_SCOPE_AGENT); }
__device__ __forceinline__ unsigned xb_xcc_id() { return (unsigned)__builtin_amdgcn_s_getreg((3 << 11) | 20) & 0xFu; }
#define XB_SPIN(cond, bar) do { unsigned _sp = 0; while (cond) { __builtin_amdgcn_s_sleep(1); \
    if ((++_sp & 255u) == 0u) { if (xb_ld(&(bar)[XB_TMO])) break; if (_sp > XB_SPIN_CAP) { atomicAdd(&(bar)[XB_TMO], 1u); break; } } } } while (0)
struct XcdBarrier { unsigned* bar; unsigned x; volatile LAS unsigned* st; };
__device__ __forceinline__ XcdBarrier xcd_barrier_post(unsigned* bar, volatile LAS unsigned* st) {
    XcdBarrier b; b.bar = bar; b.x = xb_xcc_id(); b.st = st;
    if (threadIdx.x == 0) (void)xb_add(&bar[XB_XCNT(b.x)], 1u);
    return b;
}
__device__ __forceinline__ void xcd_barrier_complete(unsigned* bar, unsigned x, unsigned& nloc, unsigned& nx) {
    const unsigned G = gridDim.x * gridDim.y * gridDim.z;
    unsigned sum, cnt, mine, sp = 0u;
    for (;;) {
        sum = 0u; cnt = 0u; mine = 0u;
#pragma unroll
        for (unsigned j = 0; j < 16; ++j) { const unsigned c = xb_ld(&bar[XB_XCNT(j)]); sum += c; cnt += (c > 0u) ? 1u : 0u; }
        mine = xb_ld(&bar[XB_XCNT(x)]);
        if (sum == G) break;
        __builtin_amdgcn_s_sleep(1);
        if ((++sp & 255u) == 0u) { if (xb_ld(&bar[XB_TMO])) break; if (sp > XB_SPIN_CAP) { atomicAdd(&bar[XB_TMO], 1u); break; } }
    }
    nloc = mine > 0u ? mine : 1u; nx = cnt > 0u ? cnt : 1u;
}
__device__ __attribute__((noinline)) void xcd_barrier(unsigned* const bbar, const unsigned bx, volatile LAS unsigned* const bst, const int tid) {
    XcdBarrier b; b.bar = bbar; b.x = bx; b.st = bst;
    asm volatile("s_waitcnt vmcnt(0)" ::: "memory");
    __syncthreads();
    if (tid == 0) {
        unsigned* bar = b.bar;
        __builtin_amdgcn_s_waitcnt(0);
        unsigned nloc = b.st[0], nx = b.st[1];
        if (nloc == 0u) { xcd_barrier_complete(bar, b.x, nloc, nx); b.st[0] = nloc; b.st[1] = nx; }
        const unsigned old = xb_add(&bar[XB_XSUB(b.x)], 1u);
        const unsigned gen = old / nloc;
        if (old + 1u == (gen + 1u) * nloc) {
            __builtin_amdgcn_fence(__ATOMIC_RELEASE, "agent");
            asm volatile("s_waitcnt vmcnt(0)" ::: "memory");
            const unsigned og = xb_add(&bar[XB_TOP], 1u);
            const unsigned tg = og / nx;
            if (og + 1u == (tg + 1u) * nx) xb_add(&bar[XB_TOPGEN], 1u);
            else XB_SPIN(xb_ld(&bar[XB_TOPGEN]) == tg, bar);
            __builtin_amdgcn_fence(__ATOMIC_ACQUIRE, "agent");
            xb_add(&bar[XB_XGEN(b.x)], 1u);
            asm volatile("s_waitcnt vmcnt(0)" ::: "memory");
        } else {
            XB_SPIN(xb_ld(&bar[XB_XGEN(b.x)]) == gen, bar);
            __builtin_amdgcn_fence(__ATOMIC_ACQUIRE, "agent");
            asm volatile("s_waitcnt vmcnt(0)" ::: "memory");
        }
    }
    __syncthreads();
}

struct Args { const float* in[28]; float* out; unsigned char* ws; int ph_lo, ph_hi, li, pad; };
struct Frame {
    LAS unsigned char* lds;
    volatile LAS unsigned* MISC;
    int tid, lane, wave, G, blk, gw, ngw;
    const Args* A;
};
#define IN_F(F, i) ((F).A->in[i])
#define x_        IN_F(F, 0)
#define c_        IN_F(F, 1)
#define ctx_      IN_F(F, 2)
#define c_ctx_    IN_F(F, 3)
#define w_ada_    IN_F(F, 4)
#define b_ada_    IN_F(F, 5)
#define g_mix_    IN_F(F, 6)
#define w_in_     IN_F(F, 7)
#define na_q_norm_ IN_F(F, 8)
#define na_k_norm_ IN_F(F, 9)
#define na_rpb_   IN_F(F, 10)
#define mla_q_a_norm_ IN_F(F, 11)
#define mla_w_q_b_ IN_F(F, 12)
#define mla_kv_a_norm_ IN_F(F, 13)
#define mla_w_kv_b_ IN_F(F, 14)
#define mla_q_norm_ IN_F(F, 15)
#define mla_k_norm_ IN_F(F, 16)
#define gla_w_gate_ IN_F(F, 17)
#define gla_b_gate_ IN_F(F, 18)
#define gla_o_norm_ IN_F(F, 19)
#define w_out_    IN_F(F, 20)
#define g_ffn_    IN_F(F, 21)
#define w_router_ IN_F(F, 22)
#define b_router_ IN_F(F, 23)
#define w_moe1_   IN_F(F, 24)
#define b_moe1_   IN_F(F, 25)
#define w_moe2_   IN_F(F, 26)
#define b_moe2_   IN_F(F, 27)
#define out_      ((F).A->out)
#define WSP(F, T, off) ((T*)((F).A->ws + (off)))
#define MOD_  WSP(F, float, WS_MOD)
#define XU_   WSP(F, bf16, WS_XU)
#define EGF_  WSP(F, bf16, WS_EGF)
#define EGB_  WSP(F, bf16, WS_EGB)
#define GQ_   WSP(F, float, WS_GQ)
#define GK_   WSP(F, float, WS_GK)
#define GV_   WSP(F, float, WS_GV)
#define CS_   WSP(F, float, WS_CS)
#define AD_   WSP(F, float, WS_AD)
#define OGF_  WSP(F, float, WS_OGF)
#define OGB_  WSP(F, float, WS_OGB)
#define TOPG_ WSP(F, float, WS_TOPG)
#define WSM_  WSP(F, bf16, WS_WSM)
#define WIN_  WSP(F, bf16, WS_WIN)
#define WOUT_ WSP(F, bf16, WS_WOUT)
#define W1_   WSP(F, bf16, WS_W1)
#define W2_   WSP(F, bf16, WS_W2)
#define H_    WSP(F, bf16, WS_H)
#define ATT_  WSP(F, bf16, WS_ATT)
#define Z_    WSP(F, bf16, WS_Z)
#define Z8_   WSP(F, unsigned char, WS_Z8)
#define Y_    WSP(F, bf16, WS_Y)
#define NAQ_  WSP(F, bf16, WS_NAQ)
#define NAK_  WSP(F, bf16, WS_NAK)
#define NAVT_ WSP(F, bf16, WS_NAVT)
#define MQ_   WSP(F, bf16, WS_MQ)
#define MK_   WSP(F, bf16, WS_MK)
#define MV_   WSP(F, bf16, WS_MV)
#define XS_   WSP(F, bf16, WS_XS)
#define ACT_  WSP(F, bf16, WS_ACT)
#define TOPE_ WSP(F, int, WS_TOPE)
#define DEST_ WSP(F, int, WS_DEST)
#define ROWMAP_ WSP(F, int, WS_GQ)
#define HISTB_ WSP(F, int, WS_HIST)
#define WHIST_ WSP(F, int, WS_HIST + 65536)

struct DenseOrder {
    int nMa, nN, G, c, skipctx, rep;
    __device__ __forceinline__ bool next(int i, pg8::Unit& u) const {
        const int x = c & 7, y = c >> 3, Y = G >> 3;
        if (rep > 1) i >>= 1;
        const int j = i * Y + y; const int mg = j / nN, pn = j - mg * nN, a = mg * 8 + x;
        if (a >= nMa) return false;
        u.pm = skipctx ? (a >> 3) * 9 + (a & 7) : a; u.pn = pn; u.pb = pn; u.pa = u.pm; return true;
    }
};
struct MoeOrder {
    const volatile LAS int* ts; const volatile LAS unsigned char* te; int nN, G, c, rep;
    __device__ __forceinline__ bool next(int i, pg8::Unit& u) const {
        const int x = c & 7, y = c >> 3, Y = G >> 3;
        const int i0 = i; if (rep > 1) i >>= 1;
        const int j = i * Y + y; const int mg = j / nN, pn = j - mg * nN, a = mg * 8 + x;
        if (a >= ts[NEXP]) return false;
        const int e = te[a]; u.pm = a; u.pn = pn; u.pb = e * nN + pn; u.pa = a;
        if (NREP(19) > 1 && rep > 1 && !(i0 & 1)) { const int a2 = (a + 296) % ts[NEXP]; u.pa = a2; u.pb = te[a2] * nN + pn; }
        return true;
    }
};

struct EpiNoPre { };
template <bool SCALED> struct EpiBf16PlainT {
    static constexpr bool PERM = true; typedef EpiNoPre Pre;
    bf16* O; int ldc;
    __device__ __forceinline__ Pre prefetch(const pg8::Unit&, int, int) const { return Pre{}; }
    __device__ __forceinline__ void operator()(const f32x4 (&acc)[2][2][4][2], const pg8::Unit& u, int wr, int wc, int fr, int fq, const Pre&) const {
        const int row0 = u.pm * 256 + wr * 64 + fr, col0 = u.pn * 256 + wc * 32 + 8 * fq;
#pragma unroll
        for (int ai = 0; ai < 2; ++ai)
#pragma unroll
            for (int m = 0; m < 4; ++m) { bf16* rowp = O + (size_t)(row0 + ai * 128 + m * 16) * ldc + col0;
#pragma unroll
                for (int bj = 0; bj < 2; ++bj) { f32x4 v0 = acc[ai][bj][m][0], v1 = acc[ai][bj][m][1];
                    if constexpr (SCALED) { v0 = v0 * (1.0f / (SC_W * SC_X)); v1 = v1 * (1.0f / (SC_W * SC_X)); }
                    u32x4 w; w.x = pg8::cvt_pk_bf16(v0[0], v0[1]); w.y = pg8::cvt_pk_bf16(v0[2], v0[3]); w.z = pg8::cvt_pk_bf16(v1[0], v1[1]); w.w = pg8::cvt_pk_bf16(v1[2], v1[3]);
                    *(u32x4*)(rowp + bj * 128) = w; } }
    }
};
typedef EpiBf16PlainT<false> EpiBf16Plain;
struct EpiZ {
    static constexpr bool PERM = true; typedef EpiNoPre Pre;
    bf16* O; unsigned char* O8;
    __device__ __forceinline__ Pre prefetch(const pg8::Unit&, int, int) const { return Pre{}; }
    __device__ __forceinline__ void operator()(const f32x4 (&acc)[2][2][4][2], const pg8::Unit& u, int wr, int wc, int fr, int fq, const Pre&) const {
        const int row0 = u.pm * 256 + wr * 64 + fr, col0 = u.pn * 256 + wc * 32 + 8 * fq;
        if (u.pn < 3) {
#pragma unroll
            for (int ai = 0; ai < 2; ++ai)
#pragma unroll
                for (int m = 0; m < 4; ++m) { unsigned char* rowp = O8 + (size_t)(row0 + ai * 128 + m * 16) * 768 + col0;
#pragma unroll
                    for (int bj = 0; bj < 2; ++bj) { const f32x4 v0 = acc[ai][bj][m][0] * (SC_YC / (SC_W * SC_X)), v1 = acc[ai][bj][m][1] * (SC_YC / (SC_W * SC_X));
                        u32x2 w; w.x = pk4f8(v0[0], v0[1], v0[2], v0[3]); w.y = pk4f8(v1[0], v1[1], v1[2], v1[3]); *(u32x2*)(rowp + bj * 128) = w; } }
        } else {
#pragma unroll
            for (int ai = 0; ai < 2; ++ai)
#pragma unroll
                for (int m = 0; m < 4; ++m) { bf16* rowp = O + (size_t)(row0 + ai * 128 + m * 16) * ZC + col0;
#pragma unroll
                    for (int bj = 0; bj < 2; ++bj) { const f32x4 v0 = acc[ai][bj][m][0] * (1.0f / (SC_W * SC_X)), v1 = acc[ai][bj][m][1] * (1.0f / (SC_W * SC_X));
                        u32x4 w; w.x = pg8::cvt_pk_bf16(v0[0], v0[1]); w.y = pg8::cvt_pk_bf16(v0[2], v0[3]); w.z = pg8::cvt_pk_bf16(v1[0], v1[1]); w.w = pg8::cvt_pk_bf16(v1[2], v1[3]);
                        *(u32x4*)(rowp + bj * 128) = w; } }
        }
    }
};
struct EpiFp8Plain {
    static constexpr bool PERM = true; typedef EpiNoPre Pre;
    unsigned char* O; int ldc;
    __device__ __forceinline__ Pre prefetch(const pg8::Unit&, int, int) const { return Pre{}; }
    __device__ __forceinline__ void operator()(const f32x4 (&acc)[2][2][4][2], const pg8::Unit& u, int wr, int wc, int fr, int fq, const Pre&) const {
        const int row0 = u.pm * 256 + wr * 64 + fr, col0 = u.pn * 256 + wc * 32 + 8 * fq;
#pragma unroll
        for (int ai = 0; ai < 2; ++ai)
#pragma unroll
            for (int m = 0; m < 4; ++m) { unsigned char* rowp = O + (size_t)(row0 + ai * 128 + m * 16) * ldc + col0;
#pragma unroll
                for (int bj = 0; bj < 2; ++bj) { const f32x4 v0 = acc[ai][bj][m][0] * SC_YC, v1 = acc[ai][bj][m][1] * SC_YC;
                    u32x2 w; w.x = pk4f8(v0[0], v0[1], v0[2], v0[3]); w.y = pk4f8(v1[0], v1[1], v1[2], v1[3]); *(u32x2*)(rowp + bj * 128) = w; } }
    }
};
struct EpiResid {
    static constexpr bool PERM = true; typedef EpiNoPre Pre;
    bf16* X; const float* gt;
    const float* xin; const float* cin;
    __device__ __forceinline__ Pre prefetch(const pg8::Unit&, int, int) const { return Pre{}; }
    __device__ __forceinline__ void operator()(const f32x4 (&acc)[2][2][4][2], const pg8::Unit& u, int wr, int wc, int fr, int fq, const Pre&) const {
        const int row0 = u.pm * 256 + wr * 64 + fr, col0 = u.pn * 256 + wc * 32 + 8 * fq;
        const int bi = u.pm / 9, t9 = u.pm - bi * 9, mc = (t9 == 8) ? 16 : bi; const float* g = gt + mc * 6144 + col0;
        const float* base = xin ? (t9 == 8 ? cin + (size_t)bi * CTXL * DM : xin + ((size_t)bi * SEQ + t9 * 256) * DM) + (size_t)(wr * 64 + fr) * DM + col0 : nullptr;
        f32x4 gv[2][2];
#pragma unroll
        for (int bj = 0; bj < 2; ++bj)
#pragma unroll
            for (int n = 0; n < 2; ++n) gv[bj][n] = *(const f32x4*)(g + bj * 128 + 4 * n);
#pragma unroll
        for (int ai = 0; ai < 2; ++ai)
#pragma unroll
            for (int m = 0; m < 4; ++m) { bf16* rowp = X + (size_t)(row0 + ai * 128 + m * 16) * DM + col0;
#pragma unroll
                for (int bj = 0; bj < 2; ++bj) { f32x4 b0, b1;
                    if (xin) { const float* bp = base + (size_t)(ai * 128 + m * 16) * DM + bj * 128; b0 = *(const f32x4*)bp; b1 = *(const f32x4*)(bp + 4); }
                    else { const u32x4 w = *(const u32x4*)(rowp + bj * 128); u32x2 lo, hi; lo.x = w.x; lo.y = w.y; hi.x = w.z; hi.y = w.w; b0 = bf4f(lo); b1 = bf4f(hi); }
                    const f32x4 v0 = b0 + gv[bj][0] * acc[ai][bj][m][0], v1 = b1 + gv[bj][1] * acc[ai][bj][m][1];
                    u32x4 o; o.x = pg8::cvt_pk_bf16(v0[0], v0[1]); o.y = pg8::cvt_pk_bf16(v0[2], v0[3]); o.z = pg8::cvt_pk_bf16(v1[0], v1[1]); o.w = pg8::cvt_pk_bf16(v1[2], v1[3]);
                    *(u32x4*)(rowp + bj * 128) = o; } }
    }
};
struct EpiSwiglu {
    static constexpr bool PERM = true; struct Pre { f32x4 bg[2], bl[2]; };
    unsigned char* O; const float* b1;
    __device__ __forceinline__ Pre prefetch(const pg8::Unit& u, int wc, int fq) const { Pre p; const float* bb = b1 + (u.pb >> 3) * 2048 + u.pn * 128 + wc * 32 + 8 * fq;
#pragma unroll
        for (int n = 0; n < 2; ++n) { p.bg[n] = *(const f32x4*)(bb + 4 * n); p.bl[n] = *(const f32x4*)(bb + 1024 + 4 * n); }
        return p; }
    __device__ __forceinline__ void operator()(const f32x4 (&acc)[2][2][4][2], const pg8::Unit& u, int wr, int wc, int fr, int fq, const Pre& pre) const {
        const int row0 = u.pm * 256 + wr * 64 + fr, oc0 = u.pn * 128 + wc * 32 + 8 * fq;
        const f32x4 (&bg)[2] = pre.bg; const f32x4 (&bl)[2] = pre.bl;
        constexpr float S = 1.0f / (SC_W * SC_X);
#pragma unroll
        for (int ai = 0; ai < 2; ++ai)
#pragma unroll
            for (int m = 0; m < 4; ++m) { u32x2 w;
#pragma unroll
                for (int n = 0; n < 2; ++n) { f32x4 gl = acc[ai][0][m][n] * S + bg[n], li = acc[ai][1][m][n] * S + bl[n];
#pragma unroll
                    for (int i = 0; i < 4; ++i) { gl[i] = fminf(gl[i], 7.0f); li[i] = __builtin_amdgcn_fmed3f(li[i], -7.0f, 7.0f); }
                    f32x4 e = gl * (-1.702f * LOG2E);
#pragma unroll
                    for (int i = 0; i < 4; ++i) e[i] = __builtin_amdgcn_exp2f(e[i]);
                    e = e + 1.0f;
#pragma unroll
                    for (int i = 0; i < 4; ++i) e[i] = __builtin_amdgcn_rcpf(e[i]);
                    const f32x4 o = (li * SC_ACT + SC_ACT) * (gl * e);
                    int p = __builtin_amdgcn_cvt_pk_fp8_f32(o[0], o[1], 0, false); p = __builtin_amdgcn_cvt_pk_fp8_f32(o[2], o[3], p, true);
                    if (n == 0) w.x = (unsigned)p; else w.y = (unsigned)p; }
                *(u32x2*)(O + (size_t)(row0 + ai * 128 + m * 16) * DM + oc0) = w; }
    }
};
struct EpiFp8Bias {
    static constexpr bool PERM = true; struct Pre { f32x4 bv[2][2]; };
    unsigned char* O; const float* b2;
    __device__ __forceinline__ Pre prefetch(const pg8::Unit& u, int wc, int fq) const { Pre p; const float* bb = b2 + (u.pb >> 2) * 1024 + u.pn * 256 + wc * 32 + 8 * fq;
#pragma unroll
        for (int bj = 0; bj < 2; ++bj)
#pragma unroll
            for (int n = 0; n < 2; ++n) p.bv[bj][n] = *(const f32x4*)(bb + bj * 128 + 4 * n);
        return p; }
    __device__ __forceinline__ void operator()(const f32x4 (&acc)[2][2][4][2], const pg8::Unit& u, int wr, int wc, int fr, int fq, const Pre& pre) const {
        const int row0 = u.pm * 256 + wr * 64 + fr, col0 = u.pn * 256 + wc * 32 + 8 * fq;
        const f32x4 (&bv)[2][2] = pre.bv;
#pragma unroll
        for (int ai = 0; ai < 2; ++ai)
#pragma unroll
            for (int m = 0; m < 4; ++m) { unsigned char* rowp = O + (size_t)(row0 + ai * 128 + m * 16) * DM + col0;
#pragma unroll
                for (int bj = 0; bj < 2; ++bj) { const f32x4 v0 = acc[ai][bj][m][0] * (SC_Y / (SC_W * SC_ACT)) + bv[bj][0] * SC_Y, v1 = acc[ai][bj][m][1] * (SC_Y / (SC_W * SC_ACT)) + bv[bj][1] * SC_Y;
                    u32x2 w; w.x = pk4f8(v0[0], v0[1], v0[2], v0[3]); w.y = pk4f8(v1[0], v1[1], v1[2], v1[3]);
                    *(u32x2*)(rowp + bj * 128) = w; } }
    }
};

__device__ __forceinline__ void relane(Frame& F) { int ln_; asm volatile("v_mbcnt_lo_u32_b32 %0, -1, 0\n\tv_mbcnt_hi_u32_b32 %0, -1, %0" : "=v"(ln_)); ln_ &= 63; F.lane = ln_; F.tid = F.wave * 64 + ln_; }

__device__ __forceinline__ void tr_item(const float* src, int ldsrc, bool valid, const float* ksc, bf16* dst, int lddst, LAS float* scr, int lane) {
    float v[32];
#pragma unroll
    for (int i = 0; i < 32; ++i) { const int kk = 2 * i + (lane >> 5); v[i] = valid ? src[(size_t)kk * ldsrc + (lane & 31)] : 0.f; }
    if (valid && ksc) {
#pragma unroll
        for (int i = 0; i < 32; ++i) v[i] *= ksc[2 * i + (lane >> 5)];
    }
#pragma unroll
    for (int i = 0; i < 32; ++i) { const int kk = 2 * i + (lane >> 5); scr[kk * 33 + (lane & 31)] = v[i]; }
    LDS_WAIT(); asm volatile("" ::: "memory");
    const int c = lane & 7;
#pragma unroll
    for (int j = 0; j < 4; ++j) { const int n = (lane >> 3) + 8 * j; const LAS float* s = scr + (8 * c) * 33 + n;
        u32x4 o; o.x = pk2(s[0 * 33], s[1 * 33]); o.y = pk2(s[2 * 33], s[3 * 33]); o.z = pk2(s[4 * 33], s[5 * 33]); o.w = pk2(s[6 * 33], s[7 * 33]);
        *(u32x4*)(dst + (size_t)n * lddst + 8 * c) = o; }
    LDS_WAIT(); asm volatile("" ::: "memory");
}
__device__ __forceinline__ void tr_item8(const float* src, int ldsrc, unsigned char* dst, int lddst, LAS float* scr, int lane) {
    float v[32];
#pragma unroll
    for (int i = 0; i < 32; ++i) { const int kk = 2 * i + (lane >> 5); v[i] = src[(size_t)kk * ldsrc + (lane & 31)] * SC_W; }
#pragma unroll
    for (int i = 0; i < 32; ++i) { const int kk = 2 * i + (lane >> 5); scr[kk * 33 + (lane & 31)] = v[i]; }
    LDS_WAIT(); asm volatile("" ::: "memory");
    const int c = lane & 7;
#pragma unroll
    for (int j = 0; j < 4; ++j) { const int n = (lane >> 3) + 8 * j; const LAS float* s = scr + (8 * c) * 33 + n;
        u32x2 o; o.x = pk4f8(s[0 * 33], s[1 * 33], s[2 * 33], s[3 * 33]); o.y = pk4f8(s[4 * 33], s[5 * 33], s[6 * 33], s[7 * 33]);
        *(u32x2*)(dst + (size_t)n * lddst + 8 * c) = o; }
    LDS_WAIT(); asm volatile("" ::: "memory");
}
__device__ __forceinline__ void tr_item8w(const float* src, int ldsrc, unsigned char* dst, LAS float* scr, int lane) {
    const int kr = lane >> 4, nc = (lane & 15) * 4;
    f32x4 v[16];
#pragma unroll
    for (int i = 0; i < 16; ++i) v[i] = *(const f32x4*)(src + (size_t)(4 * i + kr) * ldsrc + nc);
#pragma unroll
    for (int i = 0; i < 16; ++i) *(LAS f32x4*)(scr + (4 * i + kr) * 68 + nc) = v[i] * SC_W;
    LDS_WAIT(); asm volatile("" ::: "memory");
#pragma unroll
    for (int c = 0; c < 4; ++c) { const LAS float* s = scr + (16 * c) * 68 + lane; u32x4 o;
        o.x = pk4f8(s[0 * 68], s[1 * 68], s[2 * 68], s[3 * 68]); o.y = pk4f8(s[4 * 68], s[5 * 68], s[6 * 68], s[7 * 68]);
        o.z = pk4f8(s[8 * 68], s[9 * 68], s[10 * 68], s[11 * 68]); o.w = pk4f8(s[12 * 68], s[13 * 68], s[14 * 68], s[15 * 68]);
        *(u32x4*)(dst + (size_t)lane * 1024 + 16 * c) = o; }
    LDS_WAIT(); asm volatile("" ::: "memory");
}
__device__ __forceinline__ void p0_prologue(Frame& F) {
    for (int ch = F.blk; ch < 192; ch += F.G) {
        LAS float* s = (LAS float*)(F.lds + RING_OFF);
        LAS float* red = s + 17 * 1024;
        for (int idx = F.tid; idx < 17 * 1024; idx += 512) { const int m = idx >> 10, k = idx & 1023; const float cv = m < 16 ? c_[m * 1024 + k] : c_ctx_[k]; s[idx] = cv / (1.0f + __expf(-cv)); }
        __syncthreads();
        const int l = ch / 96, col0 = (ch % 96) * 64;
        const float* W = w_ada_ + (size_t)l * 1024 * 6144 + col0 + F.lane;
        float acc[17];
#pragma unroll
        for (int m = 0; m < 17; ++m) acc[m] = 0.f;
#pragma unroll 8
        for (int kk = 0; kk < 128; ++kk) { const int k = F.wave * 128 + kk; const float w = W[(size_t)k * 6144];
#pragma unroll
            for (int m = 0; m < 17; ++m) acc[m] += s[m * 1024 + k] * w; }
#pragma unroll
        for (int m = 0; m < 17; ++m) red[(F.wave * 17 + m) * 64 + F.lane] = acc[m];
        __syncthreads();
        for (int idx = F.tid; idx < 17 * 64; idx += 512) { const int m = idx >> 6, cc = idx & 63; float a = b_ada_[l * 6144 + col0 + cc];
#pragma unroll
            for (int w = 0; w < 8; ++w) a += red[(w * 17 + m) * 64 + cc];
            MOD_[((size_t)l * 17 + m) * 6144 + col0 + cc] = a; }
        __syncthreads();
    }
    LAS float* scr = (LAS float*)(F.lds + RING_OFF + F.wave * 17408);
    constexpr int IT_W1 = 64 * 512, IT_W2 = 64 * 256, IT_WIN = 2 * 512, IT_WOUT = 2 * 512, IT_SM = 2 * 240;
    static_assert(8 * 17408 <= MISC_OFF, "prologue LDS tiles");
    constexpr int NIT = IT_W1 + IT_W2 + IT_WIN + IT_WOUT + IT_SM;
    for (int it = IT_W1 + IT_W2 + F.gw; it < NIT; it += F.ngw) {
        int r = it;
        if (r < IT_W1) { const int le = r >> 9, q = r & 511, kb = q >> 5, nb = q & 31, n0 = nb * 64, pn = n0 >> 8, j = n0 & 255; const int sc = j < 128 ? 128 * pn + j : 1024 + 128 * pn + (j - 128);
            tr_item8w(w_moe1_ + ((size_t)le * 1024 + kb * 64) * 2048 + sc, 2048, (unsigned char*)W1_ + ((size_t)le * 2048 + n0) * 1024 + kb * 64, scr, F.lane); continue; }
        r -= IT_W1;
        if (r < IT_W2) { const int le = r >> 8, q = r & 255, kb = q >> 4, nb = q & 15, n0 = nb * 64;
            tr_item8w(w_moe2_ + ((size_t)le * 1024 + kb * 64) * 1024 + n0, 1024, (unsigned char*)W2_ + ((size_t)le * 1024 + n0) * 1024 + kb * 64, scr, F.lane); continue; }
        r -= IT_W2;
        if (r < IT_WIN) { const int l = r >> 9, q = r & 511, kb = q >> 5, nb = q & 31, n0 = nb * 64;
            unsigned char* dst = (unsigned char*)WIN_ + ((size_t)l * 2048 + n0) * 1024 + kb * 64;
            if (n0 < INC) tr_item8w(w_in_ + ((size_t)l * 1024 + kb * 64) * INC + n0, INC, dst, scr, F.lane);
            else { const u32x4 z = {0u, 0u, 0u, 0u};
#pragma unroll
                for (int c = 0; c < 4; ++c) *(u32x4*)(dst + (size_t)F.lane * 1024 + 16 * c) = z; }
            continue; }
        r -= IT_WIN;
        if (r < IT_WOUT) { const int l = r >> 9, q = r & 511, kb = q >> 5, nb = q & 31, n0 = nb * 32;
            tr_item(w_out_ + ((size_t)l * 1024 + kb * 64) * 1024 + n0, 1024, true, nullptr, WOUT_ + ((size_t)l * 1024 + n0) * 1024 + kb * 64, 1024, scr, F.lane); continue; }
        r -= IT_WOUT;
        { const int l = r / 240, q = r - l * 240, kb = q / 40, nb = q - kb * 40, n0 = nb * 32, k0 = kb * 64;
            bf16* dst = WSM_ + ((size_t)l * 1280 + n0) * 384 + k0;
            if (n0 < 384) tr_item(mla_w_q_b_ + ((size_t)l * 256 + (k0 & 255)) * 384 + n0, 384, k0 < 256, mla_q_a_norm_ + l * 256 + (k0 & 255), dst, 384, scr, F.lane);
            else if (n0 < 1152) tr_item(mla_w_kv_b_ + ((size_t)l * 128 + ((k0 - 256) & 127)) * 768 + (n0 - 384), 768, k0 >= 256, mla_kv_a_norm_ + l * 128 + ((k0 - 256) & 127), dst, 384, scr, F.lane);
            else tr_item(w_out_, 1024, false, nullptr, dst, 384, scr, F.lane); }
    }
    __syncthreads();
}

__device__ __forceinline__ void norm_mod_store(const f32x4 (&v)[4], float rstd, const float* g, const float* sc, const float* sh, unsigned char* orow  , int lane) {
#pragma unroll
    for (int j = 0; j < 4; ++j) { const int col = 256 * j + 4 * lane; const f32x4 gg = *(const f32x4*)(g + col), s1 = *(const f32x4*)(sc + col), s0 = *(const f32x4*)(sh + col);
        const f32x4 h = (v[j] * rstd * gg * (s1 + 1.0f) + s0) * SC_X; *(unsigned*)(orow + col) = pk4f8(h[0], h[1], h[2], h[3]); }
}
__device__ __forceinline__ float sumsq4(const f32x4 (&v)[4]) { float s = 0.f;
#pragma unroll
    for (int j = 0; j < 4; ++j) s += (v[j][0] * v[j][0] + v[j][1] * v[j][1]) + (v[j][2] * v[j][2] + v[j][3] * v[j][3]);
    return s; }

__device__ __forceinline__ const float* pA_src(Frame& F, int row) { const int b = row / TPB, p = row - b * TPB; return p < SEQ ? x_ + ((size_t)b * SEQ + p) * DM : ctx_ + ((size_t)b * CTXL + (p - SEQ)) * DM; }
__device__ __forceinline__ void pA_init(Frame& F) {
    const int lane = F.lane, step = F.ngw;
    int row = F.gw; if (row >= MROWS) return;
    f32x4 gm[4];
#pragma unroll
    for (int j = 0; j < 4; ++j) gm[j] = *(const f32x4*)(g_mix_ + 256 * j + 4 * lane);
    auto load = [&](f32x4 (&v)[4], int r) __attribute__((always_inline)) { const float* src = pA_src(F, r);
#pragma unroll
        for (int j = 0; j < 4; ++j) v[j] = *(const f32x4*)(src + 256 * j + 4 * lane); };
    auto one = [&](const f32x4 (&v)[4], int r) __attribute__((always_inline)) {
        const int b = r / TPB, p = r - b * TPB; const int mc = p < SEQ ? b : 16; const float* mod = MOD_ + (size_t)mc * 6144;
        f32x4 s1[4], s0[4];
#pragma unroll
        for (int j = 0; j < 4; ++j) { s1[j] = *(const f32x4*)(mod + 1024 + 256 * j + 4 * lane); s0[j] = *(const f32x4*)(mod + 256 * j + 4 * lane); }
        const float rstd = rsq(wave_sum(sumsq4(v)) * (1.0f / DM) + EPS);
        unsigned char* orow = (unsigned char*)H_ + (size_t)r * DM;
#pragma unroll
        for (int j = 0; j < 4; ++j) { const f32x4 h = (v[j] * rstd * gm[j] * (s1[j] + 1.0f) + s0[j]) * SC_X; *(unsigned*)(orow + 256 * j + 4 * lane) = pk4f8(h[0], h[1], h[2], h[3]); }
    };
    f32x4 A[4], B[4]; load(A, row);
    for (; row < MROWS; row += 2 * step) {
        if (row + step < MROWS) load(B, row + step);
        one(A, row);
        if (row + step >= MROWS) break;
        if (row + 2 * step < MROWS) load(A, row + 2 * step);
        one(B, row + step);
    }
}

__device__ __forceinline__ float logsigmoid(float x) { return fminf(x, 0.f) - __logf(1.0f + __expf(-fabsf(x))); }
__device__ __forceinline__ void up4(const u32x2 w, float (&f)[4]) { f[0] = __uint_as_float(w.x << 16); f[1] = __uint_as_float(w.x & 0xffff0000u); f[2] = __uint_as_float(w.y << 16); f[3] = __uint_as_float(w.y & 0xffff0000u); }
__device__ __forceinline__ void up4f8(unsigned w, float (&f)[4]) { f[0] = __builtin_amdgcn_cvt_f32_fp8((int)w, 0); f[1] = __builtin_amdgcn_cvt_f32_fp8((int)w, 1); f[2] = __builtin_amdgcn_cvt_f32_fp8((int)w, 2); f[3] = __builtin_amdgcn_cvt_f32_fp8((int)w, 3); }
__device__ __forceinline__ float f8f(unsigned char b) { return __builtin_amdgcn_cvt_f32_fp8((int)b, 0); }
struct DIn { u32x2 cq, ckv, yv; unsigned naq, nak, nav, yq, yk; u32x4 lf0, lf1, lb0, lb1; bf16 kr0, kr1; unsigned char yq0, yq1; };
__device__ __forceinline__ void pD_load(Frame& F, DIn& d, int row, int lane) {
    const int c4 = 4 * lane, hh = lane >> 4, jj = lane & 15, ra = jj >> 3, j8 = jj & 7, ri = 64 + ra * 16 + j8;
    const bf16* z = Z_ + (size_t)row * ZC; const unsigned char* y = (const unsigned char*)Y_ + (size_t)row * YC; const u32x2 zero2 = {0u, 0u};
    const unsigned char* z8 = Z8_ + (size_t)row * 768;
    d.naq = *(const unsigned*)(z8 + Z_NAQ + c4); d.nak = *(const unsigned*)(z8 + Z_NAK + c4); d.nav = *(const unsigned*)(z8 + Z_NAV + c4); d.cq = *(const u32x2*)(z + Z_CQ + c4);
    d.ckv = lane < 32 ? *(const u32x2*)(z + Z_CKV + c4) : zero2;
    d.lf0 = *(const u32x4*)(z + Z_LF); d.lf1 = *(const u32x4*)(z + Z_LF + 8); d.lb0 = *(const u32x4*)(z + Z_LB); d.lb1 = *(const u32x4*)(z + Z_LB + 8);
    d.kr0 = z[Z_KR + ra * 16 + j8]; d.kr1 = z[Z_KR + ra * 16 + j8 + 8];
    d.yq = *(const unsigned*)(y + hh * 96 + 4 * jj); d.yq0 = y[hh * 96 + ri]; d.yq1 = y[hh * 96 + ri + 8];
    d.yk = *(const unsigned*)(y + 384 + hh * 192 + 4 * jj); d.yv = *(const u32x2*)(y + 384 + hh * 192 + 64 + 8 * jj);
}
__device__ __forceinline__ int pD_row(const Frame& F, int g) { const int tile = min(F.blk + (g >> 2) * F.G, MROWS / 32 - 1); return tile * 32 + F.wave + 8 * (g & 3); }
__device__ __forceinline__ void pD_tokens(Frame& F, int l) {
    const int lane = F.lane, c4 = 4 * lane, hh = lane >> 4, jj = lane & 15, ra = jj >> 3, j8 = jj & 7;
    LAS float* wgs = (LAS float*)(F.lds + RING_OFF + 65536);
    for (int i = F.tid; i < 2 * 16 * 128; i += 512) wgs[i] = gla_w_gate_[(size_t)l * 2 * 16 * 128 + i];
    LDS_WAIT(); __syncthreads();
    typedef float f32x2v __attribute__((ext_vector_type(2)));
    const LAS float* wgl = wgs + 2 * lane;
    const float bgf0 = gla_b_gate_[(l * 2 + 0) * 128 + 2 * lane], bgf1 = gla_b_gate_[(l * 2 + 0) * 128 + 2 * lane + 1];
    const float bgb0 = gla_b_gate_[(l * 2 + 1) * 128 + 2 * lane], bgb1 = gla_b_gate_[(l * 2 + 1) * 128 + 2 * lane + 1];
    const float inv = exp2f(-(float)j8 * 1.6609640474436813f);
    const float* qn_g = na_q_norm_ + l * 64 + (c4 & 63); const float* kn_g = na_k_norm_ + l * 64 + (c4 & 63);
    const float* mq_g = mla_q_norm_ + l * 96; const float* mk_g = mla_k_norm_ + l * 96;
    const int ri = 64 + ra * 16 + j8;
    const float qg0 = qn_g[0], qg1 = qn_g[1], qg2 = qn_g[2], qg3 = qn_g[3], kg0 = kn_g[0], kg1 = kn_g[1], kg2 = kn_g[2], kg3 = kn_g[3];
    const float mqn0 = mq_g[4 * jj], mqn1 = mq_g[4 * jj + 1], mqn2 = mq_g[4 * jj + 2], mqn3 = mq_g[4 * jj + 3], mqr0 = mq_g[ri], mqr1 = mq_g[ri + 8];
    const float mkn0 = mk_g[4 * jj], mkn1 = mk_g[4 * jj + 1], mkn2 = mk_g[4 * jj + 2], mkn3 = mk_g[4 * jj + 3], mkr0 = mk_g[ri], mkr1 = mk_g[ri + 8];
    LAS unsigned char* vt = F.lds + RING_OFF;
    const int ntok = 4 * ((MROWS / 32 - F.blk + F.G - 1) / F.G);
    auto one = [&](const DIn& cur, const int g) __attribute__((always_inline)) {
        {
            const int tile = F.blk + (g >> 2) * F.G, it = g & 3, b = tile / 72, p0 = (tile - b * 72) * 32;
            const int tl = F.wave + 8 * it, row = tile * 32 + tl, p = p0 + tl; const bool lat = p < SEQ;
            float f[4];
            { up4f8(cur.naq, f); const float r = rsq(g16_sum(f[0] * f[0] + f[1] * f[1] + f[2] * f[2] + f[3] * f[3]) * (1.0f / (64 * SC_YC * SC_YC)) + EPS) * (QS_NA / SC_YC);
              st4bf(NAQ_ + (size_t)row * 256 + c4, f[0] * r * qg0, f[1] * r * qg1, f[2] * r * qg2, f[3] * r * qg3); }
            { up4f8(cur.nak, f); const float r = rsq(g16_sum(f[0] * f[0] + f[1] * f[1] + f[2] * f[2] + f[3] * f[3]) * (1.0f / (64 * SC_YC * SC_YC)) + EPS) * (1.0f / SC_YC);
              st4bf(NAK_ + (size_t)row * 256 + c4, f[0] * r * kg0, f[1] * r * kg1, f[2] * r * kg2, f[3] * r * kg3); }
            { up4f8(cur.nav, f); u32x2 w; w.x = pk2(f[0] * (1.0f / SC_YC), f[1] * (1.0f / SC_YC)); w.y = pk2(f[2] * (1.0f / SC_YC), f[3] * (1.0f / SC_YC)); *(LAS u32x2*)(vt + tl * VT_PITCH + c4 * 2) = w; }
            up4(cur.cq, f); const float rq = rsq(wave_sum(f[0] * f[0] + f[1] * f[1] + f[2] * f[2] + f[3] * f[3]) * (1.0f / 256) + EPS);
            up4(cur.ckv, f); const float rkv = rsq(wave_sum(f[0] * f[0] + f[1] * f[1] + f[2] * f[2] + f[3] * f[3]) * (1.0f / 128) + EPS);
            const float ang = lat ? (float)(ra == 0 ? (p >> 6) : (p & 63)) * inv : 0.f;
            const float cs = __cosf(ang), sn = __sinf(ang);
            const float rqy = rq * (1.0f / SC_YC), rkvy = rkv * (1.0f / SC_YC);
            { up4f8(cur.yq, f); float a0 = f8f(cur.yq0) * rqy, a1 = f8f(cur.yq1) * rqy;
#pragma unroll
              for (int i = 0; i < 4; ++i) f[i] *= rqy;
              const float r = rsq(g16_sum(f[0] * f[0] + f[1] * f[1] + f[2] * f[2] + f[3] * f[3] + a0 * a0 + a1 * a1) * (1.0f / 96) + EPS);
              a0 *= r * mqr0; a1 *= r * mqr1;
              bf16* o = MQ_ + (size_t)row * 384 + hh * 96;
              st4bf(o + 4 * jj, f[0] * r * mqn0, f[1] * r * mqn1, f[2] * r * mqn2, f[3] * r * mqn3);
              o[ri] = (bf16)f2bf(a0 * cs - a1 * sn); o[ri + 8] = (bf16)f2bf(a1 * cs + a0 * sn); }
            { up4f8(cur.yk, f); float a0 = bf2f(cur.kr0), a1 = bf2f(cur.kr1);
#pragma unroll
              for (int i = 0; i < 4; ++i) f[i] *= rkvy;
              const float r = rsq(g16_sum(f[0] * f[0] + f[1] * f[1] + f[2] * f[2] + f[3] * f[3] + a0 * a0 + a1 * a1) * (1.0f / 96) + EPS);
              a0 *= r * mkr0; a1 *= r * mkr1;
              bf16* o = MK_ + (size_t)row * 384 + hh * 96;
              st4bf(o + 4 * jj, f[0] * r * mkn0, f[1] * r * mkn1, f[2] * r * mkn2, f[3] * r * mkn3);
              o[ri] = (bf16)f2bf(a0 * cs - a1 * sn); o[ri + 8] = (bf16)f2bf(a1 * cs + a0 * sn); }
            { float g[4]; up4f8(cur.yv.x, f); up4f8(cur.yv.y, g);
              u32x4 w; w.x = pk2(f[0] * rkvy, f[1] * rkvy); w.y = pk2(f[2] * rkvy, f[3] * rkvy); w.z = pk2(g[0] * rkvy, g[1] * rkvy); w.w = pk2(g[2] * rkvy, g[3] * rkvy);
              *(u32x4*)(MV_ + (size_t)row * 512 + hh * 128 + 8 * jj) = w; }
            { float xf0 = bgf0, xf1 = bgf1, xb0 = bgb0, xb1 = bgb1;
              const unsigned lfw[8] = {cur.lf0.x, cur.lf0.y, cur.lf0.z, cur.lf0.w, cur.lf1.x, cur.lf1.y, cur.lf1.z, cur.lf1.w};
              const unsigned lbw[8] = {cur.lb0.x, cur.lb0.y, cur.lb0.z, cur.lb0.w, cur.lb1.x, cur.lb1.y, cur.lb1.z, cur.lb1.w};
#pragma unroll
              for (int k2 = 0; k2 < 8; ++k2) { const float a0 = __uint_as_float(lfw[k2] << 16), a1 = __uint_as_float(lfw[k2] & 0xffff0000u), b0 = __uint_as_float(lbw[k2] << 16), b1 = __uint_as_float(lbw[k2] & 0xffff0000u);
                  const f32x2v wf0 = *(const LAS f32x2v*)(wgl + (2 * k2) * 128), wf1 = *(const LAS f32x2v*)(wgl + (2 * k2 + 1) * 128), wb0 = *(const LAS f32x2v*)(wgl + (16 + 2 * k2) * 128), wb1 = *(const LAS f32x2v*)(wgl + (17 + 2 * k2) * 128);
                  xf0 += a0 * wf0.x + a1 * wf1.x; xf1 += a0 * wf0.y + a1 * wf1.y; xb0 += b0 * wb0.x + b1 * wb1.x; xb1 += b0 * wb0.y + b1 * wb1.y; }
              *(unsigned*)(EGF_ + (size_t)row * 128 + 2 * lane) = pk2(logsigmoid(xf0) * (1.0f / 16), logsigmoid(xf1) * (1.0f / 16));
              *(unsigned*)(EGB_ + (size_t)row * 128 + 2 * lane) = pk2(logsigmoid(xb0) * (1.0f / 16), logsigmoid(xb1) * (1.0f / 16)); }
        }
        if ((g & 3) == 3) {
            const int tile = F.blk + (g >> 2) * F.G, b = tile / 72, p0 = (tile - b * 72) * 32;
            LDS_WAIT(); __syncthreads();
            for (int cI = 0; cI < 16; ++cI) { const int cc = F.wave * 32 + 2 * cI + (lane >> 5), tk = lane & 31; const bf16 val = *(const LAS bf16*)(vt + tk * VT_PITCH + cc * 2);
                NAVT_[((size_t)(b * 4 + (cc >> 6)) * 64 + (cc & 63)) * TPB + p0 + tk] = val; }
            LDS_WAIT(); __syncthreads();
        }
    };
    DIn b0, b1, b2;
    pD_load(F, b0, pD_row(F, 0), lane); pD_load(F, b1, pD_row(F, 1), lane);
    for (int g = 0; g < ntok; g += 3) {
        pD_load(F, b2, pD_row(F, g + 2), lane); one(b0, g);
        if (g + 1 < ntok) { pD_load(F, b0, pD_row(F, g + 3), lane); one(b1, g + 1); }
        if (g + 2 < ntok) { pD_load(F, b1, pD_row(F, g + 4), lane); one(b2, g + 2); }
    }
}

template <int DV> struct AttnSt { f32x4 o[DV / 16]; float m, l; };
#define MFMA16(a, b, c) __builtin_amdgcn_mfma_f32_16x16x32_bf16((a), (b), (c), 0, 0, 0)
template <int DQK, int DV> struct KvFrag { bf16x8 k0[DQK / 32], k1[DQK / 32]; u32x2 vlo[DV / 16], vhi[DV / 16]; };
template <int DQK, int DV, bool NA, bool FIXM, class RP = const float*>
__device__ __forceinline__ void attn_math32(AttnSt<DV>& st, const bf16x8 (&qf)[DQK / 32], const KvFrag<DQK, DV>& f, int q, RP rpbrow, int kcol0, int qc, int cs) {
    const float c0 = FIXM ? -st.m : 0.f;
    f32x4 s0 = (f32x4){c0, c0, c0, c0}, s1 = s0;
#pragma unroll
    for (int s = 0; s < DQK / 32; ++s) { s0 = MFMA16(f.k0[s], qf[s], s0); s1 = MFMA16(f.k1[s], qf[s], s1); }
    if constexpr (NA) {
        float bs[8];
#pragma unroll
        for (int i = 0; i < 4; ++i) { bs[i] = rpbrow[kcol0 + 4 * q - qc + 15 + i]; bs[4 + i] = rpbrow[kcol0 + 4 * q - qc + 31 + i]; }
#pragma unroll
        for (int i = 0; i < 4; ++i) {
            const int k0 = kcol0 + 4 * q + i, k1 = k0 + 16;
            const float t0 = s0[i] + bs[i], t1 = s1[i] + bs[4 + i];
            s0[i] = (k0 >= cs && k0 < cs + 16) ? t0 : -INFINITY;
            s1[i] = (k1 >= cs && k1 < cs + 16) ? t1 : -INFINITY;
        }
    }
    float p0[4], p1[4], ps = 0.f, al = 1.f;
    if constexpr (FIXM) {
#pragma unroll
        for (int i = 0; i < 4; ++i) { p0[i] = __builtin_amdgcn_exp2f(s0[i]); p1[i] = __builtin_amdgcn_exp2f(s1[i]); ps += p0[i] + p1[i]; }
        st.l += ps;
    } else {
        float mx = fmaxf(fmaxf(fmaxf(s0[0], s0[1]), fmaxf(s0[2], s0[3])), fmaxf(fmaxf(s1[0], s1[1]), fmaxf(s1[2], s1[3])));
        mx = q4_max(mx);
        const float mn = fmaxf(st.m, mx); al = __builtin_amdgcn_exp2f(st.m - mn); st.m = mn;
#pragma unroll
        for (int i = 0; i < 4; ++i) { p0[i] = __builtin_amdgcn_exp2f(s0[i] - mn); p1[i] = __builtin_amdgcn_exp2f(s1[i] - mn); ps += p0[i] + p1[i]; }
        st.l = st.l * al + ps;
    }
    u32x4 pw; pw.x = pg8::cvt_pk_bf16(p0[0], p0[1]); pw.y = pg8::cvt_pk_bf16(p0[2], p0[3]); pw.z = pg8::cvt_pk_bf16(p1[0], p1[1]); pw.w = pg8::cvt_pk_bf16(p1[2], p1[3]);
    const bf16x8 pf = __builtin_bit_cast(bf16x8, pw);
#pragma unroll
    for (int n = 0; n < DV / 16; ++n) {
        u32x4 aw; aw.x = f.vlo[n].x; aw.y = f.vlo[n].y; aw.z = f.vhi[n].x; aw.w = f.vhi[n].y;
        if constexpr (FIXM) st.o[n] = MFMA16(__builtin_bit_cast(bf16x8, aw), pf, st.o[n]); else st.o[n] = MFMA16(__builtin_bit_cast(bf16x8, aw), pf, st.o[n] * al);
    }
}
template <int DV> __device__ __forceinline__ void attn_init(AttnSt<DV>& st, float mfix  ) { st.m = mfix; st.l = 0.f;
#pragma unroll
    for (int n = 0; n < DV / 16; ++n) st.o[n] = (f32x4){0.f, 0.f, 0.f, 0.f}; }
template <int DV> __device__ __forceinline__ void attn_store(AttnSt<DV>& st, bf16* orow  , int q) {
    const float il = __builtin_amdgcn_rcpf(q4_sum(st.l));
#pragma unroll
    for (int n = 0; n < DV / 16; ++n) st4bf(orow + 16 * n + 4 * q, st.o[n][0] * il, st.o[n][1] * il, st.o[n][2] * il, st.o[n][3] * il);
}
constexpr int NA_TILE = 2 * 9216;
__device__ __forceinline__ void na_tile_load(Frame& F, u32x4 (&st)[2], int b, int h, int key0) {
    const int kr = F.tid >> 3, kc = (F.tid & 7) * 8;
    st[0] = *(const u32x4*)(NAK_ + ((size_t)b * TPB + key0 + kr) * 256 + h * 64 + kc);
    st[1] = *(const u32x4*)(NAVT_ + ((size_t)(b * 4 + h) * 64 + kr) * TPB + key0 + kc);
}
__device__ __forceinline__ void na_tile_write(Frame& F, const u32x4 (&st)[2], int buf) {
    const int kr = F.tid >> 3, kc = (F.tid & 7) * 8; LAS unsigned char* tb = F.lds + RING_OFF + buf * NA_TILE;
    *(LAS u32x4*)(tb + kr * 144 + kc * 2) = st[0]; *(LAS u32x4*)(tb + 9216 + kr * 144 + kc * 2) = st[1];
}
__device__ __forceinline__ void na_frag_lds(KvFrag<64, 64>& f, const LAS unsigned char* tb, int kl  , int r, int q) {
#pragma unroll
    for (int s = 0; s < 2; ++s) { f.k0[s] = *(const LAS bf16x8*)(tb + (kl + r) * 144 + 64 * s + 16 * q); f.k1[s] = *(const LAS bf16x8*)(tb + (kl + 16 + r) * 144 + 64 * s + 16 * q); }
#pragma unroll
    for (int n = 0; n < 4; ++n) { const LAS unsigned char* vr = tb + 9216 + (16 * n + r) * 144 + (kl + 4 * q) * 2; f.vlo[n] = *(const LAS u32x2*)vr; f.vhi[n] = *(const LAS u32x2*)(vr + 32); }
}
template <bool FIXM> __device__ __forceinline__ void na_block_unit(Frame& F, int l, int u, float mfix) {
    const int lane = F.lane, r = lane & 15, q = lane >> 4, rp = u & 7, h = (u >> 3) & 3, b = u >> 5;
    const int g0 = 4 * rp + 2 * (F.wave >> 2), cb = F.wave & 3;
    const size_t qrow = (size_t)b * TPB + g0 * 64 + cb * 16 + r;
    bf16x8 qa[2], qb[2];
#pragma unroll
    for (int s = 0; s < 2; ++s) { qa[s] = *(const bf16x8*)(NAQ_ + qrow * 256 + h * 64 + 32 * s + 8 * q); qb[s] = *(const bf16x8*)(NAQ_ + (qrow + 64) * 256 + h * 64 + 32 * s + 8 * q); }
    AttnSt<64> sa, sb2; attn_init(sa, FIXM ? mfix : -INFINITY); attn_init(sb2, FIXM ? mfix : -INFINITY);
    const int rsA = min(max(g0 - 4, 0), 24), rsB = min(max(g0 - 3, 0), 24), kb = min(max(cb * 16 - 8, 0), 32), qc = cb * 16 + r, cs = min(max(qc - 8, 0), 48);
    const int rs_lo = min(max(4 * rp - 4, 0), 24), rs_hi = min(max(4 * rp - 1, 0), 24), nloc = rs_hi + 8 - rs_lo, nst = nloc + 4;
    LAS float* rpbs = (LAS float*)(F.lds + RING_OFF + 2 * NA_TILE);
    for (int i = F.tid; i < 15 * 31; i += 512) rpbs[i] = na_rpb_[(size_t)(l * 4 + h) * 15 * 31 + i] * LOG2E;
    const LAS float* rpbA = rpbs + (7 - g0) * 31;
    u32x4 stg[2], stg1[2], stg2[2];
#define NA_KEY0(jj) ((jj) < nloc ? (rs_lo + (jj)) * 64 : SEQ + 64 * ((jj) - nloc))
    na_tile_load(F, stg, b, h, NA_KEY0(0)); na_tile_load(F, stg1, b, h, NA_KEY0(1)); na_tile_load(F, stg2, b, h, NA_KEY0(2));
    for (int j = 0; j < nst; ++j) {
        na_tile_write(F, stg, j & 1);
        LDS_WAIT(); __syncthreads();
        stg[0] = stg1[0]; stg[1] = stg1[1]; stg1[0] = stg2[0]; stg1[1] = stg2[1];
        if (j + 3 < nst) na_tile_load(F, stg2, b, h, NA_KEY0(j + 3));
        const LAS unsigned char* tb = F.lds + RING_OFF + (j & 1) * NA_TILE;
        KvFrag<64, 64> f;
        if (j < nloc) { const int kr = rs_lo + j; const bool inA = kr >= rsA && kr < rsA + 8, inB = kr >= rsB && kr < rsB + 8;
            if (inA || inB) { na_frag_lds(f, tb, kb, r, q);
                if (inA) attn_math32<64, 64, true, FIXM, const LAS float*>(sa, qa, f, q, rpbA + kr * 31, kb, qc, cs);
                if (inB) attn_math32<64, 64, true, FIXM, const LAS float*>(sb2, qb, f, q, rpbA + (kr - 1) * 31, kb, qc, cs); }
        } else {
            na_frag_lds(f, tb, 0, r, q); attn_math32<64, 64, false, FIXM>(sa, qa, f, q, nullptr, 0, 0, 0); attn_math32<64, 64, false, FIXM>(sb2, qb, f, q, nullptr, 0, 0, 0);
            na_frag_lds(f, tb, 32, r, q); attn_math32<64, 64, false, FIXM>(sa, qa, f, q, nullptr, 0, 0, 0); attn_math32<64, 64, false, FIXM>(sb2, qb, f, q, nullptr, 0, 0, 0);
        }
    }
    attn_store(sa, ATT_ + qrow * DM + h * 64, q); attn_store(sb2, ATT_ + (qrow + 64) * DM + h * 64, q);
    LDS_WAIT(); __syncthreads();
#undef NA_KEY0
}
template <bool FIXM> __device__ __forceinline__ void ctx_block_unit(Frame& F, int u, float mfix) {
    const int lane = F.lane, r = lane & 15, q = lane >> 4, h = u & 3, b = u >> 2;
    const size_t qrow0 = (size_t)b * TPB + SEQ + 32 * F.wave + r;
    bf16x8 qa[2], qb[2];
#pragma unroll
    for (int s = 0; s < 2; ++s) { qa[s] = *(const bf16x8*)(NAQ_ + qrow0 * 256 + h * 64 + 32 * s + 8 * q); qb[s] = *(const bf16x8*)(NAQ_ + (qrow0 + 16) * 256 + h * 64 + 32 * s + 8 * q); }
    AttnSt<64> sa, sb2; attn_init(sa, FIXM ? mfix : -INFINITY); attn_init(sb2, FIXM ? mfix : -INFINITY);
    u32x4 stg[2], stg1[2], stg2[2];
    na_tile_load(F, stg, b, h, SEQ); na_tile_load(F, stg1, b, h, SEQ + 64); na_tile_load(F, stg2, b, h, SEQ + 128);
    for (int j = 0; j < 4; ++j) {
        na_tile_write(F, stg, j & 1);
        LDS_WAIT(); __syncthreads();
        stg[0] = stg1[0]; stg[1] = stg1[1]; stg1[0] = stg2[0]; stg1[1] = stg2[1];
        if (j == 0) na_tile_load(F, stg2, b, h, SEQ + 192);
        const LAS unsigned char* tb = F.lds + RING_OFF + (j & 1) * NA_TILE;
        KvFrag<64, 64> f;
        na_frag_lds(f, tb, 0, r, q); attn_math32<64, 64, false, FIXM>(sa, qa, f, q, nullptr, 0, 0, 0); attn_math32<64, 64, false, FIXM>(sb2, qb, f, q, nullptr, 0, 0, 0);
        na_frag_lds(f, tb, 32, r, q); attn_math32<64, 64, false, FIXM>(sa, qa, f, q, nullptr, 0, 0, 0); attn_math32<64, 64, false, FIXM>(sb2, qb, f, q, nullptr, 0, 0, 0);
    }
    attn_store(sa, ATT_ + qrow0 * DM + h * 64, q); attn_store(sb2, ATT_ + (qrow0 + 16) * DM + h * 64, q);
    LDS_WAIT(); __syncthreads();
}

struct BgConv { int next; unsigned char* pend; };
constexpr int BG_G1 = NEXP * 32 * 16, BG_G2 = NEXP * 16 * 16, BG_NG = BG_G1 + BG_G2;
constexpr int BG_LDS = 69632;
static_assert(BG_LDS + 8 * 8192 <= MISC_OFF, "background slots");
__device__ __forceinline__ void bg_issue(Frame& F, int l, BgConv& bg, int lane) {
    const int G = F.gw + (bg.next >> 1) * F.ngw, sub = bg.next & 1;
    if (G >= BG_NG) return;
    ++bg.next;
    const float* src; int ld;
    if (G < BG_G1) { const int le = G >> 9, q = G & 511, k0 = (q >> 5) * 64 + sub * 32, nb = q & 31, n0 = nb * 64, pn = n0 >> 8, j = n0 & 255; const int sc = j < 128 ? 128 * pn + j : 1024 + 128 * pn + (j - 128);
        src = w_moe1_ + ((size_t)(l * NEXP + le) * 1024 + k0 + (lane >> 4)) * 2048 + sc + (lane & 15) * 4; ld = 2048;
        bg.pend = (unsigned char*)W1_ + ((size_t)(l * NEXP + le) * 2048 + n0 + lane) * 1024 + k0; }
    else { const int G2 = G - BG_G1, le = G2 >> 8, q = G2 & 255, k0 = (q >> 4) * 64 + sub * 32, nb = q & 15, n0 = nb * 64;
        src = w_moe2_ + ((size_t)(l * NEXP + le) * 1024 + k0 + (lane >> 4)) * 1024 + n0 + (lane & 15) * 4; ld = 1024;
        bg.pend = (unsigned char*)W2_ + ((size_t)(l * NEXP + le) * 1024 + n0 + lane) * 1024 + k0; }
    LAS unsigned char* lb = F.lds + RING_OFF + BG_LDS + F.wave * 8192;
#pragma unroll
    for (int i = 0; i < 8; ++i) __builtin_amdgcn_global_load_lds((const unsigned*)(src + (size_t)(4 * i) * ld), (LAS unsigned*)(lb + i * 1024), 16, 0, 0);
}
__device__ __forceinline__ void bg_finish(Frame& F, BgConv& bg, int lane) {
    if (!bg.pend) return;
    const LAS float* lb = (const LAS float*)(F.lds + RING_OFF + BG_LDS + F.wave * 8192) + lane;
#pragma unroll
    for (int h = 0; h < 2; ++h) { float v[16];
#pragma unroll
        for (int i = 0; i < 16; ++i) v[i] = lb[(16 * h + i) * 64] * SC_W;
        u32x4 o; o.x = pk4f8(v[0], v[1], v[2], v[3]); o.y = pk4f8(v[4], v[5], v[6], v[7]); o.z = pk4f8(v[8], v[9], v[10], v[11]); o.w = pk4f8(v[12], v[13], v[14], v[15]);
        *(u32x4*)(bg.pend + 16 * h) = o; }
    bg.pend = nullptr;
    LDS_WAIT(); __builtin_amdgcn_sched_barrier(0);
}
__device__ __forceinline__ void bg_drain(Frame& F, int l, BgConv& bg) {
    for (;;) { VM_WAIT(); bg_finish(F, bg, F.lane); bg_issue(F, l, bg, F.lane); if (!bg.pend) break; }
}

namespace fa {
constexpr int   D = 128, NW = 8, QBLK = 32, KVBLK = 64;
constexpr float SCALE = 0.10206207261596575f;
constexpr float THR = 8.f;
constexpr int   SDEPTH = 2;
constexpr int   DQK = 96, LDQ = 384, LDKK = 384, LDK = 512, LDO = 1024;
constexpr size_t SHM_V = KVBLK * D * 2, SHM_K = KVBLK * D * 2, SHM_ATTN = 2 * SHM_V + 2 * SHM_K + NW * 64 * 4;
using s16x4  = __attribute__((ext_vector_type(4))) short;
using f32x16 = __attribute__((ext_vector_type(16))) float;
#define KSWZ(row, colB) ((row) * 256 + ((colB) ^ (((row) & 7) << 4)))
#define SBAR() __builtin_amdgcn_sched_barrier(0)
__device__ __forceinline__ int crow(int r, int hi) { return (r & 3) + 8 * (r >> 2) + 4 * hi; }
__device__ __forceinline__ unsigned cvtpk(float lo, float hi) { unsigned r; asm volatile("v_cvt_pk_bf16_f32 %0, %1, %2" : "=v"(r) : "v"(lo), "v"(hi)); return r; }
__device__ __forceinline__ void partialSM(f32x16& p0, f32x16& p1, float& m_reg, float& mn, float& alpha) {
  constexpr float C = SCALE * 1.4426950408889634f;
  float pmax = p0[0]; for (int r = 1; r < 16; ++r) pmax = fmaxf(pmax, p0[r]); for (int r = 0; r < 16; ++r) pmax = fmaxf(pmax, p1[r]);
  { auto rr = __builtin_amdgcn_permlane32_swap(__float_as_uint(pmax), __float_as_uint(pmax), false, false);
    pmax = fmaxf(__uint_as_float(rr[0]), __uint_as_float(rr[1])); }
  if (__builtin_expect(__all(pmax - m_reg <= THR / SCALE), 1)) { mn = m_reg; alpha = 1.f; }
  else { mn = fmaxf(m_reg, pmax); alpha = __builtin_amdgcn_exp2f((m_reg - mn) * C); m_reg = mn; }
  float mnC = -mn * C;
  for (int r = 0; r < 16; ++r) p0[r] = fmaf(p0[r], C, mnC); for (int r = 0; r < 16; ++r) p1[r] = fmaf(p1[r], C, mnC);
  for (int r = 0; r < 16; ++r) p0[r] = __builtin_amdgcn_exp2f(p0[r]);
}
__device__ __forceinline__ void finishSM(f32x16& p0, f32x16& p1, float alpha, float& l_reg, bf16x8& pa0, bf16x8& pa1, bf16x8& pa2, bf16x8& pa3) {
  for (int r = 0; r < 16; ++r) p1[r] = __builtin_amdgcn_exp2f(p1[r]);
  float ps = 0; for (int r = 0; r < 16; ++r) ps += p0[r]; for (int r = 0; r < 16; ++r) ps += p1[r];
  { auto rr = __builtin_amdgcn_permlane32_swap(__float_as_uint(ps), __float_as_uint(ps), false, false);
    ps = __uint_as_float(rr[0]) + __uint_as_float(rr[1]); }
  l_reg = l_reg * alpha + ps;
#define PK4(P, BASE, OUT) do { unsigned a0 = cvtpk(P[BASE + 0], P[BASE + 1]), a1 = cvtpk(P[BASE + 2], P[BASE + 3]);   \
    unsigned b0 = cvtpk(P[BASE + 4], P[BASE + 5]), b1 = cvtpk(P[BASE + 6], P[BASE + 7]);                              \
    auto r0 = __builtin_amdgcn_permlane32_swap(a0, b0, false, false); auto r1 = __builtin_amdgcn_permlane32_swap(a1, b1, false, false); \
    u32x4 w = {r0[0], r1[0], r0[1], r1[1]}; OUT = *reinterpret_cast<bf16x8*>(&w); } while (0)
  PK4(p0, 0, pa0); PK4(p0, 8, pa1); PK4(p1, 0, pa2); PK4(p1, 8, pa3);
#undef PK4
}
__device__ __forceinline__ void qkt(f32x16& p0, f32x16& p1, const bf16* Ks, const bf16x8* qr, int r32, int hi) {
  p0 = f32x16{}; p1 = f32x16{};
  for (int d0 = 0; d0 < DQK / 16; ++d0) { int cb = (d0 * 16 + hi * 8) * 2;
    bf16x8 b0 = *reinterpret_cast<const bf16x8*>((const char*)Ks + KSWZ(r32, cb));
    bf16x8 b1 = *reinterpret_cast<const bf16x8*>((const char*)Ks + KSWZ(32 + r32, cb));
    p0 = __builtin_amdgcn_mfma_f32_32x32x16_bf16(b0, qr[d0], p0, 0, 0, 0);
    p1 = __builtin_amdgcn_mfma_f32_32x32x16_bf16(b1, qr[d0], p1, 0, 0, 0); }
}
__device__ __forceinline__ int v_st(int k, int c) { const int kk = (k & ~0xC) | ((k & 4) << 1) | ((k & 8) >> 1); return ((kk >> 3) * 4 + (c >> 5)) * 512 + ((kk & 7) * 32 + (c & 31)) * 2; }
__device__ __forceinline__ int v_rd_base(int lane) { return ((lane & 3) << 3) | (((lane >> 2) & 3) << 6) | (((lane >> 4) & 1) << 5) | (((lane >> 5) & 1) << 8); }
constexpr int v_rd_off(int d0, int ks, int half) { return d0 * 512 + ks * 4096 + half * 2048; }
template <int OFF> __device__ __forceinline__ s16x4 tr_read(int vb) {
  s16x4 r; asm volatile("ds_read_b64_tr_b16 %0, %1 offset:%2" : "=&v"(r) : "v"(vb), "i"(OFF) : "memory"); return r;
}
template <int D0> __device__ __forceinline__ void pv_one(f32x16& od, int vb, bf16x8 pa0, bf16x8 pa1, bf16x8 pa2, bf16x8 pa3) {
  const s16x4 l0 = tr_read<v_rd_off(D0, 0, 0)>(vb), h0 = tr_read<v_rd_off(D0, 0, 1)>(vb), l1 = tr_read<v_rd_off(D0, 1, 0)>(vb), h1 = tr_read<v_rd_off(D0, 1, 1)>(vb);
  const s16x4 l2 = tr_read<v_rd_off(D0, 2, 0)>(vb), h2 = tr_read<v_rd_off(D0, 2, 1)>(vb), l3 = tr_read<v_rd_off(D0, 3, 0)>(vb), h3 = tr_read<v_rd_off(D0, 3, 1)>(vb);
  asm volatile("s_waitcnt lgkmcnt(0)" ::: "memory"); SBAR();
#define PK(L, H) (bf16x8){L[0], L[1], L[2], L[3], H[0], H[1], H[2], H[3]}
  od = __builtin_amdgcn_mfma_f32_32x32x16_bf16(pa0, PK(l0, h0), od, 0, 0, 0);
  od = __builtin_amdgcn_mfma_f32_32x32x16_bf16(pa1, PK(l1, h1), od, 0, 0, 0);
  od = __builtin_amdgcn_mfma_f32_32x32x16_bf16(pa2, PK(l2, h2), od, 0, 0, 0);
  od = __builtin_amdgcn_mfma_f32_32x32x16_bf16(pa3, PK(l3, h3), od, 0, 0, 0);
#undef PK
}
__device__ __forceinline__ void pv_d0(f32x16* o, int vb, bf16x8 pa0, bf16x8 pa1, bf16x8 pa2, bf16x8 pa3) {
  pv_one<0>(o[0], vb, pa0, pa1, pa2, pa3); pv_one<1>(o[1], vb, pa0, pa1, pa2, pa3); pv_one<2>(o[2], vb, pa0, pa1, pa2, pa3); pv_one<3>(o[3], vb, pa0, pa1, pa2, pa3);
}
__device__ __forceinline__ void attn_dense_body(const bf16* __restrict__ Qb, const bf16* __restrict__ Kh, const bf16* __restrict__ Vh, bf16* __restrict__ Ob, int seq, char* lds, const int tid, Frame& F, const int lyr, BgConv& bg) {
  const int wid = tid >> 6, lane = tid & 63, r32 = lane & 31, hi = lane >> 5;
  bf16* V_lds = (bf16*)lds; bf16* K_lds = (bf16*)(lds + 2 * SHM_V);
  float* ws = (float*)(lds + 2 * SHM_V + 2 * SHM_K) + wid * 64; float* li_l = ws; float* al_l = ws + 32;
  float m_reg = -1e30f, l_reg = 0; f32x16 o[4] = {}; bf16x8 qr[DQK / 16];
  const bf16* Qw = Qb + (long)(wid * QBLK + r32) * LDQ + hi * 8;
#pragma unroll
  for (int d0 = 0; d0 < DQK / 16; ++d0) qr[d0] = *reinterpret_cast<const bf16x8*>(Qw + d0 * 16);
  const int sr = tid >> 4, sc = (tid & 15) * 8, vst0 = v_st(sr, sc), vst1 = v_st(32 + sr, sc);
  const int vb0 = (int)(uintptr_t)V_lds + v_rd_base(lane);
  struct { bf16x8 vs0, vs1, ks0, ks1; } sr_[SDEPTH];
  const unsigned soff = (unsigned)(sr * LDK + sc) * 2u, soffk = (unsigned)(sr * LDKK + (sc < DQK ? sc : 0)) * 2u;
#define SLOAD(i, k0) do { const char* vt_ = (const char*)Vh + (size_t)(k0) * (LDK * 2); const char* kt_ = (const char*)Kh + (size_t)(k0) * (LDKK * 2);   \
    sr_[i].vs0 = *reinterpret_cast<const bf16x8*>(vt_ + soff); sr_[i].vs1 = *reinterpret_cast<const bf16x8*>(vt_ + 32 * LDK * 2 + soff); \
    sr_[i].ks0 = *reinterpret_cast<const bf16x8*>(kt_ + soffk); sr_[i].ks1 = *reinterpret_cast<const bf16x8*>(kt_ + 32 * LDKK * 2 + soffk); } while (0)
#define SWRITE(b, i) do { *(bf16x8*)((char*)V_lds + (b) * SHM_V + vst0) = sr_[i].vs0;          \
    *(bf16x8*)((char*)V_lds + (b) * SHM_V + vst1) = sr_[i].vs1; int kc = sc * 2;               \
    *(bf16x8*)((char*)K_lds + (b) * SHM_K + KSWZ(sr, kc)) = sr_[i].ks0;                       \
    *(bf16x8*)((char*)K_lds + (b) * SHM_K + KSWZ(32 + sr, kc)) = sr_[i].ks1; } while (0)
#define SWAIT() do { if constexpr (SDEPTH == 2) asm volatile("s_waitcnt vmcnt(4)" ::: "memory"); else asm volatile("s_waitcnt vmcnt(0)" ::: "memory"); } while (0)
#define RESC(a) do { if (__any((a) < 1.f)) { if (hi == 0) al_l[r32] = (a); asm volatile("s_waitcnt lgkmcnt(0)" ::: "memory"); \
    for (int d = 0; d < 4; ++d) for (int r = 0; r < 16; ++r) o[d][r] *= al_l[crow(r, hi)]; } } while (0)
  f32x16 pA0, pA1, pB0, pB1; float mnA, mnB, alA, alB; bf16x8 pa0, pa1, pa2, pa3; const int NT = seq / KVBLK;
  constexpr int SE = 0, SO = SDEPTH - 1;
  SLOAD(SE, 0); asm volatile("s_waitcnt vmcnt(0)" ::: "memory"); SWRITE(0, SE); __syncthreads();
  qkt(pA0, pA1, K_lds, qr, r32, hi); partialSM(pA0, pA1, m_reg, mnA, alA);
  SLOAD(SO, KVBLK); if constexpr (SDEPTH == 2) { if (2 < NT) SLOAD(SE, 2 * KVBLK); }
  SWAIT(); SWRITE(1, SO); __syncthreads();
  for (int j = 1; j + 1 < NT; j += 2) {
    bg_finish(F, bg, lane);
    if ((j >> 1) % 3 != 2) bg_issue(F, lyr, bg, lane);
    SBAR(); qkt(pB0, pB1, (bf16*)((char*)K_lds + SHM_K), qr, r32, hi);
    finishSM(pA0, pA1, alA, l_reg, pa0, pa1, pa2, pa3); SBAR();
    SLOAD(SO, (j + SDEPTH) * KVBLK); SBAR();
    pv_d0(o, vb0, pa0, pa1, pa2, pa3); partialSM(pB0, pB1, m_reg, mnB, alB);
    __syncthreads(); SWAIT(); SWRITE(0, SE);
    RESC(alB); __syncthreads();
    SBAR(); qkt(pA0, pA1, K_lds, qr, r32, hi);
    finishSM(pB0, pB1, alB, l_reg, pa0, pa1, pa2, pa3); SBAR();
    if (SDEPTH == 1 || j + 3 < NT) SLOAD(SE, (j + 1 + SDEPTH) * KVBLK); SBAR();
    pv_d0(o, vb0 + (int)SHM_V, pa0, pa1, pa2, pa3); partialSM(pA0, pA1, m_reg, mnA, alA);
    __syncthreads(); SWAIT(); SWRITE(1, SO);
    RESC(alA); __syncthreads();
  }
  SBAR(); qkt(pB0, pB1, (bf16*)((char*)K_lds + SHM_K), qr, r32, hi);
  finishSM(pA0, pA1, alA, l_reg, pa0, pa1, pa2, pa3); SBAR();
  pv_d0(o, vb0, pa0, pa1, pa2, pa3); partialSM(pB0, pB1, m_reg, mnB, alB);
  __syncthreads(); RESC(alB);
  finishSM(pB0, pB1, alB, l_reg, pa0, pa1, pa2, pa3); SBAR();
  pv_d0(o, vb0 + (int)SHM_V, pa0, pa1, pa2, pa3);
  if (hi == 0) li_l[r32] = l_reg; asm volatile("s_waitcnt lgkmcnt(0)" ::: "memory");
  int ln2; asm volatile("v_mbcnt_lo_u32_b32 %0, -1, 0\n\tv_mbcnt_hi_u32_b32 %0, -1, %0" : "=v"(ln2)); ln2 &= 63;
  const int r32e = ln2 & 31, hie = ln2 >> 5;
  float rli[16];
#pragma unroll
  for (int r = 0; r < 16; ++r) rli[r] = __builtin_amdgcn_rcpf(li_l[crow(r, hie)]);
  bf16* Ow = Ob + (long)(wid * QBLK) * LDO;
#pragma unroll
  for (int r = 0; r < 16; ++r) { const unsigned eo = (unsigned)(crow(r, hie) * LDO + r32e);
    for (int d0 = 0; d0 < 4; ++d0) Ow[eo + d0 * 32] = (bf16)(cvtpk(o[d0][r] * rli[r], 0.f) & 0xffffu); }
  if (bg.pend) { asm volatile("s_waitcnt vmcnt(0)" ::: "memory"); bg_finish(F, bg, lane); }
  __syncthreads();
#undef SLOAD
#undef SWRITE
#undef SWAIT
#undef RESC
}
#undef KSWZ
#undef SBAR
}

constexpr int GL_Q = 0, GL_K = 2048, GL_V = 4096, GL_EF = 8192, GL_EB = 10240, GL_OF = 12288, GL_OB = 16384;
__device__ __forceinline__ int gla_dirchunk(int dir, int tc) { return dir == 0 ? tc : (tc < 4 ? 3 - tc : 39 - tc); }
__device__ __forceinline__ void gla_stage_load(Frame& F, u32x4 (&st)[3], int b, int h, int tc) {
    const size_t row0 = (size_t)b * TPB + (tc < 4 ? SEQ + 64 * tc : 64 * (tc - 4));
#pragma unroll
    for (int k = 0; k < 3; ++k) { const int pid = F.tid + 512 * k, r = pid / 24, j = pid - r * 24; const size_t row = row0 + r; const bf16* src;
        if (j < 4)       src = Z_ + row * ZC + Z_GQ + h * 32 + 8 * j;
        else if (j < 8)  src = Z_ + row * ZC + Z_GK + h * 32 + 8 * (j - 4);
        else if (j < 16) src = Z_ + row * ZC + Z_GV + h * 64 + 8 * (j - 8);
        else if (j < 20) src = EGF_ + row * 128 + h * 32 + 8 * (j - 16);
        else             src = EGB_ + row * 128 + h * 32 + 8 * (j - 20);
        st[k] = *(const u32x4*)src; }
}
__device__ __forceinline__ void gla_stage_write(Frame& F, const u32x4 (&st)[3]) {
    LAS float* sm = (LAS float*)(F.lds + RING_OFF);
#pragma unroll
    for (int k = 0; k < 3; ++k) { const int pid = F.tid + 512 * k, r = pid / 24, j = pid - r * 24;
        LAS float* dst = j < 4 ? sm + GL_Q + r * 32 + 8 * j : j < 8 ? sm + GL_K + r * 32 + 8 * (j - 4) : j < 16 ? sm + GL_V + r * 64 + 8 * (j - 8) : j < 20 ? sm + GL_EF + r * 32 + 8 * (j - 16) : sm + GL_EB + r * 32 + 8 * (j - 20);
        const float sc = j < 4 ? 0.17677669529663687f : 1.0f; float f[4], g[4]; u32x2 lo, hi; lo.x = st[k].x; lo.y = st[k].y; hi.x = st[k].z; hi.y = st[k].w; up4(lo, f); up4(hi, g);
        *(LAS f32x4*)dst = (f32x4){f[0], f[1], f[2], f[3]} * sc; *(LAS f32x4*)(dst + 4) = (f32x4){g[0], g[1], g[2], g[3]} * sc; }
}
constexpr int GB_O = 0, GB_QS = 49152, GB_KT = GB_QS + 2 * 5120, GB_QE = GB_KT + 2 * 5120, GB_VT = GB_QE + 2 * 5120, GB_S0 = GB_VT + 2 * 9216, GB_END = GB_S0 + 2 * 5120;
static_assert(GB_END <= MISC_OFF, "GLA LDS map");
template <int N> __device__ __forceinline__ float dpp_shr(float v) { return __int_as_float(__builtin_amdgcn_update_dpp(0, __float_as_int(v), 0x110 + N, 0xF, 0xF, false)); }
__device__ __forceinline__ void gla_compute(Frame& F, int l, int b, int h, int tc, bool outputs) {
    LAS float* sm = (LAS float*)(F.lds + RING_OFF); LAS unsigned char* sb = F.lds + RING_OFF;
    const size_t row0 = (size_t)b * TPB + (tc < 4 ? SEQ + 64 * tc : 64 * (tc - 4));
    const int lane = F.lane, wdir = F.wave >> 2, wsub = F.wave & 3;
    float s0pre[8]; u32x4 gpre = {0u, 0u, 0u, 0u}; f32x4 gnpre0 = {0.f, 0.f, 0.f, 0.f}, gnpre1 = gnpre0;
    if (outputs) { const int dir = F.tid >> 8, e = (F.tid >> 2) & 63, dq = F.tid & 3;
        const float* ps = OGF_ + ((size_t)((b * 4 + h) * 2 + dir) * 36 + gla_dirchunk(dir, tc)) * 2048 + (size_t)(8 * dq) * 64 + e;
#pragma unroll
        for (int i = 0; i < 8; ++i) s0pre[i] = __hip_atomic_load(ps + i * 64, __ATOMIC_RELAXED, __HIP_MEMORY_SCOPE_AGENT);
        gpre = *(const u32x4*)(Z_ + (row0 + (F.tid >> 3)) * ZC + Z_GO + h * 64 + (F.tid & 7) * 8);
        gnpre0 = *(const f32x4*)(gla_o_norm_ + l * 64 + (F.tid & 7) * 8); gnpre1 = *(const f32x4*)(gla_o_norm_ + l * 64 + (F.tid & 7) * 8 + 4); }
    { const int t = wdir ? 63 - lane : lane; LAS float* gp = sm + (wdir ? GL_EB : GL_EF) + t * 32 + 8 * wsub;
#pragma unroll
      for (int i = 0; i < 8; ++i) { float x = gp[i]; x += dpp_shr<1>(x); x += dpp_shr<2>(x); x += dpp_shr<4>(x); x += dpp_shr<8>(x);
          const float t0 = rl_f(x, 15), t1 = rl_f(x, 31), t2 = rl_f(x, 47);
          x += (lane >= 16 ? t0 : 0.f) + (lane >= 32 ? t1 : 0.f) + (lane >= 48 ? t2 : 0.f); gp[i] = x; } }
    LDS_WAIT(); __syncthreads();
    { const int dir = F.tid >> 8, o = (F.tid >> 2) & 63, dq = F.tid & 3, t = dir ? 63 - o : o;
      const LAS float* Bp = sm + (dir ? GL_EB : GL_EF) + 8 * dq; const int tm = dir ? 32 : 31, te = dir ? 0 : 63;
      float Bt[8], Bm[8], Be[8], qv[8], kv[8];
#pragma unroll
      for (int i = 0; i < 8; i += 4) { *(f32x4*)(Bt + i) = *(const LAS f32x4*)(Bp + t * 32 + i); *(f32x4*)(Bm + i) = *(const LAS f32x4*)(Bp + tm * 32 + i); *(f32x4*)(Be + i) = *(const LAS f32x4*)(Bp + te * 32 + i);
          *(f32x4*)(qv + i) = *(const LAS f32x4*)(sm + GL_Q + t * 32 + 8 * dq + i); *(f32x4*)(kv + i) = *(const LAS f32x4*)(sm + GL_K + t * 32 + 8 * dq + i); }
      if (outputs) {
          float qs[8], kt[8], qe[8];
#pragma unroll
          for (int i = 0; i < 8; ++i) { qs[i] = qv[i] * __expf(Bt[i] - Bm[i]); kt[i] = kv[i] * __expf(Bm[i] - Bt[i]); qe[i] = qv[i] * __expf(Bt[i]); }
          u32x4 w; w.x = pk2(qs[0], qs[1]); w.y = pk2(qs[2], qs[3]); w.z = pk2(qs[4], qs[5]); w.w = pk2(qs[6], qs[7]); *(LAS u32x4*)(sb + GB_QS + dir * 5120 + o * 80 + 16 * dq) = w;
          w.x = pk2(kt[0], kt[1]); w.y = pk2(kt[2], kt[3]); w.z = pk2(kt[4], kt[5]); w.w = pk2(kt[6], kt[7]); *(LAS u32x4*)(sb + GB_KT + dir * 5120 + o * 80 + 16 * dq) = w;
          w.x = pk2(qe[0], qe[1]); w.y = pk2(qe[2], qe[3]); w.z = pk2(qe[4], qe[5]); w.w = pk2(qe[6], qe[7]); *(LAS u32x4*)(sb + GB_QE + dir * 5120 + o * 80 + 16 * dq) = w;
      } else {
#pragma unroll
          for (int i = 0; i < 8; ++i) *(LAS bf16*)(sb + GB_KT + dir * 5120 + (8 * dq + i) * 144 + 2 * o) = (bf16)f2bf(kv[i] * __expf(Be[i] - Bt[i]));
          if (o == 63) { const size_t sidx = (size_t)((b * 4 + h) * 2 + dir) * 36 + gla_dirchunk(dir, tc); float* ad = AD_ + sidx * 32 + 8 * dq;
#pragma unroll
              for (int i = 0; i < 8; ++i) ad[i] = __expf(Be[i]); }
      } }
    { const int dir = F.tid >> 8, e = F.tid & 63, og = (F.tid >> 6) & 3;
      float vv[16];
#pragma unroll
      for (int k = 0; k < 16; ++k) { const int o = 16 * og + k, t = dir ? 63 - o : o; vv[k] = sm[GL_V + t * 64 + e]; }
      u32x4 w0, w1; w0.x = pk2(vv[0], vv[1]); w0.y = pk2(vv[2], vv[3]); w0.z = pk2(vv[4], vv[5]); w0.w = pk2(vv[6], vv[7]); w1.x = pk2(vv[8], vv[9]); w1.y = pk2(vv[10], vv[11]); w1.z = pk2(vv[12], vv[13]); w1.w = pk2(vv[14], vv[15]);
      LAS unsigned char* vp = sb + GB_VT + dir * 9216 + e * 144 + 32 * og; *(LAS u32x4*)vp = w0; *(LAS u32x4*)(vp + 16) = w1; }
    if (outputs) {
        const int dir = F.tid >> 8, e = (F.tid >> 2) & 63, dq = F.tid & 3;
        u32x4 w; w.x = pk2(s0pre[0], s0pre[1]); w.y = pk2(s0pre[2], s0pre[3]); w.z = pk2(s0pre[4], s0pre[5]); w.w = pk2(s0pre[6], s0pre[7]); *(LAS u32x4*)(sb + GB_S0 + dir * 5120 + e * 80 + 16 * dq) = w;
    }
    LDS_WAIT(); __syncthreads();
    const int r = lane & 15, q = lane >> 4;
    if (outputs) {
        const int dir = wdir, tt = wsub; const LAS unsigned char* qsb = sb + GB_QS + dir * 5120; const LAS unsigned char* ktb = sb + GB_KT + dir * 5120;
        const LAS unsigned char* vtb = sb + GB_VT + dir * 9216; const LAS unsigned char* s0b = sb + GB_S0 + dir * 5120;
        f32x4 acc[4];
#pragma unroll
        for (int n = 0; n < 4; ++n) acc[n] = (f32x4){0.f, 0.f, 0.f, 0.f};
        const bf16x8 qsf = *(const LAS bf16x8*)(qsb + (16 * tt + r) * 80 + 16 * q);
        const int to = 16 * tt + r;
        for (int sp = 0; sp <= (tt >> 1); ++sp) {
            const bf16x8 k0 = *(const LAS bf16x8*)(ktb + (32 * sp + r) * 80 + 16 * q), k1 = *(const LAS bf16x8*)(ktb + (32 * sp + 16 + r) * 80 + 16 * q);
            f32x4 s0 = MFMA16(k0, qsf, ((f32x4){0.f, 0.f, 0.f, 0.f})), s1 = MFMA16(k1, qsf, ((f32x4){0.f, 0.f, 0.f, 0.f}));
#pragma unroll
            for (int i = 0; i < 4; ++i) { const int so = 32 * sp + 4 * q + i; s0[i] = so <= to ? s0[i] : 0.f; s1[i] = so + 16 <= to ? s1[i] : 0.f; }
            u32x4 pw; pw.x = pk2(s0[0], s0[1]); pw.y = pk2(s0[2], s0[3]); pw.z = pk2(s1[0], s1[1]); pw.w = pk2(s1[2], s1[3]);
            const bf16x8 pf = __builtin_bit_cast(bf16x8, pw);
#pragma unroll
            for (int n = 0; n < 4; ++n) { const LAS unsigned char* vr = vtb + (16 * n + r) * 144 + (32 * sp + 4 * q) * 2; const u32x2 lo = *(const LAS u32x2*)vr, hi = *(const LAS u32x2*)(vr + 32);
                u32x4 aw; aw.x = lo.x; aw.y = lo.y; aw.z = hi.x; aw.w = hi.y; acc[n] = MFMA16(__builtin_bit_cast(bf16x8, aw), pf, acc[n]); }
        }
        const bf16x8 qef = *(const LAS bf16x8*)(sb + GB_QE + dir * 5120 + (16 * tt + r) * 80 + 16 * q);
#pragma unroll
        for (int n = 0; n < 4; ++n) acc[n] = MFMA16(*(const LAS bf16x8*)(s0b + (16 * n + r) * 80 + 16 * q), qef, acc[n]);
        const int t = dir ? 63 - to : to;
#pragma unroll
        for (int n = 0; n < 4; ++n) *(LAS f32x4*)(sb + GB_O + dir * 16384 + (t * 64 + 16 * n + 4 * q) * 4) = acc[n];
        LDS_WAIT(); __syncthreads();
        const int tk = F.tid >> 3, e8 = (F.tid & 7) * 8; const size_t row = row0 + tk; const LAS float* of = (const LAS float*)(sb + GB_O) + tk * 64 + e8;
        const f32x4 f0 = *(const LAS f32x4*)of, f1 = *(const LAS f32x4*)(of + 4), b0 = *(const LAS f32x4*)(of + 4096), b1 = *(const LAS f32x4*)(of + 4100);
        const f32x4 o0 = f0 + b0, o1 = f1 + b1;
        float ss = (o0[0] * o0[0] + o0[1] * o0[1]) + (o0[2] * o0[2] + o0[3] * o0[3]) + (o1[0] * o1[0] + o1[1] * o1[1]) + (o1[2] * o1[2] + o1[3] * o1[3]);
        ss = g8_sum(ss);
        const float rn = rsq(ss * (1.0f / 64) + EPS);
        const float gn[8] = {gnpre0[0], gnpre0[1], gnpre0[2], gnpre0[3], gnpre1[0], gnpre1[1], gnpre1[2], gnpre1[3]}; float g[4], g2[4]; { u32x2 glo, ghi; glo.x = gpre.x; glo.y = gpre.y; ghi.x = gpre.z; ghi.y = gpre.w; up4(glo, g); up4(ghi, g2); }
        float w[8];
#pragma unroll
        for (int i = 0; i < 4; ++i) { w[i] = o0[i] * rn * gn[i] * g[i] * __builtin_amdgcn_rcpf(1.0f + __expf(-g[i])); w[4 + i] = o1[i] * rn * gn[4 + i] * g2[i] * __builtin_amdgcn_rcpf(1.0f + __expf(-g2[i])); }
        u32x4 pw; pw.x = pk2(w[0], w[1]); pw.y = pk2(w[2], w[3]); pw.z = pk2(w[4], w[5]); pw.w = pk2(w[6], w[7]);
        *(u32x4*)(ATT_ + row * DM + 768 + h * 64 + e8) = pw;
    } else {
        const int dir = wdir, et = wsub; const LAS unsigned char* vtb = sb + GB_VT + dir * 9216; const LAS unsigned char* khb = sb + GB_KT + dir * 5120;
        float* cs = CS_ + ((size_t)((b * 4 + h) * 2 + dir) * 36 + gla_dirchunk(dir, tc)) * 2048;
#pragma unroll
        for (int dt = 0; dt < 2; ++dt) { f32x4 acc = (f32x4){0.f, 0.f, 0.f, 0.f};
#pragma unroll
            for (int ks = 0; ks < 2; ++ks) acc = MFMA16(*(const LAS bf16x8*)(vtb + (16 * et + r) * 144 + (32 * ks + 8 * q) * 2), *(const LAS bf16x8*)(khb + (16 * dt + r) * 144 + (32 * ks + 8 * q) * 2), acc);
            *(f32x4*)(cs + (size_t)(16 * dt + r) * 64 + 16 * et + 4 * q) = acc; }
    }
}
__device__ __forceinline__ void gla_pass(Frame& F, int l, bool outputs) {
    const int nch = (outputs && l == DEPTH - 1) ? 32 : 36, c0 = 36 - nch, ntot = BATCH * 4 * nch;
    const int upb = (ntot + F.G - 1) / F.G, u_lo = min(F.blk * upb, ntot), u_hi = min(u_lo + upb, ntot);
    if (outputs) {
        const int lane = F.lane, dir = F.wave >> 2, eblk = F.wave & 3, dq = lane >> 4, e = eblk * 16 + (lane & 15);
        float S[8];
#pragma unroll
        for (int i = 0; i < 8; ++i) S[i] = 0.f;
        int pbh = -1, pc = -2;
        for (int k = 0; k < u_hi - u_lo; ++k) {
            const int u = dir == 0 ? u_lo + k : u_hi - 1 - k, bh = u / nch, tc = c0 + (u - bh * nch), c = gla_dirchunk(dir, tc);
            const size_t sidx = (size_t)(bh * 2 + dir) * 36;
            int j0 = pc;
            if (!(bh == pbh && c == pc + 1)) { j0 = 0;
#pragma unroll
                for (int i = 0; i < 8; ++i) S[i] = 0.f; }
#pragma unroll 4
            for (int j = j0; j < c; ++j) { const float* ad = AD_ + (sidx + j) * 32 + 8 * dq; const float* csp = CS_ + (sidx + j) * 2048 + (size_t)(8 * dq) * 64 + e;
                const f32x4 a0 = *(const f32x4*)ad, a1 = *(const f32x4*)(ad + 4);
#pragma unroll
                for (int i = 0; i < 4; ++i) { S[i] = a0[i] * S[i] + csp[i * 64]; S[4 + i] = a1[i] * S[4 + i] + csp[(4 + i) * 64]; } }
            float* ps = OGF_ + (sidx + c) * 2048 + (size_t)(8 * dq) * 64 + e;
#pragma unroll
            for (int i = 0; i < 8; ++i) __hip_atomic_store(ps + i * 64, S[i], __ATOMIC_RELAXED, __HIP_MEMORY_SCOPE_AGENT);
            pbh = bh; pc = c;
        }
        VM_WAIT();
    }
    u32x4 st[3];
    if (u_lo < u_hi) { const int bh = u_lo / nch; gla_stage_load(F, st, bh >> 2, bh & 3, c0 + (u_lo - bh * nch)); }
    for (int u = u_lo; u < u_hi; ++u) {
        const int bh = u / nch, tc = c0 + (u - bh * nch);
        gla_stage_write(F, st);
        LDS_WAIT(); __syncthreads();
        if (u + 1 < u_hi) { const int bh2 = (u + 1) / nch; gla_stage_load(F, st, bh2 >> 2, bh2 & 3, c0 + (u + 1 - bh2 * nch)); }
        gla_compute(F, l, bh >> 2, bh & 3, tc, outputs);
        LDS_WAIT(); __syncthreads();
    }
}
__device__ __forceinline__ void pE1(Frame& F, int l) {
    for (int rp = 0; rp < NREP(14); ++rp) gla_pass(F, l, false);
    relane(F);
    float gq = fabsf(na_q_norm_[l * 64 + F.lane]), gk = fabsf(na_k_norm_[l * 64 + F.lane]), rb = 0.f;
#pragma unroll
    for (int k = 0; k < 8; ++k) { const int i4 = F.lane + 64 * k;
        if (i4 < 465) { const f32x4 v = *(const f32x4*)(na_rpb_ + (size_t)l * 4 * 15 * 31 + 4 * i4); rb = fmaxf(rb, fmaxf(fmaxf(fabsf(v[0]), fabsf(v[1])), fmaxf(fabsf(v[2]), fabsf(v[3])))); } }
    gq = wave_max(gq); gk = wave_max(gk); rb = wave_max(rb);
    const float mfix = (QS_NA * 64.0f * gq * gk + rb * LOG2E) * 1.01f + 0.125f;
    if (mfix <= 60.0f) {
        for (int rp = 0; rp < NREP(15); ++rp)
        for (int u = F.blk; u < BATCH * 4 * 8; u += F.G) na_block_unit<true>(F, l, u, mfix);
        if (l == 0) for (int u = F.G - 1 - F.blk; u < BATCH * 4; u += F.G) ctx_block_unit<false>(F, u, mfix);
    } else {
        for (int u = F.blk; u < BATCH * 4 * 8; u += F.G) na_block_unit<false>(F, l, u, 0.f);
        if (l == 0) for (int u = F.G - 1 - F.blk; u < BATCH * 4; u += F.G) ctx_block_unit<false>(F, u, 0.f);
    }
}
__device__ __forceinline__ void pE2(Frame& F, int l) {
    const int nlat = BATCH * 4 * 8, nall = nlat + (l == 0 ? BATCH * 4 : 0);
    for (int rp = 0; rp < NREP(16); ++rp) { BgConv bg{0, nullptr};
    for (int u = F.blk; u < nall; u += F.G) {
        int b, h, qp, klo, seq;
        if (u < nlat) { const int qb = u & 7, bh = u >> 3; b = bh >> 2; h = bh & 3; qp = 256 * qb; klo = 0; seq = TPB; }
        else { const int bh = u - nlat; b = bh >> 2; h = bh & 3; qp = SEQ; klo = SEQ; seq = CTXL; }
        const size_t qrow = (size_t)b * TPB + qp, krow = (size_t)b * TPB + klo;
        fa::attn_dense_body(MQ_ + qrow * 384 + h * 96, MK_ + krow * 384 + h * 96, MV_ + krow * 512 + h * 128, ATT_ + qrow * DM + 256 + h * 128, seq, (char*)(F.lds + RING_OFF), F.tid, F, l, bg);
    }
    bg_drain(F, l, bg); }
    relane(F);
    for (int rp = 0; rp < NREP(17); ++rp) gla_pass(F, l, true);
}

__device__ __forceinline__ int moe_rpb(const Frame& F) { return (((MROWS + F.G - 1) / F.G) + 15) & ~15; }
constexpr int G1_TP = 1028;
__device__ __forceinline__ void pG1(Frame& F, int l) {
    LAS float* T = (LAS float*)(F.lds + RING_OFF);
    LAS float* P = T + 16 * G1_TP;
    volatile LAS unsigned* wh = F.MISC + MW_WH + F.wave * 32;
    if (F.lane < 32) wh[F.lane] = 0u;
    const int lane = F.lane, c = lane & 15, q = lane >> 4, rpb = moe_rpb(F), row_lo = F.blk * rpb;
    float bw[32][2];
#pragma unroll
    for (int s = 0; s < 32; ++s) { const float* wp = w_router_ + ((size_t)l * 1024 + 128 * F.wave + 32 * q + s) * NEXP + c; bw[s][0] = wp[0]; bw[s][1] = wp[16]; }
    const float brl = b_router_[l * NEXP + (lane & 31)];
    const float* gf = g_ffn_ + l * DM;
    int mcC = -1; f32x4 gsC[4], shC[4];
    u32x2 n0[4], n1[4];
    { const size_t rr = (size_t)min(row_lo + 2 * F.wave, MROWS - 2);
#pragma unroll
      for (int j = 0; j < 4; ++j) { n0[j] = *(const u32x2*)(XU_ + rr * DM + 256 * j + 4 * lane); n1[j] = *(const u32x2*)(XU_ + (rr + 1) * DM + 256 * j + 4 * lane); } }
    for (int r0 = row_lo; r0 < row_lo + rpb && r0 < MROWS; r0 += 16) {
        const int b = r0 / TPB, p0 = r0 - b * TPB;
        const int mc = p0 < SEQ ? b : 16, row = r0 + 2 * F.wave;
        f32x4 h0[4], h1[4];
#pragma unroll
        for (int j = 0; j < 4; ++j) { h0[j] = bf4f(n0[j]); h1[j] = bf4f(n1[j]); }
        { const size_t rr = (size_t)min(row + 16, MROWS - 2);
#pragma unroll
          for (int j = 0; j < 4; ++j) { n0[j] = *(const u32x2*)(XU_ + rr * DM + 256 * j + 4 * lane); n1[j] = *(const u32x2*)(XU_ + (rr + 1) * DM + 256 * j + 4 * lane); } }
        if (l == DEPTH - 1 && p0 >= SEQ) continue;
        const float rs0 = rsq(wave_sum(sumsq4(h0)) * (1.0f / DM) + EPS), rs1 = rsq(wave_sum(sumsq4(h1)) * (1.0f / DM) + EPS);
        if (mc != mcC) { const float* mod = MOD_ + ((size_t)l * 17 + mc) * 6144; mcC = mc;
#pragma unroll
            for (int j = 0; j < 4; ++j) { const int col = 256 * j + 4 * lane; gsC[j] = *(const f32x4*)(gf + col) * (*(const f32x4*)(mod + 4 * 1024 + col) + 1.0f); shC[j] = *(const f32x4*)(mod + 3 * 1024 + col); } }
#pragma unroll
        for (int j = 0; j < 4; ++j) { const int col = 256 * j + 4 * lane; const f32x4 gs = gsC[j], sh = shC[j];
            h0[j] = h0[j] * rs0 * gs + sh; h1[j] = h1[j] * rs1 * gs + sh;
            *(unsigned*)((unsigned char*)H_ + (size_t)row * DM + col) = pk4f8(h0[j][0] * SC_X, h0[j][1] * SC_X, h0[j][2] * SC_X, h0[j][3] * SC_X);
            *(unsigned*)((unsigned char*)H_ + (size_t)(row + 1) * DM + col) = pk4f8(h1[j][0] * SC_X, h1[j][1] * SC_X, h1[j][2] * SC_X, h1[j][3] * SC_X);
            *(LAS f32x4*)(T + (2 * F.wave) * G1_TP + col) = h0[j]; *(LAS f32x4*)(T + (2 * F.wave + 1) * G1_TP + col) = h1[j]; }
        LDS_WAIT(); __syncthreads();
        f32x4 a0 = (f32x4){0.f, 0.f, 0.f, 0.f}, a1 = a0;
        { const LAS float* tp = T + c * G1_TP + 128 * F.wave + 32 * q;
#pragma unroll
          for (int s4 = 0; s4 < 8; ++s4) { const f32x4 av = *(const LAS f32x4*)(tp + 4 * s4);
#pragma unroll
              for (int i = 0; i < 4; ++i) { a0 = __builtin_amdgcn_mfma_f32_16x16x4f32(av[i], bw[4 * s4 + i][0], a0, 0, 0, 0); a1 = __builtin_amdgcn_mfma_f32_16x16x4f32(av[i], bw[4 * s4 + i][1], a1, 0, 0, 0); } } }
#pragma unroll
        for (int i = 0; i < 4; ++i) { P[(F.wave * 16 + 4 * q + i) * 32 + c] = a0[i]; P[(F.wave * 16 + 4 * q + i) * 32 + 16 + c] = a1[i]; }
        LDS_WAIT(); __syncthreads();
        { const int rr = 2 * F.wave + (lane >> 5), e = lane & 31; float lg = brl;
#pragma unroll
          for (int w = 0; w < 8; ++w) lg += P[(w * 16 + rr) * 32 + e];
          float tv[4]; int ti[4];
#pragma unroll
          for (int k = 0; k < 4; ++k) { float m = lg; m = fmaxf(m, dpp_f<0xB1>(m)); m = fmaxf(m, dpp_f<0x4E>(m)); m = fmaxf(m, dpp_f<0x141>(m)); m = fmaxf(m, dpp_f<0x140>(m)); m = fmaxf(m, swz_xor<16>(m));
              const unsigned long long bal = __builtin_amdgcn_ballot_w64(lg == m); const unsigned half = (lane >> 5) ? (unsigned)(bal >> 32) : (unsigned)bal;
              const int bi = __builtin_ctz(half);
              tv[k] = m; ti[k] = bi; lg = (e == bi) ? -INFINITY : lg; }
          const float e1 = __expf(tv[1] - tv[0]), e2 = __expf(tv[2] - tv[0]), e3 = __expf(tv[3] - tv[0]); const float isum = 1.0f / (1.0f + e1 + e2 + e3);
          if (e < 4) { const int ek = e == 0 ? ti[0] : e == 1 ? ti[1] : e == 2 ? ti[2] : ti[3]; const float gg = (e == 0 ? 1.0f : e == 1 ? e1 : e == 2 ? e2 : e3) * isum;
              unsigned rank = 0;
              if (lane < 32) rank = __hip_atomic_fetch_add((LAS unsigned*)(F.MISC + MW_WH + F.wave * 32 + ek), 1u, __ATOMIC_RELAXED, __HIP_MEMORY_SCOPE_WORKGROUP);
              __builtin_amdgcn_s_waitcnt(0xc07f);
              if (lane >= 32) rank = __hip_atomic_fetch_add((LAS unsigned*)(F.MISC + MW_WH + F.wave * 32 + ek), 1u, __ATOMIC_RELAXED, __HIP_MEMORY_SCOPE_WORKGROUP);
              TOPE_[(size_t)(r0 + rr) * 4 + e] = ek | (int)(rank << 8); TOPG_[(size_t)(r0 + rr) * 4 + e] = gg; } }
        LDS_WAIT(); __syncthreads();
    }
    LDS_WAIT(); __syncthreads();
    if (F.lane < 32) WHIST_[(size_t)F.gw * 32 + F.lane] = (int)wh[F.lane];
    if (F.tid < 32) { unsigned s = 0;
#pragma nounroll
        for (int w = 0; w < 8; ++w) s += F.MISC[MW_WH + w * 32 + F.tid];
        HISTB_[F.blk * 32 + F.tid] = (int)s; }
    __syncthreads();
}
__device__ __forceinline__ void moe_tables(Frame& F) {
    const int e = F.tid & 31, part = F.tid >> 5; unsigned s = 0, sb = 0;
#pragma unroll 8
    for (int bq = part; bq < F.G; bq += 16) { const unsigned hv = (unsigned)HISTB_[bq * 32 + e]; s += hv; sb += bq < F.blk ? hv : 0u; }
    F.MISC[MW_TMP + part * 32 + e] = s; F.MISC[MW_TMP + 512 + part * 32 + e] = sb;
    LDS_WAIT(); __syncthreads();
    if (F.tid < 32) { unsigned a = 0, bsum = 0;
#pragma nounroll
        for (int pq = 0; pq < 16; ++pq) { a += F.MISC[MW_TMP + pq * 32 + F.tid]; bsum += F.MISC[MW_TMP + 512 + pq * 32 + F.tid]; }
        F.MISC[MW_CNT + F.tid] = a; F.MISC[MW_BB + F.tid] = bsum; }
    LDS_WAIT(); __syncthreads();
    if (F.tid < 64) {
        const int ln = F.tid; const unsigned nt = ln < NEXP ? (F.MISC[MW_CNT + ln] + 255u) >> 8 : 0u; unsigned inc = nt;
#pragma unroll
        for (int d = 1; d < 32; d <<= 1) { const unsigned v = (unsigned)__shfl_up((int)inc, d, 64); if (ln >= d) inc += v; }
        if (ln < NEXP) F.MISC[MW_TS + ln] = inc - nt;
        if (ln == NEXP - 1) F.MISC[MW_TS + NEXP] = inc; }
    LDS_WAIT(); __syncthreads();
    { const int q = F.tid >> 4, r = F.tid & 15; const unsigned ts = F.MISC[MW_TS + q], nt = F.MISC[MW_TS + q + 1] - ts;
      volatile LAS unsigned char* te = (volatile LAS unsigned char*)(F.MISC + MW_TE);
      for (unsigned t = r; t < nt; t += 16) te[ts + t] = (unsigned char)q; }
    LDS_WAIT(); __syncthreads();
}
__device__ __forceinline__ void pG2(Frame& F, int l) {
    moe_tables(F);
    const int lane = F.lane, rpb = moe_rpb(F), row_lo = F.blk * rpb;
    if (F.tid < 256) { const int w = F.tid >> 5, e = F.tid & 31; unsigned wb = 0;
#pragma unroll
        for (int w2 = 0; w2 < 7; ++w2) { const unsigned v = (unsigned)WHIST_[(size_t)(F.blk * 8 + w2) * 32 + e]; wb += w2 < w ? v : 0u; }
        F.MISC[MW_TMP + w * 32 + e] = 256u * F.MISC[MW_TS + e] + F.MISC[MW_BB + e] + wb; }
    LDS_WAIT(); __syncthreads();
    for (int e = F.blk; e < NEXP; e += F.G) {
        const int c = (int)F.MISC[MW_CNT + e], base = 256 * (int)F.MISC[MW_TS + e], end = 256 * (int)(F.MISC[MW_TS + e + 1] - F.MISC[MW_TS + e]);
        for (int i = c + F.tid; i < end; i += 512) ROWMAP_[base + i] = 0; }
    for (int i = F.tid; i < rpb * 4; i += 512) {
        const int row = row_lo + (i >> 2), k = i & 3; if (row >= MROWS) break;
        const int p = row % TPB; if (l == DEPTH - 1 && p >= SEQ) continue;
        const int te = TOPE_[(size_t)row * 4 + k];
        const int ow = ((row - row_lo) & 15) >> 1, ek = te & 255, rank = te >> 8;
        const int dest = (int)F.MISC[MW_TMP + ow * 32 + (ek & 31)] + rank;
        DEST_[(size_t)row * 4 + k] = dest; ROWMAP_[dest] = row;
    }
}
struct JLoad { unsigned y[4][4]; u32x2 x[4]; };
__device__ __forceinline__ int pJ_row(int l, int a) { return l == DEPTH - 1 ? (a >> 11) * TPB + (a & (SEQ - 1)) : a; }
__device__ __forceinline__ void pJ_issue(Frame& F, JLoad& L, int row, int dk, int lane) {
#pragma unroll
    for (int k = 0; k < 4; ++k) { const int d = __builtin_amdgcn_readlane(dk, k);
#pragma unroll
        for (int j = 0; j < 4; ++j) L.y[k][j] = *(const unsigned*)((const unsigned char*)XS_   + (size_t)d * DM + 256 * j + 4 * lane); }
#pragma unroll
    for (int j = 0; j < 4; ++j) L.x[j] = *(const u32x2*)(XU_ + (size_t)row * DM + 256 * j + 4 * lane);
}
__device__ __forceinline__ void pJ(Frame& F, int l) {
    const int lane = F.lane, nrows = l == DEPTH - 1 ? BATCH * SEQ : MROWS, step = F.ngw;
    int a = F.gw; if (a >= nrows) return;
    auto route = [&](int aa, int& dk, float& gk) __attribute__((always_inline)) { if (aa < nrows) { const int r = pJ_row(l, aa); dk = DEST_[(size_t)r * 4 + (lane & 3)]; gk = TOPG_[(size_t)r * 4 + (lane & 3)]; } };
    auto one = [&](const JLoad& L, const int aa, const float gkA) __attribute__((always_inline)) {
        const int row = pJ_row(l, aa), b = row / TPB, p = row - b * TPB; const int mc = p < SEQ ? b : 16; const float* mod = MOD_ + ((size_t)l * 17 + mc) * 6144;
        f32x4 g2[4], s1[4], s0[4], gm[4];
#pragma unroll
        for (int j = 0; j < 4; ++j) { const int col = 256 * j + 4 * lane; g2[j] = *(const f32x4*)(mod + 5 * 1024 + col);
            if (l != DEPTH - 1) { const float* mod1 = MOD_ + ((size_t)(l + 1) * 17 + mc) * 6144; s1[j] = *(const f32x4*)(mod1 + 1024 + col); s0[j] = *(const f32x4*)(mod1 + col); gm[j] = *(const f32x4*)(g_mix_ + (l + 1) * DM + col); } }
        float g[4];
#pragma unroll
        for (int k = 0; k < 4; ++k) g[k] = rl_f(gkA, k) * (1.0f / SC_Y);
        f32x4 v[4];
#pragma unroll
        for (int j = 0; j < 4; ++j) { f32x4 acc = (f32x4){0.f, 0.f, 0.f, 0.f};
#pragma unroll
            for (int k = 0; k < 4; ++k) { const int w = (int)L.y[k][j]; acc += (f32x4){__builtin_amdgcn_cvt_f32_fp8(w, 0), __builtin_amdgcn_cvt_f32_fp8(w, 1), __builtin_amdgcn_cvt_f32_fp8(w, 2), __builtin_amdgcn_cvt_f32_fp8(w, 3)} * g[k]; }
            v[j] = bf4f(L.x[j]) + g2[j] * acc; }
        if (l == DEPTH - 1) {
#pragma unroll
            for (int j = 0; j < 4; ++j) *(f32x4*)(out_ + ((size_t)b * SEQ + p) * DM + 256 * j + 4 * lane) = v[j];
        } else {
#pragma unroll
            for (int j = 0; j < 4; ++j) { u32x2 o; o.x = pg8::cvt_pk_bf16(v[j][0], v[j][1]); o.y = pg8::cvt_pk_bf16(v[j][2], v[j][3]); *(u32x2*)(XU_ + (size_t)row * DM + 256 * j + 4 * lane) = o; v[j] = bf4f(o); }
            const float rstd = rsq(wave_sum(sumsq4(v)) * (1.0f / DM) + EPS);
            unsigned char* orow = (unsigned char*)H_ + (size_t)row * DM;
#pragma unroll
            for (int j = 0; j < 4; ++j) { const f32x4 h = (v[j] * rstd * gm[j] * (s1[j] + 1.0f) + s0[j]) * SC_X; *(unsigned*)(orow + 256 * j + 4 * lane) = pk4f8(h[0], h[1], h[2], h[3]); }
        }
    };
    int dk0 = 0, dk1 = 0, dk2 = 0, dk3 = 0; float gk0 = 0.f, gk1 = 0.f, gk2 = 0.f, gk3 = 0.f;
    route(a, dk0, gk0); route(a + step, dk1, gk1);
    JLoad A, B; pJ_issue(F, A, pJ_row(l, a), dk0, lane);
    for (; a < nrows; a += 2 * step) {
        route(a + 2 * step, dk2, gk2);
        if (a + step < nrows) pJ_issue(F, B, pJ_row(l, a + step), dk1, lane);
        one(A, a, gk0);
        if (a + step >= nrows) break;
        route(a + 3 * step, dk3, gk3);
        if (a + 2 * step < nrows) pJ_issue(F, A, pJ_row(l, a + 2 * step), dk2, lane);
        one(B, a + step, gk1);
        dk0 = dk2; gk0 = gk2; dk1 = dk3; gk1 = gk3;
    }
}

#ifndef PH_MASK
#define PH_MASK 0x3fff
#endif
#define IN(k) (lo <= (k) && (k) < hi)
#define EN(i) ((PH_MASK >> (i)) & 1)
#define RELOAD() do { int ln_; asm volatile("v_mbcnt_lo_u32_b32 %0, -1, 0\n\tv_mbcnt_hi_u32_b32 %0, -1, %0" : "=v"(ln_)); ln_ &= 63; F.lane = ln_; F.wave = wave0; F.tid = wave0 * 64 + ln_; \
    { int b_ = (int)blockIdx.x, g_ = (int)gridDim.x, w_ = wave0; asm volatile("" : "+s"(b_), "+s"(g_), "+s"(w_)); F.blk = b_; F.G = g_; F.wave = w_ & 7; F.tid = (w_ & 7) * 64 + ln_; F.gw = b_ * 8 + (w_ & 7); F.ngw = g_ * 8; } \
    int z_ = 0; asm volatile("" : "+s"(z_)); F.A = (const Args*)((const char*)&args + z_); } while (0)
#define SEAM(k) do { if ((k) + 1 < hi) { xcd_barrier(bar.bar, bar.x, bar.st, F.tid); if (NREP(18) > 1) xcd_barrier(bar.bar, bar.x, bar.st, F.tid); } } while (0)
template <int l>
__device__ __forceinline__ void layer_phases(Frame& F, const Args& args, const XcdBarrier& bar, const int lo, const int hi, const int wave0) {
        const int pb = 1 + 13 * l; const bool lastl = (l == DEPTH - 1);
        if (EN(1) && IN(pb + 0) && l == 0) { RELOAD(); pA_init(F); SEAM(pb + 0); }
        if (EN(2) && IN(pb + 1)) { RELOAD();
            pg8::Gemm g{H_  , (const bf16*)((const unsigned char*)WIN_ + (size_t)l * 2048 * 1024), nullptr}; DenseOrder S{MROWS / 256, ZC / 256, F.G, F.blk, 0, NREP(2)}; EpiZ E{Z_, Z8_};
            pg8::gemm_phase<EpiZ, DenseOrder, 512, 512, true, true, true>(F.lds + RING_OFF, g, S, E, F.tid); SEAM(pb + 1); }
        if (EN(3) && IN(pb + 2)) { RELOAD();
            pg8::Gemm g{Z_ + Z_CQ, WSM_ + (size_t)l * 1280 * 384, nullptr}; DenseOrder S{MROWS / 256, YC / 256, F.G, F.blk, 0, NREP(3)}; EpiFp8Plain E{(unsigned char*)Y_, YC};
            pg8::gemm_phase<EpiFp8Plain, DenseOrder, 384, ZC, true, true>(F.lds + RING_OFF, g, S, E, F.tid); SEAM(pb + 2); }
        if (EN(4) && IN(pb + 3)) { for (int rp = 0; rp < NREP(4); ++rp) { RELOAD(); pD_tokens(F, l); } SEAM(pb + 3); }
        if (EN(5) && IN(pb + 4)) { for (int rp = 0; rp < NREP(5); ++rp) { RELOAD(); pE1(F, l); } SEAM(pb + 4); }
        if (EN(6) && IN(pb + 5)) { for (int rp = 0; rp < NREP(6); ++rp) { RELOAD(); pE2(F, l); } SEAM(pb + 5); }
        if (EN(8) && IN(pb + 7)) { RELOAD();
            pg8::Gemm g{ATT_, WOUT_ + (size_t)l * 1024 * 1024, nullptr}; DenseOrder S{lastl ? BATCH * 8 : MROWS / 256, DM / 256, F.G, F.blk, lastl ? 1 : 0, 1};
            EpiResid E{XU_, MOD_ + (size_t)l * 17 * 6144 + 2 * 1024, l == 0 ? x_ : nullptr, l == 0 ? ctx_ : nullptr};
            pg8::gemm_phase<EpiResid, DenseOrder, DM, DM, true, true>(F.lds + RING_OFF, g, S, E, F.tid); SEAM(pb + 7); }
        if (EN(9) && IN(pb + 8)) { for (int rp = 0; rp < NREP(9); ++rp) { RELOAD(); pG1(F, l); } SEAM(pb + 8); }
        if (EN(10) && IN(pb + 9)) { for (int rp = 0; rp < NREP(10); ++rp) { RELOAD(); pG2(F, l); } SEAM(pb + 9); }
        if (EN(11) && IN(pb + 10)) { RELOAD();
            pg8::Gemm g{H_  , (const bf16*)((const unsigned char*)W1_ + (size_t)l * NEXP * 2048 * 1024), ROWMAP_};
            MoeOrder S{(const volatile LAS int*)(F.MISC + MW_TS), (const volatile LAS unsigned char*)(F.MISC + MW_TE), 8, F.G, F.blk, NREP(11)};
            EpiSwiglu E{(unsigned char*)ACT_, b_moe1_ + (size_t)l * NEXP * 2048};
            pg8::gemm_phase<EpiSwiglu, MoeOrder, 512, 512, true, true, true, true>(F.lds + RING_OFF, g, S, E, F.tid); SEAM(pb + 10); }
        if (EN(12) && IN(pb + 11)) { RELOAD();
            pg8::Gemm g{ACT_, (const bf16*)((const unsigned char*)W2_ + (size_t)l * NEXP * 1024 * 1024), nullptr};
            MoeOrder S{(const volatile LAS int*)(F.MISC + MW_TS), (const volatile LAS unsigned char*)(F.MISC + MW_TE), 4, F.G, F.blk, NREP(12)};
            EpiFp8Bias E{(unsigned char*)XS_, b_moe2_ + (size_t)l * NEXP * 1024};
            pg8::gemm_phase<EpiFp8Bias, MoeOrder, 512, 512, true, true, true>(F.lds + RING_OFF, g, S, E, F.tid); SEAM(pb + 11); }
        if (EN(13) && IN(pb + 12)) { for (int rp = 0; rp < (lastl ? NREP(13) : 1); ++rp) { RELOAD(); pJ(F, l); } if (!lastl) SEAM(pb + 12); }
}
__global__ void __launch_bounds__(512, 2) fwd(Args args) {
    extern __shared__ __attribute__((aligned(16))) unsigned char lds[];
    Frame F;
    F.lds = (LAS unsigned char*)lds; F.MISC = (volatile LAS unsigned*)(F.lds + MISC_OFF);
    F.tid = threadIdx.x; F.lane = F.tid & 63; F.wave = __builtin_amdgcn_readfirstlane(F.tid >> 6); const int wave0 = F.wave & 7;
    F.G = gridDim.x; F.blk = blockIdx.x; F.gw = F.blk * 8 + F.wave; F.ngw = F.G * 8;
    F.A = &args; unsigned char* ws = args.ws;
    for (int u = F.tid; u < (LDS_BYTES - MISC_OFF) / 4; u += 512) F.MISC[u] = 0u;
    __syncthreads();
    XcdBarrier bar = xcd_barrier_post((unsigned*)(ws + WS_CTL) + CW_BAR + args.li * XCD_BAR_WORDS, F.MISC + MW_BAR);
    const int lo = args.ph_lo, hi = args.ph_hi;
    if (EN(0) && IN(0)) { for (int rp = 0; rp < NREP(0); ++rp) { RELOAD(); p0_prologue(F); } SEAM(0); }
    layer_phases<0>(F, args, bar, lo, hi, wave0);
    layer_phases<1>(F, args, bar, lo, hi, wave0);
    static_assert(DEPTH == 2, "two layer instantiations");
#undef IN
#undef SEAM
}

extern "C" void kernel_launch(void* const* d_in, const int* in_sizes, int n_in, void* d_out, int out_size, void* d_ws, size_t ws_size, hipStream_t stream) {
    static int grid = 0;
    if (grid == 0) {
        if (n_in != 28 || out_size != BATCH * SEQ * DM || ws_size < WS_END) { fprintf(stderr, "kernel_launch: unexpected problem (n_in %d out %d ws %zu)\n", n_in, out_size, ws_size); grid = -1; return; }
        int dev = 0, cus = 0, per_cu = 0;
        if (hipGetDevice(&dev) != hipSuccess || hipDeviceGetAttribute(&cus, hipDeviceAttributeMultiprocessorCount, dev) != hipSuccess) { grid = -1; return; }
        if (hipFuncSetAttribute((const void*)fwd, hipFuncAttributeMaxDynamicSharedMemorySize, LDS_BYTES) != hipSuccess) { fprintf(stderr, "kernel_launch: hipFuncSetAttribute failed\n"); grid = -1; return; }
        if (hipOccupancyMaxActiveBlocksPerMultiprocessor(&per_cu, (const void*)fwd, 512, LDS_BYTES) != hipSuccess || per_cu < 1) { fprintf(stderr, "kernel_launch: occupancy query says %d\n", per_cu); }
        (void)hipGetLastError();
        grid = cus & ~7;
        if (grid < 8) { grid = -1; return; }
    }
    if (grid < 0) return;
    (void)hipMemsetAsync((char*)d_ws + WS_CTL, 0, CTL_ZERO_BYTES, stream);
    Args a{};
    for (int i = 0; i < 28; ++i) a.in[i] = (const float*)d_in[i];
    a.out = (float*)d_out; a.ws = (unsigned char*)d_ws; a.pad = 0;
#if MK_N_LAUNCHES == 1
    a.ph_lo = 0; a.ph_hi = NPH; a.li = 0;
    hipLaunchKernelGGL(fwd, dim3(grid), dim3(512), LDS_BYTES, stream, a);
#else
    for (int ph = 0, li = 0; ph < NPH; ++ph) {
        if (ph == 1 + 13 || ph == 1 + 6 || ph == 1 + 13 + 6) continue;
        a.ph_lo = ph; a.ph_hi = ph + 1; a.li = li++;
        hipLaunchKernelGGL(fwd, dim3(grid), dim3(512), LDS_BYTES, stream, a);
    }
#endif
}
```

```cpp
#include <hip/hip_runtime.h>
#include <cstdio>
#include <cstdint>

#define GAS __attribute__((address_space(1)))
#define LAS __attribute__((address_space(3)))
typedef unsigned short bf16;
typedef short bf16x8 __attribute__((ext_vector_type(8)));
typedef short bf16x4 __attribute__((ext_vector_type(4)));
typedef float f32x4 __attribute__((ext_vector_type(4)));
typedef unsigned u32x4 __attribute__((ext_vector_type(4)));
typedef unsigned u32x2 __attribute__((ext_vector_type(2)));

#ifndef REP_MASK
#define REP_MASK 0
#endif
#define NREP(i) (((REP_MASK >> (i)) & 1) ? 2 : 1)
#ifndef MK_N_LAUNCHES
#define MK_N_LAUNCHES 1
#endif

namespace pg8 {
constexpr int BM = 256, BK = 64, HALF = 128, HTB = HALF * BK * 2, STAGE_BYTES = 8 * HTB;
__host__ __device__ __forceinline__ int lds_byte(int r, int c) { const int st = (r >> 4) * 2 + (c >> 5), rr = r & 15, cc = c & 31, ob = rr * 64 + cc * 2; return st * 1024 + (ob ^ (((ob >> 9) & 1) << 5)); }
__host__ __device__ __forceinline__ void stage_rc(int b, int& R, int& C) { const int st = b / 1024, sb = b % 1024, swz = sb ^ (((sb >> 9) & 1) << 5); R = (st >> 1) * 16 + swz / 64; C = (st & 1) * 32 + (swz % 64) / 2; }
__host__ __device__ __forceinline__ int perm32(int rho) { const int n = rho >> 4, i = rho & 15; return 8 * (i >> 2) + 4 * n + (i & 3); }

struct Unit { int pm, pn, pb, pa; };
struct Gemm { const bf16* A; const bf16* Bt; const int* rowmap; };

__device__ __forceinline__ unsigned cvt_pk_bf16(float lo, float hi) { unsigned r; asm volatile("v_cvt_pk_bf16_f32 %0, %1, %2" : "=v"(r) : "v"(lo), "v"(hi)); return r; }

typedef int i32x4v __attribute__((ext_vector_type(4)));
typedef int i32x8v __attribute__((ext_vector_type(8)));
template <class Epi, class Sched, int K, int LDA, bool ALIGN_EPI, bool SP2, bool FP8 = false, bool GATHER = false>
__device__ __forceinline__ void gemm_phase(LAS unsigned char* lds, const Gemm g, const Sched& S, const Epi& E, const int tid) {
    const int wid = __builtin_amdgcn_readfirstlane(tid >> 6), lane = tid & 63, wr = wid >> 2, wc = wid & 3, fr = lane & 15, fq = lane >> 4;
    constexpr int nt = K / BK;
    unsigned voffA[2], voffB[2]; int rA[2]; unsigned cA2[2];
#pragma unroll
    for (int i = 0; i < 2; ++i) { int R, C; stage_rc(tid * 16 + i * 8192, R, C); const int Rb = Epi::PERM ? ((R & ~31) + perm32(R & 31)) : R;
        voffA[i] = (unsigned)(R * LDA + C) * 2u; voffB[i] = (unsigned)(Rb * K + C) * 2u; rA[i] = R; cA2[i] = (unsigned)C * 2u; }
    constexpr size_t kstep = (size_t)(BK * 2);
    constexpr size_t hA = GATHER ? 0 : (size_t)HALF * LDA * 2, hB = (size_t)HALF * K * 2;
    constexpr size_t tA = 2 * hA, tB = 2 * hB;
    unsigned gC[2][2], gN[2][2];
#define PG8_GLOAD(dst, unit) do { if constexpr (GATHER) { _Pragma("unroll") for (int _h = 0; _h < 2; ++_h) _Pragma("unroll") for (int _i = 0; _i < 2; ++_i) \
        dst[_h][_i] = (unsigned)g.rowmap[(unit).pa * 256 + _h * 128 + rA[_i]] * (unsigned)(LDA * 2) + cA2[_i]; } } while (0)
#define PG8_STAGE_A(b, h, ptr, nx) do { if constexpr (GATHER) { _Pragma("unroll") for (int _i = 0; _i < 2; ++_i) \
        __builtin_amdgcn_global_load_lds((const unsigned*)((const char*)(ptr) + ((nx) ? gN[h][_i] : gC[h][_i])), (LAS unsigned*)(lds + PG8_SA(b, h) + ldsw + _i * 8192), 16, 0, 0); } \
        else PG8_STAGE(PG8_SA(b, h), (ptr) + (h) * hA, voffA); } while (0)
    const unsigned ldsw = (unsigned)wid * 1024u;
    const int aoff = FP8 ? lds_byte(wr * 64 + fr, (fq & 1) * 16) + (fq >> 1) * 1024 : lds_byte(wr * 64 + fr, fq * 8);
    const int boff = FP8 ? lds_byte(wc * 32 + fr, (fq & 1) * 16) + (fq >> 1) * 1024 : lds_byte(wc * 32 + fr, fq * 8);
#define PG8_SA(b, h) (((b) * 2 + (h)) * HTB)
#define PG8_SB(b, h) ((4 + (b) * 2 + (h)) * HTB)
#define PG8_STAGE(bufoff, gbase, voff) do { _Pragma("unroll") for (int _i = 0; _i < 2; ++_i) \
        __builtin_amdgcn_global_load_lds((const unsigned*)((const char*)(gbase) + (voff)[_i]), (LAS unsigned*)(lds + (bufoff) + ldsw + _i * 8192), 16, 0, 0); } while (0)
#define PG8_LDA(dst, b, h) do { _Pragma("unroll") for (int m = 0; m < 4; ++m) { if constexpr (FP8) { const i32x4v lo_ = *(const LAS i32x4v*)(lds + PG8_SA(b, h) + aoff + m * 2048), hi_ = *(const LAS i32x4v*)(lds + PG8_SA(b, h) + aoff + m * 2048 + 16); dst[m] = __builtin_shufflevector(lo_, hi_, 0, 1, 2, 3, 4, 5, 6, 7); } \
        else { dst[m].lo = *(const LAS i32x4v*)(lds + PG8_SA(b, h) + aoff + m * 2048); dst[m].hi = *(const LAS i32x4v*)(lds + PG8_SA(b, h) + aoff + m * 2048 + 1024); } } } while (0)
#define PG8_LDB(dst, b, h) do { _Pragma("unroll") for (int n = 0; n < 2; ++n) { if constexpr (FP8) { const i32x4v lo_ = *(const LAS i32x4v*)(lds + PG8_SB(b, h) + boff + n * 2048), hi_ = *(const LAS i32x4v*)(lds + PG8_SB(b, h) + boff + n * 2048 + 16); dst[n] = __builtin_shufflevector(lo_, hi_, 0, 1, 2, 3, 4, 5, 6, 7); } \
        else { dst[n].lo = *(const LAS i32x4v*)(lds + PG8_SB(b, h) + boff + n * 2048); dst[n].hi = *(const LAS i32x4v*)(lds + PG8_SB(b, h) + boff + n * 2048 + 1024); } } } while (0)
#define PG8_MMA(ai, bj, At, Bt) do { __builtin_amdgcn_s_setprio(1); _Pragma("unroll") for (int m = 0; m < 4; ++m) _Pragma("unroll") for (int n = 0; n < 2; ++n) { \
        if constexpr (FP8) asm volatile("v_mfma_scale_f32_16x16x128_f8f6f4 %0, %1, %2, %0, %3, %3 op_sel_hi:[0,0,0]" : "+v"(acc[ai][bj][m][n]) : "v"(Bt[n]), "v"(At[m]), "v"(sc8)); \
        else { const i32x4v bl_ = __builtin_shufflevector(Bt[n], Bt[n], 0, 1, 2, 3), bh_ = __builtin_shufflevector(Bt[n], Bt[n], 4, 5, 6, 7), al_ = __builtin_shufflevector(At[m], At[m], 0, 1, 2, 3), ah_ = __builtin_shufflevector(At[m], At[m], 4, 5, 6, 7); \
               acc[ai][bj][m][n] = __builtin_amdgcn_mfma_f32_16x16x32_bf16(__builtin_bit_cast(bf16x8, bl_), __builtin_bit_cast(bf16x8, al_), acc[ai][bj][m][n], 0, 0, 0);   \
               acc[ai][bj][m][n] = __builtin_amdgcn_mfma_f32_16x16x32_bf16(__builtin_bit_cast(bf16x8, bh_), __builtin_bit_cast(bf16x8, ah_), acc[ai][bj][m][n], 0, 0, 0); } } \
        __builtin_amdgcn_s_setprio(0); } while (0)
#define PG8_WAIT_V(n) asm volatile("s_waitcnt vmcnt(" #n ")" ::: "memory")
#define PG8_WAIT_L(n) asm volatile("s_waitcnt lgkmcnt(" #n ")" ::: "memory")
#define PG8_BAR __builtin_amdgcn_s_barrier()
#define PG8_SCHED __builtin_amdgcn_sched_barrier(0)
    int sc8 = 0x7f7f7f7f; asm volatile("" : "+v"(sc8));
    Unit cur, nxt; int ui = 0;
    if (!S.next(0, cur)) return;
    f32x4 acc[2][2][4][2];
#pragma unroll
    for (int a = 0; a < 2; ++a)
#pragma unroll
        for (int b = 0; b < 2; ++b)
#pragma unroll
            for (int m = 0; m < 4; ++m)
#pragma unroll
                for (int n = 0; n < 2; ++n) acc[a][b][m][n] = (f32x4){0.f, 0.f, 0.f, 0.f};
    i32x8v At[4], B0[2], B1[2];
    const char* cA = (const char*)g.A + (size_t)cur.pa * tA; const char* cB = (const char*)g.Bt + (size_t)cur.pb * tB;
    typename Epi::Pre pre = E.prefetch(cur, wc, fq);
    PG8_GLOAD(gC, cur);
#pragma unroll
    for (int _h = 0; _h < 2; ++_h)
#pragma unroll
        for (int _i = 0; _i < 2; ++_i) gN[_h][_i] = gC[_h][_i];
    if constexpr (SP2) {
        PG8_STAGE(PG8_SB(0, 0), cB, voffB); PG8_STAGE(PG8_SB(0, 1), cB + hB, voffB); PG8_STAGE_A(0, 0, cA, false); PG8_STAGE_A(0, 1, cA, false);
        if (wr == 1) PG8_BAR;
        PG8_WAIT_V(2); PG8_BAR;
        PG8_STAGE(PG8_SB(1, 0), cB + kstep, voffB); PG8_STAGE_A(1, 0, cA + kstep, false); PG8_STAGE(PG8_SB(1, 1), cB + hB + kstep, voffB);
        PG8_WAIT_V(6); PG8_BAR;
    } else {
        static_assert(!GATHER, "the gathered A operand is wired into the SP2 loop only");
        PG8_STAGE(PG8_SB(0, 0), cB, voffB); PG8_STAGE(PG8_SA(0, 0), cA, voffA); PG8_STAGE(PG8_SB(0, 1), cB + hB, voffB); PG8_STAGE(PG8_SA(0, 1), cA + hA, voffA);
        if (wr == 1) PG8_BAR;
        PG8_WAIT_V(4); PG8_BAR;
        PG8_STAGE(PG8_SB(1, 0), cB + kstep, voffB); PG8_STAGE(PG8_SA(1, 0), cA + kstep, voffA); PG8_STAGE(PG8_SB(1, 1), cB + hB + kstep, voffB);
        PG8_WAIT_V(6); PG8_BAR;
    }
    for (;;) {
        const bool has_next = S.next(ui + 1, nxt);
        const char* nA = has_next ? (const char*)g.A + (size_t)nxt.pa * tA : cA; const char* nB = has_next ? (const char*)g.Bt + (size_t)nxt.pb * tB : cB;
        if (has_next) PG8_GLOAD(gN, nxt);
#pragma nounroll
        for (int t = 0; t < nt; t += 2) {
            const bool last = (t == nt - 2);
            const char* a1 = cA + (size_t)(t + 1) * kstep;
            const char* a2 = last ? nA : cA + (size_t)(t + 2) * kstep; const char* b2 = last ? nB : cB + (size_t)(t + 2) * kstep;
            const char* a3 = a2 + kstep; const char* b3 = b2 + kstep;
            if constexpr (SP2) {
            PG8_LDB(B0, 0, 0); PG8_LDB(B1, 0, 1); PG8_SCHED; PG8_LDA(At, 0, 0); PG8_STAGE_A(1, 1, a1, false);
            PG8_WAIT_V(8); PG8_WAIT_L(0); PG8_BAR; PG8_MMA(0, 0, At, B0); PG8_MMA(0, 1, At, B1); PG8_BAR; PG8_SCHED;
            PG8_LDA(At, 0, 1); PG8_STAGE(PG8_SB(0, 0), b2, voffB); PG8_STAGE(PG8_SB(0, 1), b2 + hB, voffB); PG8_STAGE_A(0, 0, a2, last);
            PG8_WAIT_V(8); PG8_WAIT_L(0); PG8_BAR; PG8_MMA(1, 0, At, B0); PG8_MMA(1, 1, At, B1); PG8_BAR; PG8_SCHED;
            PG8_LDB(B0, 1, 0); PG8_LDB(B1, 1, 1); PG8_SCHED; PG8_LDA(At, 1, 0); PG8_STAGE_A(0, 1, a2, last);
            PG8_WAIT_V(8); PG8_WAIT_L(0); PG8_BAR; PG8_MMA(0, 0, At, B0); PG8_MMA(0, 1, At, B1); PG8_BAR; PG8_SCHED;
            PG8_LDA(At, 1, 1); PG8_STAGE(PG8_SB(1, 0), b3, voffB); PG8_STAGE(PG8_SB(1, 1), b3 + hB, voffB); PG8_STAGE_A(1, 0, a3, last);
            PG8_WAIT_V(8); PG8_WAIT_L(0); PG8_BAR; PG8_MMA(1, 0, At, B0); PG8_MMA(1, 1, At, B1); PG8_BAR; PG8_SCHED;
            } else {
            PG8_LDB(B0, 0, 0); PG8_SCHED; PG8_LDA(At, 0, 0); PG8_STAGE(PG8_SA(1, 1), a1 + hA, voffA);
            PG8_WAIT_L(8); PG8_BAR; PG8_WAIT_L(0); PG8_MMA(0, 0, At, B0); PG8_BAR; PG8_SCHED;
            PG8_LDB(B1, 0, 1); PG8_STAGE(PG8_SB(0, 0), b2, voffB);
            PG8_BAR; PG8_WAIT_L(0); PG8_MMA(0, 1, At, B1); PG8_BAR;
            PG8_LDA(At, 0, 1); PG8_STAGE(PG8_SA(0, 0), a2, voffA);
            PG8_BAR; PG8_WAIT_L(0); PG8_MMA(1, 0, At, B0); PG8_BAR; PG8_SCHED;
            PG8_STAGE(PG8_SB(0, 1), b2 + hB, voffB);
            PG8_WAIT_V(6); PG8_BAR; PG8_MMA(1, 1, At, B1); PG8_BAR;
            PG8_LDB(B0, 1, 0); PG8_SCHED; PG8_LDA(At, 1, 0); PG8_STAGE(PG8_SA(0, 1), a2 + hA, voffA);
            PG8_WAIT_L(8); PG8_BAR; PG8_WAIT_L(0); PG8_MMA(0, 0, At, B0); PG8_BAR; PG8_SCHED;
            PG8_LDB(B1, 1, 1); PG8_STAGE(PG8_SB(1, 0), b3, voffB);
            PG8_BAR; PG8_WAIT_L(0); PG8_MMA(0, 1, At, B1); PG8_BAR;
            PG8_LDA(At, 1, 1); PG8_STAGE(PG8_SA(1, 0), a3, voffA);
            PG8_BAR; PG8_WAIT_L(0); PG8_MMA(1, 0, At, B0); PG8_BAR; PG8_SCHED;
            PG8_STAGE(PG8_SB(1, 1), b3 + hB, voffB);
            PG8_WAIT_V(6); PG8_BAR; PG8_MMA(1, 1, At, B1); PG8_BAR;
            }
        }
        if constexpr (FP8) asm volatile("s_nop 15\n\ts_nop 15" ::: "memory");
        if constexpr (ALIGN_EPI) { if (wr == 0) PG8_BAR; }
        E(acc, cur, wr, wc, fr, fq, pre);
        if (!has_next) break;
        pre = E.prefetch(nxt, wc, fq);
#pragma unroll
        for (int a = 0; a < 2; ++a)
#pragma unroll
            for (int b = 0; b < 2; ++b)
#pragma unroll
                for (int m = 0; m < 4; ++m)
#pragma unroll
                    for (int n = 0; n < 2; ++n) acc[a][b][m][n] = (f32x4){0.f, 0.f, 0.f, 0.f};
        cur = nxt; cA = nA; cB = nB; ++ui;
#pragma unroll
        for (int _h = 0; _h < 2; ++_h)
#pragma unroll
            for (int _i = 0; _i < 2; ++_i) gC[_h][_i] = gN[_h][_i];
        if constexpr (ALIGN_EPI) { if (wr == 1) PG8_BAR; }
    }
    PG8_WAIT_V(0);
    if constexpr (!ALIGN_EPI) { if (wr == 0) PG8_BAR; }
    PG8_BAR;
#undef PG8_SA
#undef PG8_SB
#undef PG8_STAGE
#undef PG8_STAGE_A
#undef PG8_GLOAD
#undef PG8_LDA
#undef PG8_LDB
#undef PG8_MMA
#undef PG8_WAIT_V
#undef PG8_WAIT_L
#undef PG8_BAR
#undef PG8_SCHED
}
}

constexpr int BATCH = 16, SEQ = 2048, CTXL = 256, TPB = SEQ + CTXL, MROWS = BATCH * TPB, DM = 1024, DEPTH = 2;
constexpr int ZC = 2048, YC = 1280, INC = 1984;
constexpr int NEXP = 32, MAXTILES = 608, XSROWS = MAXTILES * 256;
constexpr float EPS = 1e-6f, LOG2E = 1.4426950408889634f;
constexpr float QS_NA = 0.125f * LOG2E;
constexpr float QS_MLA = 0.10206207261596575f * LOG2E;
constexpr int Z_NAQ = 0, Z_NAK = 256, Z_NAV = 512, Z_CQ = 768, Z_CKV = 1024, Z_KR = 1152, Z_GQ = 1184, Z_GK = 1312, Z_GV = 1440, Z_GO = 1696, Z_LF = 1952, Z_LB = 1968;
constexpr int NPH = 1 + 13 * DEPTH;

constexpr size_t MiB = 1u << 20;
constexpr size_t WS_CTL = 0, CTL_ZERO_BYTES = 1 * MiB;
constexpr size_t WS_MOD = 1 * MiB, WS_WSM = 2 * MiB, WS_WIN = 4 * MiB, WS_WOUT = 12 * MiB, WS_W1 = 16 * MiB, WS_W2 = 272 * MiB;
constexpr size_t WS_XU = 400 * MiB, WS_H = 544 * MiB, WS_ATT = 616 * MiB, WS_Z = 688 * MiB, WS_Y = 832 * MiB;
constexpr size_t WS_NAQ = 922 * MiB, WS_NAK = 940 * MiB, WS_NAVT = 958 * MiB, WS_MQ = 976 * MiB, WS_MK = 1012 * MiB, WS_MV = 1048 * MiB;
constexpr size_t WS_EGF = 1084 * MiB, WS_EGB = 1102 * MiB, WS_GQ = 1120 * MiB, WS_GK = 1138 * MiB, WS_GV = 1156 * MiB, WS_CS = 1192 * MiB, WS_AD = 1228 * MiB;
constexpr size_t WS_OGF = 1229 * MiB, WS_OGB = 1265 * MiB, WS_TOPE = 1301 * MiB, WS_TOPG = 1302 * MiB, WS_DEST = 1303 * MiB, WS_HIST = 1304 * MiB;
constexpr size_t WS_XS = 1305 * MiB, WS_ACT = 1609 * MiB, WS_Z8 = 1913 * MiB, WS_END = 1941 * MiB;
static_assert((size_t)XSROWS * DM * 2 <= 304 * MiB && (size_t)MROWS * YC * 2 <= 90 * MiB && (size_t)MROWS * 384 * 2 <= 27 * MiB, "ws map");
constexpr int CW_BAR = 4096;

constexpr int RING_OFF = 0, MISC_OFF = 139264, LDS_BYTES = 147456;
constexpr int MW_BAR = 8, MW_CNT = 64, MW_BB = 96, MW_TS = 128, MW_TE = 192, MW_TMP = 384, MW_WH = 1536;
constexpr int WRT_PITCH = 1028;
constexpr int VT_PITCH = 1544;
static_assert(NEXP * WRT_PITCH * 4 <= MISC_OFF && 64 * VT_PITCH <= MISC_OFF, "LDS map");

#define RLX_AGENT __ATOMIC_RELAXED, __HIP_MEMORY_SCOPE_AGENT
#define LDS_WAIT() asm volatile("s_waitcnt lgkmcnt(0)" ::: "memory")
#define VM_WAIT() asm volatile("s_waitcnt vmcnt(0)" ::: "memory")
__device__ __forceinline__ float bf2f(unsigned u) { return __uint_as_float(u << 16); }
__device__ __forceinline__ unsigned pk2(float lo, float hi) { unsigned r; asm("v_cvt_pk_bf16_f32 %0, %1, %2" : "=v"(r) : "v"(lo), "v"(hi)); return r; }
__device__ __forceinline__ unsigned f2bf(float f) { return pk2(f, 0.f) & 0xffffu; }
__device__ __forceinline__ float clamp8(float v) { return fminf(fmaxf(v, -448.0f), 448.0f); }
__device__ __forceinline__ unsigned pk4f8(float a, float b, float c, float d) {
    int p = __builtin_amdgcn_cvt_pk_fp8_f32(clamp8(a), clamp8(b), 0, false); p = __builtin_amdgcn_cvt_pk_fp8_f32(clamp8(c), clamp8(d), p, true); return (unsigned)p; }
constexpr float SC_YC = 16.0f;
constexpr float SC_Y = 8.0f;
constexpr float SC_W = 256.0f, SC_X = 16.0f, SC_ACT = 4.0f;
__device__ __forceinline__ void ld4bf(const bf16* p, float (&f)[4]) { const u32x2 w = *(const u32x2*)p; f[0] = __uint_as_float(w.x << 16); f[1] = __uint_as_float(w.x & 0xffff0000u); f[2] = __uint_as_float(w.y << 16); f[3] = __uint_as_float(w.y & 0xffff0000u); }
__device__ __forceinline__ f32x4 bf4f(const u32x2 w) { return (f32x4){__uint_as_float(w.x << 16), __uint_as_float(w.x & 0xffff0000u), __uint_as_float(w.y << 16), __uint_as_float(w.y & 0xffff0000u)}; }
__device__ __forceinline__ void st4bf(bf16* p, float a, float b, float c, float d) { u32x2 w; w.x = pk2(a, b); w.y = pk2(c, d); *(u32x2*)p = w; }
template <int M> __device__ __forceinline__ float swz_xor(float v) { return __int_as_float(__builtin_amdgcn_ds_swizzle(__float_as_int(v), 0x1f | (M << 10))); }
__device__ __forceinline__ float half_sum(float v) { auto rr = __builtin_amdgcn_permlane32_swap(__float_as_uint(v), __float_as_uint(v), false, false); return __uint_as_float(rr[0]) + __uint_as_float(rr[1]); }
__device__ __forceinline__ float half_max(float v) { auto rr = __builtin_amdgcn_permlane32_swap(__float_as_uint(v), __float_as_uint(v), false, false); return fmaxf(__uint_as_float(rr[0]), __uint_as_float(rr[1])); }
template <int CTRL> __device__ __forceinline__ float dpp_f(float v) { return __int_as_float(__builtin_amdgcn_update_dpp(0, __float_as_int(v), CTRL, 0xF, 0xF, true)); }
__device__ __forceinline__ float g8_sum(float v) { v += dpp_f<0xB1>(v); v += dpp_f<0x4E>(v); v += dpp_f<0x141>(v); return v; }
__device__ __forceinline__ float g16_sum(float v) { v = g8_sum(v); v += dpp_f<0x140>(v); return v; }
__device__ __forceinline__ float rl_f(float v, int l) { return __int_as_float(__builtin_amdgcn_readlane(__float_as_int(v), l)); }
__device__ __forceinline__ float wave_sum(float v) { v = g16_sum(v); return (rl_f(v, 0) + rl_f(v, 16)) + (rl_f(v, 32) + rl_f(v, 48)); }
__device__ __forceinline__ float row_sum(float v) { auto rr = __builtin_amdgcn_permlane16_swap(__float_as_uint(v), __float_as_uint(v), false, false); return __uint_as_float(rr[0]) + __uint_as_float(rr[1]); }
__device__ __forceinline__ float row_max(float v) { auto rr = __builtin_amdgcn_permlane16_swap(__float_as_uint(v), __float_as_uint(v), false, false); return fmaxf(__uint_as_float(rr[0]), __uint_as_float(rr[1])); }
template <int CTRL> __device__ __forceinline__ float dpp_max(float v) { return fmaxf(v, dpp_f<CTRL>(v)); }
__device__ __forceinline__ float wave_max(float v) { v = dpp_max<0xB1>(v); v = dpp_max<0x4E>(v); v = dpp_max<0x141>(v); v = dpp_max<0x140>(v); return fmaxf(fmaxf(rl_f(v, 0), rl_f(v, 16)), fmaxf(rl_f(v, 32), rl_f(v, 48))); }
__device__ __forceinline__ float q4_sum(float v) { return half_sum(row_sum(v)); }
__device__ __forceinline__ float q4_max(float v) { return half_max(row_max(v)); }
__device__ __forceinline__ float rsq(float x) { return __builtin_amdgcn_rsqf(x); }

#define XB_TMO      128
#define XB_XCNT(j)  (256  + 64 * (j))
#define XB_XSUB(j)  (1280 + 64 * (j))
#define XB_XGEN(j)  (2304 + 64 * (j))
#define XB_TOP      3328
#define XB_TOPGEN   3392
#define XCD_BAR_WORDS 3456
#define XB_SPIN_CAP (1u << 18)
__device__ __forceinline__ unsigned xb_ld(unsigned* p)              { return __hip_atomic_load(p, __ATOMIC_RELAXED, __HIP_MEMORY_SCOPE_AGENT); }
__device__ __forceinline__ unsigned xb_add(unsigned* p, unsigned v) { return __hip_atomic_fetch_add(p, v, __ATOMIC_RELAXED, __HIP_MEMORY_SCOPE_AGENT); }
__device__ __forceinline__ unsigned xb_xcc_id() { return (unsigned)__builtin_amdgcn_s_getreg((3 << 11) | 20) & 0xFu; }
#define XB_SPIN(cond, bar) do { unsigned _sp = 0; while (cond) { __builtin_amdgcn_s_sleep(1); \
    if ((++_sp & 255u) == 0u) { if (xb_ld(&(bar)[XB_TMO])) break; if (_sp > XB_SPIN_CAP) { atomicAdd(&(bar)[XB_TMO], 1u); break; } } } } while (0)
struct XcdBarrier { unsigned* bar; unsigned x; volatile LAS unsigned* st; };
__device__ __forceinline__ XcdBarrier xcd_barrier_post(unsigned* bar, volatile LAS unsigned* st) {
    XcdBarrier b; b.bar = bar; b.x = xb_xcc_id(); b.st = st;
    if (threadIdx.x == 0) (void)xb_add(&bar[XB_XCNT(b.x)], 1u);
    return b;
}
__device__ __forceinline__ void xcd_barrier_complete(unsigned* bar, unsigned x, unsigned& nloc, unsigned& nx) {
    const unsigned G = gridDim.x * gridDim.y * gridDim.z;
    unsigned sum, cnt, mine, sp = 0u;
    for (;;) {
        sum = 0u; cnt = 0u; mine = 0u;
#pragma unroll
        for (unsigned j = 0; j < 16; ++j) { const unsigned c = xb_ld(&bar[XB_XCNT(j)]); sum += c; cnt += (c > 0u) ? 1u : 0u; }
        mine = xb_ld(&bar[XB_XCNT(x)]);
        if (sum == G) break;
        __builtin_amdgcn_s_sleep(1);
        if ((++sp & 255u) == 0u) { if (xb_ld(&bar[XB_TMO])) break; if (sp > XB_SPIN_CAP) { atomicAdd(&bar[XB_TMO], 1u); break; } }
    }
    nloc = mine > 0u ? mine : 1u; nx = cnt > 0u ? cnt : 1u;
}
__device__ __attribute__((noinline)) void xcd_barrier(unsigned* const bbar, const unsigned bx, volatile LAS unsigned* const bst, const int tid) {
    XcdBarrier b; b.bar = bbar; b.x = bx; b.st = bst;
    asm volatile("s_waitcnt vmcnt(0)" ::: "memory");
    __syncthreads();
    if (tid == 0) {
        unsigned* bar = b.bar;
        __builtin_amdgcn_s_waitcnt(0);
        unsigned nloc = b.st[0], nx = b.st[1];
        if (nloc == 0u) { xcd_barrier_complete(bar, b.x, nloc, nx); b.st[0] = nloc; b.st[1] = nx; }
        const unsigned old = xb_add(&bar[XB_XSUB(b.x)], 1u);
        const unsigned gen = old / nloc;
        if (old + 1u == (gen + 1u) * nloc) {
            __builtin_amdgcn_fence(__ATOMIC_RELEASE, "agent");
            asm volatile("s_waitcnt vmcnt(0)" ::: "memory");
            const unsigned og = xb_add(&bar[XB_TOP], 1u);
            const unsigned tg = og / nx;
            if (og + 1u == (tg + 1u) * nx) xb_add(&bar[XB_TOPGEN], 1u);
            else XB_SPIN(xb_ld(&bar[XB_TOPGEN]) == tg, bar);
            __builtin_amdgcn_fence(__ATOMIC_ACQUIRE, "agent");
            xb_add(&bar[XB_XGEN(b.x)], 1u);
            asm volatile("s_waitcnt vmcnt(0)" ::: "memory");
        } else {
            XB_SPIN(xb_ld(&bar[XB_XGEN(b.x)]) == gen, bar);
            __builtin_amdgcn_fence(__ATOMIC_ACQUIRE, "agent");
            asm volatile("s_waitcnt vmcnt(0)" ::: "memory");
        }
    }
    __syncthreads();
}

struct Args { const float* in[28]; float* out; unsigned char* ws; int ph_lo, ph_hi, li, pad; };
struct Frame {
    LAS unsigned char* lds;
    volatile LAS unsigned* MISC;
    int tid, lane, wave, G, blk, gw, ngw;
    const Args* A;
};
#define IN_F(F, i) ((F).A->in[i])
#define x_        IN_F(F, 0)
#define c_        IN_F(F, 1)
#define ctx_      IN_F(F, 2)
#define c_ctx_    IN_F(F, 3)
#define w_ada_    IN_F(F, 4)
#define b_ada_    IN_F(F, 5)
#define g_mix_    IN_F(F, 6)
#define w_in_     IN_F(F, 7)
#define na_q_norm_ IN_F(F, 8)
#define na_k_norm_ IN_F(F, 9)
#define na_rpb_   IN_F(F, 10)
#define mla_q_a_norm_ IN_F(F, 11)
#define mla_w_q_b_ IN_F(F, 12)
#define mla_kv_a_norm_ IN_F(F, 13)
#define mla_w_kv_b_ IN_F(F, 14)
#define mla_q_norm_ IN_F(F, 15)
#define mla_k_norm_ IN_F(F, 16)
#define gla_w_gate_ IN_F(F, 17)
#define gla_b_gate_ IN_F(F, 18)
#define gla_o_norm_ IN_F(F, 19)
#define w_out_    IN_F(F, 20)
#define g_ffn_    IN_F(F, 21)
#define w_router_ IN_F(F, 22)
#define b_router_ IN_F(F, 23)
#define w_moe1_   IN_F(F, 24)
#define b_moe1_   IN_F(F, 25)
#define w_moe2_   IN_F(F, 26)
#define b_moe2_   IN_F(F, 27)
#define out_      ((F).A->out)
#define WSP(F, T, off) ((T*)((F).A->ws + (off)))
#define MOD_  WSP(F, float, WS_MOD)
#define XU_   WSP(F, bf16, WS_XU)
#define EGF_  WSP(F, bf16, WS_EGF)
#define EGB_  WSP(F, bf16, WS_EGB)
#define GQ_   WSP(F, float, WS_GQ)
#define GK_   WSP(F, float, WS_GK)
#define GV_   WSP(F, float, WS_GV)
#define CS_   WSP(F, float, WS_CS)
#define AD_   WSP(F, float, WS_AD)
#define OGF_  WSP(F, float, WS_OGF)
#define OGB_  WSP(F, float, WS_OGB)
#define TOPG_ WSP(F, float, WS_TOPG)
#define WSM_  WSP(F, bf16, WS_WSM)
#define WIN_  WSP(F, bf16, WS_WIN)
#define WOUT_ WSP(F, bf16, WS_WOUT)
#define W1_   WSP(F, bf16, WS_W1)
#define W2_   WSP(F, bf16, WS_W2)
#define H_    WSP(F, bf16, WS_H)
#define ATT_  WSP(F, bf16, WS_ATT)
#define Z_    WSP(F, bf16, WS_Z)
#define Z8_   WSP(F, unsigned char, WS_Z8)
#define Y_    WSP(F, bf16, WS_Y)
#define NAQ_  WSP(F, bf16, WS_NAQ)
#define NAK_  WSP(F, bf16, WS_NAK)
#define NAVT_ WSP(F, bf16, WS_NAVT)
#define MQ_   WSP(F, bf16, WS_MQ)
#define MK_   WSP(F, bf16, WS_MK)
#define MV_   WSP(F, bf16, WS_MV)
#define XS_   WSP(F, bf16, WS_XS)
#define ACT_  WSP(F, bf16, WS_ACT)
#define TOPE_ WSP(F, int, WS_TOPE)
#define DEST_ WSP(F, int, WS_DEST)
#define ROWMAP_ WSP(F, int, WS_GQ)
#define HISTB_ WSP(F, int, WS_HIST)
#define WHIST_ WSP(F, int, WS_HIST + 65536)

struct DenseOrder {
    int nMa, nN, G, c, skipctx, rep;
    __device__ __forceinline__ bool next(int i, pg8::Unit& u) const {
        const int x = c & 7, y = c >> 3, Y = G >> 3;
        if (rep > 1) i >>= 1;
        const int j = i * Y + y; const int mg = j / nN, pn = j - mg * nN, a = mg * 8 + x;
        if (a >= nMa) return false;
        u.pm = skipctx ? (a >> 3) * 9 + (a & 7) : a; u.pn = pn; u.pb = pn; u.pa = u.pm; return true;
    }
};
struct MoeOrder {
    const volatile LAS int* ts; const volatile LAS unsigned char* te; int nN, G, c, rep;
    __device__ __forceinline__ bool next(int i, pg8::Unit& u) const {
        const int x = c & 7, y = c >> 3, Y = G >> 3;
        const int i0 = i; if (rep > 1) i >>= 1;
        const int j = i * Y + y; const int mg = j / nN, pn = j - mg * nN, a = mg * 8 + x;
        if (a >= ts[NEXP]) return false;
        const int e = te[a]; u.pm = a; u.pn = pn; u.pb = e * nN + pn; u.pa = a;
        if (NREP(19) > 1 && rep > 1 && !(i0 & 1)) { const int a2 = (a + 296) % ts[NEXP]; u.pa = a2; u.pb = te[a2] * nN + pn; }
        return true;
    }
};

struct EpiNoPre { };
template <bool SCALED> struct EpiBf16PlainT {
    static constexpr bool PERM = true; typedef EpiNoPre Pre;
    bf16* O; int ldc;
    __device__ __forceinline__ Pre prefetch(const pg8::Unit&, int, int) const { return Pre{}; }
    __device__ __forceinline__ void operator()(const f32x4 (&acc)[2][2][4][2], const pg8::Unit& u, int wr, int wc, int fr, int fq, const Pre&) const {
        const int row0 = u.pm * 256 + wr * 64 + fr, col0 = u.pn * 256 + wc * 32 + 8 * fq;
#pragma unroll
        for (int ai = 0; ai < 2; ++ai)
#pragma unroll
            for (int m = 0; m < 4; ++m) { bf16* rowp = O + (size_t)(row0 + ai * 128 + m * 16) * ldc + col0;
#pragma unroll
                for (int bj = 0; bj < 2; ++bj) { f32x4 v0 = acc[ai][bj][m][0], v1 = acc[ai][bj][m][1];
                    if constexpr (SCALED) { v0 = v0 * (1.0f / (SC_W * SC_X)); v1 = v1 * (1.0f / (SC_W * SC_X)); }
                    u32x4 w; w.x = pg8::cvt_pk_bf16(v0[0], v0[1]); w.y = pg8::cvt_pk_bf16(v0[2], v0[3]); w.z = pg8::cvt_pk_bf16(v1[0], v1[1]); w.w = pg8::cvt_pk_bf16(v1[2], v1[3]);
                    *(u32x4*)(rowp + bj * 128) = w; } }
    }
};
typedef EpiBf16PlainT<false> EpiBf16Plain;
struct EpiZ {
    static constexpr bool PERM = true; typedef EpiNoPre Pre;
    bf16* O; unsigned char* O8;
    __device__ __forceinline__ Pre prefetch(const pg8::Unit&, int, int) const { return Pre{}; }
    __device__ __forceinline__ void operator()(const f32x4 (&acc)[2][2][4][2], const pg8::Unit& u, int wr, int wc, int fr, int fq, const Pre&) const {
        const int row0 = u.pm * 256 + wr * 64 + fr, col0 = u.pn * 256 + wc * 32 + 8 * fq;
        if (u.pn < 3) {
#pragma unroll
            for (int ai = 0; ai < 2; ++ai)
#pragma unroll
                for (int m = 0; m < 4; ++m) { unsigned char* rowp = O8 + (size_t)(row0 + ai * 128 + m * 16) * 768 + col0;
#pragma unroll
                    for (int bj = 0; bj < 2; ++bj) { const f32x4 v0 = acc[ai][bj][m][0] * (SC_YC / (SC_W * SC_X)), v1 = acc[ai][bj][m][1] * (SC_YC / (SC_W * SC_X));
                        u32x2 w; w.x = pk4f8(v0[0], v0[1], v0[2], v0[3]); w.y = pk4f8(v1[0], v1[1], v1[2], v1[3]); *(u32x2*)(rowp + bj * 128) = w; } }
        } else {
#pragma unroll
            for (int ai = 0; ai < 2; ++ai)
#pragma unroll
                for (int m = 0; m < 4; ++m) { bf16* rowp = O + (size_t)(row0 + ai * 128 + m * 16) * ZC + col0;
#pragma unroll
                    for (int bj = 0; bj < 2; ++bj) { const f32x4 v0 = acc[ai][bj][m][0] * (1.0f / (SC_W * SC_X)), v1 = acc[ai][bj][m][1] * (1.0f / (SC_W * SC_X));
                        u32x4 w; w.x = pg8::cvt_pk_bf16(v0[0], v0[1]); w.y = pg8::cvt_pk_bf16(v0[2], v0[3]); w.z = pg8::cvt_pk_bf16(v1[0], v1[1]); w.w = pg8::cvt_pk_bf16(v1[2], v1[3]);
                        *(u32x4*)(rowp + bj * 128) = w; } }
        }
    }
};
struct EpiFp8Plain {
    static constexpr bool PERM = true; typedef EpiNoPre Pre;
    unsigned char* O; int ldc;
    __device__ __forceinline__ Pre prefetch(const pg8::Unit&, int, int) const { return Pre{}; }
    __device__ __forceinline__ void operator()(const f32x4 (&acc)[2][2][4][2], const pg8::Unit& u, int wr, int wc, int fr, int fq, const Pre&) const {
        const int row0 = u.pm * 256 + wr * 64 + fr, col0 = u.pn * 256 + wc * 32 + 8 * fq;
#pragma unroll
        for (int ai = 0; ai < 2; ++ai)
#pragma unroll
            for (int m = 0; m < 4; ++m) { unsigned char* rowp = O + (size_t)(row0 + ai * 128 + m * 16) * ldc + col0;
#pragma unroll
                for (int bj = 0; bj < 2; ++bj) { const f32x4 v0 = acc[ai][bj][m][0] * SC_YC, v1 = acc[ai][bj][m][1] * SC_YC;
                    u32x2 w; w.x = pk4f8(v0[0], v0[1], v0[2], v0[3]); w.y = pk4f8(v1[0], v1[1], v1[2], v1[3]); *(u32x2*)(rowp + bj * 128) = w; } }
    }
};
struct EpiResid {
    static constexpr bool PERM = true; typedef EpiNoPre Pre;
    bf16* X; const float* gt;
    const float* xin; const float* cin;
    __device__ __forceinline__ Pre prefetch(const pg8::Unit&, int, int) const { return Pre{}; }
    __device__ __forceinline__ void operator()(const f32x4 (&acc)[2][2][4][2], const pg8::Unit& u, int wr, int wc, int fr, int fq, const Pre&) const {
        const int row0 = u.pm * 256 + wr * 64 + fr, col0 = u.pn * 256 + wc * 32 + 8 * fq;
        const int bi = u.pm / 9, t9 = u.pm - bi * 9, mc = (t9 == 8) ? 16 : bi; const float* g = gt + mc * 6144 + col0;
        const float* base = xin ? (t9 == 8 ? cin + (size_t)bi * CTXL * DM : xin + ((size_t)bi * SEQ + t9 * 256) * DM) + (size_t)(wr * 64 + fr) * DM + col0 : nullptr;
        f32x4 gv[2][2];
#pragma unroll
        for (int bj = 0; bj < 2; ++bj)
#pragma unroll
            for (int n = 0; n < 2; ++n) gv[bj][n] = *(const f32x4*)(g + bj * 128 + 4 * n);
#pragma unroll
        for (int ai = 0; ai < 2; ++ai)
#pragma unroll
            for (int m = 0; m < 4; ++m) { bf16* rowp = X + (size_t)(row0 + ai * 128 + m * 16) * DM + col0;
#pragma unroll
                for (int bj = 0; bj < 2; ++bj) { f32x4 b0, b1;
                    if (xin) { const float* bp = base + (size_t)(ai * 128 + m * 16) * DM + bj * 128; b0 = *(const f32x4*)bp; b1 = *(const f32x4*)(bp + 4); }
                    else { const u32x4 w = *(const u32x4*)(rowp + bj * 128); u32x2 lo, hi; lo.x = w.x; lo.y = w.y; hi.x = w.z; hi.y = w.w; b0 = bf4f(lo); b1 = bf4f(hi); }
                    const f32x4 v0 = b0 + gv[bj][0] * acc[ai][bj][m][0], v1 = b1 + gv[bj][1] * acc[ai][bj][m][1];
                    u32x4 o; o.x = pg8::cvt_pk_bf16(v0[0], v0[1]); o.y = pg8::cvt_pk_bf16(v0[2], v0[3]); o.z = pg8::cvt_pk_bf16(v1[0], v1[1]); o.w = pg8::cvt_pk_bf16(v1[2], v1[3]);
                    *(u32x4*)(rowp + bj * 128) = o; } }
    }
};
struct EpiSwiglu {
    static constexpr bool PERM = true; struct Pre { f32x4 bg[2], bl[2]; };
    unsigned char* O; const float* b1;
    __device__ __forceinline__ Pre prefetch(const pg8::Unit& u, int wc, int fq) const { Pre p; const float* bb = b1 + (u.pb >> 3) * 2048 + u.pn * 128 + wc * 32 + 8 * fq;
#pragma unroll
        for (int n = 0; n < 2; ++n) { p.bg[n] = *(const f32x4*)(bb + 4 * n); p.bl[n] = *(const f32x4*)(bb + 1024 + 4 * n); }
        return p; }
    __device__ __forceinline__ void operator()(const f32x4 (&acc)[2][2][4][2], const pg8::Unit& u, int wr, int wc, int fr, int fq, const Pre& pre) const {
        const int row0 = u.pm * 256 + wr * 64 + fr, oc0 = u.pn * 128 + wc * 32 + 8 * fq;
        const f32x4 (&bg)[2] = pre.bg; const f32x4 (&bl)[2] = pre.bl;
        constexpr float S = 1.0f / (SC_W * SC_X);
#pragma unroll
        for (int ai = 0; ai < 2; ++ai)
#pragma unroll
            for (int m = 0; m < 4; ++m) { u32x2 w;
#pragma unroll
                for (int n = 0; n < 2; ++n) { f32x4 gl = acc[ai][0][m][n] * S + bg[n], li = acc[ai][1][m][n] * S + bl[n];
#pragma unroll
                    for (int i = 0; i < 4; ++i) { gl[i] = fminf(gl[i], 7.0f); li[i] = __builtin_amdgcn_fmed3f(li[i], -7.0f, 7.0f); }
                    f32x4 e = gl * (-1.702f * LOG2E);
#pragma unroll
                    for (int i = 0; i < 4; ++i) e[i] = __builtin_amdgcn_exp2f(e[i]);
                    e = e + 1.0f;
#pragma unroll
                    for (int i = 0; i < 4; ++i) e[i] = __builtin_amdgcn_rcpf(e[i]);
                    const f32x4 o = (li * SC_ACT + SC_ACT) * (gl * e);
                    int p = __builtin_amdgcn_cvt_pk_fp8_f32(o[0], o[1], 0, false); p = __builtin_amdgcn_cvt_pk_fp8_f32(o[2], o[3], p, true);
                    if (n == 0) w.x = (unsigned)p; else w.y = (unsigned)p; }
                *(u32x2*)(O + (size_t)(row0 + ai * 128 + m * 16) * DM + oc0) = w; }
    }
};
struct EpiFp8Bias {
    static constexpr bool PERM = true; struct Pre { f32x4 bv[2][2]; };
    unsigned char* O; const float* b2;
    __device__ __forceinline__ Pre prefetch(const pg8::Unit& u, int wc, int fq) const { Pre p; const float* bb = b2 + (u.pb >> 2) * 1024 + u.pn * 256 + wc * 32 + 8 * fq;
#pragma unroll
        for (int bj = 0; bj < 2; ++bj)
#pragma unroll
            for (int n = 0; n < 2; ++n) p.bv[bj][n] = *(const f32x4*)(bb + bj * 128 + 4 * n);
        return p; }
    __device__ __forceinline__ void operator()(const f32x4 (&acc)[2][2][4][2], const pg8::Unit& u, int wr, int wc, int fr, int fq, const Pre& pre) const {
        const int row0 = u.pm * 256 + wr * 64 + fr, col0 = u.pn * 256 + wc * 32 + 8 * fq;
        const f32x4 (&bv)[2][2] = pre.bv;
#pragma unroll
        for (int ai = 0; ai < 2; ++ai)
#pragma unroll
            for (int m = 0; m < 4; ++m) { unsigned char* rowp = O + (size_t)(row0 + ai * 128 + m * 16) * DM + col0;
#pragma unroll
                for (int bj = 0; bj < 2; ++bj) { const f32x4 v0 = acc[ai][bj][m][0] * (SC_Y / (SC_W * SC_ACT)) + bv[bj][0] * SC_Y, v1 = acc[ai][bj][m][1] * (SC_Y / (SC_W * SC_ACT)) + bv[bj][1] * SC_Y;
                    u32x2 w; w.x = pk4f8(v0[0], v0[1], v0[2], v0[3]); w.y = pk4f8(v1[0], v1[1], v1[2], v1[3]);
                    *(u32x2*)(rowp + bj * 128) = w; } }
    }
};

__device__ __forceinline__ void relane(Frame& F) { int ln_; asm volatile("v_mbcnt_lo_u32_b32 %0, -1, 0\n\tv_mbcnt_hi_u32_b32 %0, -1, %0" : "=v"(ln_)); ln_ &= 63; F.lane = ln_; F.tid = F.wave * 64 + ln_; }

__device__ __forceinline__ void tr_item(const float* src, int ldsrc, bool valid, const float* ksc, bf16* dst, int lddst, LAS float* scr, int lane) {
    float v[32];
#pragma unroll
    for (int i = 0; i < 32; ++i) { const int kk = 2 * i + (lane >> 5); v[i] = valid ? src[(size_t)kk * ldsrc + (lane & 31)] : 0.f; }
    if (valid && ksc) {
#pragma unroll
        for (int i = 0; i < 32; ++i) v[i] *= ksc[2 * i + (lane >> 5)];
    }
#pragma unroll
    for (int i = 0; i < 32; ++i) { const int kk = 2 * i + (lane >> 5); scr[kk * 33 + (lane & 31)] = v[i]; }
    LDS_WAIT(); asm volatile("" ::: "memory");
    const int c = lane & 7;
#pragma unroll
    for (int j = 0; j < 4; ++j) { const int n = (lane >> 3) + 8 * j; const LAS float* s = scr + (8 * c) * 33 + n;
        u32x4 o; o.x = pk2(s[0 * 33], s[1 * 33]); o.y = pk2(s[2 * 33], s[3 * 33]); o.z = pk2(s[4 * 33], s[5 * 33]); o.w = pk2(s[6 * 33], s[7 * 33]);
        *(u32x4*)(dst + (size_t)n * lddst + 8 * c) = o; }
    LDS_WAIT(); asm volatile("" ::: "memory");
}
__device__ __forceinline__ void tr_item8(const float* src, int ldsrc, unsigned char* dst, int lddst, LAS float* scr, int lane) {
    float v[32];
#pragma unroll
    for (int i = 0; i < 32; ++i) { const int kk = 2 * i + (lane >> 5); v[i] = src[(size_t)kk * ldsrc + (lane & 31)] * SC_W; }
#pragma unroll
    for (int i = 0; i < 32; ++i) { const int kk = 2 * i + (lane >> 5); scr[kk * 33 + (lane & 31)] = v[i]; }
    LDS_WAIT(); asm volatile("" ::: "memory");
    const int c = lane & 7;
#pragma unroll
    for (int j = 0; j < 4; ++j) { const int n = (lane >> 3) + 8 * j; const LAS float* s = scr + (8 * c) * 33 + n;
        u32x2 o; o.x = pk4f8(s[0 * 33], s[1 * 33], s[2 * 33], s[3 * 33]); o.y = pk4f8(s[4 * 33], s[5 * 33], s[6 * 33], s[7 * 33]);
        *(u32x2*)(dst + (size_t)n * lddst + 8 * c) = o; }
    LDS_WAIT(); asm volatile("" ::: "memory");
}
__device__ __forceinline__ void tr_item8w(const float* src, int ldsrc, unsigned char* dst, LAS float* scr, int lane) {
    const int kr = lane >> 4, nc = (lane & 15) * 4;
    f32x4 v[16];
#pragma unroll
    for (int i = 0; i < 16; ++i) v[i] = *(const f32x4*)(src + (size_t)(4 * i + kr) * ldsrc + nc);
#pragma unroll
    for (int i = 0; i < 16; ++i) *(LAS f32x4*)(scr + (4 * i + kr) * 68 + nc) = v[i] * SC_W;
    LDS_WAIT(); asm volatile("" ::: "memory");
#pragma unroll
    for (int c = 0; c < 4; ++c) { const LAS float* s = scr + (16 * c) * 68 + lane; u32x4 o;
        o.x = pk4f8(s[0 * 68], s[1 * 68], s[2 * 68], s[3 * 68]); o.y = pk4f8(s[4 * 68], s[5 * 68], s[6 * 68], s[7 * 68]);
        o.z = pk4f8(s[8 * 68], s[9 * 68], s[10 * 68], s[11 * 68]); o.w = pk4f8(s[12 * 68], s[13 * 68], s[14 * 68], s[15 * 68]);
        *(u32x4*)(dst + (size_t)lane * 1024 + 16 * c) = o; }
    LDS_WAIT(); asm volatile("" ::: "memory");
}
__device__ __forceinline__ void p0_prologue(Frame& F) {
    for (int ch = F.blk; ch < 192; ch += F.G) {
        LAS float* s = (LAS float*)(F.lds + RING_OFF);
        LAS float* red = s + 17 * 1024;
        for (int idx = F.tid; idx < 17 * 1024; idx += 512) { const int m = idx >> 10, k = idx & 1023; const float cv = m < 16 ? c_[m * 1024 + k] : c_ctx_[k]; s[idx] = cv / (1.0f + __expf(-cv)); }
        __syncthreads();
        const int l = ch / 96, col0 = (ch % 96) * 64;
        const float* W = w_ada_ + (size_t)l * 1024 * 6144 + col0 + F.lane;
        float acc[17];
#pragma unroll
        for (int m = 0; m < 17; ++m) acc[m] = 0.f;
#pragma unroll 8
        for (int kk = 0; kk < 128; ++kk) { const int k = F.wave * 128 + kk; const float w = W[(size_t)k * 6144];
#pragma unroll
            for (int m = 0; m < 17; ++m) acc[m] += s[m * 1024 + k] * w; }
#pragma unroll
        for (int m = 0; m < 17; ++m) red[(F.wave * 17 + m) * 64 + F.lane] = acc[m];
        __syncthreads();
        for (int idx = F.tid; idx < 17 * 64; idx += 512) { const int m = idx >> 6, cc = idx & 63; float a = b_ada_[l * 6144 + col0 + cc];
#pragma unroll
            for (int w = 0; w < 8; ++w) a += red[(w * 17 + m) * 64 + cc];
            MOD_[((size_t)l * 17 + m) * 6144 + col0 + cc] = a; }
        __syncthreads();
    }
    LAS float* scr = (LAS float*)(F.lds + RING_OFF + F.wave * 17408);
    constexpr int IT_W1 = 64 * 512, IT_W2 = 64 * 256, IT_WIN = 2 * 512, IT_WOUT = 2 * 512, IT_SM = 2 * 240;
    static_assert(8 * 17408 <= MISC_OFF, "prologue LDS tiles");
    constexpr int NIT = IT_W1 + IT_W2 + IT_WIN + IT_WOUT + IT_SM;
    for (int it = IT_W1 + IT_W2 + F.gw; it < NIT; it += F.ngw) {
        int r = it;
        if (r < IT_W1) { const int le = r >> 9, q = r & 511, kb = q >> 5, nb = q & 31, n0 = nb * 64, pn = n0 >> 8, j = n0 & 255; const int sc = j < 128 ? 128 * pn + j : 1024 + 128 * pn + (j - 128);
            tr_item8w(w_moe1_ + ((size_t)le * 1024 + kb * 64) * 2048 + sc, 2048, (unsigned char*)W1_ + ((size_t)le * 2048 + n0) * 1024 + kb * 64, scr, F.lane); continue; }
        r -= IT_W1;
        if (r < IT_W2) { const int le = r >> 8, q = r & 255, kb = q >> 4, nb = q & 15, n0 = nb * 64;
            tr_item8w(w_moe2_ + ((size_t)le * 1024 + kb * 64) * 1024 + n0, 1024, (unsigned char*)W2_ + ((size_t)le * 1024 + n0) * 1024 + kb * 64, scr, F.lane); continue; }
        r -= IT_W2;
        if (r < IT_WIN) { const int l = r >> 9, q = r & 511, kb = q >> 5, nb = q & 31, n0 = nb * 64;
            unsigned char* dst = (unsigned char*)WIN_ + ((size_t)l * 2048 + n0) * 1024 + kb * 64;
            if (n0 < INC) tr_item8w(w_in_ + ((size_t)l * 1024 + kb * 64) * INC + n0, INC, dst, scr, F.lane);
            else { const u32x4 z = {0u, 0u, 0u, 0u};
#pragma unroll
                for (int c = 0; c < 4; ++c) *(u32x4*)(dst + (size_t)F.lane * 1024 + 16 * c) = z; }
            continue; }
        r -= IT_WIN;
        if (r < IT_WOUT) { const int l = r >> 9, q = r & 511, kb = q >> 5, nb = q & 31, n0 = nb * 32;
            tr_item(w_out_ + ((size_t)l * 1024 + kb * 64) * 1024 + n0, 1024, true, nullptr, WOUT_ + ((size_t)l * 1024 + n0) * 1024 + kb * 64, 1024, scr, F.lane); continue; }
        r -= IT_WOUT;
        { const int l = r / 240, q = r - l * 240, kb = q / 40, nb = q - kb * 40, n0 = nb * 32, k0 = kb * 64;
            bf16* dst = WSM_ + ((size_t)l * 1280 + n0) * 384 + k0;
            if (n0 < 384) tr_item(mla_w_q_b_ + ((size_t)l * 256 + (k0 & 255)) * 384 + n0, 384, k0 < 256, mla_q_a_norm_ + l * 256 + (k0 & 255), dst, 384, scr, F.lane);
            else if (n0 < 1152) tr_item(mla_w_kv_b_ + ((size_t)l * 128 + ((k0 - 256) & 127)) * 768 + (n0 - 384), 768, k0 >= 256, mla_kv_a_norm_ + l * 128 + ((k0 - 256) & 127), dst, 384, scr, F.lane);
            else tr_item(w_out_, 1024, false, nullptr, dst, 384, scr, F.lane); }
    }
    __syncthreads();
}

__device__ __forceinline__ void norm_mod_store(const f32x4 (&v)[4], float rstd, const float* g, const float* sc, const float* sh, unsigned char* orow  , int lane) {
#pragma unroll
    for (int j = 0; j < 4; ++j) { const int col = 256 * j + 4 * lane; const f32x4 gg = *(const f32x4*)(g + col), s1 = *(const f32x4*)(sc + col), s0 = *(const f32x4*)(sh + col);
        const f32x4 h = (v[j] * rstd * gg * (s1 + 1.0f) + s0) * SC_X; *(unsigned*)(orow + col) = pk4f8(h[0], h[1], h[2], h[3]); }
}
__device__ __forceinline__ float sumsq4(const f32x4 (&v)[4]) { float s = 0.f;
#pragma unroll
    for (int j = 0; j < 4; ++j) s += (v[j][0] * v[j][0] + v[j][1] * v[j][1]) + (v[j][2] * v[j][2] + v[j][3] * v[j][3]);
    return s; }

__device__ __forceinline__ const float* pA_src(Frame& F, int row) { const int b = row / TPB, p = row - b * TPB; return p < SEQ ? x_ + ((size_t)b * SEQ + p) * DM : ctx_ + ((size_t)b * CTXL + (p - SEQ)) * DM; }
__device__ __forceinline__ void pA_init(Frame& F) {
    const int lane = F.lane, step = F.ngw;
    int row = F.gw; if (row >= MROWS) return;
    f32x4 gm[4];
#pragma unroll
    for (int j = 0; j < 4; ++j) gm[j] = *(const f32x4*)(g_mix_ + 256 * j + 4 * lane);
    auto load = [&](f32x4 (&v)[4], int r) __attribute__((always_inline)) { const float* src = pA_src(F, r);
#pragma unroll
        for (int j = 0; j < 4; ++j) v[j] = *(const f32x4*)(src + 256 * j + 4 * lane); };
    auto one = [&](const f32x4 (&v)[4], int r) __attribute__((always_inline)) {
        const int b = r / TPB, p = r - b * TPB; const int mc = p < SEQ ? b : 16; const float* mod = MOD_ + (size_t)mc * 6144;
        f32x4 s1[4], s0[4];
#pragma unroll
        for (int j = 0; j < 4; ++j) { s1[j] = *(const f32x4*)(mod + 1024 + 256 * j + 4 * lane); s0[j] = *(const f32x4*)(mod + 256 * j + 4 * lane); }
        const float rstd = rsq(wave_sum(sumsq4(v)) * (1.0f / DM) + EPS);
        unsigned char* orow = (unsigned char*)H_ + (size_t)r * DM;
#pragma unroll
        for (int j = 0; j < 4; ++j) { const f32x4 h = (v[j] * rstd * gm[j] * (s1[j] + 1.0f) + s0[j]) * SC_X; *(unsigned*)(orow + 256 * j + 4 * lane) = pk4f8(h[0], h[1], h[2], h[3]); }
    };
    f32x4 A[4], B[4]; load(A, row);
    for (; row < MROWS; row += 2 * step) {
        if (row + step < MROWS) load(B, row + step);
        one(A, row);
        if (row + step >= MROWS) break;
        if (row + 2 * step < MROWS) load(A, row + 2 * step);
        one(B, row + step);
    }
}

__device__ __forceinline__ float logsigmoid(float x) { return fminf(x, 0.f) - __logf(1.0f + __expf(-fabsf(x))); }
__device__ __forceinline__ void up4(const u32x2 w, float (&f)[4]) { f[0] = __uint_as_float(w.x << 16); f[1] = __uint_as_float(w.x & 0xffff0000u); f[2] = __uint_as_float(w.y << 16); f[3] = __uint_as_float(w.y & 0xffff0000u); }
__device__ __forceinline__ void up4f8(unsigned w, float (&f)[4]) { f[0] = __builtin_amdgcn_cvt_f32_fp8((int)w, 0); f[1] = __builtin_amdgcn_cvt_f32_fp8((int)w, 1); f[2] = __builtin_amdgcn_cvt_f32_fp8((int)w, 2); f[3] = __builtin_amdgcn_cvt_f32_fp8((int)w, 3); }
__device__ __forceinline__ float f8f(unsigned char b) { return __builtin_amdgcn_cvt_f32_fp8((int)b, 0); }
struct DIn { u32x2 cq, ckv, yv; unsigned naq, nak, nav, yq, yk; u32x4 lf0, lf1, lb0, lb1; bf16 kr0, kr1; unsigned char yq0, yq1; };
__device__ __forceinline__ void pD_load(Frame& F, DIn& d, int row, int lane) {
    const int c4 = 4 * lane, hh = lane >> 4, jj = lane & 15, ra = jj >> 3, j8 = jj & 7, ri = 64 + ra * 16 + j8;
    const bf16* z = Z_ + (size_t)row * ZC; const unsigned char* y = (const unsigned char*)Y_ + (size_t)row * YC; const u32x2 zero2 = {0u, 0u};
    const unsigned char* z8 = Z8_ + (size_t)row * 768;
    d.naq = *(const unsigned*)(z8 + Z_NAQ + c4); d.nak = *(const unsigned*)(z8 + Z_NAK + c4); d.nav = *(const unsigned*)(z8 + Z_NAV + c4); d.cq = *(const u32x2*)(z + Z_CQ + c4);
    d.ckv = lane < 32 ? *(const u32x2*)(z + Z_CKV + c4) : zero2;
    d.lf0 = *(const u32x4*)(z + Z_LF); d.lf1 = *(const u32x4*)(z + Z_LF + 8); d.lb0 = *(const u32x4*)(z + Z_LB); d.lb1 = *(const u32x4*)(z + Z_LB + 8);
    d.kr0 = z[Z_KR + ra * 16 + j8]; d.kr1 = z[Z_KR + ra * 16 + j8 + 8];
    d.yq = *(const unsigned*)(y + hh * 96 + 4 * jj); d.yq0 = y[hh * 96 + ri]; d.yq1 = y[hh * 96 + ri + 8];
    d.yk = *(const unsigned*)(y + 384 + hh * 192 + 4 * jj); d.yv = *(const u32x2*)(y + 384 + hh * 192 + 64 + 8 * jj);
}
struct DMap { int nfull, rem, half; };
__device__ __forceinline__ DMap pD_mapinit(const Frame& F) { DMap m; m.nfull = (MROWS / 32) / F.G; m.rem = MROWS / 32 - m.nfull * F.G; m.half = (m.rem > 0 && 2 * m.rem <= F.G) ? 1 : 0; return m; }
__device__ __forceinline__ int pD_ntok(const Frame& F, const DMap& m) { return m.half ? 4 * m.nfull + (F.blk < 2 * m.rem ? 2 : 0) : 4 * ((MROWS / 32 - F.blk + F.G - 1) / F.G); }
__device__ __forceinline__ void pD_map(const Frame& F, const DMap& m, int g, int& tile, int& tl, bool& halft) {
    const int k = g >> 2, it = g & 3;
    if (m.half && k >= m.nfull) { halft = true; tile = m.nfull * F.G + (F.blk >> 1); tl = 16 * (F.blk & 1) + F.wave + 8 * (it & 1); }
    else { halft = false; tile = F.blk + k * F.G; tl = F.wave + 8 * it; }
}
__device__ __forceinline__ int pD_row(const Frame& F, const DMap& m, int g, int ntok) { int tile, tl; bool h; pD_map(F, m, min(g, ntok - 1), tile, tl, h); return min(tile, MROWS / 32 - 1) * 32 + tl; }
__device__ __forceinline__ void pD_tokens(Frame& F, int l) {
    const int lane = F.lane, c4 = 4 * lane, hh = lane >> 4, jj = lane & 15, ra = jj >> 3, j8 = jj & 7;
    LAS float* wgs = (LAS float*)(F.lds + RING_OFF + 65536);
    for (int i = F.tid; i < 2 * 16 * 128; i += 512) wgs[i] = gla_w_gate_[(size_t)l * 2 * 16 * 128 + i];
    LDS_WAIT(); __syncthreads();
    typedef float f32x2v __attribute__((ext_vector_type(2)));
    const LAS float* wgl = wgs + 2 * lane;
    const float bgf0 = gla_b_gate_[(l * 2 + 0) * 128 + 2 * lane], bgf1 = gla_b_gate_[(l * 2 + 0) * 128 + 2 * lane + 1];
    const float bgb0 = gla_b_gate_[(l * 2 + 1) * 128 + 2 * lane], bgb1 = gla_b_gate_[(l * 2 + 1) * 128 + 2 * lane + 1];
    const float inv = exp2f(-(float)j8 * 1.6609640474436813f);
    const float* qn_g = na_q_norm_ + l * 64 + (c4 & 63); const float* kn_g = na_k_norm_ + l * 64 + (c4 & 63);
    const float* mq_g = mla_q_norm_ + l * 96; const float* mk_g = mla_k_norm_ + l * 96;
    const int ri = 64 + ra * 16 + j8;
    const float qg0 = qn_g[0], qg1 = qn_g[1], qg2 = qn_g[2], qg3 = qn_g[3], kg0 = kn_g[0], kg1 = kn_g[1], kg2 = kn_g[2], kg3 = kn_g[3];
    const float mqn0 = mq_g[4 * jj], mqn1 = mq_g[4 * jj + 1], mqn2 = mq_g[4 * jj + 2], mqn3 = mq_g[4 * jj + 3], mqr0 = mq_g[ri], mqr1 = mq_g[ri + 8];
    const float mkn0 = mk_g[4 * jj], mkn1 = mk_g[4 * jj + 1], mkn2 = mk_g[4 * jj + 2], mkn3 = mk_g[4 * jj + 3], mkr0 = mk_g[ri], mkr1 = mk_g[ri + 8];
    LAS unsigned char* vt = F.lds + RING_OFF;
    const DMap dm = pD_mapinit(F); const int ntok = pD_ntok(F, dm);
    auto one = [&](const DIn& cur, const int g) __attribute__((always_inline)) {
        {
            int tile, tl; bool halft; pD_map(F, dm, g, tile, tl, halft); const int b = tile / 72, p0 = (tile - b * 72) * 32;
            const int row = tile * 32 + tl, p = p0 + tl; const bool lat = p < SEQ;
            float f[4];
            { up4f8(cur.naq, f); const float r = rsq(g16_sum(f[0] * f[0] + f[1] * f[1] + f[2] * f[2] + f[3] * f[3]) * (1.0f / (64 * SC_YC * SC_YC)) + EPS) * (QS_NA / SC_YC);
              st4bf(NAQ_ + (size_t)row * 256 + c4, f[0] * r * qg0, f[1] * r * qg1, f[2] * r * qg2, f[3] * r * qg3); }
            { up4f8(cur.nak, f); const float r = rsq(g16_sum(f[0] * f[0] + f[1] * f[1] + f[2] * f[2] + f[3] * f[3]) * (1.0f / (64 * SC_YC * SC_YC)) + EPS) * (1.0f / SC_YC);
              st4bf(NAK_ + (size_t)row * 256 + c4, f[0] * r * kg0, f[1] * r * kg1, f[2] * r * kg2, f[3] * r * kg3); }
            { up4f8(cur.nav, f); u32x2 w; w.x = pk2(f[0] * (1.0f / SC_YC), f[1] * (1.0f / SC_YC)); w.y = pk2(f[2] * (1.0f / SC_YC), f[3] * (1.0f / SC_YC)); *(LAS u32x2*)(vt + tl * VT_PITCH + c4 * 2) = w; }
            up4(cur.cq, f); const float rq = rsq(wave_sum(f[0] * f[0] + f[1] * f[1] + f[2] * f[2] + f[3] * f[3]) * (1.0f / 256) + EPS);
            up4(cur.ckv, f); const float rkv = rsq(wave_sum(f[0] * f[0] + f[1] * f[1] + f[2] * f[2] + f[3] * f[3]) * (1.0f / 128) + EPS);
            const float ang = lat ? (float)(ra == 0 ? (p >> 6) : (p & 63)) * inv : 0.f;
            const float cs = __cosf(ang), sn = __sinf(ang);
            const float rqy = rq * (1.0f / SC_YC), rkvy = rkv * (1.0f / SC_YC);
            { up4f8(cur.yq, f); float a0 = f8f(cur.yq0) * rqy, a1 = f8f(cur.yq1) * rqy;
#pragma unroll
              for (int i = 0; i < 4; ++i) f[i] *= rqy;
              const float r = rsq(g16_sum(f[0] * f[0] + f[1] * f[1] + f[2] * f[2] + f[3] * f[3] + a0 * a0 + a1 * a1) * (1.0f / 96) + EPS);
              a0 *= r * mqr0; a1 *= r * mqr1;
              bf16* o = MQ_ + (size_t)row * 384 + hh * 96;
              st4bf(o + 4 * jj, f[0] * r * mqn0, f[1] * r * mqn1, f[2] * r * mqn2, f[3] * r * mqn3);
              o[ri] = (bf16)f2bf(a0 * cs - a1 * sn); o[ri + 8] = (bf16)f2bf(a1 * cs + a0 * sn); }
            { up4f8(cur.yk, f); float a0 = bf2f(cur.kr0), a1 = bf2f(cur.kr1);
#pragma unroll
              for (int i = 0; i < 4; ++i) f[i] *= rkvy;
              const float r = rsq(g16_sum(f[0] * f[0] + f[1] * f[1] + f[2] * f[2] + f[3] * f[3] + a0 * a0 + a1 * a1) * (1.0f / 96) + EPS);
              a0 *= r * mkr0; a1 *= r * mkr1;
              bf16* o = MK_ + (size_t)row * 384 + hh * 96;
              st4bf(o + 4 * jj, f[0] * r * mkn0, f[1] * r * mkn1, f[2] * r * mkn2, f[3] * r * mkn3);
              o[ri] = (bf16)f2bf(a0 * cs - a1 * sn); o[ri + 8] = (bf16)f2bf(a1 * cs + a0 * sn); }
            { float g[4]; up4f8(cur.yv.x, f); up4f8(cur.yv.y, g);
              u32x4 w; w.x = pk2(f[0] * rkvy, f[1] * rkvy); w.y = pk2(f[2] * rkvy, f[3] * rkvy); w.z = pk2(g[0] * rkvy, g[1] * rkvy); w.w = pk2(g[2] * rkvy, g[3] * rkvy);
              *(u32x4*)(MV_ + (size_t)row * 512 + hh * 128 + 8 * jj) = w; }
            { float xf0 = bgf0, xf1 = bgf1, xb0 = bgb0, xb1 = bgb1;
              const unsigned lfw[8] = {cur.lf0.x, cur.lf0.y, cur.lf0.z, cur.lf0.w, cur.lf1.x, cur.lf1.y, cur.lf1.z, cur.lf1.w};
              const unsigned lbw[8] = {cur.lb0.x, cur.lb0.y, cur.lb0.z, cur.lb0.w, cur.lb1.x, cur.lb1.y, cur.lb1.z, cur.lb1.w};
#pragma unroll
              for (int k2 = 0; k2 < 8; ++k2) { const float a0 = __uint_as_float(lfw[k2] << 16), a1 = __uint_as_float(lfw[k2] & 0xffff0000u), b0 = __uint_as_float(lbw[k2] << 16), b1 = __uint_as_float(lbw[k2] & 0xffff0000u);
                  const f32x2v wf0 = *(const LAS f32x2v*)(wgl + (2 * k2) * 128), wf1 = *(const LAS f32x2v*)(wgl + (2 * k2 + 1) * 128), wb0 = *(const LAS f32x2v*)(wgl + (16 + 2 * k2) * 128), wb1 = *(const LAS f32x2v*)(wgl + (17 + 2 * k2) * 128);
                  xf0 += a0 * wf0.x + a1 * wf1.x; xf1 += a0 * wf0.y + a1 * wf1.y; xb0 += b0 * wb0.x + b1 * wb1.x; xb1 += b0 * wb0.y + b1 * wb1.y; }
              *(unsigned*)(EGF_ + (size_t)row * 128 + 2 * lane) = pk2(logsigmoid(xf0) * (1.0f / 16), logsigmoid(xf1) * (1.0f / 16));
              *(unsigned*)(EGB_ + (size_t)row * 128 + 2 * lane) = pk2(logsigmoid(xb0) * (1.0f / 16), logsigmoid(xb1) * (1.0f / 16)); }
        }
        int tileE, tlE; bool halfE; pD_map(F, dm, g, tileE, tlE, halfE);
        if (halfE ? (g & 3) == 1 : (g & 3) == 3) {
            const int tile = tileE, b = tile / 72, p0 = (tile - b * 72) * 32, hsel = F.blk & 1;
            LDS_WAIT(); __syncthreads();
            for (int cI = 0; cI < 16; ++cI) { const int cc = F.wave * 32 + 2 * cI + (lane >> 5), tk = lane & 31; const bf16 val = *(const LAS bf16*)(vt + tk * VT_PITCH + cc * 2);
                if (!halfE || (tk >> 4) == hsel) NAVT_[((size_t)(b * 4 + (cc >> 6)) * 64 + (cc & 63)) * TPB + p0 + tk] = val; }
            LDS_WAIT(); __syncthreads();
        }
    };
    DIn b0, b1, b2;
    pD_load(F, b0, pD_row(F, dm, 0, ntok), lane); pD_load(F, b1, pD_row(F, dm, 1, ntok), lane);
    for (int g = 0; g < ntok; g += 3) {
        pD_load(F, b2, pD_row(F, dm, g + 2, ntok), lane); one(b0, g);
        if (g + 1 < ntok) { pD_load(F, b0, pD_row(F, dm, g + 3, ntok), lane); one(b1, g + 1); }
        if (g + 2 < ntok) { pD_load(F, b1, pD_row(F, dm, g + 4, ntok), lane); one(b2, g + 2); }
    }
}

template <int DV> struct AttnSt { f32x4 o[DV / 16]; float m, l; };
#define MFMA16(a, b, c) __builtin_amdgcn_mfma_f32_16x16x32_bf16((a), (b), (c), 0, 0, 0)
template <int DQK, int DV> struct KvFrag { bf16x8 k0[DQK / 32], k1[DQK / 32]; u32x2 vlo[DV / 16], vhi[DV / 16]; };
template <int DQK, int DV, bool NA, bool FIXM, class RP = const float*>
__device__ __forceinline__ void attn_math32(AttnSt<DV>& st, const bf16x8 (&qf)[DQK / 32], const KvFrag<DQK, DV>& f, int q, RP rpbrow, int kcol0, int qc, int cs) {
    const float c0 = FIXM ? -st.m : 0.f;
    f32x4 s0 = (f32x4){c0, c0, c0, c0}, s1 = s0;
#pragma unroll
    for (int s = 0; s < DQK / 32; ++s) { s0 = MFMA16(f.k0[s], qf[s], s0); s1 = MFMA16(f.k1[s], qf[s], s1); }
    if constexpr (NA) {
        float bs[8];
#pragma unroll
        for (int i = 0; i < 4; ++i) { bs[i] = rpbrow[kcol0 + 4 * q - qc + 15 + i]; bs[4 + i] = rpbrow[kcol0 + 4 * q - qc + 31 + i]; }
#pragma unroll
        for (int i = 0; i < 4; ++i) {
            const int k0 = kcol0 + 4 * q + i, k1 = k0 + 16;
            const float t0 = s0[i] + bs[i], t1 = s1[i] + bs[4 + i];
            s0[i] = (k0 >= cs && k0 < cs + 16) ? t0 : -INFINITY;
            s1[i] = (k1 >= cs && k1 < cs + 16) ? t1 : -INFINITY;
        }
    }
    float p0[4], p1[4], ps = 0.f, al = 1.f;
    if constexpr (FIXM) {
#pragma unroll
        for (int i = 0; i < 4; ++i) { p0[i] = __builtin_amdgcn_exp2f(s0[i]); p1[i] = __builtin_amdgcn_exp2f(s1[i]); ps += p0[i] + p1[i]; }
        st.l += ps;
    } else {
        float mx = fmaxf(fmaxf(fmaxf(s0[0], s0[1]), fmaxf(s0[2], s0[3])), fmaxf(fmaxf(s1[0], s1[1]), fmaxf(s1[2], s1[3])));
        mx = q4_max(mx);
        const float mn = fmaxf(st.m, mx); al = __builtin_amdgcn_exp2f(st.m - mn); st.m = mn;
#pragma unroll
        for (int i = 0; i < 4; ++i) { p0[i] = __builtin_amdgcn_exp2f(s0[i] - mn); p1[i] = __builtin_amdgcn_exp2f(s1[i] - mn); ps += p0[i] + p1[i]; }
        st.l = st.l * al + ps;
    }
    u32x4 pw; pw.x = pg8::cvt_pk_bf16(p0[0], p0[1]); pw.y = pg8::cvt_pk_bf16(p0[2], p0[3]); pw.z = pg8::cvt_pk_bf16(p1[0], p1[1]); pw.w = pg8::cvt_pk_bf16(p1[2], p1[3]);
    const bf16x8 pf = __builtin_bit_cast(bf16x8, pw);
#pragma unroll
    for (int n = 0; n < DV / 16; ++n) {
        u32x4 aw; aw.x = f.vlo[n].x; aw.y = f.vlo[n].y; aw.z = f.vhi[n].x; aw.w = f.vhi[n].y;
        if constexpr (FIXM) st.o[n] = MFMA16(__builtin_bit_cast(bf16x8, aw), pf, st.o[n]); else st.o[n] = MFMA16(__builtin_bit_cast(bf16x8, aw), pf, st.o[n] * al);
    }
}
template <int DV> __device__ __forceinline__ void attn_init(AttnSt<DV>& st, float mfix  ) { st.m = mfix; st.l = 0.f;
#pragma unroll
    for (int n = 0; n < DV / 16; ++n) st.o[n] = (f32x4){0.f, 0.f, 0.f, 0.f}; }
template <int DV> __device__ __forceinline__ void attn_store(AttnSt<DV>& st, bf16* orow  , int q) {
    const float il = __builtin_amdgcn_rcpf(q4_sum(st.l));
#pragma unroll
    for (int n = 0; n < DV / 16; ++n) st4bf(orow + 16 * n + 4 * q, st.o[n][0] * il, st.o[n][1] * il, st.o[n][2] * il, st.o[n][3] * il);
}
constexpr int NA_TILE = 2 * 9216;
__device__ __forceinline__ void na_tile_load(Frame& F, u32x4 (&st)[2], int b, int h, int key0) {
    const int kr = F.tid >> 3, kc = (F.tid & 7) * 8;
    st[0] = *(const u32x4*)(NAK_ + ((size_t)b * TPB + key0 + kr) * 256 + h * 64 + kc);
    st[1] = *(const u32x4*)(NAVT_ + ((size_t)(b * 4 + h) * 64 + kr) * TPB + key0 + kc);
}
__device__ __forceinline__ void na_tile_write(Frame& F, const u32x4 (&st)[2], int buf) {
    const int kr = F.tid >> 3, kc = (F.tid & 7) * 8; LAS unsigned char* tb = F.lds + RING_OFF + buf * NA_TILE;
    *(LAS u32x4*)(tb + kr * 144 + kc * 2) = st[0]; *(LAS u32x4*)(tb + 9216 + kr * 144 + kc * 2) = st[1];
}
__device__ __forceinline__ void na_frag_lds(KvFrag<64, 64>& f, const LAS unsigned char* tb, int kl  , int r, int q) {
#pragma unroll
    for (int s = 0; s < 2; ++s) { f.k0[s] = *(const LAS bf16x8*)(tb + (kl + r) * 144 + 64 * s + 16 * q); f.k1[s] = *(const LAS bf16x8*)(tb + (kl + 16 + r) * 144 + 64 * s + 16 * q); }
#pragma unroll
    for (int n = 0; n < 4; ++n) { const LAS unsigned char* vr = tb + 9216 + (16 * n + r) * 144 + (kl + 4 * q) * 2; f.vlo[n] = *(const LAS u32x2*)vr; f.vhi[n] = *(const LAS u32x2*)(vr + 32); }
}
template <bool FIXM> __device__ __forceinline__ void na_block_unit(Frame& F, int l, int u, float mfix) {
    const int lane = F.lane, r = lane & 15, q = lane >> 4, rp = u & 7, h = (u >> 3) & 3, b = u >> 5;
    const int g0 = 4 * rp + 2 * (F.wave >> 2), cb = F.wave & 3;
    const size_t qrow = (size_t)b * TPB + g0 * 64 + cb * 16 + r;
    bf16x8 qa[2], qb[2];
#pragma unroll
    for (int s = 0; s < 2; ++s) { qa[s] = *(const bf16x8*)(NAQ_ + qrow * 256 + h * 64 + 32 * s + 8 * q); qb[s] = *(const bf16x8*)(NAQ_ + (qrow + 64) * 256 + h * 64 + 32 * s + 8 * q); }
    AttnSt<64> sa, sb2; attn_init(sa, FIXM ? mfix : -INFINITY); attn_init(sb2, FIXM ? mfix : -INFINITY);
    const int rsA = min(max(g0 - 4, 0), 24), rsB = min(max(g0 - 3, 0), 24), kb = min(max(cb * 16 - 8, 0), 32), qc = cb * 16 + r, cs = min(max(qc - 8, 0), 48);
    const int rs_lo = min(max(4 * rp - 4, 0), 24), rs_hi = min(max(4 * rp - 1, 0), 24), nloc = rs_hi + 8 - rs_lo, nst = nloc + 4;
    LAS float* rpbs = (LAS float*)(F.lds + RING_OFF + 2 * NA_TILE);
    for (int i = F.tid; i < 15 * 31; i += 512) rpbs[i] = na_rpb_[(size_t)(l * 4 + h) * 15 * 31 + i] * LOG2E;
    const LAS float* rpbA = rpbs + (7 - g0) * 31;
    u32x4 stg[2], stg1[2], stg2[2];
#define NA_KEY0(jj) ((jj) < nloc ? (rs_lo + (jj)) * 64 : SEQ + 64 * ((jj) - nloc))
    na_tile_load(F, stg, b, h, NA_KEY0(0)); na_tile_load(F, stg1, b, h, NA_KEY0(1)); na_tile_load(F, stg2, b, h, NA_KEY0(2));
    for (int j = 0; j < nst; ++j) {
        na_tile_write(F, stg, j & 1);
        LDS_WAIT(); __syncthreads();
        stg[0] = stg1[0]; stg[1] = stg1[1]; stg1[0] = stg2[0]; stg1[1] = stg2[1];
        if (j + 3 < nst) na_tile_load(F, stg2, b, h, NA_KEY0(j + 3));
        const LAS unsigned char* tb = F.lds + RING_OFF + (j & 1) * NA_TILE;
        KvFrag<64, 64> f;
        if (j < nloc) { const int kr = rs_lo + j; const bool inA = kr >= rsA && kr < rsA + 8, inB = kr >= rsB && kr < rsB + 8;
            if (inA || inB) { na_frag_lds(f, tb, kb, r, q);
                if (inA) attn_math32<64, 64, true, FIXM, const LAS float*>(sa, qa, f, q, rpbA + kr * 31, kb, qc, cs);
                if (inB) attn_math32<64, 64, true, FIXM, const LAS float*>(sb2, qb, f, q, rpbA + (kr - 1) * 31, kb, qc, cs); }
        } else {
            na_frag_lds(f, tb, 0, r, q); attn_math32<64, 64, false, FIXM>(sa, qa, f, q, nullptr, 0, 0, 0); attn_math32<64, 64, false, FIXM>(sb2, qb, f, q, nullptr, 0, 0, 0);
            na_frag_lds(f, tb, 32, r, q); attn_math32<64, 64, false, FIXM>(sa, qa, f, q, nullptr, 0, 0, 0); attn_math32<64, 64, false, FIXM>(sb2, qb, f, q, nullptr, 0, 0, 0);
        }
    }
    attn_store(sa, ATT_ + qrow * DM + h * 64, q); attn_store(sb2, ATT_ + (qrow + 64) * DM + h * 64, q);
    LDS_WAIT(); __syncthreads();
#undef NA_KEY0
}
template <bool FIXM> __device__ __forceinline__ void ctx_block_unit(Frame& F, int u, float mfix) {
    const int lane = F.lane, r = lane & 15, q = lane >> 4, h = u & 3, b = u >> 2;
    const size_t qrow0 = (size_t)b * TPB + SEQ + 32 * F.wave + r;
    bf16x8 qa[2], qb[2];
#pragma unroll
    for (int s = 0; s < 2; ++s) { qa[s] = *(const bf16x8*)(NAQ_ + qrow0 * 256 + h * 64 + 32 * s + 8 * q); qb[s] = *(const bf16x8*)(NAQ_ + (qrow0 + 16) * 256 + h * 64 + 32 * s + 8 * q); }
    AttnSt<64> sa, sb2; attn_init(sa, FIXM ? mfix : -INFINITY); attn_init(sb2, FIXM ? mfix : -INFINITY);
    u32x4 stg[2], stg1[2], stg2[2];
    na_tile_load(F, stg, b, h, SEQ); na_tile_load(F, stg1, b, h, SEQ + 64); na_tile_load(F, stg2, b, h, SEQ + 128);
    for (int j = 0; j < 4; ++j) {
        na_tile_write(F, stg, j & 1);
        LDS_WAIT(); __syncthreads();
        stg[0] = stg1[0]; stg[1] = stg1[1]; stg1[0] = stg2[0]; stg1[1] = stg2[1];
        if (j == 0) na_tile_load(F, stg2, b, h, SEQ + 192);
        const LAS unsigned char* tb = F.lds + RING_OFF + (j & 1) * NA_TILE;
        KvFrag<64, 64> f;
        na_frag_lds(f, tb, 0, r, q); attn_math32<64, 64, false, FIXM>(sa, qa, f, q, nullptr, 0, 0, 0); attn_math32<64, 64, false, FIXM>(sb2, qb, f, q, nullptr, 0, 0, 0);
        na_frag_lds(f, tb, 32, r, q); attn_math32<64, 64, false, FIXM>(sa, qa, f, q, nullptr, 0, 0, 0); attn_math32<64, 64, false, FIXM>(sb2, qb, f, q, nullptr, 0, 0, 0);
    }
    attn_store(sa, ATT_ + qrow0 * DM + h * 64, q); attn_store(sb2, ATT_ + (qrow0 + 16) * DM + h * 64, q);
    LDS_WAIT(); __syncthreads();
}

struct BgConv { int next; unsigned pend0, pend1; };
constexpr int BG_G1 = NEXP * 32 * 16, BG_G2 = NEXP * 16 * 16, BG_NG = BG_G1 + BG_G2;
constexpr int BG_LDS = 69632;
static_assert(BG_LDS + 8 * 8192 <= MISC_OFF, "background slots");
template <int SLOT> __device__ __forceinline__ void bg_issue(Frame& F, int l, BgConv& bg, int lane) {
    const int G = F.gw + (bg.next >> 2) * F.ngw, sub = bg.next & 3;
    if (G >= BG_NG) return;
    ++bg.next;
    const float* src; int ld; unsigned dst;
    if (G < BG_G1) { const int le = G >> 9, q = G & 511, k0 = (q >> 5) * 64 + sub * 16, nb = q & 31, n0 = nb * 64, pn = n0 >> 8, j = n0 & 255; const int sc = j < 128 ? 128 * pn + j : 1024 + 128 * pn + (j - 128);
        src = w_moe1_ + ((size_t)(l * NEXP + le) * 1024 + k0 + (lane >> 4)) * 2048 + sc + (lane & 15) * 4; ld = 2048;
        dst = (unsigned)(((size_t)(l * NEXP + le) * 2048 + n0) * 1024 + k0) + 1u; }
    else { const int G2 = G - BG_G1, le = G2 >> 8, q = G2 & 255, k0 = (q >> 4) * 64 + sub * 16, nb = q & 15, n0 = nb * 64;
        src = w_moe2_ + ((size_t)(l * NEXP + le) * 1024 + k0 + (lane >> 4)) * 1024 + n0 + (lane & 15) * 4; ld = 1024;
        dst = (unsigned)((WS_W2 - WS_W1) + ((size_t)(l * NEXP + le) * 1024 + n0) * 1024 + k0) + 1u; }
    if (SLOT == 0) bg.pend0 = dst; else bg.pend1 = dst;
    LAS unsigned char* lb = F.lds + RING_OFF + BG_LDS + F.wave * 8192 + SLOT * 4096;
#pragma unroll
    for (int i = 0; i < 4; ++i) __builtin_amdgcn_global_load_lds((const unsigned*)(src + (size_t)(4 * i) * ld), (LAS unsigned*)(lb + i * 1024), 16, 0, 0);
}
template <int SLOT> __device__ __forceinline__ void bg_finish1(Frame& F, unsigned& pend, int lane) {
    if (!pend) return;
    const LAS float* lb = (const LAS float*)(F.lds + RING_OFF + BG_LDS + F.wave * 8192 + SLOT * 4096) + lane;
    float v[16];
#pragma unroll
    for (int i = 0; i < 16; ++i) v[i] = lb[i * 64] * SC_W;
    u32x4 o; o.x = pk4f8(v[0], v[1], v[2], v[3]); o.y = pk4f8(v[4], v[5], v[6], v[7]); o.z = pk4f8(v[8], v[9], v[10], v[11]); o.w = pk4f8(v[12], v[13], v[14], v[15]);
    *(u32x4*)((unsigned char*)W1_ + (size_t)(pend - 1u) + (size_t)lane * 1024) = o;
    pend = 0u;
}
__device__ __forceinline__ void bg_finish(Frame& F, BgConv& bg, int lane) {
    bg_finish1<0>(F, bg.pend0, lane); bg_finish1<1>(F, bg.pend1, lane);
    LDS_WAIT(); __builtin_amdgcn_sched_barrier(0);
}
__device__ __forceinline__ void bg_drain(Frame& F, int l, BgConv& bg) {
    for (;;) { VM_WAIT(); bg_finish(F, bg, F.lane); bg_issue<0>(F, l, bg, F.lane); bg_issue<1>(F, l, bg, F.lane); if (!bg.pend0 && !bg.pend1) break; }
}

namespace fa {
constexpr int   D = 128, NW = 8, QBLK = 32, KVBLK = 64;
constexpr float SCALE = 0.10206207261596575f;
constexpr float THR = 8.f;
constexpr int   SDEPTH = 2;
constexpr int   DQK = 96, LDQ = 384, LDKK = 384, LDK = 512, LDO = 1024;
constexpr size_t SHM_V = KVBLK * D * 2, SHM_K = KVBLK * D * 2, SHM_ATTN = 2 * SHM_V + 2 * SHM_K + NW * 64 * 4;
using s16x4  = __attribute__((ext_vector_type(4))) short;
using f32x16 = __attribute__((ext_vector_type(16))) float;
#define KSWZ(row, colB) ((row) * 256 + ((colB) ^ (((row) & 7) << 4)))
#define SBAR() __builtin_amdgcn_sched_barrier(0)
__device__ __forceinline__ int crow(int r, int hi) { return (r & 3) + 8 * (r >> 2) + 4 * hi; }
__device__ __forceinline__ unsigned cvtpk(float lo, float hi) { unsigned r; asm volatile("v_cvt_pk_bf16_f32 %0, %1, %2" : "=v"(r) : "v"(lo), "v"(hi)); return r; }
__device__ __forceinline__ void partialSM(f32x16& p0, f32x16& p1, float& m_reg, float& mn, float& alpha) {
  constexpr float C = SCALE * 1.4426950408889634f;
  float pmax = p0[0]; for (int r = 1; r < 16; ++r) pmax = fmaxf(pmax, p0[r]); for (int r = 0; r < 16; ++r) pmax = fmaxf(pmax, p1[r]);
  { auto rr = __builtin_amdgcn_permlane32_swap(__float_as_uint(pmax), __float_as_uint(pmax), false, false);
    pmax = fmaxf(__uint_as_float(rr[0]), __uint_as_float(rr[1])); }
  if (__builtin_expect(__all(pmax - m_reg <= THR / SCALE), 1)) { mn = m_reg; alpha = 1.f; }
  else { mn = fmaxf(m_reg, pmax); alpha = __builtin_amdgcn_exp2f((m_reg - mn) * C); m_reg = mn; }
  float mnC = -mn * C;
  for (int r = 0; r < 16; ++r) p0[r] = fmaf(p0[r], C, mnC); for (int r = 0; r < 16; ++r) p1[r] = fmaf(p1[r], C, mnC);
  for (int r = 0; r < 16; ++r) p0[r] = __builtin_amdgcn_exp2f(p0[r]);
}
__device__ __forceinline__ void finishSM(f32x16& p0, f32x16& p1, float alpha, float& l_reg, bf16x8& pa0, bf16x8& pa1, bf16x8& pa2, bf16x8& pa3) {
  for (int r = 0; r < 16; ++r) p1[r] = __builtin_amdgcn_exp2f(p1[r]);
  float ps = 0; for (int r = 0; r < 16; ++r) ps += p0[r]; for (int r = 0; r < 16; ++r) ps += p1[r];
  { auto rr = __builtin_amdgcn_permlane32_swap(__float_as_uint(ps), __float_as_uint(ps), false, false);
    ps = __uint_as_float(rr[0]) + __uint_as_float(rr[1]); }
  l_reg = l_reg * alpha + ps;
#define PK4(P, BASE, OUT) do { unsigned a0 = cvtpk(P[BASE + 0], P[BASE + 1]), a1 = cvtpk(P[BASE + 2], P[BASE + 3]);   \
    unsigned b0 = cvtpk(P[BASE + 4], P[BASE + 5]), b1 = cvtpk(P[BASE + 6], P[BASE + 7]);                              \
    auto r0 = __builtin_amdgcn_permlane32_swap(a0, b0, false, false); auto r1 = __builtin_amdgcn_permlane32_swap(a1, b1, false, false); \
    u32x4 w = {r0[0], r1[0], r0[1], r1[1]}; OUT = *reinterpret_cast<bf16x8*>(&w); } while (0)
  PK4(p0, 0, pa0); PK4(p0, 8, pa1); PK4(p1, 0, pa2); PK4(p1, 8, pa3);
#undef PK4
}
__device__ __forceinline__ void qkt(f32x16& p0, f32x16& p1, const bf16* Ks, const bf16x8* qr, int r32, int hi) {
  p0 = f32x16{}; p1 = f32x16{};
  for (int d0 = 0; d0 < DQK / 16; ++d0) { int cb = (d0 * 16 + hi * 8) * 2;
    bf16x8 b0 = *reinterpret_cast<const bf16x8*>((const char*)Ks + KSWZ(r32, cb));
    bf16x8 b1 = *reinterpret_cast<const bf16x8*>((const char*)Ks + KSWZ(32 + r32, cb));
    p0 = __builtin_amdgcn_mfma_f32_32x32x16_bf16(b0, qr[d0], p0, 0, 0, 0);
    p1 = __builtin_amdgcn_mfma_f32_32x32x16_bf16(b1, qr[d0], p1, 0, 0, 0); }
}
__device__ __forceinline__ int v_st(int k, int c) { const int kk = (k & ~0xC) | ((k & 4) << 1) | ((k & 8) >> 1); return ((kk >> 3) * 4 + (c >> 5)) * 512 + ((kk & 7) * 32 + (c & 31)) * 2; }
__device__ __forceinline__ int v_rd_base(int lane) { return ((lane & 3) << 3) | (((lane >> 2) & 3) << 6) | (((lane >> 4) & 1) << 5) | (((lane >> 5) & 1) << 8); }
constexpr int v_rd_off(int d0, int ks, int half) { return d0 * 512 + ks * 4096 + half * 2048; }
template <int OFF> __device__ __forceinline__ s16x4 tr_read(int vb) {
  s16x4 r; asm volatile("ds_read_b64_tr_b16 %0, %1 offset:%2" : "=&v"(r) : "v"(vb), "i"(OFF) : "memory"); return r;
}
template <int D0> __device__ __forceinline__ void pv_one(f32x16& od, int vb, bf16x8 pa0, bf16x8 pa1, bf16x8 pa2, bf16x8 pa3) {
  const s16x4 l0 = tr_read<v_rd_off(D0, 0, 0)>(vb), h0 = tr_read<v_rd_off(D0, 0, 1)>(vb), l1 = tr_read<v_rd_off(D0, 1, 0)>(vb), h1 = tr_read<v_rd_off(D0, 1, 1)>(vb);
  const s16x4 l2 = tr_read<v_rd_off(D0, 2, 0)>(vb), h2 = tr_read<v_rd_off(D0, 2, 1)>(vb), l3 = tr_read<v_rd_off(D0, 3, 0)>(vb), h3 = tr_read<v_rd_off(D0, 3, 1)>(vb);
  asm volatile("s_waitcnt lgkmcnt(0)" ::: "memory"); SBAR();
#define PK(L, H) (bf16x8){L[0], L[1], L[2], L[3], H[0], H[1], H[2], H[3]}
  od = __builtin_amdgcn_mfma_f32_32x32x16_bf16(pa0, PK(l0, h0), od, 0, 0, 0);
  od = __builtin_amdgcn_mfma_f32_32x32x16_bf16(pa1, PK(l1, h1), od, 0, 0, 0);
  od = __builtin_amdgcn_mfma_f32_32x32x16_bf16(pa2, PK(l2, h2), od, 0, 0, 0);
  od = __builtin_amdgcn_mfma_f32_32x32x16_bf16(pa3, PK(l3, h3), od, 0, 0, 0);
#undef PK
}
__device__ __forceinline__ void pv_d0(f32x16* o, int vb, bf16x8 pa0, bf16x8 pa1, bf16x8 pa2, bf16x8 pa3) {
  pv_one<0>(o[0], vb, pa0, pa1, pa2, pa3); pv_one<1>(o[1], vb, pa0, pa1, pa2, pa3); pv_one<2>(o[2], vb, pa0, pa1, pa2, pa3); pv_one<3>(o[3], vb, pa0, pa1, pa2, pa3);
}
__device__ __forceinline__ void attn_dense_body(const bf16* __restrict__ Qb, const bf16* __restrict__ Kh, const bf16* __restrict__ Vh, bf16* __restrict__ Ob, int seq, char* lds, const int tid, Frame& F, const int lyr, BgConv& bg) {
  const int wid = tid >> 6, lane = tid & 63, r32 = lane & 31, hi = lane >> 5;
  bf16* V_lds = (bf16*)lds; bf16* K_lds = (bf16*)(lds + 2 * SHM_V);
  float* ws = (float*)(lds + 2 * SHM_V + 2 * SHM_K) + wid * 64; float* li_l = ws; float* al_l = ws + 32;
  float m_reg = -1e30f, l_reg = 0; f32x16 o[4] = {}; bf16x8 qr[DQK / 16];
  const bf16* Qw = Qb + (long)(wid * QBLK + r32) * LDQ + hi * 8;
#pragma unroll
  for (int d0 = 0; d0 < DQK / 16; ++d0) qr[d0] = *reinterpret_cast<const bf16x8*>(Qw + d0 * 16);
  const int sr = tid >> 4, sc = (tid & 15) * 8, vst0 = v_st(sr, sc), vst1 = v_st(32 + sr, sc);
  const int vb0 = (int)(uintptr_t)V_lds + v_rd_base(lane);
  struct { bf16x8 vs0, vs1, ks0, ks1; } sr_[SDEPTH];
  const unsigned soff = (unsigned)(sr * LDK + sc) * 2u, soffk = (unsigned)(sr * LDKK + (sc < DQK ? sc : 0)) * 2u;
#define SLOAD(i, k0) do { const char* vt_ = (const char*)Vh + (size_t)(k0) * (LDK * 2); const char* kt_ = (const char*)Kh + (size_t)(k0) * (LDKK * 2);   \
    sr_[i].vs0 = *reinterpret_cast<const bf16x8*>(vt_ + soff); sr_[i].vs1 = *reinterpret_cast<const bf16x8*>(vt_ + 32 * LDK * 2 + soff); \
    sr_[i].ks0 = *reinterpret_cast<const bf16x8*>(kt_ + soffk); sr_[i].ks1 = *reinterpret_cast<const bf16x8*>(kt_ + 32 * LDKK * 2 + soffk); } while (0)
#define SWRITE(b, i) do { *(bf16x8*)((char*)V_lds + (b) * SHM_V + vst0) = sr_[i].vs0;          \
    *(bf16x8*)((char*)V_lds + (b) * SHM_V + vst1) = sr_[i].vs1; int kc = sc * 2;               \
    *(bf16x8*)((char*)K_lds + (b) * SHM_K + KSWZ(sr, kc)) = sr_[i].ks0;                       \
    *(bf16x8*)((char*)K_lds + (b) * SHM_K + KSWZ(32 + sr, kc)) = sr_[i].ks1; } while (0)
#define SWRITE_V(b, i) do { *(bf16x8*)((char*)V_lds + (b) * SHM_V + vst0) = sr_[i].vs0; *(bf16x8*)((char*)V_lds + (b) * SHM_V + vst1) = sr_[i].vs1; } while (0)
#define SWRITE_K(b, i) do { int kc = sc * 2; *(bf16x8*)((char*)K_lds + (b) * SHM_K + KSWZ(sr, kc)) = sr_[i].ks0; *(bf16x8*)((char*)K_lds + (b) * SHM_K + KSWZ(32 + sr, kc)) = sr_[i].ks1; } while (0)
#define SWAIT() do { if constexpr (SDEPTH == 2) asm volatile("s_waitcnt vmcnt(4)" ::: "memory"); else asm volatile("s_waitcnt vmcnt(0)" ::: "memory"); } while (0)
#define RESC(a) do { if (__any((a) < 1.f)) { if (hi == 0) al_l[r32] = (a); asm volatile("s_waitcnt lgkmcnt(0)" ::: "memory"); \
    for (int d = 0; d < 4; ++d) for (int r = 0; r < 16; ++r) o[d][r] *= al_l[crow(r, hi)]; } } while (0)
  f32x16 pA0, pA1, pB0, pB1; float mnA, mnB, alA, alB; bf16x8 pa0, pa1, pa2, pa3; const int NT = seq / KVBLK;
  constexpr int SE = 0, SO = SDEPTH - 1;
  SLOAD(SE, 0); SLOAD(SO, KVBLK); asm volatile("s_waitcnt vmcnt(4)" ::: "memory"); SWRITE(0, SE); SBAR();
  if (2 < NT) SLOAD(SE, 2 * KVBLK);
  __syncthreads();
  qkt(pA0, pA1, K_lds, qr, r32, hi); partialSM(pA0, pA1, m_reg, mnA, alA);
  SWAIT(); SWRITE(1, SO); __syncthreads();
  for (int j = 1; j + 1 < NT; j += 2) {
    bg_finish(F, bg, lane);
    bg_issue<0>(F, lyr, bg, lane);
    static_assert(SDEPTH == 2, "the single-barrier schedule keeps two staged tiles");
    SWRITE_V(1, SO); SBAR();
    SBAR(); qkt(pB0, pB1, (bf16*)((char*)K_lds + SHM_K), qr, r32, hi);
    finishSM(pA0, pA1, alA, l_reg, pa0, pa1, pa2, pa3); SBAR();
    SLOAD(SO, (j + 2) * KVBLK); SBAR();
    pv_d0(o, vb0, pa0, pa1, pa2, pa3); partialSM(pB0, pB1, m_reg, mnB, alB);
    RESC(alB); SWAIT(); SWRITE_K(0, SE);
    __syncthreads();
    SWRITE_V(0, SE); SBAR();
    if ((((j >> 1) + F.blk) & 1) == 0) bg_issue<1>(F, lyr, bg, lane);
    SBAR(); qkt(pA0, pA1, K_lds, qr, r32, hi);
    finishSM(pB0, pB1, alB, l_reg, pa0, pa1, pa2, pa3); SBAR();
    if (j + 3 < NT) SLOAD(SE, (j + 3) * KVBLK); SBAR();
    pv_d0(o, vb0 + (int)SHM_V, pa0, pa1, pa2, pa3); partialSM(pA0, pA1, m_reg, mnA, alA);
    RESC(alA); SWAIT(); SWRITE_K(1, SO);
    __syncthreads();
  }
  SWRITE_V(1, SO); SBAR();
  SBAR(); qkt(pB0, pB1, (bf16*)((char*)K_lds + SHM_K), qr, r32, hi);
  finishSM(pA0, pA1, alA, l_reg, pa0, pa1, pa2, pa3); SBAR();
  pv_d0(o, vb0, pa0, pa1, pa2, pa3); partialSM(pB0, pB1, m_reg, mnB, alB);
  __syncthreads(); RESC(alB);
  finishSM(pB0, pB1, alB, l_reg, pa0, pa1, pa2, pa3); SBAR();
  pv_d0(o, vb0 + (int)SHM_V, pa0, pa1, pa2, pa3);
  if (hi == 0) li_l[r32] = l_reg; asm volatile("s_waitcnt lgkmcnt(0)" ::: "memory");
  int ln2; asm volatile("v_mbcnt_lo_u32_b32 %0, -1, 0\n\tv_mbcnt_hi_u32_b32 %0, -1, %0" : "=v"(ln2)); ln2 &= 63;
  const int r32e = ln2 & 31, hie = ln2 >> 5;
  float rli[16];
#pragma unroll
  for (int r = 0; r < 16; ++r) rli[r] = __builtin_amdgcn_rcpf(li_l[crow(r, hie)]);
  bf16* Ow = Ob + (long)(wid * QBLK) * LDO;
#pragma unroll
  for (int r = 0; r < 16; ++r) { const unsigned eo = (unsigned)(crow(r, hie) * LDO + r32e);
    for (int d0 = 0; d0 < 4; ++d0) Ow[eo + d0 * 32] = (bf16)(cvtpk(o[d0][r] * rli[r], 0.f) & 0xffffu); }
  if (bg.pend0 || bg.pend1) { asm volatile("s_waitcnt vmcnt(0)" ::: "memory"); bg_finish(F, bg, lane); }
  __syncthreads();
#undef SLOAD
#undef SWRITE
#undef SWRITE_V
#undef SWRITE_K
#undef SWAIT
#undef RESC
}
#undef KSWZ
#undef SBAR
}

constexpr int GL_EP = 65;
constexpr int GL_Q = 0, GL_K = 2048, GL_V = 4096, GL_EF = 8192, GL_EB = GL_EF + 32 * GL_EP;
constexpr int GL_OP = 68;
__device__ __forceinline__ int gla_dirchunk(int dir, int tc) { return dir == 0 ? tc : (tc < 4 ? 3 - tc : 39 - tc); }
__device__ __forceinline__ void gla_stage_load(Frame& F, u32x4 (&st)[3], int b, int h, int tc) {
    const size_t row0 = (size_t)b * TPB + (tc < 4 ? SEQ + 64 * tc : 64 * (tc - 4));
    const unsigned char* zb = (const unsigned char*)Z_; const unsigned char* fb = (const unsigned char*)EGF_; const long ebd = (const unsigned char*)EGB_ - fb;
#pragma unroll
    for (int k = 0; k < 3; ++k) { const int pid = F.tid + 512 * k, r = pid / 24, j = pid - r * 24; const size_t row = row0 + r;
        const int zcol = j < 4 ? Z_GQ + h * 32 + 8 * j : j < 8 ? Z_GK + h * 32 + 8 * (j - 4) : Z_GV + h * 64 + 8 * (j - 8);
        const size_t zoff = (row * ZC + (size_t)zcol) * 2, eoff = (row * 128 + (size_t)(h * 32 + 8 * ((j - 16) & 3))) * 2 + (size_t)(j >= 20 ? ebd : 0);
        const unsigned char* src = j < 16 ? zb + zoff : fb + eoff;
        st[k] = *(const u32x4*)src; }
}
__device__ __forceinline__ void gla_stage_write(Frame& F, const u32x4 (&st)[3]) {
    LAS float* sm = (LAS float*)(F.lds + RING_OFF);
#pragma unroll
    for (int k = 0; k < 3; ++k) { const int pid = F.tid + 512 * k, r = pid / 24, j = pid - r * 24;
        float f[4], g[4]; u32x2 lo, hi; lo.x = st[k].x; lo.y = st[k].y; hi.x = st[k].z; hi.y = st[k].w; up4(lo, f); up4(hi, g);
        if (j < 16) { LAS float* dst = j < 4 ? sm + GL_Q + r * 32 + 8 * j : j < 8 ? sm + GL_K + r * 32 + 8 * (j - 4) : sm + GL_V + r * 64 + 8 * (j - 8);
            const float sc = j < 4 ? 0.17677669529663687f : 1.0f;
            *(LAS f32x4*)dst = (f32x4){f[0], f[1], f[2], f[3]} * sc; *(LAS f32x4*)(dst + 4) = (f32x4){g[0], g[1], g[2], g[3]} * sc; }
        else { LAS float* dst = (j < 20 ? sm + GL_EF + 8 * (j - 16) * GL_EP : sm + GL_EB + 8 * (j - 20) * GL_EP) + r;
#pragma unroll
            for (int i = 0; i < 4; ++i) { dst[i * GL_EP] = f[i]; dst[(4 + i) * GL_EP] = g[i]; } } }
}
static_assert((GL_EB + 32 * GL_EP) * 4 <= 49664 && 2 * 64 * GL_OP * 4 <= 49664, "GLA staging");
constexpr int GB_O = 0, GB_QS = 49664, GB_KT = GB_QS + 2 * 5120, GB_QE = GB_KT + 2 * 5120, GB_VT = GB_QE + 2 * 5120, GB_S0 = GB_VT + 2 * 9216, GB_END = GB_S0 + 2 * 5120;
static_assert(GB_END <= MISC_OFF, "GLA LDS map");
template <int N> __device__ __forceinline__ float dpp_shr(float v) { return __int_as_float(__builtin_amdgcn_update_dpp(0, __float_as_int(v), 0x110 + N, 0xF, 0xF, true)); }
__device__ __forceinline__ float dpp_bcast15(float v) { return __int_as_float(__builtin_amdgcn_update_dpp(0, __float_as_int(v), 0x142, 0xA, 0xF, false)); }
__device__ __forceinline__ float dpp_bcast31(float v) { return __int_as_float(__builtin_amdgcn_update_dpp(0, __float_as_int(v), 0x143, 0xC, 0xF, false)); }
struct GlaPre { float s0[8]; u32x4 gate; };
__device__ __forceinline__ void gla_pre_load(Frame& F, GlaPre& P, int b, int h, int tc) {
    const size_t row0 = (size_t)b * TPB + (tc < 4 ? SEQ + 64 * tc : 64 * (tc - 4));
    const int dir = F.tid >> 8, e = (F.tid >> 2) & 63, dq = F.tid & 3;
    const float* ps = OGF_ + ((size_t)((b * 4 + h) * 2 + dir) * 36 + gla_dirchunk(dir, tc)) * 2048 + (size_t)(8 * dq) * 64 + e;
#pragma unroll
    for (int i = 0; i < 8; ++i) P.s0[i] = __hip_atomic_load(ps + i * 64, __ATOMIC_RELAXED, __HIP_MEMORY_SCOPE_AGENT);
    P.gate = *(const u32x4*)(Z_ + (row0 + (F.tid >> 3)) * ZC + Z_GO + h * 64 + (F.tid & 7) * 8);
}
__device__ __forceinline__ void gla_compute(Frame& F, int l, int b, int h, int tc, bool outputs, const GlaPre& PR, const f32x4 gnpre0, const f32x4 gnpre1) {
    LAS float* sm = (LAS float*)(F.lds + RING_OFF); LAS unsigned char* sb = F.lds + RING_OFF;
    const size_t row0 = (size_t)b * TPB + (tc < 4 ? SEQ + 64 * tc : 64 * (tc - 4));
    const int lane = F.lane, wdir = F.wave >> 2, wsub = F.wave & 3;
    const float (&s0pre)[8] = PR.s0; const u32x4 gpre = PR.gate;
    { const int t = wdir ? 63 - lane : lane; LAS float* gp = sm + (wdir ? GL_EB : GL_EF) + 8 * wsub * GL_EP + t;
#pragma unroll
      for (int i = 0; i < 8; ++i) { float x = gp[i * GL_EP]; x += dpp_shr<1>(x); x += dpp_shr<2>(x); x += dpp_shr<4>(x); x += dpp_shr<8>(x);
          x += dpp_bcast15(x); x += dpp_bcast31(x); gp[i * GL_EP] = x; } }
    LDS_WAIT(); __syncthreads();
    { const int dir = F.tid >> 8, o = (F.tid >> 2) & 63, dq = F.tid & 3, t = dir ? 63 - o : o;
      const LAS float* Bp = sm + (dir ? GL_EB : GL_EF) + 8 * dq * GL_EP; const int tm = dir ? 32 : 31, te = dir ? 0 : 63;
      float Bt[8], Bm[8], Be[8], qv[8], kv[8];
#pragma unroll
      for (int i = 0; i < 8; ++i) { Bt[i] = Bp[i * GL_EP + t]; Bm[i] = Bp[i * GL_EP + tm]; Be[i] = Bp[i * GL_EP + te]; }
#pragma unroll
      for (int i = 0; i < 8; i += 4) { *(f32x4*)(qv + i) = *(const LAS f32x4*)(sm + GL_Q + t * 32 + 8 * dq + i); *(f32x4*)(kv + i) = *(const LAS f32x4*)(sm + GL_K + t * 32 + 8 * dq + i); }
      if (outputs) {
          float qs[8], kt[8], qe[8];
#pragma unroll
          for (int i = 0; i < 8; ++i) { qs[i] = qv[i] * __expf(Bt[i] - Bm[i]); kt[i] = kv[i] * __expf(Bm[i] - Bt[i]); qe[i] = qv[i] * __expf(Bt[i]); }
          u32x4 w; w.x = pk2(qs[0], qs[1]); w.y = pk2(qs[2], qs[3]); w.z = pk2(qs[4], qs[5]); w.w = pk2(qs[6], qs[7]); *(LAS u32x4*)(sb + GB_QS + dir * 5120 + o * 80 + 16 * dq) = w;
          w.x = pk2(kt[0], kt[1]); w.y = pk2(kt[2], kt[3]); w.z = pk2(kt[4], kt[5]); w.w = pk2(kt[6], kt[7]); *(LAS u32x4*)(sb + GB_KT + dir * 5120 + o * 80 + 16 * dq) = w;
          w.x = pk2(qe[0], qe[1]); w.y = pk2(qe[2], qe[3]); w.z = pk2(qe[4], qe[5]); w.w = pk2(qe[6], qe[7]); *(LAS u32x4*)(sb + GB_QE + dir * 5120 + o * 80 + 16 * dq) = w;
      } else {
#pragma unroll
          for (int i = 0; i < 8; ++i) *(LAS bf16*)(sb + GB_KT + dir * 5120 + (8 * dq + i) * 144 + 2 * o) = (bf16)f2bf(kv[i] * __expf(Be[i] - Bt[i]));
          if (o == 63) { const size_t sidx = (size_t)((b * 4 + h) * 2 + dir) * 36 + gla_dirchunk(dir, tc); float* ad = AD_ + sidx * 32 + 8 * dq;
#pragma unroll
              for (int i = 0; i < 8; ++i) ad[i] = __expf(Be[i]); }
      } }
    { const int dir = F.tid >> 8, e = F.tid & 63, og = (F.tid >> 6) & 3;
      float vv[16];
#pragma unroll
      for (int k = 0; k < 16; ++k) { const int o = 16 * og + k, t = dir ? 63 - o : o; vv[k] = sm[GL_V + t * 64 + e]; }
      u32x4 w0, w1; w0.x = pk2(vv[0], vv[1]); w0.y = pk2(vv[2], vv[3]); w0.z = pk2(vv[4], vv[5]); w0.w = pk2(vv[6], vv[7]); w1.x = pk2(vv[8], vv[9]); w1.y = pk2(vv[10], vv[11]); w1.z = pk2(vv[12], vv[13]); w1.w = pk2(vv[14], vv[15]);
      LAS unsigned char* vp = sb + GB_VT + dir * 9216 + e * 144 + 32 * og; *(LAS u32x4*)vp = w0; *(LAS u32x4*)(vp + 16) = w1; }
    if (outputs) {
        const int dir = F.tid >> 8, e = (F.tid >> 2) & 63, dq = F.tid & 3;
        u32x4 w; w.x = pk2(s0pre[0], s0pre[1]); w.y = pk2(s0pre[2], s0pre[3]); w.z = pk2(s0pre[4], s0pre[5]); w.w = pk2(s0pre[6], s0pre[7]); *(LAS u32x4*)(sb + GB_S0 + dir * 5120 + e * 80 + 16 * dq) = w;
    }
    LDS_WAIT(); __syncthreads();
    const int r = lane & 15, q = lane >> 4;
    if (outputs) {
        const int dir = wdir, tt = wsub; const LAS unsigned char* qsb = sb + GB_QS + dir * 5120; const LAS unsigned char* ktb = sb + GB_KT + dir * 5120;
        const LAS unsigned char* vtb = sb + GB_VT + dir * 9216; const LAS unsigned char* s0b = sb + GB_S0 + dir * 5120;
        f32x4 acc[4];
#pragma unroll
        for (int n = 0; n < 4; ++n) acc[n] = (f32x4){0.f, 0.f, 0.f, 0.f};
        const bf16x8 qsf = *(const LAS bf16x8*)(qsb + (16 * tt + r) * 80 + 16 * q);
        const int to = 16 * tt + r;
        for (int sp = 0; sp <= (tt >> 1); ++sp) {
            const bf16x8 k0 = *(const LAS bf16x8*)(ktb + (32 * sp + r) * 80 + 16 * q), k1 = *(const LAS bf16x8*)(ktb + (32 * sp + 16 + r) * 80 + 16 * q);
            f32x4 s0 = MFMA16(k0, qsf, ((f32x4){0.f, 0.f, 0.f, 0.f})), s1 = MFMA16(k1, qsf, ((f32x4){0.f, 0.f, 0.f, 0.f}));
#pragma unroll
            for (int i = 0; i < 4; ++i) { const int so = 32 * sp + 4 * q + i; s0[i] = so <= to ? s0[i] : 0.f; s1[i] = so + 16 <= to ? s1[i] : 0.f; }
            u32x4 pw; pw.x = pk2(s0[0], s0[1]); pw.y = pk2(s0[2], s0[3]); pw.z = pk2(s1[0], s1[1]); pw.w = pk2(s1[2], s1[3]);
            const bf16x8 pf = __builtin_bit_cast(bf16x8, pw);
#pragma unroll
            for (int n = 0; n < 4; ++n) { const LAS unsigned char* vr = vtb + (16 * n + r) * 144 + (32 * sp + 4 * q) * 2; const u32x2 lo = *(const LAS u32x2*)vr, hi = *(const LAS u32x2*)(vr + 32);
                u32x4 aw; aw.x = lo.x; aw.y = lo.y; aw.z = hi.x; aw.w = hi.y; acc[n] = MFMA16(__builtin_bit_cast(bf16x8, aw), pf, acc[n]); }
        }
        const bf16x8 qef = *(const LAS bf16x8*)(sb + GB_QE + dir * 5120 + (16 * tt + r) * 80 + 16 * q);
#pragma unroll
        for (int n = 0; n < 4; ++n) acc[n] = MFMA16(*(const LAS bf16x8*)(s0b + (16 * n + r) * 80 + 16 * q), qef, acc[n]);
        const int t = dir ? 63 - to : to;
#pragma unroll
        for (int n = 0; n < 4; ++n) *(LAS f32x4*)(sb + GB_O + dir * (64 * GL_OP * 4) + (t * GL_OP + 16 * n + 4 * q) * 4) = acc[n];
        LDS_WAIT(); __syncthreads();
        const int tk = F.tid >> 3, e8 = (F.tid & 7) * 8; const size_t row = row0 + tk; const LAS float* of = (const LAS float*)(sb + GB_O) + tk * GL_OP + e8;
        const f32x4 f0 = *(const LAS f32x4*)of, f1 = *(const LAS f32x4*)(of + 4), b0 = *(const LAS f32x4*)(of + 64 * GL_OP), b1 = *(const LAS f32x4*)(of + 64 * GL_OP + 4);
        const f32x4 o0 = f0 + b0, o1 = f1 + b1;
        float ss = (o0[0] * o0[0] + o0[1] * o0[1]) + (o0[2] * o0[2] + o0[3] * o0[3]) + (o1[0] * o1[0] + o1[1] * o1[1]) + (o1[2] * o1[2] + o1[3] * o1[3]);
        ss = g8_sum(ss);
        const float rn = rsq(ss * (1.0f / 64) + EPS);
        const float gn[8] = {gnpre0[0], gnpre0[1], gnpre0[2], gnpre0[3], gnpre1[0], gnpre1[1], gnpre1[2], gnpre1[3]}; float g[4], g2[4]; { u32x2 glo, ghi; glo.x = gpre.x; glo.y = gpre.y; ghi.x = gpre.z; ghi.y = gpre.w; up4(glo, g); up4(ghi, g2); }
        float w[8];
#pragma unroll
        for (int i = 0; i < 4; ++i) { w[i] = o0[i] * rn * gn[i] * g[i] * __builtin_amdgcn_rcpf(1.0f + __expf(-g[i])); w[4 + i] = o1[i] * rn * gn[4 + i] * g2[i] * __builtin_amdgcn_rcpf(1.0f + __expf(-g2[i])); }
        u32x4 pw; pw.x = pk2(w[0], w[1]); pw.y = pk2(w[2], w[3]); pw.z = pk2(w[4], w[5]); pw.w = pk2(w[6], w[7]);
        *(u32x4*)(ATT_ + row * DM + 768 + h * 64 + e8) = pw;
    } else {
        const int dir = wdir, et = wsub; const LAS unsigned char* vtb = sb + GB_VT + dir * 9216; const LAS unsigned char* khb = sb + GB_KT + dir * 5120;
        float* cs = CS_ + ((size_t)((b * 4 + h) * 2 + dir) * 36 + gla_dirchunk(dir, tc)) * 2048;
#pragma unroll
        for (int dt = 0; dt < 2; ++dt) { f32x4 acc = (f32x4){0.f, 0.f, 0.f, 0.f};
#pragma unroll
            for (int ks = 0; ks < 2; ++ks) acc = MFMA16(*(const LAS bf16x8*)(vtb + (16 * et + r) * 144 + (32 * ks + 8 * q) * 2), *(const LAS bf16x8*)(khb + (16 * dt + r) * 144 + (32 * ks + 8 * q) * 2), acc);
            *(f32x4*)(cs + (size_t)(16 * dt + r) * 64 + 16 * et + 4 * q) = acc; }
    }
}
__device__ __forceinline__ void gla_pass(Frame& F, int l, bool outputs) {
    const int nch = (outputs && l == DEPTH - 1) ? 32 : 36, c0 = 36 - nch, ntot = BATCH * 4 * nch;
    const int upb = (ntot + F.G - 1) / F.G, u_lo = min(F.blk * upb, ntot), u_hi = min(u_lo + upb, ntot);
    if (outputs) {
        const int lane = F.lane, dir = F.wave >> 2, eblk = F.wave & 3, dq = lane >> 4, e = eblk * 16 + (lane & 15);
        float S[8];
#pragma unroll
        for (int i = 0; i < 8; ++i) S[i] = 0.f;
        const int n = u_hi - u_lo;
        auto unit_of = [&](int k, int& bh, int& c) { const int u = dir == 0 ? u_lo + k : u_hi - 1 - k; bh = u / nch; c = gla_dirchunk(dir, c0 + (u - bh * nch)); };
        for (int k = 0; k < n; ) {
            int bh, c_start; unit_of(k, bh, c_start);
            int len = 1;
            for (; k + len < n; ++len) { int bh2, c2; unit_of(k + len, bh2, c2); if (bh2 != bh || c2 != c_start + len) break; }
            const size_t sidx = (size_t)(bh * 2 + dir) * 36; const int nsteps = c_start + len - 1;
#pragma unroll
            for (int i = 0; i < 8; ++i) S[i] = 0.f;
            if (c_start == 0) { float* ps = OGF_ + sidx * 2048 + (size_t)(8 * dq) * 64 + e;
#pragma unroll
                for (int i = 0; i < 8; ++i) __hip_atomic_store(ps + i * 64, 0.f, __ATOMIC_RELAXED, __HIP_MEMORY_SCOPE_AGENT); }
            for (int j0 = 0; j0 < nsteps; j0 += 9) {
                f32x4 a0[9], a1[9]; float cs[9][8];
#pragma unroll
                for (int t = 0; t < 9; ++t) { const int j = min(j0 + t, nsteps - 1); const float* ad = AD_ + (sidx + j) * 32 + 8 * dq; const float* csp = CS_ + (sidx + j) * 2048 + (size_t)(8 * dq) * 64 + e;
                    a0[t] = *(const f32x4*)ad; a1[t] = *(const f32x4*)(ad + 4);
#pragma unroll
                    for (int i = 0; i < 8; ++i) cs[t][i] = csp[i * 64]; }
#pragma unroll
                for (int t = 0; t < 9; ++t) { const int j = j0 + t; if (j < nsteps) {
#pragma unroll
                    for (int i = 0; i < 4; ++i) { S[i] = a0[t][i] * S[i] + cs[t][i]; S[4 + i] = a1[t][i] * S[4 + i] + cs[t][4 + i]; }
                    if (j + 1 >= c_start) { float* ps = OGF_ + (sidx + j + 1) * 2048 + (size_t)(8 * dq) * 64 + e;
#pragma unroll
                        for (int i = 0; i < 8; ++i) __hip_atomic_store(ps + i * 64, S[i], __ATOMIC_RELAXED, __HIP_MEMORY_SCOPE_AGENT); } } }
            }
            k += len;
        }
        VM_WAIT(); __syncthreads();
    }
    u32x4 st[3]; GlaPre PA, PB;
#pragma unroll
    for (int i = 0; i < 8; ++i) { PA.s0[i] = 0.f; PB.s0[i] = 0.f; }
    PA.gate = (u32x4){0u, 0u, 0u, 0u}; PB.gate = PA.gate;
    f32x4 gn0 = {0.f, 0.f, 0.f, 0.f}, gn1 = gn0;
    if (outputs) { gn0 = *(const f32x4*)(gla_o_norm_ + l * 64 + (F.tid & 7) * 8); gn1 = *(const f32x4*)(gla_o_norm_ + l * 64 + (F.tid & 7) * 8 + 4); }
    if (u_lo < u_hi) { const int bh = u_lo / nch; gla_stage_load(F, st, bh >> 2, bh & 3, c0 + (u_lo - bh * nch)); if (outputs) gla_pre_load(F, PA, bh >> 2, bh & 3, c0 + (u_lo - bh * nch)); }
    for (int u = u_lo; u < u_hi; u += 2) {
        { const int bh = u / nch, tc = c0 + (u - bh * nch);
          gla_stage_write(F, st);
          LDS_WAIT(); __syncthreads();
          if (u + 1 < u_hi) { const int bh2 = (u + 1) / nch, tc2 = c0 + (u + 1 - bh2 * nch); gla_stage_load(F, st, bh2 >> 2, bh2 & 3, tc2); if (outputs) gla_pre_load(F, PB, bh2 >> 2, bh2 & 3, tc2); }
          gla_compute(F, l, bh >> 2, bh & 3, tc, outputs, PA, gn0, gn1);
          LDS_WAIT(); __syncthreads(); }
        if (u + 1 >= u_hi) break;
        { const int bh = (u + 1) / nch, tc = c0 + (u + 1 - bh * nch);
          gla_stage_write(F, st);
          LDS_WAIT(); __syncthreads();
          if (u + 2 < u_hi) { const int bh2 = (u + 2) / nch, tc2 = c0 + (u + 2 - bh2 * nch); gla_stage_load(F, st, bh2 >> 2, bh2 & 3, tc2); if (outputs) gla_pre_load(F, PA, bh2 >> 2, bh2 & 3, tc2); }
          gla_compute(F, l, bh >> 2, bh & 3, tc, outputs, PB, gn0, gn1);
          LDS_WAIT(); __syncthreads(); }
    }
}
__device__ __forceinline__ void pE1(Frame& F, int l) {
    for (int rp = 0; rp < NREP(14); ++rp) gla_pass(F, l, false);
    relane(F);
    float gq = fabsf(na_q_norm_[l * 64 + F.lane]), gk = fabsf(na_k_norm_[l * 64 + F.lane]), rb = 0.f;
#pragma unroll
    for (int k = 0; k < 8; ++k) { const int i4 = F.lane + 64 * k;
        if (i4 < 465) { const f32x4 v = *(const f32x4*)(na_rpb_ + (size_t)l * 4 * 15 * 31 + 4 * i4); rb = fmaxf(rb, fmaxf(fmaxf(fabsf(v[0]), fabsf(v[1])), fmaxf(fabsf(v[2]), fabsf(v[3])))); } }
    gq = wave_max(gq); gk = wave_max(gk); rb = wave_max(rb);
    const float mfix = (QS_NA * 64.0f * gq * gk + rb * LOG2E) * 1.01f + 0.125f;
    if (mfix <= 60.0f) {
        for (int rp = 0; rp < NREP(15); ++rp)
        for (int u = F.blk; u < BATCH * 4 * 8; u += F.G) na_block_unit<true>(F, l, u, mfix);
        if (l == 0) for (int u = F.G - 1 - F.blk; u < BATCH * 4; u += F.G) ctx_block_unit<false>(F, u, mfix);
    } else {
        for (int u = F.blk; u < BATCH * 4 * 8; u += F.G) na_block_unit<false>(F, l, u, 0.f);
        if (l == 0) for (int u = F.G - 1 - F.blk; u < BATCH * 4; u += F.G) ctx_block_unit<false>(F, u, 0.f);
    }
}
__device__ __forceinline__ void pE2(Frame& F, int l) {
    const int nlat = BATCH * 4 * 8, nall = nlat + (l == 0 ? BATCH * 4 : 0);
    for (int rp = 0; rp < NREP(16); ++rp) { BgConv bg{0, 0u, 0u};
    for (int u = F.blk; u < nall; u += F.G) {
        int b, h, qp, klo, seq;
        if (u < nlat) { const int qb = u & 7, bh = u >> 3; b = bh >> 2; h = bh & 3; qp = 256 * qb; klo = 0; seq = TPB; }
        else { const int bh = u - nlat; b = bh >> 2; h = bh & 3; qp = SEQ; klo = SEQ; seq = CTXL; }
        const size_t qrow = (size_t)b * TPB + qp, krow = (size_t)b * TPB + klo;
        fa::attn_dense_body(MQ_ + qrow * 384 + h * 96, MK_ + krow * 384 + h * 96, MV_ + krow * 512 + h * 128, ATT_ + qrow * DM + 256 + h * 128, seq, (char*)(F.lds + RING_OFF), F.tid, F, l, bg);
    }
    relane(F); bg_drain(F, l, bg); }
    relane(F);
    for (int rp = 0; rp < NREP(17); ++rp) gla_pass(F, l, true);
}

__device__ __forceinline__ void split_bf16x8(const float (&x)[8], bf16x8& hi, bf16x8& lo) {
    u32x4 h, lw;
#pragma unroll
    for (int i = 0; i < 4; ++i) { const unsigned hp = pk2(x[2 * i], x[2 * i + 1]); const float h0 = __uint_as_float(hp << 16), h1 = __uint_as_float(hp & 0xffff0000u);
        h[i] = hp; lw[i] = pk2(x[2 * i] - h0, x[2 * i + 1] - h1); }
    hi = __builtin_bit_cast(bf16x8, h); lo = __builtin_bit_cast(bf16x8, lw);
}
__device__ __forceinline__ int moe_rpb(const Frame& F) { return (((MROWS + F.G - 1) / F.G) + 15) & ~15; }
constexpr int G1_TP = 1028;
__device__ __forceinline__ void pG1(Frame& F, int l) {
    LAS float* T = (LAS float*)(F.lds + RING_OFF);
    LAS float* P = T + 16 * G1_TP;
    volatile LAS unsigned* wh = F.MISC + MW_WH + F.wave * 32;
    if (F.lane < 32) wh[F.lane] = 0u;
    const int lane = F.lane, c = lane & 15, q = lane >> 4, rpb = moe_rpb(F), row_lo = F.blk * rpb;
    bf16x8 bwh[4][2], bwl[4][2];
#pragma unroll
    for (int s = 0; s < 4; ++s)
#pragma unroll
        for (int t = 0; t < 2; ++t) { float w8[8];
#pragma unroll
            for (int j = 0; j < 8; ++j) w8[j] = w_router_[((size_t)l * 1024 + 128 * F.wave + 32 * s + 8 * q + j) * NEXP + 16 * t + c];
            split_bf16x8(w8, bwh[s][t], bwl[s][t]); }
    const float brl = b_router_[l * NEXP + (lane & 31)];
    const float* gf = g_ffn_ + l * DM;
    int mcC = -1; f32x4 gsC[4], shC[4];
    u32x2 n0[4], n1[4];
    { const size_t rr = (size_t)min(row_lo + 2 * F.wave, MROWS - 2);
#pragma unroll
      for (int j = 0; j < 4; ++j) { n0[j] = *(const u32x2*)(XU_ + rr * DM + 256 * j + 4 * lane); n1[j] = *(const u32x2*)(XU_ + (rr + 1) * DM + 256 * j + 4 * lane); } }
    for (int r0 = row_lo; r0 < row_lo + rpb && r0 < MROWS; r0 += 16) {
        const int b = r0 / TPB, p0 = r0 - b * TPB;
        const int mc = p0 < SEQ ? b : 16, row = r0 + 2 * F.wave;
        f32x4 h0[4], h1[4];
#pragma unroll
        for (int j = 0; j < 4; ++j) { h0[j] = bf4f(n0[j]); h1[j] = bf4f(n1[j]); }
        { const size_t rr = (size_t)min(row + 16, MROWS - 2);
#pragma unroll
          for (int j = 0; j < 4; ++j) { n0[j] = *(const u32x2*)(XU_ + rr * DM + 256 * j + 4 * lane); n1[j] = *(const u32x2*)(XU_ + (rr + 1) * DM + 256 * j + 4 * lane); } }
        if (l == DEPTH - 1 && p0 >= SEQ) continue;
        const float rs0 = rsq(wave_sum(sumsq4(h0)) * (1.0f / DM) + EPS), rs1 = rsq(wave_sum(sumsq4(h1)) * (1.0f / DM) + EPS);
        if (mc != mcC) { const float* mod = MOD_ + ((size_t)l * 17 + mc) * 6144; mcC = mc;
#pragma unroll
            for (int j = 0; j < 4; ++j) { const int col = 256 * j + 4 * lane; gsC[j] = *(const f32x4*)(gf + col) * (*(const f32x4*)(mod + 4 * 1024 + col) + 1.0f); shC[j] = *(const f32x4*)(mod + 3 * 1024 + col); } }
#pragma unroll
        for (int j = 0; j < 4; ++j) { const int col = 256 * j + 4 * lane; const f32x4 gs = gsC[j], sh = shC[j];
            h0[j] = h0[j] * rs0 * gs + sh; h1[j] = h1[j] * rs1 * gs + sh;
            *(unsigned*)((unsigned char*)H_ + (size_t)row * DM + col) = pk4f8(h0[j][0] * SC_X, h0[j][1] * SC_X, h0[j][2] * SC_X, h0[j][3] * SC_X);
            *(unsigned*)((unsigned char*)H_ + (size_t)(row + 1) * DM + col) = pk4f8(h1[j][0] * SC_X, h1[j][1] * SC_X, h1[j][2] * SC_X, h1[j][3] * SC_X);
            *(LAS f32x4*)(T + (2 * F.wave) * G1_TP + col) = h0[j]; *(LAS f32x4*)(T + (2 * F.wave + 1) * G1_TP + col) = h1[j]; }
        LDS_WAIT(); __syncthreads();
        f32x4 a0 = (f32x4){0.f, 0.f, 0.f, 0.f}, a1 = a0;
        { const LAS float* tp = T + c * G1_TP + 128 * F.wave + 8 * q;
#pragma unroll
          for (int s = 0; s < 4; ++s) { float x8[8]; *(f32x4*)x8 = *(const LAS f32x4*)(tp + 32 * s); *(f32x4*)(x8 + 4) = *(const LAS f32x4*)(tp + 32 * s + 4);
              bf16x8 ah, al; split_bf16x8(x8, ah, al);
              a0 = MFMA16(ah, bwh[s][0], a0); a1 = MFMA16(ah, bwh[s][1], a1);
              a0 = MFMA16(ah, bwl[s][0], a0); a1 = MFMA16(ah, bwl[s][1], a1);
              a0 = MFMA16(al, bwh[s][0], a0); a1 = MFMA16(al, bwh[s][1], a1); } }
#pragma unroll
        for (int i = 0; i < 4; ++i) { P[(F.wave * 16 + 4 * q + i) * 32 + c] = a0[i]; P[(F.wave * 16 + 4 * q + i) * 32 + 16 + c] = a1[i]; }
        LDS_WAIT(); __syncthreads();
        { const int rr = 2 * F.wave + (lane >> 5), e = lane & 31; float lg = brl;
#pragma unroll
          for (int w = 0; w < 8; ++w) lg += P[(w * 16 + rr) * 32 + e];
          float tv[4]; int ti[4];
#pragma unroll
          for (int k = 0; k < 4; ++k) { float m = lg; m = fmaxf(m, dpp_f<0xB1>(m)); m = fmaxf(m, dpp_f<0x4E>(m)); m = fmaxf(m, dpp_f<0x141>(m)); m = fmaxf(m, dpp_f<0x140>(m)); m = fmaxf(m, swz_xor<16>(m));
              const unsigned long long bal = __builtin_amdgcn_ballot_w64(lg == m); const unsigned half = (lane >> 5) ? (unsigned)(bal >> 32) : (unsigned)bal;
              const int bi = __builtin_ctz(half);
              tv[k] = m; ti[k] = bi; lg = (e == bi) ? -INFINITY : lg; }
          const float e1 = __expf(tv[1] - tv[0]), e2 = __expf(tv[2] - tv[0]), e3 = __expf(tv[3] - tv[0]); const float isum = 1.0f / (1.0f + e1 + e2 + e3);
          if (e < 4) { const int ek = e == 0 ? ti[0] : e == 1 ? ti[1] : e == 2 ? ti[2] : ti[3]; const float gg = (e == 0 ? 1.0f : e == 1 ? e1 : e == 2 ? e2 : e3) * isum;
              unsigned rank = 0;
              if (lane < 32) rank = __hip_atomic_fetch_add((LAS unsigned*)(F.MISC + MW_WH + F.wave * 32 + ek), 1u, __ATOMIC_RELAXED, __HIP_MEMORY_SCOPE_WORKGROUP);
              __builtin_amdgcn_s_waitcnt(0xc07f);
              if (lane >= 32) rank = __hip_atomic_fetch_add((LAS unsigned*)(F.MISC + MW_WH + F.wave * 32 + ek), 1u, __ATOMIC_RELAXED, __HIP_MEMORY_SCOPE_WORKGROUP);
              TOPE_[(size_t)(r0 + rr) * 4 + e] = ek | (int)(rank << 8); TOPG_[(size_t)(r0 + rr) * 4 + e] = gg; } }
        LDS_WAIT(); __syncthreads();
    }
    LDS_WAIT(); __syncthreads();
    if (F.lane < 32) WHIST_[(size_t)F.gw * 32 + F.lane] = (int)wh[F.lane];
    if (F.tid < 32) { unsigned s = 0;
#pragma nounroll
        for (int w = 0; w < 8; ++w) s += F.MISC[MW_WH + w * 32 + F.tid];
        HISTB_[F.blk * 32 + F.tid] = (int)s; }
    __syncthreads();
}
__device__ __forceinline__ void moe_tables(Frame& F) {
    const int e = F.tid & 31, part = F.tid >> 5; unsigned s = 0, sb = 0;
#pragma unroll 8
    for (int bq = part; bq < F.G; bq += 16) { const unsigned hv = (unsigned)HISTB_[bq * 32 + e]; s += hv; sb += bq < F.blk ? hv : 0u; }
    F.MISC[MW_TMP + part * 32 + e] = s; F.MISC[MW_TMP + 512 + part * 32 + e] = sb;
    LDS_WAIT(); __syncthreads();
    if (F.tid < 32) { unsigned a = 0, bsum = 0;
#pragma nounroll
        for (int pq = 0; pq < 16; ++pq) { a += F.MISC[MW_TMP + pq * 32 + F.tid]; bsum += F.MISC[MW_TMP + 512 + pq * 32 + F.tid]; }
        F.MISC[MW_CNT + F.tid] = a; F.MISC[MW_BB + F.tid] = bsum; }
    LDS_WAIT(); __syncthreads();
    if (F.tid < 64) {
        const int ln = F.tid; const unsigned nt = ln < NEXP ? (F.MISC[MW_CNT + ln] + 255u) >> 8 : 0u; unsigned inc = nt;
#pragma unroll
        for (int d = 1; d < 32; d <<= 1) { const unsigned v = (unsigned)__shfl_up((int)inc, d, 64); if (ln >= d) inc += v; }
        if (ln < NEXP) F.MISC[MW_TS + ln] = inc - nt;
        if (ln == NEXP - 1) F.MISC[MW_TS + NEXP] = inc; }
    LDS_WAIT(); __syncthreads();
    { const int q = F.tid >> 4, r = F.tid & 15; const unsigned ts = F.MISC[MW_TS + q], nt = F.MISC[MW_TS + q + 1] - ts;
      volatile LAS unsigned char* te = (volatile LAS unsigned char*)(F.MISC + MW_TE);
      for (unsigned t = r; t < nt; t += 16) te[ts + t] = (unsigned char)q; }
    LDS_WAIT(); __syncthreads();
}
__device__ __forceinline__ void pG2(Frame& F, int l) {
    moe_tables(F);
    const int lane = F.lane, rpb = moe_rpb(F), row_lo = F.blk * rpb;
    if (F.tid < 256) { const int w = F.tid >> 5, e = F.tid & 31; unsigned wb = 0;
#pragma unroll
        for (int w2 = 0; w2 < 7; ++w2) { const unsigned v = (unsigned)WHIST_[(size_t)(F.blk * 8 + w2) * 32 + e]; wb += w2 < w ? v : 0u; }
        F.MISC[MW_TMP + w * 32 + e] = 256u * F.MISC[MW_TS + e] + F.MISC[MW_BB + e] + wb; }
    LDS_WAIT(); __syncthreads();
    for (int e = F.blk; e < NEXP; e += F.G) {
        const int c = (int)F.MISC[MW_CNT + e], base = 256 * (int)F.MISC[MW_TS + e], end = 256 * (int)(F.MISC[MW_TS + e + 1] - F.MISC[MW_TS + e]);
        for (int i = c + F.tid; i < end; i += 512) ROWMAP_[base + i] = 0; }
    for (int i = F.tid; i < rpb * 4; i += 512) {
        const int row = row_lo + (i >> 2), k = i & 3; if (row >= MROWS) break;
        const int p = row % TPB; if (l == DEPTH - 1 && p >= SEQ) continue;
        const int te = TOPE_[(size_t)row * 4 + k];
        const int ow = ((row - row_lo) & 15) >> 1, ek = te & 255, rank = te >> 8;
        const int dest = (int)F.MISC[MW_TMP + ow * 32 + (ek & 31)] + rank;
        DEST_[(size_t)row * 4 + k] = dest; ROWMAP_[dest] = row;
    }
}
struct JLoad { unsigned y[4][4]; u32x2 x[4]; };
__device__ __forceinline__ int pJ_row(int l, int a) { return l == DEPTH - 1 ? (a >> 11) * TPB + (a & (SEQ - 1)) : a; }
__device__ __forceinline__ void pJ_issue(Frame& F, JLoad& L, int row, int dk, int lane) {
#pragma unroll
    for (int k = 0; k < 4; ++k) { const int d = __builtin_amdgcn_readlane(dk, k);
#pragma unroll
        for (int j = 0; j < 4; ++j) L.y[k][j] = *(const unsigned*)((const unsigned char*)XS_   + (size_t)d * DM + 256 * j + 4 * lane); }
#pragma unroll
    for (int j = 0; j < 4; ++j) L.x[j] = *(const u32x2*)(XU_ + (size_t)row * DM + 256 * j + 4 * lane);
}
__device__ __forceinline__ void pJ(Frame& F, int l) {
    const int lane = F.lane, nrows = l == DEPTH - 1 ? BATCH * SEQ : MROWS, step = F.ngw;
    int a = F.gw; if (a >= nrows) return;
    auto route = [&](int aa, int& dk, float& gk) __attribute__((always_inline)) { if (aa < nrows) { const int r = pJ_row(l, aa); dk = DEST_[(size_t)r * 4 + (lane & 3)]; gk = TOPG_[(size_t)r * 4 + (lane & 3)]; } };
    auto one = [&](const JLoad& L, const int aa, const float gkA) __attribute__((always_inline)) {
        const int row = pJ_row(l, aa), b = row / TPB, p = row - b * TPB; const int mc = p < SEQ ? b : 16; const float* mod = MOD_ + ((size_t)l * 17 + mc) * 6144;
        f32x4 g2[4], s1[4], s0[4], gm[4];
#pragma unroll
        for (int j = 0; j < 4; ++j) { const int col = 256 * j + 4 * lane; g2[j] = *(const f32x4*)(mod + 5 * 1024 + col);
            if (l != DEPTH - 1) { const float* mod1 = MOD_ + ((size_t)(l + 1) * 17 + mc) * 6144; s1[j] = *(const f32x4*)(mod1 + 1024 + col); s0[j] = *(const f32x4*)(mod1 + col); gm[j] = *(const f32x4*)(g_mix_ + (l + 1) * DM + col); } }
        float g[4];
#pragma unroll
        for (int k = 0; k < 4; ++k) g[k] = rl_f(gkA, k) * (1.0f / SC_Y);
        f32x4 v[4];
#pragma unroll
        for (int j = 0; j < 4; ++j) { f32x4 acc = (f32x4){0.f, 0.f, 0.f, 0.f};
#pragma unroll
            for (int k = 0; k < 4; ++k) { const int w = (int)L.y[k][j]; acc += (f32x4){__builtin_amdgcn_cvt_f32_fp8(w, 0), __builtin_amdgcn_cvt_f32_fp8(w, 1), __builtin_amdgcn_cvt_f32_fp8(w, 2), __builtin_amdgcn_cvt_f32_fp8(w, 3)} * g[k]; }
            v[j] = bf4f(L.x[j]) + g2[j] * acc; }
        if (l == DEPTH - 1) {
#pragma unroll
            for (int j = 0; j < 4; ++j) *(f32x4*)(out_ + ((size_t)b * SEQ + p) * DM + 256 * j + 4 * lane) = v[j];
        } else {
#pragma unroll
            for (int j = 0; j < 4; ++j) { u32x2 o; o.x = pg8::cvt_pk_bf16(v[j][0], v[j][1]); o.y = pg8::cvt_pk_bf16(v[j][2], v[j][3]); *(u32x2*)(XU_ + (size_t)row * DM + 256 * j + 4 * lane) = o; v[j] = bf4f(o); }
            const float rstd = rsq(wave_sum(sumsq4(v)) * (1.0f / DM) + EPS);
            unsigned char* orow = (unsigned char*)H_ + (size_t)row * DM;
#pragma unroll
            for (int j = 0; j < 4; ++j) { const f32x4 h = (v[j] * rstd * gm[j] * (s1[j] + 1.0f) + s0[j]) * SC_X; *(unsigned*)(orow + 256 * j + 4 * lane) = pk4f8(h[0], h[1], h[2], h[3]); }
        }
    };
    int dk0 = 0, dk1 = 0, dk2 = 0, dk3 = 0; float gk0 = 0.f, gk1 = 0.f, gk2 = 0.f, gk3 = 0.f;
    route(a, dk0, gk0); route(a + step, dk1, gk1);
    JLoad A, B; pJ_issue(F, A, pJ_row(l, a), dk0, lane);
    for (; a < nrows; a += 2 * step) {
        route(a + 2 * step, dk2, gk2);
        if (a + step < nrows) pJ_issue(F, B, pJ_row(l, a + step), dk1, lane);
        one(A, a, gk0);
        if (a + step >= nrows) break;
        route(a + 3 * step, dk3, gk3);
        if (a + 2 * step < nrows) pJ_issue(F, A, pJ_row(l, a + 2 * step), dk2, lane);
        one(B, a + step, gk1);
        dk0 = dk2; gk0 = gk2; dk1 = dk3; gk1 = gk3;
    }
}

#ifndef PH_MASK
#define PH_MASK 0x3fff
#endif
#define IN(k) (lo <= (k) && (k) < hi)
#define EN(i) ((PH_MASK >> (i)) & 1)
#define RELOAD() do { int ln_; asm volatile("v_mbcnt_lo_u32_b32 %0, -1, 0\n\tv_mbcnt_hi_u32_b32 %0, -1, %0" : "=v"(ln_)); ln_ &= 63; F.lane = ln_; F.wave = wave0; F.tid = wave0 * 64 + ln_; \
    { int b_ = (int)blockIdx.x, g_ = (int)gridDim.x, w_ = wave0; asm volatile("" : "+s"(b_), "+s"(g_), "+s"(w_)); F.blk = b_; F.G = g_; F.wave = w_ & 7; F.tid = (w_ & 7) * 64 + ln_; F.gw = b_ * 8 + (w_ & 7); F.ngw = g_ * 8; } \
    int z_ = 0; asm volatile("" : "+s"(z_)); F.A = (const Args*)((const char*)&args + z_); } while (0)
#define SEAM(k) do { if ((k) + 1 < hi) { xcd_barrier(bar.bar, bar.x, bar.st, F.tid); if (NREP(18) > 1) xcd_barrier(bar.bar, bar.x, bar.st, F.tid); } } while (0)
template <int l>
__device__ __forceinline__ void layer_phases(Frame& F, const Args& args, const XcdBarrier& bar, const int lo, const int hi, const int wave0) {
        const int pb = 1 + 13 * l; const bool lastl = (l == DEPTH - 1);
        if (EN(1) && IN(pb + 0) && l == 0) { RELOAD(); pA_init(F); SEAM(pb + 0); }
        if (EN(2) && IN(pb + 1)) { RELOAD();
            pg8::Gemm g{H_  , (const bf16*)((const unsigned char*)WIN_ + (size_t)l * 2048 * 1024), nullptr}; DenseOrder S{MROWS / 256, ZC / 256, F.G, F.blk, 0, NREP(2)}; EpiZ E{Z_, Z8_};
            pg8::gemm_phase<EpiZ, DenseOrder, 512, 512, true, true, true>(F.lds + RING_OFF, g, S, E, F.tid); SEAM(pb + 1); }
        if (EN(3) && IN(pb + 2)) { RELOAD();
            pg8::Gemm g{Z_ + Z_CQ, WSM_ + (size_t)l * 1280 * 384, nullptr}; DenseOrder S{MROWS / 256, YC / 256, F.G, F.blk, 0, NREP(3)}; EpiFp8Plain E{(unsigned char*)Y_, YC};
            pg8::gemm_phase<EpiFp8Plain, DenseOrder, 384, ZC, true, true>(F.lds + RING_OFF, g, S, E, F.tid); SEAM(pb + 2); }
        if (EN(4) && IN(pb + 3)) { for (int rp = 0; rp < NREP(4); ++rp) { RELOAD(); pD_tokens(F, l); } SEAM(pb + 3); }
        if (EN(5) && IN(pb + 4)) { for (int rp = 0; rp < NREP(5); ++rp) { RELOAD(); pE1(F, l); } SEAM(pb + 4); }
        if (EN(6) && IN(pb + 5)) { for (int rp = 0; rp < NREP(6); ++rp) { RELOAD(); pE2(F, l); } SEAM(pb + 5); }
        if (EN(8) && IN(pb + 7)) { RELOAD();
            pg8::Gemm g{ATT_, WOUT_ + (size_t)l * 1024 * 1024, nullptr}; DenseOrder S{lastl ? BATCH * 8 : MROWS / 256, DM / 256, F.G, F.blk, lastl ? 1 : 0, 1};
            EpiResid E{XU_, MOD_ + (size_t)l * 17 * 6144 + 2 * 1024, l == 0 ? x_ : nullptr, l == 0 ? ctx_ : nullptr};
            pg8::gemm_phase<EpiResid, DenseOrder, DM, DM, true, true>(F.lds + RING_OFF, g, S, E, F.tid); SEAM(pb + 7); }
        if (EN(9) && IN(pb + 8)) { for (int rp = 0; rp < NREP(9); ++rp) { RELOAD(); pG1(F, l); } SEAM(pb + 8); }
        if (EN(10) && IN(pb + 9)) { for (int rp = 0; rp < NREP(10); ++rp) { RELOAD(); pG2(F, l); } SEAM(pb + 9); }
        if (EN(11) && IN(pb + 10)) { RELOAD();
            pg8::Gemm g{H_  , (const bf16*)((const unsigned char*)W1_ + (size_t)l * NEXP * 2048 * 1024), ROWMAP_};
            MoeOrder S{(const volatile LAS int*)(F.MISC + MW_TS), (const volatile LAS unsigned char*)(F.MISC + MW_TE), 8, F.G, F.blk, NREP(11)};
            EpiSwiglu E{(unsigned char*)ACT_, b_moe1_ + (size_t)l * NEXP * 2048};
            pg8::gemm_phase<EpiSwiglu, MoeOrder, 512, 512, true, true, true, true>(F.lds + RING_OFF, g, S, E, F.tid); SEAM(pb + 10); }
        if (EN(12) && IN(pb + 11)) { RELOAD();
            pg8::Gemm g{ACT_, (const bf16*)((const unsigned char*)W2_ + (size_t)l * NEXP * 1024 * 1024), nullptr};
            MoeOrder S{(const volatile LAS int*)(F.MISC + MW_TS), (const volatile LAS unsigned char*)(F.MISC + MW_TE), 4, F.G, F.blk, NREP(12)};
            EpiFp8Bias E{(unsigned char*)XS_, b_moe2_ + (size_t)l * NEXP * 1024};
            pg8::gemm_phase<EpiFp8Bias, MoeOrder, 512, 512, true, true, true>(F.lds + RING_OFF, g, S, E, F.tid); SEAM(pb + 11); }
        if (EN(13) && IN(pb + 12)) { for (int rp = 0; rp < (lastl ? NREP(13) : 1); ++rp) { RELOAD(); pJ(F, l); } if (!lastl) SEAM(pb + 12); }
}
__global__ void __launch_bounds__(512, 2) fwd(Args args) {
    extern __shared__ __attribute__((aligned(16))) unsigned char lds[];
    Frame F;
    F.lds = (LAS unsigned char*)lds; F.MISC = (volatile LAS unsigned*)(F.lds + MISC_OFF);
    F.tid = threadIdx.x; F.lane = F.tid & 63; F.wave = __builtin_amdgcn_readfirstlane(F.tid >> 6); const int wave0 = F.wave & 7;
    F.G = gridDim.x; F.blk = blockIdx.x; F.gw = F.blk * 8 + F.wave; F.ngw = F.G * 8;
    F.A = &args; unsigned char* ws = args.ws;
    for (int u = F.tid; u < (LDS_BYTES - MISC_OFF) / 4; u += 512) F.MISC[u] = 0u;
    __syncthreads();
    XcdBarrier bar = xcd_barrier_post((unsigned*)(ws + WS_CTL) + CW_BAR + args.li * XCD_BAR_WORDS, F.MISC + MW_BAR);
    const int lo = args.ph_lo, hi = args.ph_hi;
    if (EN(0) && IN(0)) { for (int rp = 0; rp < NREP(0); ++rp) { RELOAD(); p0_prologue(F); } SEAM(0); }
    layer_phases<0>(F, args, bar, lo, hi, wave0);
    layer_phases<1>(F, args, bar, lo, hi, wave0);
    static_assert(DEPTH == 2, "two layer instantiations");
#undef IN
#undef SEAM
}

extern "C" void kernel_launch(void* const* d_in, const int* in_sizes, int n_in, void* d_out, int out_size, void* d_ws, size_t ws_size, hipStream_t stream) {
    static int grid = 0;
    if (grid == 0) {
        if (n_in != 28 || out_size != BATCH * SEQ * DM || ws_size < WS_END) { fprintf(stderr, "kernel_launch: unexpected problem (n_in %d out %d ws %zu)\n", n_in, out_size, ws_size); grid = -1; return; }
        int dev = 0, cus = 0, per_cu = 0;
        if (hipGetDevice(&dev) != hipSuccess || hipDeviceGetAttribute(&cus, hipDeviceAttributeMultiprocessorCount, dev) != hipSuccess) { grid = -1; return; }
        if (hipFuncSetAttribute((const void*)fwd, hipFuncAttributeMaxDynamicSharedMemorySize, LDS_BYTES) != hipSuccess) { fprintf(stderr, "kernel_launch: hipFuncSetAttribute failed\n"); grid = -1; return; }
        if (hipOccupancyMaxActiveBlocksPerMultiprocessor(&per_cu, (const void*)fwd, 512, LDS_BYTES) != hipSuccess || per_cu < 1) { fprintf(stderr, "kernel_launch: occupancy query says %d\n", per_cu); }
        (void)hipGetLastError();
        grid = cus & ~7;
        if (grid < 8) { grid = -1; return; }
    }
    if (grid < 0) return;
    (void)hipMemsetAsync((char*)d_ws + WS_CTL, 0, CTL_ZERO_BYTES, stream);
    Args a{};
    for (int i = 0; i < 28; ++i) a.in[i] = (const float*)d_in[i];
    a.out = (float*)d_out; a.ws = (unsigned char*)d_ws; a.pad = 0;
#if MK_N_LAUNCHES == 1
    a.ph_lo = 0; a.ph_hi = NPH; a.li = 0;
    hipLaunchKernelGGL(fwd, dim3(grid), dim3(512), LDS_BYTES, stream, a);
#else
    for (int ph = 0, li = 0; ph < NPH; ++ph) {
        if (ph == 1 + 13 || ph == 1 + 6 || ph == 1 + 13 + 6) continue;
        a.ph_lo = ph; a.ph_hi = ph + 1; a.li = li++;
        hipLaunchKernelGGL(fwd, dim3(grid), dim3(512), LDS_BYTES, stream, a);
    }
#endif
}
```
